# Optimizing an MI355X kernel written in HIP

```python
import jax
import jax.numpy as jnp
from jax import lax
import numpy as np

D_MODEL = 1024
BATCH = 8
SEQ = 4096
DEPTH = 2

HEAD_DIM = 64
ROPE_DIM = HEAD_DIM // 4
ROPE_THETA = 500000.0
NORM_EPS = 1e-6
NEG_INF = -1e30
FORCE_SCORE = 1e6

NSA_HEADS = 8
NSA_KV_GROUPS = 2
NSA_HPG = NSA_HEADS // NSA_KV_GROUPS
CMP_LEN = 32
CMP_STRIDE = 16
SLC_BLOCK = 64
SLC_TOPK = 16
WINDOW = 512

FOX_HEADS = 8

Q_BLOCK = 128
SLC_SUB = 32

NSA_Q = NSA_HEADS * HEAD_DIM
NSA_KV = NSA_KV_GROUPS * HEAD_DIM
NSA_GATES = 3 * NSA_HEADS
FOX_W = FOX_HEADS * HEAD_DIM
A_SPLITS = (NSA_Q, NSA_KV, NSA_KV, NSA_KV, NSA_KV, NSA_KV, NSA_KV, NSA_GATES, FOX_W, FOX_W, FOX_W, FOX_HEADS)
IN_A_WIDTH = sum(A_SPLITS)
MIX_A_WIDTH = NSA_Q + FOX_W

GLA_HEADS = 4
GLA_DK = D_MODEL // 2
GLA_DV = D_MODEL
GLA_DK_HEAD = GLA_DK // GLA_HEADS
GLA_DV_HEAD = GLA_DV // GLA_HEADS
GLA_RANK = 16
GLA_TAU = 16.0
GLA_CHUNK = 64
C_SPLITS = (GLA_DK, GLA_DK, GLA_DV, GLA_DV, GLA_RANK)
IN_C_WIDTH = sum(C_SPLITS)

D_FF = ((8 * D_MODEL // 3 + 127) // 128) * 128
N_EXPERTS = 8
TOP_K = 2

N_EVEN = (DEPTH + 1) // 2
N_ODD = DEPTH // 2

kernel_name = 'hybrid_nsa_fox_gla_moe_block'


def _split(t, sizes):
    return jnp.split(t, np.cumsum(sizes)[:-1].tolist(), axis=-1)


def rmsnorm(x, g):
    xf = x.astype(jnp.float32)
    y = xf * lax.rsqrt(jnp.mean(xf * xf, axis=-1, keepdims=True) + NORM_EPS)
    return (y * g.astype(jnp.float32)).astype(x.dtype)


def rope_tables(pos):
    inv = ROPE_THETA ** (-jnp.arange(0, ROPE_DIM, 2, dtype=jnp.float32) / ROPE_DIM)
    ang = pos.astype(jnp.float32)[:, None] * inv[None, :]
    return jnp.cos(ang), jnp.sin(ang)


def partial_rope(x, cos, sin):
    r = x[..., :ROPE_DIM].astype(jnp.float32)
    half = ROPE_DIM // 2
    x1, x2 = r[..., :half], r[..., half:]
    c, s = cos[None, :, None, :], sin[None, :, None, :]
    rot = jnp.concatenate([x1 * c - x2 * s, x1 * s + x2 * c], axis=-1).astype(x.dtype)
    return jnp.concatenate([rot, x[..., ROPE_DIM:]], axis=-1)


def masked_softmax(s, mask):
    s = jnp.where(mask, s.astype(jnp.float32), NEG_INF)
    p = jax.nn.softmax(s, axis=-1)
    return jnp.where(mask, p, 0.0)


def swiglu(x, w_gate, w_up, w_down):
    return (jax.nn.silu(x @ w_gate) * (x @ w_up)) @ w_down


def nsa_fox_mixer(h, w_in, nsa_q_norm, nsa_k_norm, pe_k, pe_v, ck1, ck2, cv1, cv2,
                  gate_bias, fox_q_norm, fox_k_norm, fox_f_bias, w_out):
    B, S, _ = h.shape
    G, R, dh = NSA_KV_GROUPS, NSA_HPG, HEAD_DIM
    n_blk = S // Q_BLOCK
    scale = dh ** -0.5
    proj = h @ w_in
    qa, kc, vc, ksl, vsl, kwn, vwn, ga, qb, kb, vb, fb = _split(proj, A_SPLITS)

    def heads(t, n):
        return t.reshape(B, S, n, dh)

    pos = jnp.arange(S)
    cos, sin = rope_tables(pos)

    qa = partial_rope(rmsnorm(heads(qa, NSA_HEADS), nsa_q_norm), cos, sin)
    ksl = partial_rope(rmsnorm(heads(ksl, G), nsa_k_norm), cos, sin)
    kwn = partial_rope(rmsnorm(heads(kwn, G), nsa_k_norm), cos, sin)
    vsl, vwn = heads(vsl, G), heads(vwn, G)

    n_cmp = (S - CMP_LEN) // CMP_STRIDE + 1
    cmp_idx = jnp.arange(n_cmp)[:, None] * CMP_STRIDE + jnp.arange(CMP_LEN)[None, :]

    def compress(tok, pe, w1, w2):
        blk = heads(tok, G)[:, cmp_idx] + pe[None, None, :, None, :]
        blk = blk.transpose(0, 1, 3, 2, 4).reshape(B, n_cmp, G, CMP_LEN * dh)
        return jax.nn.gelu(blk @ w1) @ w2

    cmp_end = jnp.arange(n_cmp) * CMP_STRIDE + CMP_LEN - 1
    ccos, csin = rope_tables(cmp_end)
    k_cmp = partial_rope(rmsnorm(compress(kc, pe_k, ck1, ck2), nsa_k_norm), ccos, csin)
    v_cmp = compress(vc, pe_v, cv1, cv2)

    n_slc = S // SLC_BLOCK
    k_sel = min(SLC_TOPK, n_slc)
    c_start = jnp.arange(n_cmp) * CMP_STRIDE
    s_start = jnp.arange(n_slc) * SLC_BLOCK
    overlap = jnp.maximum(
        jnp.minimum(c_start[:, None] + CMP_LEN, s_start[None, :] + SLC_BLOCK)
        - jnp.maximum(c_start[:, None], s_start[None, :]), 0).astype(jnp.float32) / CMP_LEN

    ks_blocks = ksl.reshape(B, n_slc, SLC_BLOCK, G, dh).transpose(0, 3, 1, 2, 4)
    vs_blocks = vsl.reshape(B, n_slc, SLC_BLOCK, G, dh).transpose(0, 3, 1, 2, 4)
    gather_blocks = jax.vmap(jax.vmap(lambda kbk, ix: kbk[ix]))

    k_pad = jnp.pad(kwn, ((0, 0), (WINDOW, 0), (0, 0), (0, 0)))
    v_pad = jnp.pad(vwn, ((0, 0), (WINDOW, 0), (0, 0), (0, 0)))
    blk_ids = jnp.arange(n_slc)

    def nsa_block(i):
        q0 = i * Q_BLOCK
        qg = lax.dynamic_slice_in_dim(qa, q0, Q_BLOCK, axis=1).reshape(B, Q_BLOCK, G, R, dh)
        tq = q0 + jnp.arange(Q_BLOCK)
        s_c = jnp.einsum('bqgrd,bngd->bgrqn', qg, k_cmp) * scale
        p_c = masked_softmax(s_c, cmp_end[None, :] <= tq[:, None])
        o_c = jnp.einsum('bgrqn,bngd->bqgrd', p_c.astype(v_cmp.dtype), v_cmp)
        imp = jnp.einsum('bgrqn,ns->bgqs', p_c, overlap)
        cur = tq // SLC_BLOCK
        forced = (blk_ids[None, :] == 0) | (blk_ids[None, :] == cur[:, None]) | (blk_ids[None, :] == cur[:, None] - 1)
        future = blk_ids[None, :] > cur[:, None]
        imp = jnp.where(forced, FORCE_SCORE, jnp.where(future, -FORCE_SCORE, imp))
        _, sel = lax.top_k(imp, k_sel)

        def slc_sub(j):
            qs = lax.dynamic_slice_in_dim(qg, j * SLC_SUB, SLC_SUB, axis=1)
            idx = lax.dynamic_slice_in_dim(sel, j * SLC_SUB, SLC_SUB, axis=2)
            ts = lax.dynamic_slice_in_dim(tq, j * SLC_SUB, SLC_SUB)
            kg = gather_blocks(ks_blocks, idx).reshape(B, G, SLC_SUB, k_sel * SLC_BLOCK, dh)
            vg = gather_blocks(vs_blocks, idx).reshape(B, G, SLC_SUB, k_sel * SLC_BLOCK, dh)
            kpos = (idx[..., None] * SLC_BLOCK + jnp.arange(SLC_BLOCK)).reshape(B, G, SLC_SUB, k_sel * SLC_BLOCK)
            m = kpos <= ts[None, None, :, None]
            s_s = jnp.einsum('bqgrd,bgqkd->bgrqk', qs, kg) * scale
            p_s = masked_softmax(s_s, m[:, :, None])
            return jnp.einsum('bgrqk,bgqkd->bqgrd', p_s.astype(vg.dtype), vg)

        o_s = lax.map(slc_sub, jnp.arange(Q_BLOCK // SLC_SUB))
        o_s = o_s.transpose(1, 0, 2, 3, 4, 5).reshape(B, Q_BLOCK, G, R, dh)

        kw = lax.dynamic_slice_in_dim(k_pad, q0, WINDOW + Q_BLOCK, axis=1)
        vw = lax.dynamic_slice_in_dim(v_pad, q0, WINDOW + Q_BLOCK, axis=1)
        kpos_w = q0 - WINDOW + jnp.arange(WINDOW + Q_BLOCK)
        dist = tq[:, None] - kpos_w[None, :]
        m_w = (dist >= 0) & (dist < WINDOW) & (kpos_w[None, :] >= 0)
        s_w = jnp.einsum('bqgrd,bkgd->bgrqk', qg, kw) * scale
        p_w = masked_softmax(s_w, m_w)
        o_w = jnp.einsum('bgrqk,bkgd->bqgrd', p_w.astype(vw.dtype), vw)
        return o_c, o_s, o_w

    o_c, o_s, o_w = lax.map(nsa_block, jnp.arange(n_blk))

    def unblock_a(o):
        return o.transpose(1, 0, 2, 3, 4, 5).reshape(B, S, NSA_HEADS, dh)

    gates = jax.nn.sigmoid((ga + gate_bias).astype(jnp.float32)).reshape(B, S, NSA_HEADS, 3)
    o_a = (gates[..., 0:1] * unblock_a(o_c) + gates[..., 1:2] * unblock_a(o_s)
           + gates[..., 2:3] * unblock_a(o_w)).astype(h.dtype).reshape(B, S, NSA_Q)

    qb = rmsnorm(heads(qb, FOX_HEADS), fox_q_norm)
    kb = rmsnorm(heads(kb, FOX_HEADS), fox_k_norm)
    vb = heads(vb, FOX_HEADS)
    log_f = jax.nn.log_sigmoid(fb.astype(jnp.float32) + fox_f_bias.astype(jnp.float32))
    cum_t = jnp.cumsum(log_f, axis=1).transpose(0, 2, 1)

    def fox_block(i):
        q0 = i * Q_BLOCK
        q = lax.dynamic_slice_in_dim(qb, q0, Q_BLOCK, axis=1)
        cq = lax.dynamic_slice_in_dim(cum_t, q0, Q_BLOCK, axis=2)
        tq = q0 + jnp.arange(Q_BLOCK)
        s_f = (jnp.einsum('bqhd,bkhd->bhqk', q, kb).astype(jnp.float32) * scale
               + cq[..., None] - cum_t[:, :, None, :])
        p_f = masked_softmax(s_f, pos[None, :] <= tq[:, None])
        return jnp.einsum('bhqk,bkhd->bqhd', p_f.astype(vb.dtype), vb)

    o_b = lax.map(fox_block, jnp.arange(n_blk)).transpose(1, 0, 2, 3, 4).reshape(B, S, FOX_W)

    return jnp.concatenate([o_a, o_b], axis=-1) @ w_out


def gla_mixer(h, w_in, w_a2, b_a, o_norm, w_out):
    B, S, _ = h.shape
    H, dk, dv, C = GLA_HEADS, GLA_DK_HEAD, GLA_DV_HEAD, GLA_CHUNK
    n_ch = S // C
    q, k, v, r, a1 = _split(h @ w_in, C_SPLITS)
    q = q.reshape(B, S, H, dk) * (dk ** -0.5)
    k = k.reshape(B, S, H, dk)
    v = v.reshape(B, S, H, dv)
    log_a = (jax.nn.log_sigmoid((a1 @ w_a2 + b_a).astype(jnp.float32)) / GLA_TAU).reshape(B, S, H, dk)

    def chunks(t):
        return t.astype(jnp.float32).reshape(B, n_ch, C, H, t.shape[-1]).transpose(1, 0, 3, 2, 4)

    causal = jnp.tril(jnp.ones((C, C), dtype=bool))[None, None, :, :, None]

    def step(state, inp):
        qc, kc, vc, gc = inp
        b = jnp.cumsum(gc, axis=2)
        o_inter = jnp.einsum('bhcd,bhde->bhce', qc * jnp.exp(b), state)
        dlt = b[:, :, :, None, :] - b[:, :, None, :, :]
        decay = jnp.where(causal, jnp.exp(jnp.where(causal, dlt, 0.0)), 0.0)
        att = jnp.einsum('bhid,bhjd,bhijd->bhij', qc, kc, decay)
        o_intra = jnp.einsum('bhij,bhje->bhie', att, vc)
        b_last = b[:, :, -1:, :]
        state = (jnp.exp(b_last[:, :, 0, :, None]) * state
                 + jnp.einsum('bhcd,bhce->bhde', kc * jnp.exp(b_last - b), vc))
        return state, o_inter + o_intra

    state0 = jnp.zeros((B, H, dk, dv), jnp.float32)
    _, o = lax.scan(step, state0, (chunks(q), chunks(k), chunks(v), chunks(log_a)))
    o = o.transpose(1, 0, 3, 2, 4).reshape(B, S, H, dv)
    o = rmsnorm(o, o_norm).astype(h.dtype).reshape(B, S, GLA_DV) * jax.nn.silu(r)
    return o @ w_out


def moe_ffn(h, router, w_gate, w_up, w_down):
    B, S, D = h.shape
    xt = h.reshape(B * S, D)
    logits = (xt @ router).astype(jnp.float32)
    top_v, top_i = lax.top_k(logits, TOP_K)
    top_w = jax.nn.softmax(top_v, axis=-1)
    gates = jnp.sum(jax.nn.one_hot(top_i, N_EXPERTS, dtype=jnp.float32) * top_w[..., None], axis=1)
    out = jnp.zeros((B * S, D), jnp.float32)
    for e in range(N_EXPERTS):
        out = out + gates[:, e:e + 1] * swiglu(xt, w_gate[e], w_up[e], w_down[e]).astype(jnp.float32)
    return out.astype(h.dtype).reshape(B, S, D)


def setup_inputs(seed: int = 0) -> dict:
    key = jax.random.key(seed)
    keys = iter(jax.random.split(key, 40))

    def w(shape, fan_in):
        return jax.random.normal(next(keys), shape, jnp.float32) * (fan_in ** -0.5)

    def gain(shape):
        return 1.0 + 0.05 * jax.random.normal(next(keys), shape, jnp.float32)

    def small(shape, s=0.02):
        return s * jax.random.normal(next(keys), shape, jnp.float32)

    NE, NO = N_EVEN, N_ODD
    return {
        'x': jax.random.normal(next(keys), (BATCH, SEQ, D_MODEL), jnp.float32),
        'a_norm': gain((NE, D_MODEL)),
        'a_w_in': w((NE, D_MODEL, IN_A_WIDTH), D_MODEL),
        'a_q_norm': gain((NE, HEAD_DIM)),
        'a_k_norm': gain((NE, HEAD_DIM)),
        'a_pe_k': small((NE, CMP_LEN, HEAD_DIM), 0.1),
        'a_pe_v': small((NE, CMP_LEN, HEAD_DIM), 0.1),
        'a_cmp_k_w1': w((NE, CMP_LEN * HEAD_DIM, HEAD_DIM), CMP_LEN * HEAD_DIM),
        'a_cmp_k_w2': w((NE, HEAD_DIM, HEAD_DIM), HEAD_DIM),
        'a_cmp_v_w1': w((NE, CMP_LEN * HEAD_DIM, HEAD_DIM), CMP_LEN * HEAD_DIM),
        'a_cmp_v_w2': w((NE, HEAD_DIM, HEAD_DIM), HEAD_DIM),
        'a_gate_bias': small((NE, NSA_GATES), 0.1),
        'a_fox_q_norm': gain((NE, HEAD_DIM)),
        'a_fox_k_norm': gain((NE, HEAD_DIM)),
        'a_fox_f_bias': 2.0 + small((NE, FOX_HEADS), 0.5),
        'a_w_out': w((NE, MIX_A_WIDTH, D_MODEL), MIX_A_WIDTH),
        'f_norm': gain((NE, D_MODEL)),
        'f_w_gate': w((NE, D_MODEL, D_FF), D_MODEL),
        'f_w_up': w((NE, D_MODEL, D_FF), D_MODEL),
        'f_w_down': w((NE, D_FF, D_MODEL), D_FF),
        'c_norm': gain((NO, D_MODEL)),
        'c_w_in': w((NO, D_MODEL, IN_C_WIDTH), D_MODEL),
        'c_w_a2': w((NO, GLA_RANK, GLA_DK), GLA_RANK),
        'c_b_a': small((NO, GLA_DK), 0.1),
        'c_o_norm': gain((NO, GLA_DV_HEAD)),
        'c_w_out': w((NO, GLA_DV, D_MODEL), GLA_DV),
        'm_norm': gain((NO, D_MODEL)),
        'm_router': w((NO, D_MODEL, N_EXPERTS), D_MODEL),
        'm_w_gate': w((NO, N_EXPERTS, D_MODEL, D_FF), D_MODEL),
        'm_w_up': w((NO, N_EXPERTS, D_MODEL, D_FF), D_MODEL),
        'm_w_down': w((NO, N_EXPERTS, D_FF, D_MODEL), D_FF),
    }


def reference(x, a_norm, a_w_in, a_q_norm, a_k_norm, a_pe_k, a_pe_v, a_cmp_k_w1, a_cmp_k_w2,
              a_cmp_v_w1, a_cmp_v_w2, a_gate_bias, a_fox_q_norm, a_fox_k_norm, a_fox_f_bias, a_w_out,
              f_norm, f_w_gate, f_w_up, f_w_down,
              c_norm, c_w_in, c_w_a2, c_b_a, c_o_norm, c_w_out,
              m_norm, m_router, m_w_gate, m_w_up, m_w_down):
    for layer in range(DEPTH):
        i = layer // 2
        if layer % 2 == 0:
            x = x + nsa_fox_mixer(rmsnorm(x, a_norm[i]), a_w_in[i], a_q_norm[i], a_k_norm[i],
                                  a_pe_k[i], a_pe_v[i], a_cmp_k_w1[i], a_cmp_k_w2[i],
                                  a_cmp_v_w1[i], a_cmp_v_w2[i], a_gate_bias[i],
                                  a_fox_q_norm[i], a_fox_k_norm[i], a_fox_f_bias[i], a_w_out[i])
            x = x + swiglu(rmsnorm(x, f_norm[i]), f_w_gate[i], f_w_up[i], f_w_down[i])
        else:
            x = x + gla_mixer(rmsnorm(x, c_norm[i]), c_w_in[i], c_w_a2[i], c_b_a[i], c_o_norm[i], c_w_out[i])
            x = x + moe_ffn(rmsnorm(x, m_norm[i]), m_router[i], m_w_gate[i], m_w_up[i], m_w_down[i])
    return x
```

```cpp
#include <hip/hip_runtime.h>
#include <hip/hip_cooperative_groups.h>
#include <cstdio>
#include <cstdint>
namespace cg = cooperative_groups;

#define DI __device__ __forceinline__
#define LAS __attribute__((address_space(3)))
#define GAS __attribute__((address_space(1)))
typedef unsigned short bf16_t;
typedef short bf16x8 __attribute__((ext_vector_type(8)));
typedef short s16x4 __attribute__((ext_vector_type(4)));
typedef float f32x2 __attribute__((ext_vector_type(2)));
typedef float f32x4 __attribute__((ext_vector_type(4)));
typedef float f32x16 __attribute__((ext_vector_type(16)));
typedef unsigned u32x2 __attribute__((ext_vector_type(2)));
typedef unsigned u32x4 __attribute__((ext_vector_type(4)));

constexpr int BATCH = 8, SEQ = 4096, DM = 1024, T = BATCH * SEQ;
constexpr int HD = 64;
constexpr int NSA_H = 8, NSA_G = 2, FOX_H = 8;
constexpr int NCMP = 255, NCMP_PAD = 256;
constexpr int IN_A = 2848, LDA = 2816  , NA_PAD = 3072;
constexpr int DFF = 2816;
constexpr int IN_C = 3088, LDC = 3072  , NC_PAD = 3328;
constexpr int NEXP = 8;
constexpr int MOE_TILES_MAX = 264, MOE_PASS_TILES = 128, MOE_PASS1_MAX = 136;
constexpr float EPS = 1e-6f;
constexpr float LOG2E = 1.4426950408889634f;
constexpr float QSCALE = 0.125f * LOG2E;
constexpr int PA_QA = 0, PA_KSL = 512, PA_KWN = 640, PA_VSL = 768, PA_VWN = 896, PA_KC = 1024, PA_VC = 1152, PA_QB = 1280, PA_KB = 1792, PA_VB = 2304;
constexpr int PC_Q = 0, PC_K = 512, PC_V = 1024, PC_R = 2048;

constexpr size_t MiB = 1u << 20;
constexpr size_t CT_CTR = 0;
constexpr size_t CT_BAR = 65536;
constexpr size_t CT_SS1 = 501 * MiB, CT_SS2 = 503 * MiB, CT_SS3 = 505 * MiB;
constexpr size_t CT_ZERO_BYTES = 1 * MiB;
static_assert(CT_BAR + 16384 <= CT_ZERO_BYTES, "zero region");
constexpr size_t CT_RSTD0 = 1 * MiB;
constexpr size_t CT_ROPE = CT_RSTD0 + (size_t)T * 4;
constexpr size_t CT_LOGF = 2 * MiB;
constexpr size_t CT_CUM = 3 * MiB;
constexpr size_t CT_GATE = 4 * MiB;
constexpr size_t CT_A1 = 7 * MiB;
constexpr size_t CT_KCMP = 9 * MiB, CT_VCMP = CT_KCMP + 512 * 1024;
constexpr size_t CT_CW = 10 * MiB;
constexpr size_t CT_MOE = 11 * MiB;
constexpr size_t WS_WA = 16 * MiB;
constexpr size_t WS_WO = WS_WA + 6 * MiB;
constexpr size_t WS_WFGU = WS_WO + 2 * MiB;
constexpr size_t WS_WFD = WS_WFGU + 11 * MiB;
constexpr size_t WS_WC = WS_WFD + 5632 * 1024;
constexpr size_t WS_WCO = WS_WC + 6656 * 1024;
constexpr size_t WS_WMGU = 49 * MiB;
constexpr size_t WS_WMD = WS_WMGU + 88 * MiB;
static_assert(WS_WCO + 2 * MiB <= WS_WMGU, "weights map");
constexpr size_t WS_XB = 181 * MiB;
constexpr size_t WS_O = 245 * MiB;
constexpr size_t WS_ATT = WS_WA;
constexpr size_t WS_BIG = 309 * MiB;
constexpr size_t WS_XY = 181 * MiB;
constexpr size_t WS_HM = 313 * MiB;
constexpr size_t WS_END = 512 * MiB;
static_assert(WS_WMD + 44 * MiB <= WS_XB && WS_BIG + (size_t)T * LDC * 2 <= WS_END && WS_XY + (size_t)MOE_TILES_MAX * 256 * 1024 * 2 <= WS_HM && WS_HM + (size_t)MOE_PASS1_MAX * 256 * DFF * 2 <= WS_END, "d_ws map");
constexpr size_t MO_TOKE = CT_MOE;
constexpr size_t MO_TOKW = MO_TOKE + (size_t)T * 4;
constexpr size_t MO_TOKR = MO_TOKW + (size_t)T * 8;
constexpr size_t MO_POS = MO_TOKR + (size_t)T * 4;
constexpr size_t MO_HIST = MO_POS + (size_t)T * 8;
constexpr size_t MO_RSCALE = MO_HIST + 8192;
constexpr size_t MO_RGATE = MO_RSCALE + (size_t)MOE_TILES_MAX * 256 * 4;
constexpr size_t MO_RKEEP = MO_RGATE + (size_t)MOE_TILES_MAX * 256 * 4;
constexpr size_t MO_TILEE = MO_RKEEP + (size_t)MOE_TILES_MAX * 256 * 4;
static_assert(MO_TILEE + 2048 <= WS_WA, "moe tables");

constexpr int LDS_BYTES = 163840;
constexpr int LDS_MISC = 163584;

DI unsigned cvtpk(float lo, float hi) { typedef __bf16 b2 __attribute__((ext_vector_type(2))); f32x2 v = {lo, hi}; b2 b = __builtin_convertvector(v, b2); return __builtin_bit_cast(unsigned, b); }
DI float bf2f(unsigned short h) { return __uint_as_float((unsigned)h << 16); }
DI float bflo(unsigned w) { return __uint_as_float(w << 16); }
DI float bfhi(unsigned w) { return __uint_as_float(w & 0xffff0000u); }
DI float wave_sum(float v) {
#pragma unroll
    for (int o = 1; o < 64; o <<= 1) v += __shfl_xor(v, o);
    return v;
}
DI float sigmoidf_(float z) { return 1.0f / (1.0f + __expf(-z)); }
DI float log_sigmoidf_(float z) { return fminf(z, 0.f) - __logf(1.0f + __expf(-fabsf(z))); }
DI float siluf_(float z) { return z * __builtin_amdgcn_rcpf(1.0f + __builtin_amdgcn_exp2f(-LOG2E * z)); }
DI float gelu_tanh(float x) { const float u = 0.7978845608028654f * (x + 0.044715f * x * x * x); const float e = __expf(2.f * u); const float t = 1.f - 2.f / (e + 1.f); return 0.5f * x * (1.f + t); }

struct Args {
    const float* in[31];
    float* out;
    unsigned char* ws;
    int ph_lo, ph_hi;
};
namespace pg8 {
#define PG8_LAS __attribute__((address_space(3)))
typedef unsigned short bf16_t;
typedef short bf16x8 __attribute__((ext_vector_type(8)));
typedef float f32x4 __attribute__((ext_vector_type(4)));
typedef unsigned u32x4 __attribute__((ext_vector_type(4)));
constexpr int BM = 256, BK = 64, HALF = 128, HTB = HALF * BK * 2  , STAGE_BYTES = 8 * HTB, NXCD = 8, WGM = 8;

__host__ __device__ __forceinline__ int lds_byte(int r, int c) { const int st = (r >> 4) * 2 + (c >> 5), rr = r & 15, cc = c & 31, ob = rr * 64 + cc * 2; return st * 1024 + (ob ^ (((ob >> 9) & 1) << 5)); }
__host__ __device__ __forceinline__ void stage_rc(int b, int& R, int& C) { const int st = b / 1024, sb = b % 1024, swz = sb ^ (((sb >> 9) & 1) << 5); R = (st >> 1) * 16 + swz / 64; C = (st & 1) * 32 + (swz % 64) / 2; }
__host__ __device__ __forceinline__ int perm32(int rho) { const int n = rho >> 4, i = rho & 15; return 8 * (i >> 2) + 4 * n + (i & 3); }

struct Unit { int pm, pn; };
struct Gemm { const bf16_t* A; const bf16_t* Bt; int M, N, K; };

struct StaticOrder {
    int nM, nN, nwg, G, c;
    __host__ __device__ void init(int M, int N, int G_, int c_) { nM = M / BM; nN = N / BM; nwg = nM * nN; G = G_; c = c_; }
    __host__ __device__ bool next(int i, Unit& u) const {
        const long L = (long)i * G + c; if (L >= nwg) return false;
        int wgid = (int)L; { const int q = nwg / NXCD, r = nwg % NXCD, xcd = wgid % NXCD, off = wgid / NXCD; wgid = (xcd < r ? xcd * (q + 1) : r * (q + 1) + (xcd - r) * q) + off; }
        const int nig = WGM * nN, gid = wgid / nig, fm = gid * WGM, gsz = (nM - fm) < WGM ? (nM - fm) : WGM;
        u.pm = fm + ((wgid % nig) % gsz); u.pn = (wgid % nig) / gsz; return true;
    }
    __device__ __forceinline__ void a_ready(const Unit&) const {}
    __device__ __forceinline__ void done(const Unit&) const {}
};


#define EPI_ROWS(...) _Pragma("unroll") for (int ai = 0; ai < 2; ++ai) _Pragma("unroll") for (int m = 0; m < 4; ++m) { const int rowl = u.pm * BM + ai * HALF + wr * 64 + m * 16 + fr; __VA_ARGS__ }

struct EpiInA {
    static constexpr bool PERM = true, AFTER_DRAIN = false;
    bf16_t* projA; const float* rstd0; const float* cosT; const float* sinT;
    const float *qn, *kn, *fqn, *fkn, *gbias, *fbias; float* gate; float* logf;
    __device__ __forceinline__ void operator()(const f32x4 (&acc)[2][2][4][2], const Unit& u, int wr, int wc, int fr, int fq) const {
        const int s = u.pn * 4 + wc;
        if (s > 44) return;
        int kind = 0; const float* gain = qn; float scale = 1.f;
        if (s < 8) { kind = 2; gain = qn; scale = QSCALE; }
        else if (s < 12) { kind = 2; gain = kn; }
        else if (s < 20) { kind = 0; }
        else if (s < 28) { kind = 1; gain = fqn; scale = QSCALE; }
        else if (s < 36) { kind = 1; gain = fkn; }
        else if (s < 44) { kind = 0; }
        else kind = 3;
        float rsv[8];
#pragma unroll
        for (int q = 0; q < 8; ++q) rsv[q] = rstd0[u.pm * BM + (q >> 2) * HALF + wr * 64 + (q & 3) * 16 + fr];
        if (kind == 3) {
            EPI_ROWS(
                const float rs = rsv[ai * 4 + m];
                float v[8];
                _Pragma("unroll") for (int n = 0; n < 2; ++n) _Pragma("unroll") for (int e = 0; e < 4; ++e) v[n * 4 + e] = acc[ai][0][m][n][e] * rs;
                if (fq < 3) { float o[8]; _Pragma("unroll") for (int j = 0; j < 8; ++j) o[j] = sigmoidf_(v[j] + gbias[8 * fq + j]);
                    *(f32x4*)(gate + (size_t)rowl * 24 + 8 * fq) = (f32x4){o[0], o[1], o[2], o[3]}; *(f32x4*)(gate + (size_t)rowl * 24 + 8 * fq + 4) = (f32x4){o[4], o[5], o[6], o[7]}; }
                else { float o[8]; _Pragma("unroll") for (int j = 0; j < 8; ++j) o[j] = log_sigmoidf_(v[j] + fbias[j]);
                    _Pragma("unroll") for (int j = 0; j < 8; ++j) logf[((size_t)(rowl >> 12) * 8 + j) * SEQ + (rowl & (SEQ - 1))] = o[j]; }
            )
            return;
        }
        const bool do_norm = kind >= 1, do_rope = kind == 2;
        float g[16];
#pragma unroll
        for (int i = 0; i < 16; ++i) g[i] = (do_norm ? gain[32 * (i >> 3) + 8 * fq + (i & 7)] : 1.f) * scale;
        const float ir[8] = {0.15915494309189535f, 0.03086376340470123f, 0.005985185712713705f, 0.001160663641240061f, 0.00022507907903927653f, 4.364795279280289e-05f, 8.464330808241401e-06f, 1.6414262627950345e-06f};
        const bool rope_lane = do_rope && fq < 2;
        EPI_ROWS(
            const float rs = rsv[ai * 4 + m];
            float v[16];
            _Pragma("unroll") for (int bj = 0; bj < 2; ++bj) _Pragma("unroll") for (int n = 0; n < 2; ++n) _Pragma("unroll") for (int e = 0; e < 4; ++e) v[bj * 8 + n * 4 + e] = acc[ai][bj][m][n][e] * rs;
            float ss = 0.f;
            _Pragma("unroll") for (int i = 0; i < 16; ++i) ss += v[i] * v[i];
            ss += __shfl_xor(ss, 16); ss += __shfl_xor(ss, 32);
            const float r = do_norm ? rsqrtf(ss * (1.0f / 64.0f) + EPS) : 1.f;
            _Pragma("unroll") for (int i = 0; i < 16; ++i) v[i] = v[i] * (r * g[i]);
            float oth[8];
            _Pragma("unroll") for (int j = 0; j < 8; ++j) oth[j] = __shfl_xor(v[j], 16);
            const float pos = rope_lane ? (float)(rowl & (SEQ - 1)) : 0.f;
            const float sgn = (fq == 0) ? -1.f : 1.f;
            _Pragma("unroll") for (int j = 0; j < 8; ++j) { const float rev = pos * ir[j]; const float fr_ = rev - floorf(rev); const float cc = __builtin_amdgcn_cosf(fr_), sn = __builtin_amdgcn_sinf(fr_) * sgn;
                v[j] = v[j] * cc + oth[j] * sn; }
            bf16_t* dst = projA + (size_t)rowl * LDA + s * 64 + 8 * fq;
            _Pragma("unroll") for (int bj = 0; bj < 2; ++bj) { u32x4 w; w.x = ::cvtpk(v[bj * 8 + 0], v[bj * 8 + 1]); w.y = ::cvtpk(v[bj * 8 + 2], v[bj * 8 + 3]);
                w.z = ::cvtpk(v[bj * 8 + 4], v[bj * 8 + 5]); w.w = ::cvtpk(v[bj * 8 + 6], v[bj * 8 + 7]); *(u32x4*)(dst + 32 * bj) = w; }
        )
    }
};

__device__ __forceinline__ float row_rstd(const float* ssp, int row) { const f32x4* q = (const f32x4*)(ssp + (size_t)row * 16); const f32x4 a = q[0], b = q[1], c = q[2], d = q[3];
    const float s = (((a[0] + a[1]) + (a[2] + a[3])) + ((b[0] + b[1]) + (b[2] + b[3]))) + (((c[0] + c[1]) + (c[2] + c[3])) + ((d[0] + d[1]) + (d[2] + d[3]))); return rsqrtf(s * (1.0f / 1024.0f) + EPS); }
template <bool RES_F32> struct EpiResid {
    static constexpr bool PERM = true, AFTER_DRAIN = false;
    const void* res; bf16_t* outb; float* ss;
    __device__ __forceinline__ void operator()(const f32x4 (&acc)[2][2][4][2], const Unit& u, int wr, int wc, int fr, int fq) const {
        EPI_ROWS(
            const size_t off = (size_t)rowl * DM + u.pn * BM + wc * 32 + 8 * fq; float part = 0.f;
            _Pragma("unroll") for (int bj = 0; bj < 2; ++bj) {
                f32x4 r0, r1;
                if (RES_F32) { r0 = *(const f32x4*)((const float*)res + off + bj * HALF); r1 = *(const f32x4*)((const float*)res + off + bj * HALF + 4); }
                else { const u32x4 rw = *(const u32x4*)((const bf16_t*)res + off + bj * HALF); r0 = (f32x4){bflo(rw.x), bfhi(rw.x), bflo(rw.y), bfhi(rw.y)}; r1 = (f32x4){bflo(rw.z), bfhi(rw.z), bflo(rw.w), bfhi(rw.w)}; }
                const f32x4 x0 = r0 + acc[ai][bj][m][0], x1 = r1 + acc[ai][bj][m][1];
                u32x4 w; w.x = ::cvtpk(x0[0], x0[1]); w.y = ::cvtpk(x0[2], x0[3]); w.z = ::cvtpk(x1[0], x1[1]); w.w = ::cvtpk(x1[2], x1[3]); *(u32x4*)(outb + off + bj * HALF) = w;
                part += (x0[0] * x0[0] + x0[1] * x0[1]) + (x0[2] * x0[2] + x0[3] * x0[3]) + (x1[0] * x1[0] + x1[1] * x1[1]) + (x1[2] * x1[2] + x1[3] * x1[3]);
            }
            part += __shfl_xor(part, 16); part += __shfl_xor(part, 32);
            if (fq == 0 && ss) ss[(size_t)rowl * 16 + u.pn * 4 + wc] = part;
        )
    }
};

template <bool MOE> struct EpiSwiglu {
    static constexpr bool PERM = true, AFTER_DRAIN = false;
    bf16_t* h; const float* rsrc; int row_off;
    __device__ __forceinline__ void operator()(const f32x4 (&acc)[2][2][4][2], const Unit& u, int wr, int wc, int fr, int fq) const {
        const int pnl = MOE ? (u.pn % 22) : u.pn;
        EPI_ROWS(
            const float rs = MOE ? rsrc[row_off + rowl] : row_rstd(rsrc, rowl);
            float o[8];
            _Pragma("unroll") for (int n = 0; n < 2; ++n) _Pragma("unroll") for (int e = 0; e < 4; ++e) { const float gg = acc[ai][0][m][n][e] * rs, uu = acc[ai][1][m][n][e] * rs; o[n * 4 + e] = siluf_(gg) * uu; }
            u32x4 w; w.x = ::cvtpk(o[0], o[1]); w.y = ::cvtpk(o[2], o[3]); w.z = ::cvtpk(o[4], o[5]); w.w = ::cvtpk(o[6], o[7]);
            *(u32x4*)(h + (size_t)rowl * DFF + pnl * 128 + wc * 32 + 8 * fq) = w;
        )
    }
};

struct EpiGlaIn {
    static constexpr bool PERM = true, AFTER_DRAIN = false;
    bf16_t* projC; const float* ss2;
    __device__ __forceinline__ void operator()(const f32x4 (&acc)[2][2][4][2], const Unit& u, int wr, int wc, int fr, int fq) const {
        EPI_ROWS(
            float rs = row_rstd(ss2, rowl); if (u.pn < 2) rs *= 0.08838834764831845f;
            _Pragma("unroll") for (int bj = 0; bj < 2; ++bj) { const f32x4 x0 = acc[ai][bj][m][0] * rs, x1 = acc[ai][bj][m][1] * rs;
                u32x4 w; w.x = ::cvtpk(x0[0], x0[1]); w.y = ::cvtpk(x0[2], x0[3]); w.z = ::cvtpk(x1[0], x1[1]); w.w = ::cvtpk(x1[2], x1[3]);
                *(u32x4*)(projC + (size_t)rowl * LDC + u.pn * BM + bj * HALF + wc * 32 + 8 * fq) = w; }
        )
    }
};

struct EpiMoeDown {
    static constexpr bool PERM = true, AFTER_DRAIN = false;
    bf16_t* xy; const float* rgate; const float* rkeep; int row_off;
    __device__ __forceinline__ void operator()(const f32x4 (&acc)[2][2][4][2], const Unit& u, int wr, int wc, int fr, int fq) const {
        const int pnl = u.pn & 3;
        EPI_ROWS(
            const int rowg = row_off + rowl; const float w8 = rgate[rowg], kp = rkeep[rowg];
            _Pragma("unroll") for (int bj = 0; bj < 2; ++bj) {
                bf16_t* dst = xy + (size_t)rowg * DM + pnl * BM + bj * HALF + wc * 32 + 8 * fq;
                const u32x4 rw = *(const u32x4*)dst;
                const f32x4 r0 = (f32x4){bflo(rw.x), bfhi(rw.x), bflo(rw.y), bfhi(rw.y)}, r1 = (f32x4){bflo(rw.z), bfhi(rw.z), bflo(rw.w), bfhi(rw.w)};
                const f32x4 x0 = r0 * kp + acc[ai][bj][m][0] * w8, x1 = r1 * kp + acc[ai][bj][m][1] * w8;
                u32x4 w; w.x = ::cvtpk(x0[0], x0[1]); w.y = ::cvtpk(x0[2], x0[3]); w.z = ::cvtpk(x1[0], x1[1]); w.w = ::cvtpk(x1[2], x1[3]);
                *(u32x4*)dst = w; }
        )
    }
};

struct GroupedOrder {
    StaticOrder so; const int* tile_e; int tile0, nN;
    __device__ __forceinline__ bool next(int i, Unit& u) const { if (!so.next(i, u)) return false; u.pn = __builtin_amdgcn_readfirstlane(tile_e[tile0 + u.pm]) * nN + u.pn; return true; }
    __device__ __forceinline__ void a_ready(const Unit&) const {}
    __device__ __forceinline__ void done(const Unit&) const {}
};
template <class Epi, class Sched, bool ALIGN_EPI = false, bool SP2 = false>
__device__ __forceinline__ void gemm_phase(PG8_LAS unsigned char* lds, const Gemm g, const Sched& S, const Epi& E) {
    int tid_l_ = threadIdx.x; asm volatile("" : "+v"(tid_l_)); const int tid = tid_l_, wid = __builtin_amdgcn_readfirstlane(tid >> 6), lane = tid & 63, wr = wid >> 2, wc = wid & 3, fr = lane & 15, fq = lane >> 4;
    const int K = g.K, nt = K / BK;
    unsigned voffA[2], voffB[2];
#pragma unroll
    for (int i = 0; i < 2; ++i) { int R, C; stage_rc(tid * 16 + i * 8192, R, C); const int Rb = Epi::PERM ? ((R & ~31) + perm32(R & 31)) : R;
        voffA[i] = (unsigned)(R * K + C) * 2u; voffB[i] = (unsigned)(Rb * K + C) * 2u; }
    const size_t kstep = (size_t)(BK * 2);
    const size_t hstep = (size_t)HALF * K * 2;
    const size_t tstep = 2 * hstep;
    const unsigned ldsw = (unsigned)wid * 1024u;
    const int aoff = lds_byte(wr * 64 + fr, fq * 8), boff = lds_byte(wc * 32 + fr, fq * 8);
#define PG8_SA(b, h) (((b) * 2 + (h)) * HTB)
#define PG8_SB(b, h) ((4 + (b) * 2 + (h)) * HTB)
#define PG8_STAGE(bufoff, gbase, voff) do { _Pragma("unroll") for (int _i = 0; _i < 2; ++_i) \
        __builtin_amdgcn_global_load_lds((const unsigned*)((const char*)(gbase) + (voff)[_i]), (PG8_LAS unsigned*)(lds + (bufoff) + ldsw + _i * 8192), 16, 0, 0); } while (0)
#define PG8_LDA(dst, b, h) do { _Pragma("unroll") for (int m = 0; m < 4; ++m) _Pragma("unroll") for (int k = 0; k < 2; ++k) dst[m][k] = *(const PG8_LAS bf16x8*)(lds + PG8_SA(b, h) + aoff + m * 2048 + k * 1024); } while (0)
#define PG8_LDB(dst, b, h) do { _Pragma("unroll") for (int n = 0; n < 2; ++n) _Pragma("unroll") for (int k = 0; k < 2; ++k) dst[n][k] = *(const PG8_LAS bf16x8*)(lds + PG8_SB(b, h) + boff + n * 2048 + k * 1024); } while (0)
#define PG8_MMA(ai, bj, At, Bt) do { __builtin_amdgcn_s_setprio(1); _Pragma("unroll") for (int m = 0; m < 4; ++m) _Pragma("unroll") for (int n = 0; n < 2; ++n) _Pragma("unroll") for (int k = 0; k < 2; ++k) \
        acc[ai][bj][m][n] = __builtin_amdgcn_mfma_f32_16x16x32_bf16(Bt[n][k], At[m][k], acc[ai][bj][m][n], 0, 0, 0); __builtin_amdgcn_s_setprio(0); } while (0)
#define PG8_WAIT_V(n) asm volatile("s_waitcnt vmcnt(" #n ")" ::: "memory")
#define PG8_WAIT_L(n) asm volatile("s_waitcnt lgkmcnt(" #n ")" ::: "memory")
#define PG8_BAR __builtin_amdgcn_s_barrier()
#define PG8_SCHED __builtin_amdgcn_sched_barrier(0)
    Unit cur, nxt; int ui = 0;
    if (!S.next(0, cur)) return;
    f32x4 acc[2][2][4][2];
#pragma unroll
    for (int a = 0; a < 2; ++a)
#pragma unroll
        for (int b = 0; b < 2; ++b)
#pragma unroll
            for (int m = 0; m < 4; ++m)
#pragma unroll
                for (int n = 0; n < 2; ++n) acc[a][b][m][n] = (f32x4){0.f, 0.f, 0.f, 0.f};
    bf16x8 At[4][2], B0[2][2], B1[2][2];
    const char* cA = (const char*)g.A + (size_t)cur.pm * tstep; const char* cB = (const char*)g.Bt + (size_t)cur.pn * tstep;
    S.a_ready(cur);
    if constexpr (SP2) {
        PG8_STAGE(PG8_SB(0, 0), cB, voffB); PG8_STAGE(PG8_SB(0, 1), cB + hstep, voffB); PG8_STAGE(PG8_SA(0, 0), cA, voffA); PG8_STAGE(PG8_SA(0, 1), cA + hstep, voffA);
        if (wr == 1) PG8_BAR;
        PG8_WAIT_V(2); PG8_BAR;
        PG8_STAGE(PG8_SB(1, 0), cB + kstep, voffB); PG8_STAGE(PG8_SA(1, 0), cA + kstep, voffA); PG8_STAGE(PG8_SB(1, 1), cB + hstep + kstep, voffB);
        PG8_WAIT_V(6); PG8_BAR;
    } else {
        PG8_STAGE(PG8_SB(0, 0), cB, voffB); PG8_STAGE(PG8_SA(0, 0), cA, voffA); PG8_STAGE(PG8_SB(0, 1), cB + hstep, voffB); PG8_STAGE(PG8_SA(0, 1), cA + hstep, voffA);
        if (wr == 1) PG8_BAR;
        PG8_WAIT_V(4); PG8_BAR;
        PG8_STAGE(PG8_SB(1, 0), cB + kstep, voffB); PG8_STAGE(PG8_SA(1, 0), cA + kstep, voffA); PG8_STAGE(PG8_SB(1, 1), cB + hstep + kstep, voffB);
        PG8_WAIT_V(6); PG8_BAR;
    }
    for (;;) {
        const bool has_next = S.next(ui + 1, nxt);
        const char* nA = has_next ? (const char*)g.A + (size_t)nxt.pm * tstep : cA; const char* nB = has_next ? (const char*)g.Bt + (size_t)nxt.pn * tstep : cB;
        for (int t = 0; t < nt; t += 2) {
            const bool last = (t == nt - 2);
            const char* a1 = cA + (size_t)(t + 1) * kstep;
            const char* a2 = last ? nA : cA + (size_t)(t + 2) * kstep; const char* b2 = last ? nB : cB + (size_t)(t + 2) * kstep;
            const char* a3 = a2 + kstep; const char* b3 = b2 + kstep;
            if (last && has_next) S.a_ready(nxt);
            if constexpr (SP2) {
            PG8_LDB(B0, 0, 0); PG8_LDB(B1, 0, 1); PG8_SCHED; PG8_LDA(At, 0, 0); PG8_STAGE(PG8_SA(1, 1), a1 + hstep, voffA);
            PG8_WAIT_V(8); PG8_WAIT_L(0); PG8_BAR; PG8_MMA(0, 0, At, B0); PG8_MMA(0, 1, At, B1); PG8_BAR; PG8_SCHED;
            PG8_LDA(At, 0, 1); PG8_STAGE(PG8_SB(0, 0), b2, voffB); PG8_STAGE(PG8_SB(0, 1), b2 + hstep, voffB); PG8_STAGE(PG8_SA(0, 0), a2, voffA);
            PG8_WAIT_V(8); PG8_WAIT_L(0); PG8_BAR; PG8_MMA(1, 0, At, B0); PG8_MMA(1, 1, At, B1); PG8_BAR; PG8_SCHED;
            PG8_LDB(B0, 1, 0); PG8_LDB(B1, 1, 1); PG8_SCHED; PG8_LDA(At, 1, 0); PG8_STAGE(PG8_SA(0, 1), a2 + hstep, voffA);
            PG8_WAIT_V(8); PG8_WAIT_L(0); PG8_BAR; PG8_MMA(0, 0, At, B0); PG8_MMA(0, 1, At, B1); PG8_BAR; PG8_SCHED;
            PG8_LDA(At, 1, 1); PG8_STAGE(PG8_SB(1, 0), b3, voffB); PG8_STAGE(PG8_SB(1, 1), b3 + hstep, voffB); PG8_STAGE(PG8_SA(1, 0), a3, voffA);
            PG8_WAIT_V(8); PG8_WAIT_L(0); PG8_BAR; PG8_MMA(1, 0, At, B0); PG8_MMA(1, 1, At, B1); PG8_BAR; PG8_SCHED;
            } else {
            PG8_LDB(B0, 0, 0); PG8_SCHED; PG8_LDA(At, 0, 0); PG8_STAGE(PG8_SA(1, 1), a1 + hstep, voffA);
            PG8_WAIT_L(8); PG8_BAR; PG8_WAIT_L(0); PG8_MMA(0, 0, At, B0); PG8_BAR; PG8_SCHED;
            PG8_LDB(B1, 0, 1); PG8_STAGE(PG8_SB(0, 0), b2, voffB);
            PG8_BAR; PG8_WAIT_L(0); PG8_MMA(0, 1, At, B1); PG8_BAR;
            PG8_LDA(At, 0, 1); PG8_STAGE(PG8_SA(0, 0), a2, voffA);
            PG8_BAR; PG8_WAIT_L(0); PG8_MMA(1, 0, At, B0); PG8_BAR; PG8_SCHED;
            PG8_STAGE(PG8_SB(0, 1), b2 + hstep, voffB);
            PG8_WAIT_V(6); PG8_BAR; PG8_MMA(1, 1, At, B1); PG8_BAR;
            PG8_LDB(B0, 1, 0); PG8_SCHED; PG8_LDA(At, 1, 0); PG8_STAGE(PG8_SA(0, 1), a2 + hstep, voffA);
            PG8_WAIT_L(8); PG8_BAR; PG8_WAIT_L(0); PG8_MMA(0, 0, At, B0); PG8_BAR; PG8_SCHED;
            PG8_LDB(B1, 1, 1); PG8_STAGE(PG8_SB(1, 0), b3, voffB);
            PG8_BAR; PG8_WAIT_L(0); PG8_MMA(0, 1, At, B1); PG8_BAR;
            PG8_LDA(At, 1, 1); PG8_STAGE(PG8_SA(1, 0), a3, voffA);
            PG8_BAR; PG8_WAIT_L(0); PG8_MMA(1, 0, At, B0); PG8_BAR; PG8_SCHED;
            PG8_STAGE(PG8_SB(1, 1), b3 + hstep, voffB);
            PG8_WAIT_V(6); PG8_BAR; PG8_MMA(1, 1, At, B1); PG8_BAR;
            }
        }
        if constexpr (ALIGN_EPI) { if (wr == 0) PG8_BAR; }
        if constexpr (!Epi::AFTER_DRAIN) { E(acc, cur, wr, wc, fr, fq);
            S.done(cur); }
        if (!has_next) break;
#pragma unroll
        for (int a = 0; a < 2; ++a)
#pragma unroll
            for (int b = 0; b < 2; ++b)
#pragma unroll
                for (int m = 0; m < 4; ++m)
#pragma unroll
                    for (int n = 0; n < 2; ++n) acc[a][b][m][n] = (f32x4){0.f, 0.f, 0.f, 0.f};
        cur = nxt; cA = nA; cB = nB; ++ui;
        if constexpr (ALIGN_EPI) { if (wr == 1) PG8_BAR; }
    }
    PG8_WAIT_V(0);
    if constexpr (!ALIGN_EPI) { if (wr == 0) PG8_BAR; }
    PG8_BAR;
    if constexpr (Epi::AFTER_DRAIN) { E.fused(acc, cur, wr, wc, fr, fq, lds, wid, lane); S.done(cur); }
#undef PG8_SA
#undef PG8_SB
#undef PG8_STAGE
#undef PG8_LDA
#undef PG8_LDB
#undef PG8_MMA
#undef PG8_WAIT_V
#undef PG8_WAIT_L
#undef PG8_BAR
#undef PG8_SCHED
}
}

namespace att {
constexpr int A_KV = 0, A_KB = 49152, A_WS = 49920, A_MASK = 51968, A_SHQ = 52480, A_IMP = 53248, A_OC = 119808, A_IVC = 152576;
DI constexpr int crc(int r) { return (r & 3) + 8 * (r >> 2); }
constexpr int IMP_LD = 65;
DI int crow(int r, int hi) { return (r & 3) + 8 * (r >> 2) + 4 * hi; }
#define MFMA32(a, b, c) __builtin_amdgcn_mfma_f32_32x32x16_bf16((a), (b), (c), 0, 0, 0)

struct KVRegs { u32x4 k, v; float kb; };
struct Sweep {
    const bf16_t* K; const bf16_t* V; int ld;
    const float* kbias;
};
DI void kv_issue(KVRegs& r, const Sweep& s, int tile, int tid) {
    const int key = tid & 63, ch = tid >> 6;
    const size_t row0 = (size_t)tile * 64;
    r.k = *(const u32x4*)(s.K + (row0 + key) * s.ld + ch * 8);
    const int p = tid >> 6, l = tid & 63; const int row = 16 * (p & 3) + (l >> 2), col = (p >> 2) * 32 + (l & 3) * 8;
    r.v = *(const u32x4*)(s.V + (row0 + row) * s.ld + col);
    r.kb = (s.kbias && tid < 64) ? s.kbias[row0 + tid] : 0.f;
}
DI void kv_commit(const KVRegs& r, LAS char* lds, int slot, int tid, bool has_kb) {
    LAS char* sl = lds + A_KV + slot * 16384;
    *(LAS u32x4*)(sl + (tid >> 6) * 1024 + (tid & 63) * 16) = r.k;
    *(LAS u32x4*)(sl + 8192 + tid * 16) = r.v;
    if (has_kb && tid < 64) *(LAS float*)(lds + A_KB + slot * 256 + tid * 4) = r.kb;
}
DI void glds16(const void* gsrc, unsigned lds_dst) { unsigned keep;
    asm volatile("s_mov_b32 %0, m0\n\ts_mov_b32 m0, %2\n\ts_nop 0\n\tglobal_load_lds_dwordx4 %1, off\n\ts_mov_b32 m0, %0" : "=&s"(keep) : "v"(gsrc), "s"(lds_dst) : "memory"); }
DI void glds4(const void* gsrc, unsigned lds_dst) { unsigned keep;
    asm volatile("s_mov_b32 %0, m0\n\ts_mov_b32 m0, %2\n\ts_nop 0\n\tglobal_load_lds_dword %1, off\n\ts_mov_b32 m0, %0" : "=&s"(keep) : "v"(gsrc), "s"(lds_dst) : "memory"); }
DI void kv_dma(const Sweep& s, int tile, LAS char* lds, int slot, int tid, int wid, bool has_kb) {
    const int l = tid & 63;
    const size_t row0 = (size_t)tile * 64;
    const bf16_t* ksrc = s.K + (row0 + l) * s.ld + wid * 8;
    const bf16_t* vsrc = s.V + (row0 + 16 * (wid & 3) + (l >> 2)) * s.ld + (wid >> 2) * 32 + (l & 3) * 8;
    const unsigned sl = (unsigned)__builtin_amdgcn_readfirstlane((int)(unsigned)(uintptr_t)(lds + A_KV + slot * 16384 + wid * 1024));
    glds16(ksrc, sl);
    glds16(vsrc, sl + 8192);
    if (has_kb) glds4(s.kbias + row0 + l, (unsigned)__builtin_amdgcn_readfirstlane((int)(unsigned)(uintptr_t)(lds + A_KB + slot * 256)));
}
struct FState { float m, l; f32x16 o0, o1, la, negm; };
DI float max3f(float a, float b, float c) { float r; asm("v_max3_f32 %0, %1, %2, %3" : "=v"(r) : "v"(a), "v"(b), "v"(c)); return r; }
DI void fs_init(FState& s) { s.m = 0.f; s.l = 0.f;

#pragma unroll
    for (int r = 0; r < 16; ++r) { s.o0[r] = 0.f; s.o1[r] = 0.f; s.la[r] = 0.f; s.negm[r] = 0.f; } }

DI void qk_tile(f32x16& p0, f32x16& p1, const f32x16& c0, const f32x16& c1, const LAS char* Ks, const bf16x8 (&qr)[4], int r32, int hi) {
    const LAS char* kb = Ks + hi * 1024 + r32 * 16;
    bf16x8 kf[8];
#pragma unroll
    for (int d0 = 0; d0 < 4; ++d0) { kf[2 * d0] = *(const LAS bf16x8*)(kb + d0 * 2048); kf[2 * d0 + 1] = *(const LAS bf16x8*)(kb + d0 * 2048 + 512); }
    __builtin_amdgcn_s_setprio(1);
#pragma unroll
    for (int d0 = 0; d0 < 4; ++d0) {
        if (d0 == 0) { p0 = MFMA32(kf[0], qr[0], c0); p1 = MFMA32(kf[1], qr[0], c1); }
        else { p0 = MFMA32(kf[2 * d0], qr[d0], p0); p1 = MFMA32(kf[2 * d0 + 1], qr[d0], p1); }
    }
    __builtin_amdgcn_s_setprio(0);
}
DI s16x4 vtr(const LAS char* p) { typedef short v4i16_t __attribute__((ext_vector_type(4))); return __builtin_bit_cast(s16x4, __builtin_amdgcn_ds_read_tr16_b64_v4i16((LAS v4i16_t*)p)); }

template <bool NOMAX, bool SUML> DI void softmax_pv(FState& s, f32x16& p0, f32x16& p1, const LAS char* Vs, LAS float* wsf, int lane, int r32, int hi) {
    if (!NOMAX) {
        asm volatile("s_nop 15\n\ts_nop 7" : "+v"(p0), "+v"(p1));
        float rm = max3f(p0[0], p0[1], p1[0]), rm2 = max3f(p0[2], p0[3], p1[1]);
        rm = max3f(rm, p1[2], p1[3]);
#pragma unroll
        for (int r = 4; r < 16; r += 4) { rm = max3f(rm, p0[r], p0[r + 1]); rm2 = max3f(rm2, p0[r + 2], p0[r + 3]); rm = max3f(rm, p1[r], p1[r + 1]); rm2 = max3f(rm2, p1[r + 2], p1[r + 3]); }
        rm = fmaxf(rm, rm2);
        rm = fmaxf(rm, __shfl_xor(rm, 32));
        if (__any(rm > 8.0f)) {
            const float dl = fmaxf(rm, 0.f);
            s.m += dl; const float alpha = __builtin_amdgcn_exp2f(-dl);
#pragma unroll
            for (int r = 0; r < 16; ++r) s.negm[r] = -s.m;
#pragma unroll
            for (int r = 0; r < 16; ++r) { p0[r] -= dl; p1[r] -= dl; }
            if (hi == 0) wsf[r32] = alpha;
#pragma unroll
            for (int r = 0; r < 16; ++r) { const float a = wsf[crow(r, hi)]; s.o0[r] *= a; s.o1[r] *= a; s.la[r] *= a; }
            if (SUML) s.l *= alpha;
        }
    }
#pragma unroll
    for (int r = 0; r < 16; ++r) { p0[r] = __builtin_amdgcn_exp2f(p0[r]); p1[r] = __builtin_amdgcn_exp2f(p1[r]); }
    if (SUML) { float sum = 0.f;
#pragma unroll
        for (int r = 0; r < 16; ++r) sum += p0[r] + p1[r];
        s.l += sum; }
    u32x4 pw[4];
    pw[0] = (u32x4){cvtpk(p0[0], p0[1]), cvtpk(p0[2], p0[3]), cvtpk(p0[4], p0[5]), cvtpk(p0[6], p0[7])};
    pw[1] = (u32x4){cvtpk(p0[8], p0[9]), cvtpk(p0[10], p0[11]), cvtpk(p0[12], p0[13]), cvtpk(p0[14], p0[15])};
    pw[2] = (u32x4){cvtpk(p1[0], p1[1]), cvtpk(p1[2], p1[3]), cvtpk(p1[4], p1[5]), cvtpk(p1[6], p1[7])};
    pw[3] = (u32x4){cvtpk(p1[8], p1[9]), cvtpk(p1[10], p1[11]), cvtpk(p1[12], p1[13]), cvtpk(p1[14], p1[15])};
    const bf16x8 ones = (bf16x8){0x3F80, 0x3F80, 0x3F80, 0x3F80, 0x3F80, 0x3F80, 0x3F80, 0x3F80};
    const LAS char* vp = Vs + ((lane >> 4) & 1) * 32 + (lane & 3) * 8 + (4 * hi + ((lane & 15) >> 2)) * 64;
#pragma unroll
    for (int ks = 0; ks < 4; ++ks) {
        const bf16x8 pa = __builtin_bit_cast(bf16x8, pw[ks]);
        { const s16x4 lo = vtr(vp + ks * 1024), hh = vtr(vp + ks * 1024 + 512); const bf16x8 vf = (bf16x8){lo[0], lo[1], lo[2], lo[3], hh[0], hh[1], hh[2], hh[3]}; s.o0 = MFMA32(pa, vf, s.o0); }
        { const s16x4 lo = vtr(vp + 4096 + ks * 1024), hh = vtr(vp + 4096 + ks * 1024 + 512); const bf16x8 vf = (bf16x8){lo[0], lo[1], lo[2], lo[3], hh[0], hh[1], hh[2], hh[3]}; s.o1 = MFMA32(pa, vf, s.o1); }
        s.la = MFMA32(pa, ones, s.la);
    }
}
template <int MODE> DI float fs_finish(const FState& s, const float (&gr)[16], LAS float* wsf, LAS char* stg_bf, LAS char* stg_f32, int r32, int hi) {
    LAS bf16_t* sb = (LAS bf16_t*)stg_bf; LAS float* sf = (LAS float*)stg_f32;
#pragma unroll
    for (int r = 0; r < 16; ++r) {
        const int orow = crow(r, hi); const float lt = s.la[r]; const float inv = lt > 0.f ? __builtin_amdgcn_rcpf(lt) : 0.f; const float f = inv * gr[r];
        float c0 = s.o0[r] * f, c1 = s.o1[r] * f;
        if (MODE == 1) { c0 += bf2f(sb[orow * 64 + r32]); c1 += bf2f(sb[orow * 64 + 32 + r32]); sf[orow * 64 + r32] = c0; sf[orow * 64 + 32 + r32] = c1; }
        else { if (MODE == 2) { c0 += sf[orow * 64 + r32]; c1 += sf[orow * 64 + 32 + r32]; }
            sb[orow * 64 + r32] = (bf16_t)(cvtpk(c0, 0.f) & 0xffffu); sb[orow * 64 + 32 + r32] = (bf16_t)(cvtpk(c1, 0.f) & 0xffffu); }
    }
    if (MODE == 0) { const float lt = s.l + __shfl_xor(s.l, 32); return lt > 0.f ? 1.0f / lt : 0.f; }
    return 0.f;
}
DI void store_o(bf16_t* Orow0  , int ldo, const LAS char* stg, int lane) {
#pragma unroll
    for (int i = 0; i < 4; ++i) { const int row = i * 8 + (lane >> 3), ch = lane & 7; const u32x4 v = *(const LAS u32x4*)(stg + row * 128 + ch * 16); *(u32x4*)(Orow0 + (size_t)row * ldo + ch * 8) = v; }
}

struct BrP { int cur; int tq; int tt; unsigned long long msk, anym; int jlo, jhi; int fox_lim, fox_lo; float m_c, inv_c; int head_l, tok_l; };
template <int BR> DI int next_tile(const BrP& b, int j) {
    ++j;
    if (BR == 1) { while (j <= b.jhi && !((b.anym >> j) & 1ull)) ++j; }
    return j <= b.jhi ? j : -1;
}
template <int BR, bool NOMAX> DI void sweep(FState& st, const Sweep& sw, const BrP& b, const bf16x8 (&qr)[4], LAS char* lds, LAS float* wsf, int tid, int lane, int r32, int hi, float& carry) {
    const int wid_ = __builtin_amdgcn_readfirstlane(tid >> 6);
#define ATT_WAIT_BAR(n) asm volatile("s_waitcnt vmcnt(" #n ") lgkmcnt(0)\n\ts_barrier" ::: "memory")
#define ATT_END_TILE(more) do { if (more) { if (BR == 3) ATT_WAIT_BAR(3); else ATT_WAIT_BAR(2); } else ATT_WAIT_BAR(0); } while (0)
    int j = next_tile<BR>(b, b.jlo - 1);
    if (j < 0) return;
    int jn = next_tile<BR>(b, j);
    kv_dma(sw, j, lds, 0, tid, wid_, BR == 3);
    if (jn >= 0) kv_dma(sw, jn, lds, 1, tid, wid_, BR == 3);
    ATT_END_TILE(jn >= 0);
    int slot = 0;
    while (j >= 0) {
        const int jn2 = jn >= 0 ? next_tile<BR>(b, jn) : -1;
        if (jn2 >= 0) kv_dma(sw, jn2, lds, slot >= 1 ? slot - 1 : 2, tid, wid_, BR == 3);
        const LAS char* Ks = lds + A_KV + slot * 16384; const LAS char* Vs = Ks + 8192;
        bool active = true;
        if (BR == 3) active = (j <= b.fox_lim) && (j >= b.fox_lo);
        if (active) {
            f32x16 p0, p1;
            const float NEG = -__builtin_inff();
            if (BR == 3) {
                f32x16 c0, c1;
                const LAS float* kb = (const LAS float*)(lds + A_KB + slot * 256);
#pragma unroll
                for (int i = 0; i < 4; ++i) { const f32x4 k0 = *(const LAS f32x4*)(kb + 8 * i + 4 * hi), k1 = *(const LAS f32x4*)(kb + 32 + 8 * i + 4 * hi);
#pragma unroll
                    for (int e = 0; e < 4; ++e) { c0[4 * i + e] = k0[e] + st.negm[4 * i + e]; c1[4 * i + e] = k1[e] + st.negm[4 * i + e]; } }
                qk_tile(p0, p1, c0, c1, Ks, qr, r32, hi);
            } else if (BR == 1) {
                f32x16 cs; const bool sel = (b.msk >> j) & 1ull;
#pragma unroll
                for (int r = 0; r < 16; ++r) cs[r] = sel ? (NOMAX ? 0.f : st.negm[r]) : NEG;
                qk_tile(p0, p1, cs, cs, Ks, qr, r32, hi);
            } else if (NOMAX) {
                f32x16 z;
#pragma unroll
                for (int r = 0; r < 16; ++r) z[r] = 0.f;
                qk_tile(p0, p1, z, z, Ks, qr, r32, hi);
            } else qk_tile(p0, p1, st.negm, st.negm, Ks, qr, r32, hi);
            int tth = b.tt - 4 * hi; asm volatile("" : "+v"(tth));
            if (BR == 0 || BR == 4) {
                int lim = ((b.tq - 31) >> 4) - 64 * j - 4 * hi; asm volatile("" : "+v"(lim));
#pragma unroll
                for (int r = 0; r < 16; ++r) { if (crc(r) > lim) p0[r] = NEG; if (crc(r) + 32 > lim) p1[r] = NEG; }
            } else if (BR == 1) {
                if (j == b.cur) {
#pragma unroll
                    for (int r = 0; r < 16; ++r) { if (crc(r) > tth) p0[r] = NEG; if (crc(r) + 32 > tth) p1[r] = NEG; }
                }
            } else if (BR == 2) {
                if (j == b.cur) {
#pragma unroll
                    for (int r = 0; r < 16; ++r) { if (crc(r) > tth) p0[r] = NEG; if (crc(r) + 32 > tth) p1[r] = NEG; }
                } else if (j == b.cur - 8) {
#pragma unroll
                    for (int r = 0; r < 16; ++r) { if (crc(r) <= tth) p0[r] = NEG; if (crc(r) + 32 <= tth) p1[r] = NEG; }
                }
            } else if (BR == 3) {
                if (j == b.fox_lim) {
#pragma unroll
                    for (int r = 0; r < 16; ++r) { if (crc(r) > tth) p0[r] = NEG; if (crc(r) + 32 > tth) p1[r] = NEG; }
                }
            }
            if (BR != 4) softmax_pv<NOMAX, BR == 0>(st, p0, p1, Vs, wsf, lane, r32, hi);
            if (BR == 4 || (BR == 0 && NOMAX)) {
                const float scl = (BR == 4) ? b.inv_c : 1.0f;
                float G[8], H[8];
#pragma unroll
                for (int i = 0; i < 4; ++i) {
                    float a[4], c[4];
#pragma unroll
                    for (int e = 0; e < 4; ++e) { a[e] = (BR == 4 ? __builtin_amdgcn_exp2f(p0[4 * i + e]) : p0[4 * i + e]) * scl; c[e] = (BR == 4 ? __builtin_amdgcn_exp2f(p1[4 * i + e]) : p1[4 * i + e]) * scl; }
                    H[i] = 0.5f * a[3]; G[i] = a[0] + a[1] + a[2] + H[i]; H[4 + i] = 0.5f * c[3]; G[4 + i] = c[0] + c[1] + c[2] + H[4 + i];
                }
                float Hp[8];
#pragma unroll
                for (int k = 0; k < 8; ++k) Hp[k] = __shfl_xor(H[k], 32);
                LAS float* imp = (LAS float*)(lds + A_IMP) + (b.head_l * 64 + b.tok_l) * IMP_LD + 16 * j;
#pragma unroll
                for (int k = 0; k < 8; ++k) {
                    const float prev = (hi == 1) ? Hp[k] : (k == 0 ? carry : Hp[k - 1]);
                    const int sidx = (k < 4) ? (2 * k + hi) : (8 + 2 * (k - 4) + hi);
                    imp[sidx] = G[k] + prev;
                }
                carry = Hp[7];
            }
        }
        ATT_END_TILE(jn2 >= 0);
        slot = slot == 2 ? 0 : slot + 1; j = jn; jn = jn2;
    }
#undef ATT_WAIT_BAR
#undef ATT_END_TILE
}

struct Tensors {
    const bf16_t* projA; const bf16_t* kcmp; const bf16_t* vcmp; const float* gate; const float* cumneg; bf16_t* O; const float* fqn; const float* fkn; const float* aqn; const float* akn;
};

template <bool NOMAX> DI void nsa_unit(const Tensors& T_, int b, int g, int qt, LAS char* lds) {
    int tid_ = threadIdx.x; asm volatile("" : "+v"(tid_));
    const int tid = tid_, lane = tid & 63, r32 = lane & 31, hi = lane >> 5, wid = __builtin_amdgcn_readfirstlane(tid >> 6);
    LAS float* wsf = (LAS float*)(lds + A_WS) + wid * 64;
    const int head_l = wid >> 1, head = 4 * g + head_l, tok_l = 32 * (wid & 1) + r32;
    const int tq = 64 * qt + tok_l;
    const size_t rowq = (size_t)b * SEQ + tq;
    bf16x8 qr[4];
#pragma unroll
    for (int d0 = 0; d0 < 4; ++d0) qr[d0] = *(const bf16x8*)(T_.projA + rowq * LDA + PA_QA + head * 64 + d0 * 16 + hi * 8);
    LAS char* stg_bf = lds + A_OC + wid * 4096; LAS char* stg_f32 = lds + A_IMP + wid * 8192;
    const size_t rowbase = (size_t)b * SEQ + 64 * qt + 32 * (wid & 1);
    float gr[16];
    BrP bp; bp.cur = qt; bp.tq = tq; bp.tt = tok_l; bp.msk = 0; bp.anym = 0; bp.fox_lim = 0; bp.fox_lo = 0; bp.head_l = head_l; bp.tok_l = tok_l; bp.m_c = 0.f; bp.inv_c = 0.f;
    float carry = 0.f;
    {
        Sweep sw; sw.K = T_.kcmp + ((size_t)b * NCMP_PAD * 2 + g) * 64; sw.V = T_.vcmp + ((size_t)b * NCMP_PAD * 2 + g) * 64; sw.ld = 128; sw.kbias = nullptr;
        const int ntc = (4 * qt + 2) / 64 + 1;
        bp.jlo = 0; bp.jhi = ntc - 1;
        FState st; fs_init(st);
        LAS float* imp = (LAS float*)(lds + A_IMP) + (head_l * 64 + tok_l) * IMP_LD;
        for (int s2 = 16 * ntc + hi; s2 < 64; s2 += 2) imp[s2] = 0.f;
        carry = 0.f;
        sweep<0, NOMAX>(st, sw, bp, qr, lds, wsf, tid, lane, r32, hi, carry);
#pragma unroll
        for (int r = 0; r < 16; ++r) gr[r] = T_.gate[(rowbase + crow(r, hi)) * 24 + 3 * head + 0];
        bp.inv_c = fs_finish<0>(st, gr, wsf, stg_bf, stg_f32, r32, hi); bp.m_c = st.m;
        if (hi == 0) ((LAS float*)(lds + A_IVC))[head_l * 64 + tok_l] = NOMAX ? bp.inv_c : 1.0f;
        if (!NOMAX) { carry = 0.f; sweep<4, NOMAX>(st, sw, bp, qr, lds, wsf, tid, lane, r32, hi, carry); }
    }
    __syncthreads();
    {
        LAS float* imp = (LAS float*)(lds + A_IMP); const LAS float* ivc = (const LAS float*)(lds + A_IVC);
        const int tok = tid >> 3, part = tid & 7;
        float v[8];
#pragma unroll
        for (int k = 0; k < 8; ++k) { const int s2 = 8 * part + k;
            float x = ((imp[(0 * 64 + tok) * IMP_LD + s2] * ivc[tok] + imp[(1 * 64 + tok) * IMP_LD + s2] * ivc[64 + tok]) + imp[(2 * 64 + tok) * IMP_LD + s2] * ivc[128 + tok]) + imp[(3 * 64 + tok) * IMP_LD + s2] * ivc[192 + tok];
            if (s2 == 0 || s2 == qt || s2 == qt - 1) x = 1e6f; else if (s2 > qt) x = -1e6f;
            v[k] = x; }
        __syncthreads();
#pragma unroll
        for (int k = 0; k < 8; ++k) imp[tok * IMP_LD + 8 * part + k] = v[k];
        __syncthreads();
        int rank[8];
#pragma unroll
        for (int k = 0; k < 8; ++k) rank[k] = 0;
        for (int s2 = 0; s2 < 64; ++s2) { const float x = imp[tok * IMP_LD + s2];
#pragma unroll
            for (int k = 0; k < 8; ++k) rank[k] += (x > v[k] || (x == v[k] && s2 < 8 * part + k)) ? 1 : 0; }
        unsigned byte = 0;
#pragma unroll
        for (int k = 0; k < 8; ++k) byte |= (rank[k] < 16 ? 1u : 0u) << k;
        ((LAS unsigned char*)(lds + A_MASK))[tok * 8 + part] = (unsigned char)byte;
        __syncthreads();
        const LAS unsigned long long* mk = (const LAS unsigned long long*)(lds + A_MASK);
        bp.msk = mk[tok_l];
        unsigned long long am = mk[lane];
        unsigned lo = (unsigned)am, hh = (unsigned)(am >> 32);
#pragma unroll
        for (int o = 1; o < 64; o <<= 1) { lo |= (unsigned)__shfl_xor((int)lo, o); hh |= (unsigned)__shfl_xor((int)hh, o); }
        bp.anym = ((unsigned long long)(unsigned)__builtin_amdgcn_readfirstlane((int)hh) << 32) | (unsigned)__builtin_amdgcn_readfirstlane((int)lo);
    }
    {
        Sweep sw; sw.K = T_.projA + (size_t)b * SEQ * LDA + PA_KSL + g * 64; sw.V = T_.projA + (size_t)b * SEQ * LDA + PA_VSL + g * 64; sw.ld = LDA; sw.kbias = nullptr;
        bp.jlo = 0; bp.jhi = qt;
        FState st; fs_init(st);
        sweep<1, NOMAX>(st, sw, bp, qr, lds, wsf, tid, lane, r32, hi, carry);
#pragma unroll
        for (int r = 0; r < 16; ++r) gr[r] = T_.gate[(rowbase + crow(r, hi)) * 24 + 3 * head + 1];
        fs_finish<1>(st, gr, wsf, stg_bf, stg_f32, r32, hi);
    }
    {
        Sweep sw; sw.K = T_.projA + (size_t)b * SEQ * LDA + PA_KWN + g * 64; sw.V = T_.projA + (size_t)b * SEQ * LDA + PA_VWN + g * 64; sw.ld = LDA; sw.kbias = nullptr;
        bp.jlo = qt - 8 < 0 ? 0 : qt - 8; bp.jhi = qt;
        FState st; fs_init(st);
        sweep<2, NOMAX>(st, sw, bp, qr, lds, wsf, tid, lane, r32, hi, carry);
#pragma unroll
        for (int r = 0; r < 16; ++r) gr[r] = T_.gate[(rowbase + crow(r, hi)) * 24 + 3 * head + 2];
        fs_finish<2>(st, gr, wsf, stg_bf, stg_f32, r32, hi);
    }
    store_o(T_.O + rowbase * DM + head * 64, DM, stg_bf, lane);
    __syncthreads();
}

DI void fox_unit(const Tensors& T_, int b, int h, int qb, LAS char* lds) {
    int tid_ = threadIdx.x; asm volatile("" : "+v"(tid_));
    const int tid = tid_, lane = tid & 63, r32 = lane & 31, hi = lane >> 5, wid = __builtin_amdgcn_readfirstlane(tid >> 6);
    LAS float* wsf = (LAS float*)(lds + A_WS) + wid * 64;
    const int tq = 256 * qb + 32 * wid + r32;
    const size_t rowq = (size_t)b * SEQ + tq;
    bf16x8 qr[4];
#pragma unroll
    for (int d0 = 0; d0 < 4; ++d0) qr[d0] = *(const bf16x8*)(T_.projA + rowq * LDA + PA_QB + h * 64 + d0 * 16 + hi * 8);
    LAS char* stg_bf = lds + A_OC + wid * 4096;
    BrP bp; bp.cur = 0; bp.tq = tq; bp.tt = 32 * (wid & 1) + r32; bp.msk = 0; bp.anym = 0; bp.head_l = 0; bp.tok_l = 0; bp.m_c = 0.f; bp.inv_c = 0.f;
    bp.jlo = 0; bp.jhi = 4 * qb + 3; bp.fox_lim = 4 * qb + (wid >> 1);
    {
        float gq = fabsf(T_.fqn[lane]), gk = fabsf(T_.fkn[lane]);
#pragma unroll
        for (int o = 1; o < 64; o <<= 1) { gq = fmaxf(gq, __shfl_xor(gq, o)); gk = fmaxf(gk, __shfl_xor(gk, o)); }
        const float need = 2.0f * 11.66f * gq * gk + 40.0f;
        const float* kbp = T_.cumneg + ((size_t)b * FOX_H + h) * SEQ;
        const float kb0 = kbp[256 * qb];
        const bool needed = (lane <= bp.jhi) && (kb0 - kbp[64 * lane + 63] <= need);
        const unsigned long long bal = __ballot(needed);
        bp.jlo = bal ? (int)__builtin_ctzll(bal) : 0;
        const bool needed_w = (lane <= bp.jhi) && (kbp[256 * qb + 32 * wid] - kbp[64 * lane + 63] <= need);
        const unsigned long long balw = __ballot(needed_w);
        bp.fox_lo = balw ? (int)__builtin_ctzll(balw) : 0;
    }
    Sweep sw; sw.K = T_.projA + (size_t)b * SEQ * LDA + PA_KB + h * 64; sw.V = T_.projA + (size_t)b * SEQ * LDA + PA_VB + h * 64; sw.ld = LDA;
    sw.kbias = T_.cumneg + ((size_t)b * FOX_H + h) * SEQ;
    FState st; fs_init(st);
    float carry = 0.f;
    sweep<3, false>(st, sw, bp, qr, lds, wsf, tid, lane, r32, hi, carry);
    float gr[16];
#pragma unroll
    for (int r = 0; r < 16; ++r) gr[r] = 1.f;
    fs_finish<3>(st, gr, wsf, stg_bf, stg_bf, r32, hi);
    const size_t rowbase = (size_t)b * SEQ + 256 * qb + 32 * wid;
    store_o(T_.O + rowbase * DM + 512 + h * 64, DM, stg_bf, lane);
    __syncthreads();
}

DI void attn_phase(const Tensors& T_, unsigned* ctr, LAS char* lds) {
    LAS int* shq = (LAS int*)(lds + A_SHQ);
    bool nomax;
    { const int lane = threadIdx.x & 63; float gq = fabsf(T_.aqn[lane]), gk = fabsf(T_.akn[lane]);
#pragma unroll
      for (int o = 1; o < 64; o <<= 1) { gq = fmaxf(gq, __shfl_xor(gq, o)); gk = fmaxf(gk, __shfl_xor(gk, o)); }
      nomax = __builtin_amdgcn_readfirstlane((int)(11.66f * gq * gk < 50.0f)) != 0; }
    for (;;) {
        if (threadIdx.x == 0) shq[0] = (int)__hip_atomic_fetch_add(ctr, 1u, __ATOMIC_RELAXED, __HIP_MEMORY_SCOPE_AGENT);
        __syncthreads();
        const int i = __builtin_amdgcn_readfirstlane(shq[0]);
        __syncthreads();
        if (i >= 2048) break;
        if (i < 1024) { if (nomax) nsa_unit<true>(T_, (i & 15) >> 1, i & 1, 63 - (i >> 4), lds); else nsa_unit<false>(T_, (i & 15) >> 1, i & 1, 63 - (i >> 4), lds); }
        else { const int r = i - 1024; fox_unit(T_, (r & 63) >> 3, r & 7, 15 - (r >> 6), lds); }
    }
}
}

namespace gla {
constexpr int G_A1 = 0, G_QI = 4096, G_QR = 20480, G_KR = 36864, G_KH = 53248, G_V = 69632, G_BQ = 73728, G_ST = 77824, G_DEC = 94208;
DI int swo(int row, int colbyte) { return row * 256 + (colbyte ^ ((row & 15) << 4)); }
using att::crow; using att::vtr;

struct GlaT { bf16_t* projC; const float* a1; const float* w_a2; const float* b_a; bf16_t* O; bf16_t* att; float* dec; };

DI void gla_a1_item(const bf16_t* xb, const bf16_t* wa1t  , const float* ss2, float* a1, int item, LAS char* lds) {
    int tid_l_ = threadIdx.x; asm volatile("" : "+v"(tid_l_)); const int tid = tid_l_, lane = tid & 63, r32 = lane & 31, hi = lane >> 5, wid = __builtin_amdgcn_readfirstlane(tid >> 6);
    const int rg = wid & 3, kh = wid >> 2;
    const size_t row0 = (size_t)item * 128 + 32 * rg;
    const bf16_t* ap = xb + (row0 + r32) * DM + 512 * kh + 8 * hi;
    const bf16_t* bp = wa1t + (size_t)(r32 & 15) * DM + 512 * kh + 8 * hi;
    f32x16 c;
#pragma unroll
    for (int r = 0; r < 16; ++r) c[r] = 0.f;
#pragma unroll 8
    for (int ks = 0; ks < 32; ++ks) {
        const bf16x8 A = *(const bf16x8*)(ap + 16 * ks);
        bf16x8 B = *(const bf16x8*)(bp + 16 * ks);
        if (r32 >= 16) B = (bf16x8){0, 0, 0, 0, 0, 0, 0, 0};
        c = MFMA32(A, B, c);
    }
    LAS float* red = (LAS float*)lds + rg * 1024;
    if (kh == 1) {
#pragma unroll
        for (int r = 0; r < 16; ++r) red[crow(r, hi) * 32 + r32] = c[r];
    }
    __syncthreads();
    if (kh == 0 && r32 < 16) {
#pragma unroll
        for (int r = 0; r < 16; ++r) { const int rw = crow(r, hi); const size_t grow = row0 + rw;
            a1[grow * 16 + r32] = (c[r] + red[rw * 32 + r32]) * pg8::row_rstd(ss2, (int)grow); }
    }
    __syncthreads();
}

constexpr int P_A1 = 0, P_QR = 4096, P_KR = 20480, P_BQ = 36864;
struct PrepRegs { unsigned q[8], k[8]; f32x4 a1; };
DI void prep_load(PrepRegs& R, const GlaT& G, int item, int tid) {
    const int ch = item & 63, h = (item >> 6) & 3, b = item >> 8, d0 = 2 * (tid & 63), tg = tid >> 6;
    const size_t rb = (size_t)b * SEQ + 64 * ch;
#pragma unroll
    for (int c8 = 0; c8 < 8; ++c8) { const size_t rw = rb + 8 * tg + c8; R.q[c8] = *(const unsigned*)(G.projC + rw * LDC + PC_Q + h * 128 + d0); R.k[c8] = *(const unsigned*)(G.projC + rw * LDC + PC_K + h * 128 + d0); }
    R.a1 = (tid < 256) ? *(const f32x4*)(G.a1 + (rb + (tid >> 2)) * 16 + (tid & 3) * 4) : (f32x4){0.f, 0.f, 0.f, 0.f};
}
DI void gla_prep(const GlaT& G, int item, const PrepRegs& R, LAS char* lds) {
    int tid_l_ = threadIdx.x; asm volatile("" : "+v"(tid_l_)); const int tid = tid_l_, lane = tid & 63, r32 = lane & 31, hi = lane >> 5, wid = __builtin_amdgcn_readfirstlane(tid >> 6);
    const int ch = item & 63, h = (item >> 6) & 3, b = item >> 8;
    const int dp = tid & 63, tg = wid, d0 = 2 * dp;
    const size_t rb = (size_t)b * SEQ + 64 * ch;
    unsigned qraw[8], kraw[8];
#pragma unroll
    for (int c8 = 0; c8 < 8; ++c8) { qraw[c8] = R.q[c8]; kraw[c8] = R.k[c8]; }
    if (tid < 256) *(LAS f32x4*)(lds + P_A1 + tid * 16) = R.a1;
    float w2a[16], w2b[16];
#pragma unroll
    for (int r = 0; r < 16; ++r) { const f32x2 w = *(const f32x2*)(G.w_a2 + r * 512 + h * 128 + d0); w2a[r] = w[0]; w2b[r] = w[1]; }
    const f32x2 bav = *(const f32x2*)(G.b_a + h * 128 + d0);
    __syncthreads();
    float lp0[8], lp1[8]; float run0 = 0.f, run1 = 0.f;
#pragma unroll
    for (int c8 = 0; c8 < 8; ++c8) {
        const LAS f32x4* ar = (const LAS f32x4*)(lds + P_A1 + (8 * tg + c8) * 64);
        float z0 = bav[0], z1 = bav[1];
#pragma unroll
        for (int q4 = 0; q4 < 4; ++q4) { const f32x4 a = ar[q4];
#pragma unroll
            for (int e = 0; e < 4; ++e) { z0 += a[e] * w2a[4 * q4 + e]; z1 += a[e] * w2b[4 * q4 + e]; } }
        const float l0 = fminf(z0, 0.f) - __logf(1.0f + __expf(-fabsf(z0))), l1 = fminf(z1, 0.f) - __logf(1.0f + __expf(-fabsf(z1)));
        run0 += l0 * (1.0f / 16.0f); run1 += l1 * (1.0f / 16.0f);
        lp0[c8] = run0; lp1[c8] = run1;
    }
    *(LAS f32x2*)(lds + P_BQ + tg * 512 + d0 * 4) = (f32x2){run0, run1};
    __syncthreads();
    {
        float off0 = 0.f, off1 = 0.f, ref0 = 0.f, ref1 = 0.f, last0 = 0.f, last1 = 0.f;
#pragma unroll
        for (int t8 = 0; t8 < 8; ++t8) { const f32x2 q = *(const LAS f32x2*)(lds + P_BQ + t8 * 512 + d0 * 4);
            if (t8 < tg) { off0 += q[0]; off1 += q[1]; } if (t8 < 4) { ref0 += q[0]; ref1 += q[1]; } last0 += q[0]; last1 += q[1]; }
        const float emr0 = __expf(-ref0), emr1 = __expf(-ref1), epr0 = __expf(ref0), epr1 = __expf(ref1), epl0 = __expf(last0), epl1 = __expf(last1);
#pragma unroll
        for (int c8 = 0; c8 < 8; ++c8) {
            const int c = 8 * tg + c8;
            const float eb0 = __expf(off0 + lp0[c8]), eb1 = __expf(off1 + lp1[c8]);
            const float ib0 = __builtin_amdgcn_rcpf(eb0), ib1 = __builtin_amdgcn_rcpf(eb1);
            const float q0 = bflo(qraw[c8]), q1 = bfhi(qraw[c8]), k0 = bflo(kraw[c8]), k1 = bfhi(kraw[c8]);
            const float qi0 = q0 * eb0, qi1 = q1 * eb1, kb0 = k0 * ib0, kb1 = k1 * ib1;
            const int o = swo(c, 4 * dp);
            *(LAS unsigned*)(lds + P_QR + o) = cvtpk(qi0 * emr0, qi1 * emr1);
            *(LAS unsigned*)(lds + P_KR + o) = cvtpk(kb0 * epr0, kb1 * epr1);
            const size_t rw = rb + c;
            *(unsigned*)(G.projC + rw * LDC + PC_Q + h * 128 + d0) = cvtpk(qi0, qi1);
            *(unsigned*)(G.projC + rw * LDC + PC_K + h * 128 + d0) = cvtpk(kb0 * epl0, kb1 * epl1);
        }
        if (tg == 0) *(f32x2*)(G.dec + (size_t)item * 128 + d0) = (f32x2){epl0, epl1};
    }
    __syncthreads();
    if (wid < 3) {
        const int jt = wid == 2 ? 1 : 0, it = wid == 0 ? 0 : 1;
        f32x16 X;
#pragma unroll
        for (int r = 0; r < 16; ++r) X[r] = 0.f;
#pragma unroll
        for (int ks = 0; ks < 8; ++ks) {
            const bf16x8 A = *(const LAS bf16x8*)(lds + P_KR + swo(32 * jt + r32, (16 * ks + 8 * hi) * 2));
            const bf16x8 B = *(const LAS bf16x8*)(lds + P_QR + swo(32 * it + r32, (16 * ks + 8 * hi) * 2));
            X = MFMA32(A, B, X);
        }
        if (jt == it) {
#pragma unroll
            for (int r = 0; r < 16; ++r) if (att::crc(r) > r32 - 4 * hi) X[r] = 0.f;
        }
        bf16_t* ap = G.att + (size_t)item * 4096 + (32 * it + r32) * 64 + 32 * jt + 4 * hi;
#pragma unroll
        for (int g4 = 0; g4 < 4; ++g4) *(u32x2*)(ap + 8 * g4) = (u32x2){cvtpk(X[4 * g4], X[4 * g4 + 1]), cvtpk(X[4 * g4 + 2], X[4 * g4 + 3])};
    }
    __syncthreads();
}

constexpr int R_QI = 0, R_KH = 16384, R_ATT = 32768, R_V = 40960, R_DEC = 45056, R_BUF = 45568, R_ST = 2 * R_BUF;
DI void gla_unit(const GlaT& G, int b, int h, int es, LAS char* lds) {
    int tid_l_ = threadIdx.x; asm volatile("" : "+v"(tid_l_)); const int tid = tid_l_, lane = tid & 63, r32 = lane & 31, hi = lane >> 5, wid = __builtin_amdgcn_readfirstlane(tid >> 6);
    f32x16 S;
#pragma unroll
    for (int r = 0; r < 16; ++r) S[r] = 0.f;
    *(LAS u32x4*)(lds + R_ST + tid * 16) = (u32x4){0u, 0u, 0u, 0u};
    const size_t row00 = (size_t)b * SEQ;
    const int lrow = tid >> 3, lc = tid & 7;
    u32x4 rq0, rq1, rk0, rk1, ra, rv;
#define GLA_LOAD(ch) do { const size_t rw_ = row00 + 64 * (ch) + lrow; const bf16_t* pq_ = G.projC + rw_ * LDC + h * 128 + lc * 8; \
        rq0 = *(const u32x4*)(pq_ + PC_Q); rq1 = *(const u32x4*)(pq_ + PC_Q + 64); rk0 = *(const u32x4*)(pq_ + PC_K); rk1 = *(const u32x4*)(pq_ + PC_K + 64); \
        ra = *(const u32x4*)(G.att + ((size_t)((b * 4 + h) * 64 + (ch))) * 4096 + tid * 8); \
        if (tid < 256) rv = *(const u32x4*)(G.projC + (row00 + 64 * (ch) + (tid >> 2)) * LDC + PC_V + h * 256 + 32 * es + (tid & 3) * 8); \
        else if (tid < 288) rv = *(const u32x4*)(G.dec + ((size_t)((b * 4 + h) * 64 + (ch))) * 128 + (tid - 256) * 4); } while (0)
#define GLA_COMMIT(buf) do { LAS char* bb_ = lds + (buf) * R_BUF; \
        *(LAS u32x4*)(bb_ + R_QI + swo(lrow, lc * 16)) = rq0; *(LAS u32x4*)(bb_ + R_QI + swo(lrow, (lc + 8) * 16)) = rq1; \
        *(LAS u32x4*)(bb_ + R_KH + swo(lrow, lc * 16)) = rk0; *(LAS u32x4*)(bb_ + R_KH + swo(lrow, (lc + 8) * 16)) = rk1; \
        *(LAS u32x4*)(bb_ + R_ATT + lrow * 128 + ((lc ^ (lrow & 7)) * 16)) = ra; \
        if (tid < 256) *(LAS u32x4*)(bb_ + R_V + tid * 16) = rv; else if (tid < 288) *(LAS u32x4*)(bb_ + R_DEC + (tid - 256) * 16) = rv; } while (0)
    GLA_LOAD(0); GLA_COMMIT(0);
    __syncthreads();
    for (int ch = 0; ch < 64; ++ch) {
        const int par = ch & 1;
        if (ch + 1 < 64) GLA_LOAD(ch + 1);
        const LAS char* bb = lds + par * R_BUF;
        const size_t rowc = row00 + 64 * ch;
        if (wid < 2) {
            const int it = wid;
            f32x16 oacc;
#pragma unroll
            for (int r = 0; r < 16; ++r) oacc[r] = 0.f;
#pragma unroll
            for (int s = 0; s < 4; ++s) {
                if (s < 2 || it == 1) {
                    const int i = 32 * it + r32;
                    const bf16x8 A = *(const LAS bf16x8*)(bb + R_ATT + i * 128 + (((2 * s + hi) ^ (i & 7)) * 16));
                    const LAS char* vb = bb + R_V + (16 * s + 8 * hi + ((lane & 15) >> 2)) * 64 + ((lane >> 4) & 1) * 32 + (lane & 3) * 8;
                    const s16x4 lo = vtr(vb), hh = vtr(vb + 256);
                    const bf16x8 vf = (bf16x8){lo[0], lo[1], lo[2], lo[3], hh[0], hh[1], hh[2], hh[3]};
                    oacc = MFMA32(A, vf, oacc);
                }
            }
#pragma unroll
            for (int ks = 0; ks < 8; ++ks) {
                const bf16x8 A = *(const LAS bf16x8*)(bb + R_QI + swo(32 * it + r32, (16 * ks + 8 * hi) * 2));
                const bf16x8 B = *(const LAS bf16x8*)(lds + R_ST + par * 8192 + swo(r32, (16 * ks + 8 * hi) * 2));
                oacc = MFMA32(A, B, oacc);
            }
            LAS bf16_t* stg = (LAS bf16_t*)(lds + R_ST + 16384) + it * 1024;
#pragma unroll
            for (int r = 0; r < 16; ++r) stg[crow(r, hi) * 32 + r32] = (bf16_t)(cvtpk(oacc[r], 0.f) & 0xffffu);
#pragma unroll
            for (int i = 0; i < 2; ++i) { const int pc = lane + 64 * i, row = pc >> 2, q4 = pc & 3; const u32x4 v = *(const LAS u32x4*)(stg + row * 32 + q4 * 8);
                *(u32x4*)(G.O + (rowc + 32 * it + row) * DM + h * 256 + 32 * es + q4 * 8) = v; }
        } else if (wid >= 4) {
            const int dt = wid - 4;
            const LAS float* dec = (const LAS float*)(bb + R_DEC) + 32 * dt;
#pragma unroll
            for (int i = 0; i < 4; ++i) { const f32x4 dv = *(const LAS f32x4*)(dec + 8 * i + 4 * hi);
#pragma unroll
                for (int e = 0; e < 4; ++e) S[4 * i + e] *= dv[e]; }
#pragma unroll
            for (int s = 0; s < 4; ++s) {
                const int cq = 16 * s + 4 * hi + ((lane & 15) >> 2), colb = (32 * dt + 16 * ((lane >> 4) & 1) + 4 * (lane & 3)) * 2;
                const s16x4 alo = vtr(bb + R_KH + swo(cq, colb)), ahh = vtr(bb + R_KH + swo(cq + 8, colb));
                const LAS char* vb = bb + R_V + cq * 64 + ((lane >> 4) & 1) * 32 + (lane & 3) * 8;
                const s16x4 lo = vtr(vb), hh = vtr(vb + 512);
                const bf16x8 af = (bf16x8){alo[0], alo[1], alo[2], alo[3], ahh[0], ahh[1], ahh[2], ahh[3]};
                const bf16x8 vf = (bf16x8){lo[0], lo[1], lo[2], lo[3], hh[0], hh[1], hh[2], hh[3]};
                S = MFMA32(af, vf, S);
            }
#pragma unroll
            for (int i = 0; i < 4; ++i)
                *(LAS u32x2*)(lds + R_ST + (par ^ 1) * 8192 + swo(r32, (32 * dt + 8 * i + 4 * hi) * 2)) = (u32x2){cvtpk(S[4 * i], S[4 * i + 1]), cvtpk(S[4 * i + 2], S[4 * i + 3])};
        }
        if (ch + 1 < 64) GLA_COMMIT(par ^ 1);
        __syncthreads();
    }
#undef GLA_LOAD
#undef GLA_COMMIT
}

DI void gla_gate_rows2(bf16_t* O, const bf16_t* R, const float* gain, int m0, int lane) {
    u32x4 o0[2], o1[2], r0[2], r1[2];
#pragma unroll
    for (int u = 0; u < 2; ++u) { const bf16_t* Orow = O + (size_t)(m0 + u) * DM; const bf16_t* Rrow = R + (size_t)(m0 + u) * LDC;
        o0[u] = *(const u32x4*)(Orow + lane * 16); o1[u] = *(const u32x4*)(Orow + lane * 16 + 8); r0[u] = *(const u32x4*)(Rrow + lane * 16); r1[u] = *(const u32x4*)(Rrow + lane * 16 + 8); }
    const int c0 = (lane & 15) * 16;
    float gn[16];
#pragma unroll
    for (int i = 0; i < 4; ++i) { const f32x4 g4 = *(const f32x4*)(gain + c0 + 4 * i); gn[4 * i] = g4[0]; gn[4 * i + 1] = g4[1]; gn[4 * i + 2] = g4[2]; gn[4 * i + 3] = g4[3]; }
#pragma unroll
    for (int u = 0; u < 2; ++u) {
        float o[16], rr[16];
#pragma unroll
        for (int i = 0; i < 4; ++i) { o[2 * i] = bflo(o0[u][i]); o[2 * i + 1] = bfhi(o0[u][i]); o[8 + 2 * i] = bflo(o1[u][i]); o[8 + 2 * i + 1] = bfhi(o1[u][i]);
            rr[2 * i] = bflo(r0[u][i]); rr[2 * i + 1] = bfhi(r0[u][i]); rr[8 + 2 * i] = bflo(r1[u][i]); rr[8 + 2 * i + 1] = bfhi(r1[u][i]); }
        float ss = 0.f;
#pragma unroll
        for (int i = 0; i < 16; ++i) ss += o[i] * o[i];
        ss += __shfl_xor(ss, 1); ss += __shfl_xor(ss, 2); ss += __shfl_xor(ss, 4); ss += __shfl_xor(ss, 8);
        const float rs = rsqrtf(ss * (1.0f / 256.0f) + EPS);
        unsigned w[8];
#pragma unroll
        for (int i = 0; i < 8; ++i) { const float x0 = o[2 * i] * rs * gn[2 * i] * siluf_(rr[2 * i]), x1 = o[2 * i + 1] * rs * gn[2 * i + 1] * siluf_(rr[2 * i + 1]); w[i] = cvtpk(x0, x1); }
        bf16_t* Orow = O + (size_t)(m0 + u) * DM;
        *(u32x4*)(Orow + lane * 16) = (u32x4){w[0], w[1], w[2], w[3]}; *(u32x4*)(Orow + lane * 16 + 8) = (u32x4){w[4], w[5], w[6], w[7]};
    }
}
}

struct Ptrs {
    const float* in[31]; float* out; unsigned char* ws;
    DI bf16_t* bf(size_t off) const { return (bf16_t*)(ws + off); }
    DI float* f32(size_t off) const { return (float*)(ws + off); }
    DI int* i32(size_t off) const { return (int*)(ws + off); }
};
enum { I_X = 0, I_ANORM, I_AWIN, I_AQN, I_AKN, I_APEK, I_APEV, I_CK1, I_CK2, I_CV1, I_CV2, I_GBIAS, I_FQN, I_FKN, I_FFB, I_AWOUT, I_FNORM, I_FWG, I_FWU, I_FWD,
       I_CNORM, I_CWIN, I_CWA2, I_CBA, I_CONORM, I_CWOUT, I_MNORM, I_MROUTER, I_MWG, I_MWU, I_MWD };

namespace pro {
struct ConvM { const float* src; const float* src2; const float* gain; bf16_t* dst; int K, Ns, Nd, mode; };
DI int srccolA(int n) {
    const int pn = n >> 8, bj = (n >> 7) & 1, wc = (n >> 5) & 3, j = n & 31, s = 4 * pn + wc, d = 32 * bj + j;
    if (s < 8) return 64 * s + d;
    if (s < 10) return 768 + 64 * (s - 8) + d;
    if (s < 12) return 1024 + 64 * (s - 10) + d;
    if (s < 14) return 896 + 64 * (s - 12) + d;
    if (s < 16) return 1152 + 64 * (s - 14) + d;
    if (s < 18) return 512 + 64 * (s - 16) + d;
    if (s < 20) return 640 + 64 * (s - 18) + d;
    if (s < 28) return 1304 + 64 * (s - 20) + d;
    if (s < 36) return 1816 + 64 * (s - 28) + d;
    if (s < 44) return 2328 + 64 * (s - 36) + d;
    if (s == 44) { if (d < 24) return 1280 + d; if (d < 32) return 2840 + d - 24; }
    return -1;
}
DI void conv_item(const ConvM& M, int item, LAS float* scr, int lane) {
    const int nblk = M.Nd / 32, kb = item / nblk, nb = item % nblk, k0 = 64 * kb, n0 = 32 * nb;
    const int n = n0 + (lane & 31);
    const float* sp = M.src; int col = n;
    if (M.mode == 0) { if (n >= M.Ns) col = -1; }
    else if (M.mode == 1) col = srccolA(n);
    else { const int pn = n >> 8, half = (n >> 7) & 1, j = n & 127; sp = half ? M.src2 : M.src; col = 128 * pn + j; }
#pragma unroll 8
    for (int i = 0; i < 32; ++i) { const int kk = 2 * i + (lane >> 5); float w = 0.f; if (col >= 0) w = sp[(size_t)(k0 + kk) * M.Ns + col]; if (M.gain) w *= M.gain[k0 + kk]; scr[kk * 33 + (lane & 31)] = w; }
    const int c = lane & 7;
#pragma unroll
    for (int j = 0; j < 4; ++j) { const int nn = (lane >> 3) + 8 * j; const LAS float* s = scr + (8 * c) * 33 + nn;
        u32x4 o; o.x = cvtpk(s[0 * 33], s[1 * 33]); o.y = cvtpk(s[2 * 33], s[3 * 33]); o.z = cvtpk(s[4 * 33], s[5 * 33]); o.w = cvtpk(s[6 * 33], s[7 * 33]);
        *(u32x4*)(M.dst + (size_t)(n0 + nn) * M.K + k0 + 8 * c) = o; }
}
struct ConvRegs { f32x4 v[8]; };
DI void conv_big_load(ConvRegs& R, const ConvM& M, int item, int wid, int lane) {
    const int nblk = M.Nd / 256, kb = item / nblk, nb = item % nblk;
    const int k0 = 64 * kb + 8 * wid, n = 256 * nb + 4 * lane;
    const float* sp = M.src; int col = n;
    if (M.mode == 0) { if (n >= M.Ns) col = -1; }
    else if (M.mode == 1) col = srccolA(n);
    else { const int pn = n >> 8, half = (n >> 7) & 1, j = n & 127; sp = half ? M.src2 : M.src; col = 128 * pn + j; }
#pragma unroll
    for (int j = 0; j < 8; ++j) R.v[j] = (col >= 0) ? *(const f32x4*)(sp + (size_t)(k0 + j) * M.Ns + col) : (f32x4){0.f, 0.f, 0.f, 0.f};
}
DI void conv_big_store(ConvRegs& R, const ConvM& M, int item, LAS char* tile, int tid, int wid, int lane) {
    const int nblk = M.Nd / 256, kb = item / nblk, nb = item % nblk;
    if (M.gain) { const int k0 = 64 * kb + 8 * wid;
#pragma unroll
        for (int j = 0; j < 8; ++j) R.v[j] = R.v[j] * M.gain[k0 + j]; }
#pragma unroll
    for (int c = 0; c < 4; ++c) { u32x4 o; o.x = cvtpk(R.v[0][c], R.v[1][c]); o.y = cvtpk(R.v[2][c], R.v[3][c]); o.z = cvtpk(R.v[4][c], R.v[5][c]); o.w = cvtpk(R.v[6][c], R.v[7][c]);
        const int nl = 4 * lane + c; *(LAS u32x4*)(tile + nl * 128 + ((wid ^ (lane & 7)) * 16)) = o; }
    __syncthreads();
#pragma unroll
    for (int i = 0; i < 4; ++i) { const int r = (tid >> 3) + 64 * i, ch = tid & 7; const u32x4 o = *(const LAS u32x4*)(tile + r * 128 + ((ch ^ ((r >> 2) & 7)) * 16));
        *(u32x4*)(M.dst + (size_t)(256 * nb + r) * M.K + 64 * kb + 8 * ch) = o; }
    __syncthreads();
}
DI ConvM conv_desc(const Ptrs& P, int mat) {
    ConvM M; M.src2 = nullptr; M.gain = nullptr; M.mode = 0;
    switch (mat) {
    case 0: M.src = P.in[I_AWIN]; M.gain = P.in[I_ANORM]; M.dst = P.bf(WS_WA); M.K = 1024; M.Ns = IN_A; M.Nd = NA_PAD; M.mode = 1; break;
    case 1: M.src = P.in[I_AWOUT]; M.dst = P.bf(WS_WO); M.K = 1024; M.Ns = 1024; M.Nd = 1024; break;
    case 2: M.src = P.in[I_FWG]; M.src2 = P.in[I_FWU]; M.gain = P.in[I_FNORM]; M.dst = P.bf(WS_WFGU); M.K = 1024; M.Ns = DFF; M.Nd = 2 * DFF; M.mode = 2; break;
    case 3: M.src = P.in[I_FWD]; M.dst = P.bf(WS_WFD); M.K = DFF; M.Ns = 1024; M.Nd = 1024; break;
    case 4: M.src = P.in[I_CWIN]; M.gain = P.in[I_CNORM]; M.dst = P.bf(WS_WC); M.K = 1024; M.Ns = IN_C; M.Nd = NC_PAD; break;
    case 5: M.src = P.in[I_CWOUT]; M.dst = P.bf(WS_WCO); M.K = 1024; M.Ns = 1024; M.Nd = 1024; break;
    case 6: M.src = P.in[I_CK1]; M.dst = P.bf(CT_CW); M.K = 2048; M.Ns = 64; M.Nd = 64; break;
    case 7: M.src = P.in[I_CV1]; M.dst = P.bf(CT_CW + 262144); M.K = 2048; M.Ns = 64; M.Nd = 64; break;
    case 8: M.src = P.in[I_CK2]; M.dst = P.bf(CT_CW + 524288); M.K = 64; M.Ns = 64; M.Nd = 64; break;
    case 9: M.src = P.in[I_CV2]; M.dst = P.bf(CT_CW + 524288 + 8192); M.K = 64; M.Ns = 64; M.Nd = 64; break;
    default:
        if (mat < 18) { const int e = mat - 10; M.src = P.in[I_MWG] + (size_t)e * 1024 * DFF; M.src2 = P.in[I_MWU] + (size_t)e * 1024 * DFF; M.gain = P.in[I_MNORM];
            M.dst = P.bf(WS_WMGU) + (size_t)e * 2 * DFF * 1024; M.K = 1024; M.Ns = DFF; M.Nd = 2 * DFF; M.mode = 2; }
        else { const int e = mat - 18; M.src = P.in[I_MWD] + (size_t)e * DFF * 1024; M.dst = P.bf(WS_WMD) + (size_t)e * 1024 * DFF; M.K = DFF; M.Ns = 1024; M.Nd = 1024; }
    }
    return M;
}
DI int conv_items(int mat) {
    switch (mat) { case 0: return 16 * 12; case 1: return 16 * 4; case 2: return 16 * 22; case 3: return 44 * 4; case 4: return 16 * 13; case 5: return 16 * 4;
                   case 6: case 7: return 32 * 2; case 8: case 9: return 2; default: return mat < 18 ? 16 * 22 : 44 * 4; }
}
DI void prologue(const Ptrs& P, LAS char* lds) {
    int tid_l_ = threadIdx.x; asm volatile("" : "+v"(tid_l_)); const int tid = tid_l_, lane = tid & 63, wid = __builtin_amdgcn_readfirstlane(tid >> 6);
    const int gw = blockIdx.x * 8 + wid, NGW = gridDim.x * 8;
    LAS float* scr = (LAS float*)(lds + wid * 16384);
    {
        ConvRegs Ra, Rb; ConvM Ma, Mb; int ia = -1, ib = -1;
        int g = blockIdx.x, mat = 25, base = 0;
        auto advance = [&](ConvM& M, int& it) {
            it = -1;
            while (mat >= 0) {
                if (mat >= 6 && mat <= 9) { --mat; continue; }
                const int ni = conv_items(mat);
                if (g - base < ni) { M = conv_desc(P, mat); it = g - base; g += gridDim.x; return; }
                base += ni; --mat;
            }
        };
        advance(Ma, ia); if (ia >= 0) conv_big_load(Ra, Ma, ia, wid, lane);
        while (ia >= 0) {
            advance(Mb, ib); if (ib >= 0) conv_big_load(Rb, Mb, ib, wid, lane);
            conv_big_store(Ra, Ma, ia, lds + 65536 + 2048, tid, wid, lane);
            if (ib < 0) break;
            advance(Ma, ia); if (ia >= 0) conv_big_load(Ra, Ma, ia, wid, lane);
            conv_big_store(Rb, Mb, ib, lds + 65536 + 2048, tid, wid, lane);
        }
        for (int m2 = 6; m2 <= 9; ++m2) { const ConvM M = conv_desc(P, m2); const int ni = conv_items(m2); for (int it = gw; it < ni; it += NGW) conv_item(M, it, scr, lane); }
    }
    const float* x = P.in[I_X]; bf16_t* xb = P.bf(WS_XB); float* rstd0 = P.f32(CT_RSTD0);
    for (int m0 = gw * 2; m0 < T; m0 += NGW * 2) {
        f32x4 v[2][4];
#pragma unroll
        for (int u = 0; u < 2; ++u) { const f32x4* xr = (const f32x4*)(x + (size_t)(m0 + u) * DM) + lane;
#pragma unroll
            for (int j = 0; j < 4; ++j) v[u][j] = xr[64 * j]; }
#pragma unroll
        for (int u = 0; u < 2; ++u) {
            float s = 0.f;
#pragma unroll
            for (int j = 0; j < 4; ++j) s += (v[u][j][0] * v[u][j][0] + v[u][j][1] * v[u][j][1]) + (v[u][j][2] * v[u][j][2] + v[u][j][3] * v[u][j][3]);
            s = wave_sum(s);
            if (lane == 0) rstd0[m0 + u] = rsqrtf(s * (1.0f / 1024.0f) + EPS);
            u32x2* o8 = (u32x2*)(xb + (size_t)(m0 + u) * DM) + lane;
#pragma unroll
            for (int j = 0; j < 4; ++j) o8[64 * j] = (u32x2){cvtpk(v[u][j][0], v[u][j][1]), cvtpk(v[u][j][2], v[u][j][3])};
        }
    }
    float* cosT = P.f32(CT_ROPE); float* sinT = cosT + SEQ * 8;
    for (int idx = blockIdx.x * 512 + tid; idx < SEQ * 8; idx += gridDim.x * 512) {
        const int pos = idx >> 3, i = idx & 7;
        const float inv = powf(500000.0f, -(float)(2 * i) / 16.0f);
        const float ang = (float)pos * inv;
        const double rev = (double)ang * 0.15915494309189535; const float fr = (float)(rev - floor(rev));
        cosT[idx] = __builtin_amdgcn_cosf(fr); sinT[idx] = __builtin_amdgcn_sinf(fr);
    }
}

DI void fox_cum(const Ptrs& P, int bh, int lane) {
    const f32x4* lf = (const f32x4*)(P.f32(CT_LOGF) + (size_t)bh * SEQ + 64 * lane); f32x4* dst = (f32x4*)(P.f32(CT_CUM) + (size_t)bh * SEQ + 64 * lane);
    f32x4 v[16]; float tot = 0.f;
#pragma unroll
    for (int i = 0; i < 16; ++i) { v[i] = lf[i]; }
#pragma unroll
    for (int i = 0; i < 16; ++i) { v[i][1] += v[i][0]; v[i][2] += v[i][1]; v[i][3] += v[i][2]; const float t = v[i][3]; v[i] = v[i] + tot; tot += t; }
    float inc = tot;
#pragma unroll
    for (int o = 1; o < 64; o <<= 1) { const float t = __shfl_up(inc, o); if (lane >= o) inc += t; }
    const float base = inc - tot;
#pragma unroll
    for (int i = 0; i < 16; ++i) dst[i] = (v[i] + base) * (-LOG2E);
}

DI void compress_item(const Ptrs& P, int item, LAS char* lds) {
    int tid_l_ = threadIdx.x; asm volatile("" : "+v"(tid_l_)); const int tid = tid_l_, lane = tid & 63, r32 = lane & 31, hi = lane >> 5, wid = __builtin_amdgcn_readfirstlane(tid >> 6);
    const int kv = item >> 7, b = (item >> 4) & 7, g = (item >> 3) & 1, nt = item & 7;
    const bf16_t* projA = P.bf(WS_BIG);
    const float* pe = (kv ? P.in[I_APEV] : P.in[I_APEK]);
    const bf16_t* w1t = P.bf(CT_CW + (kv ? 262144 : 0)); const bf16_t* w2t = P.bf(CT_CW + 524288 + (kv ? 8192 : 0));
    int n = 32 * nt + r32; if (n > 254) n = 254;
    f32x16 c0, c1;
#pragma unroll
    for (int r = 0; r < 16; ++r) { c0[r] = 0.f; c1[r] = 0.f; }
#pragma unroll 8
    for (int kk = 0; kk < 16; ++kk) { const int ks = 16 * wid + kk;
        const int l = ks >> 2, d = 16 * (ks & 3) + 8 * hi;
        const u32x4 raw = *(const u32x4*)(projA + ((size_t)b * SEQ + 16 * n + l) * LDA + (kv ? PA_VC : PA_KC) + g * 64 + d);
        const f32x4 p0 = *(const f32x4*)(pe + l * 64 + d), p1 = *(const f32x4*)(pe + l * 64 + d + 4);
        u32x4 aw; aw.x = cvtpk(bflo(raw.x) + p0[0], bfhi(raw.x) + p0[1]); aw.y = cvtpk(bflo(raw.y) + p0[2], bfhi(raw.y) + p0[3]);
        aw.z = cvtpk(bflo(raw.z) + p1[0], bfhi(raw.z) + p1[1]); aw.w = cvtpk(bflo(raw.w) + p1[2], bfhi(raw.w) + p1[3]);
        const bf16x8 A = __builtin_bit_cast(bf16x8, aw);
        const bf16x8 B0 = *(const bf16x8*)(w1t + (size_t)r32 * 2048 + 16 * ks + 8 * hi), B1 = *(const bf16x8*)(w1t + (size_t)(32 + r32) * 2048 + 16 * ks + 8 * hi);
        c0 = MFMA32(A, B0, c0); c1 = MFMA32(A, B1, c1);
    }
    LAS float* red = (LAS float*)lds + wid * 2048;
#pragma unroll
    for (int r = 0; r < 16; ++r) { const int nn = att::crow(r, hi); red[nn * 64 + r32] = c0[r]; red[nn * 64 + 32 + r32] = c1[r]; }
    __syncthreads();
    {
        LAS bf16_t* H1 = (LAS bf16_t*)(lds + 65536);
        const LAS float* rd = (const LAS float*)lds;
        float s4[4];
#pragma unroll
        for (int e = 0; e < 4; ++e) { float s = 0.f;
#pragma unroll
            for (int w = 0; w < 8; ++w) s += rd[w * 2048 + tid * 4 + e];
            s4[e] = gelu_tanh(s); }
        *(LAS u32x2*)(H1 + tid * 4) = (u32x2){cvtpk(s4[0], s4[1]), cvtpk(s4[2], s4[3])};
    }
    __syncthreads();
    if (wid == 0) {
        f32x16 o0, o1;
#pragma unroll
        for (int r = 0; r < 16; ++r) { o0[r] = 0.f; o1[r] = 0.f; }
#pragma unroll
        for (int ks = 0; ks < 4; ++ks) {
            const bf16x8 A = *(const LAS bf16x8*)(lds + 65536 + r32 * 128 + (16 * ks + 8 * hi) * 2);
            const bf16x8 B0 = *(const bf16x8*)(w2t + r32 * 64 + 16 * ks + 8 * hi), B1 = *(const bf16x8*)(w2t + (32 + r32) * 64 + 16 * ks + 8 * hi);
            o0 = MFMA32(A, B0, o0); o1 = MFMA32(A, B1, o1);
        }
        bf16_t* dst = P.bf(kv ? CT_VCMP : CT_KCMP);
        if (kv == 0) {
            const float* kn = P.in[I_AKN]; const float g0 = kn[r32], g1 = kn[32 + r32];
            const float* cosT = P.f32(CT_ROPE); const float* sinT = cosT + SEQ * 8;
#pragma unroll
            for (int r = 0; r < 16; ++r) {
                float ss = o0[r] * o0[r] + o1[r] * o1[r];
                ss += __shfl_xor(ss, 1); ss += __shfl_xor(ss, 2); ss += __shfl_xor(ss, 4); ss += __shfl_xor(ss, 8); ss += __shfl_xor(ss, 16);
                const float rs = rsqrtf(ss * (1.0f / 64.0f) + EPS);
                float y0 = o0[r] * rs * g0; const float y1 = o1[r] * rs * g1;
                const float oth = __shfl_xor(y0, 8);
                const int nn = 32 * nt + att::crow(r, hi); const int pos = (16 * nn + 31) & (SEQ - 1);
                const float cc = cosT[pos * 8 + (r32 & 7)], sn = sinT[pos * 8 + (r32 & 7)];
                if (r32 < 8) y0 = y0 * cc - oth * sn; else if (r32 < 16) y0 = oth * sn + y0 * cc;
                o0[r] = y0; o1[r] = y1;
            }
        }
#pragma unroll
        for (int r = 0; r < 16; ++r) {
            const int nn = 32 * nt + att::crow(r, hi);
            const bool pad = nn > 254;
            bf16_t* dp = dst + (((size_t)b * NCMP_PAD + nn) * 2 + g) * 64;
            dp[r32] = pad ? (bf16_t)0 : (bf16_t)(cvtpk(o0[r], 0.f) & 0xffffu); dp[32 + r32] = pad ? (bf16_t)0 : (bf16_t)(cvtpk(o1[r], 0.f) & 0xffffu);
        }
    }
    __syncthreads();
}
}

namespace moe {
DI void route_block(const Ptrs& P, int blk, LAS char* lds) {
    int tid_l_ = threadIdx.x; asm volatile("" : "+v"(tid_l_)); const int tid = tid_l_, lane = tid & 63, r32 = lane & 31, hi = lane >> 5, wid = __builtin_amdgcn_readfirstlane(tid >> 6);
    constexpr int RPITCH = 1032;
    LAS bf16_t* RBH = (LAS bf16_t*)lds; LAS bf16_t* RBL = RBH + 8 * RPITCH;
    LAS float* PART = (LAS float*)(lds + 36864); LAS float* LG = (LAS float*)(lds + 40960);
    LAS int* einfo = (LAS int*)(lds + 33280);
    const float* router = P.in[I_MROUTER]; const float* mg = P.in[I_MNORM];
    for (int i = tid; i < 8192; i += 512) { const int k = i >> 3, e = i & 7; const float v = router[i] * mg[k];
        const unsigned hb = cvtpk(v, 0.f) & 0xffffu; const float vh = __uint_as_float(hb << 16); const unsigned lb = cvtpk(v - vh, 0.f) & 0xffffu;
        RBH[e * RPITCH + k] = (bf16_t)hb; RBL[e * RPITCH + k] = (bf16_t)lb; }
    __syncthreads();
    const bf16_t* xb3 = P.bf(WS_HM);
    {
        const int rt = wid & 3, kh = wid >> 2;
        const bf16_t* ap = xb3 + ((size_t)blk * 128 + 32 * rt + r32) * DM + 512 * kh + 8 * hi;
        const LAS bf16_t* bh = RBH + (r32 & 7) * RPITCH + 512 * kh + 8 * hi; const LAS bf16_t* bl = RBL + (r32 & 7) * RPITCH + 512 * kh + 8 * hi;
        f32x16 c;
#pragma unroll
        for (int r = 0; r < 16; ++r) c[r] = 0.f;
#pragma unroll 8
        for (int ks = 0; ks < 32; ++ks) {
            const bf16x8 A = *(const bf16x8*)(ap + 16 * ks);
            c = MFMA32(A, *(const LAS bf16x8*)(bh + 16 * ks), c); c = MFMA32(A, *(const LAS bf16x8*)(bl + 16 * ks), c);
        }
        if (kh == 1 && r32 < 8) {
#pragma unroll
            for (int r = 0; r < 16; ++r) PART[(32 * rt + att::crow(r, hi)) * 8 + r32] = c[r];
        }
        __syncthreads();
        if (kh == 0 && r32 < 8) {
#pragma unroll
            for (int r = 0; r < 16; ++r) { const int tk = 32 * rt + att::crow(r, hi); LG[tk * 8 + r32] = c[r] + PART[tk * 8 + r32]; }
        }
        __syncthreads();
    }
    if (tid < 128) {
        const int tl = tid, t = blk * 128 + tl;
        const f32x4 la = *(const LAS f32x4*)(LG + tl * 8), lb = *(const LAS f32x4*)(LG + tl * 8 + 4);
        const float rs = pg8::row_rstd(P.f32(CT_SS3), t);
        const float acc[8] = {la[0], la[1], la[2], la[3], lb[0], lb[1], lb[2], lb[3]};
        int e1 = 0; float l1 = acc[0] * rs;
#pragma unroll
        for (int e = 1; e < 8; ++e) { const float l = acc[e] * rs; if (l > l1) { l1 = l; e1 = e; } }
        int e2 = -1; float l2 = -3.0e38f;
#pragma unroll
        for (int e = 0; e < 8; ++e) { const float l = acc[e] * rs; if (e != e1 && l > l2) { l2 = l; e2 = e; } }
        const float w1 = 1.0f / (1.0f + __expf(l2 - l1));
        einfo[tl * 2] = e1; einfo[tl * 2 + 1] = e2;
        P.f32(MO_TOKW)[(size_t)t * 2] = w1; P.f32(MO_TOKW)[(size_t)t * 2 + 1] = 1.0f - w1;
        P.f32(MO_TOKR)[t] = rs;
    }
    __syncthreads();
    LAS int* rk = (LAS int*)(lds + 34304);
    if (tid < 256) { const int e = einfo[tid]; int r = 0; for (int j = 0; j < tid; ++j) r += (einfo[j] == e) ? 1 : 0; rk[tid] = r; }
    if (tid >= 256 && tid < 264) { const int e = tid - 256; int c = 0; for (int j = 0; j < 256; ++j) c += (einfo[j] == e) ? 1 : 0; P.i32(MO_HIST)[blk * 8 + e] = c; }
    __syncthreads();
    if (tid < 128) { const int t = blk * 128 + tid; ((unsigned*)P.i32(MO_TOKE))[t] = (unsigned)einfo[2 * tid] | ((unsigned)einfo[2 * tid + 1] << 4) | ((unsigned)rk[2 * tid] << 8) | ((unsigned)rk[2 * tid + 1] << 20); }
    __syncthreads();
}
DI void scatter_block(const Ptrs& P, int blk, LAS char* lds) {
    int tid_l_ = threadIdx.x; asm volatile("" : "+v"(tid_l_)); const int tid = tid_l_, lane = tid & 63, wid = __builtin_amdgcn_readfirstlane(tid >> 6);
    LAS int* sh = (LAS int*)lds;
    const int* hist = P.i32(MO_HIST);
    { typedef int i32x4 __attribute__((ext_vector_type(4))); *(LAS i32x4*)(sh + 64 + tid * 4) = *(const i32x4*)(hist + tid * 4); }
    __syncthreads();
    if (tid < 8) { int c = 0, pre = 0; for (int j = 0; j < 256; ++j) { const int v = sh[64 + j * 8 + tid]; c += v; if (j < blk) pre += v; } sh[tid] = c; sh[8 + tid] = pre; }
    __syncthreads();
    if (tid == 0) { int acc = 0; for (int e = 0; e < 8; ++e) { sh[16 + e] = acc; acc += ((sh[e] + 255) >> 8) << 8; } sh[24] = acc; }
    __syncthreads();
    const bf16_t* xb3 = P.bf(WS_HM); bf16_t* xy = P.bf(WS_XY);
    for (int q0 = wid * 32; q0 < wid * 32 + 32; q0 += 4) {
        u32x4 a[4], c[4]; int rowv[4];
#pragma unroll
        for (int u = 0; u < 4; ++u) {
            const int q = q0 + u, tl = q >> 1, slot = q & 1, t = blk * 128 + tl;
            const unsigned info = ((const unsigned*)P.i32(MO_TOKE))[t];
            const int e = slot ? (info >> 4) & 15 : info & 15, lr = slot ? (info >> 20) & 4095 : (info >> 8) & 4095;
            rowv[u] = sh[16 + e] + sh[8 + e] + lr;
            const u32x4* src = (const u32x4*)(xb3 + (size_t)t * DM) + lane;
            a[u] = src[0]; c[u] = src[64];
            if (lane == 0) { P.f32(MO_RSCALE)[rowv[u]] = P.f32(MO_TOKR)[t]; P.f32(MO_RGATE)[rowv[u]] = P.f32(MO_TOKW)[(size_t)t * 2 + slot]; P.f32(MO_RKEEP)[rowv[u]] = slot ? 0.f : 1.f; P.i32(MO_POS)[(size_t)t * 2 + slot] = rowv[u]; }
        }
#pragma unroll
        for (int u = 0; u < 4; ++u) { u32x4* dst = (u32x4*)(xy + (size_t)rowv[u] * DM) + lane; dst[0] = a[u]; dst[64] = c[u]; }
    }
    if (blk < 8) {
        const int e = blk, r0 = sh[16 + e] + sh[e], r1 = sh[16 + e + 1];
        for (int row = r0 + wid; row < r1; row += 8) { u32x2* o8 = (u32x2*)(xy + (size_t)row * DM) + lane;
#pragma unroll
            for (int j = 0; j < 4; ++j) o8[64 * j] = (u32x2){0u, 0u};
            if (lane == 0) { P.f32(MO_RSCALE)[row] = 0.f; P.f32(MO_RGATE)[row] = 0.f; P.f32(MO_RKEEP)[row] = 0.f; } }
    }
    if (blk == 8) {
        int* te = P.i32(MO_TILEE); const int ntl = sh[24] >> 8;
        for (int tl = tid; tl < 271; tl += 512) { int e = 0; for (int k = 1; k < 8; ++k) if (tl * 256 >= sh[16 + k]) e = k; te[tl] = e; }
        if (tid == 0) te[271] = ntl;
    }
    __syncthreads();
}
template <int NR> DI void combine_rows(const Ptrs& P, int t0, int lane) {
    const bf16_t* y = P.bf(WS_XY);
    int p1[NR], p2[NR];
#pragma unroll
    for (int u = 0; u < NR; ++u) { p1[u] = P.i32(MO_POS)[(size_t)(t0 + u) * 2]; p2[u] = P.i32(MO_POS)[(size_t)(t0 + u) * 2 + 1]; }
    u32x2 a[NR][4], c[NR][4];
#pragma unroll
    for (int u = 0; u < NR; ++u) {
        const u32x2* y1 = (const u32x2*)(y + (size_t)p1[u] * DM) + lane; const u32x2* y2 = (const u32x2*)(y + (size_t)p2[u] * DM) + lane;
#pragma unroll
        for (int j = 0; j < 4; ++j) { a[u][j] = y1[64 * j]; c[u][j] = y2[64 * j]; }
    }
#pragma unroll
    for (int u = 0; u < NR; ++u) {
        f32x4* orow = (f32x4*)(P.out + (size_t)(t0 + u) * DM) + lane;
#pragma unroll
        for (int j = 0; j < 4; ++j) { f32x4 w; w[0] = bflo(a[u][j][0]) + bflo(c[u][j][0]); w[1] = bfhi(a[u][j][0]) + bfhi(c[u][j][0]); w[2] = bflo(a[u][j][1]) + bflo(c[u][j][1]); w[3] = bfhi(a[u][j][1]) + bfhi(c[u][j][1]); orow[64 * j] = w; }
    }
}
}
#define XB_TMO      128
#define XB_XCNT(j)  (256  + 64 * (j))
#define XB_XSUB(j)  (1280 + 64 * (j))
#define XB_XGEN(j)  (2304 + 64 * (j))
#define XB_TOP      3328
#define XB_TOPGEN   3392
#define XCD_BAR_WORDS 3456
#define XB_SPIN_CAP (1u << 18)

__device__ __forceinline__ unsigned xb_ld(unsigned* p)              { return __hip_atomic_load(p, __ATOMIC_RELAXED, __HIP_MEMORY_SCOPE_AGENT); }
__device__ __forceinline__ unsigned xb_add(unsigned* p, unsigned v) { return __hip_atomic_fetch_add(p, v, __ATOMIC_RELAXED, __HIP_MEMORY_SCOPE_AGENT); }
__device__ __forceinline__ unsigned xb_xcc_id() { return (unsigned)__builtin_amdgcn_s_getreg((3 << 11) | 20) & 0xFu; }
#define XB_SPIN(cond, bar) do { unsigned _sp = 0; while (cond) { __builtin_amdgcn_s_sleep(1); \
    if ((++_sp & 255u) == 0u) { if (xb_ld(&(bar)[XB_TMO])) break; if (_sp > XB_SPIN_CAP) { atomicAdd(&(bar)[XB_TMO], 1u); break; } } } } while (0)

struct XcdBarrier {
    unsigned* bar; unsigned x;
    volatile LAS unsigned* st;
};

__device__ __forceinline__ XcdBarrier xcd_barrier_post(unsigned* bar, volatile LAS unsigned* st) {
    XcdBarrier b; b.bar = bar; b.x = xb_xcc_id(); b.st = st;
    if (threadIdx.x == 0) (void)xb_add(&bar[XB_XCNT(b.x)], 1u);
    return b;
}
__device__ __forceinline__ void xcd_barrier_complete(unsigned* bar, unsigned x, unsigned& nloc, unsigned& nx) {
    const unsigned G = gridDim.x * gridDim.y * gridDim.z;
    unsigned sum, cnt, mine, sp = 0u;
    for (;;) {
        sum = 0u; cnt = 0u; mine = 0u;
#pragma unroll
        for (unsigned j = 0; j < 16; ++j) { const unsigned c = xb_ld(&bar[XB_XCNT(j)]); sum += c; cnt += (c > 0u) ? 1u : 0u; mine = (j == x) ? c : mine; }
        if (sum == G) break;
        __builtin_amdgcn_s_sleep(1);
        if ((++sp & 255u) == 0u) { if (xb_ld(&bar[XB_TMO])) break; if (sp > XB_SPIN_CAP) { atomicAdd(&bar[XB_TMO], 1u); break; } }
    }
    nloc = mine > 0u ? mine : 1u; nx = cnt > 0u ? cnt : 1u;
}

__device__ __forceinline__ void xcd_barrier(const XcdBarrier& b) {
    asm volatile("s_waitcnt vmcnt(0)" ::: "memory");
    __syncthreads();
    if (threadIdx.x == 0) {
        unsigned* bar = b.bar;
        __builtin_amdgcn_s_waitcnt(0);
        unsigned nloc = b.st[0], nx = b.st[1];
        if (nloc == 0u) { xcd_barrier_complete(bar, b.x, nloc, nx); b.st[0] = nloc; b.st[1] = nx; }
        const unsigned old = xb_add(&bar[XB_XSUB(b.x)], 1u);
        const unsigned gen = old / nloc;
        if (old + 1u == (gen + 1u) * nloc) {
            __builtin_amdgcn_fence(__ATOMIC_RELEASE, "agent");
            asm volatile("s_waitcnt vmcnt(0)" ::: "memory");
            const unsigned og = xb_add(&bar[XB_TOP], 1u);
            const unsigned tg = og / nx;
            if (og + 1u == (tg + 1u) * nx) xb_add(&bar[XB_TOPGEN], 1u);
            else XB_SPIN(xb_ld(&bar[XB_TOPGEN]) == tg, bar);
            __builtin_amdgcn_fence(__ATOMIC_ACQUIRE, "agent");
            xb_add(&bar[XB_XGEN(b.x)], 1u);
            asm volatile("s_waitcnt vmcnt(0)" ::: "memory");
        } else {
            XB_SPIN(xb_ld(&bar[XB_XGEN(b.x)]) == gen, bar);
            __builtin_amdgcn_fence(__ATOMIC_ACQUIRE, "agent");
            asm volatile("s_waitcnt vmcnt(0)" ::: "memory");
        }
    }
    __syncthreads();
}

#ifndef MK_N_LAUNCHES
#define MK_N_LAUNCHES 1
#endif
constexpr int N_PHASES = 18;

__global__ void __launch_bounds__(512, 2) mega_fwd(Args args) {
    extern __shared__ __attribute__((aligned(16))) unsigned char lds_raw[];
    LAS char* lds = (LAS char*)lds_raw;
    cg::grid_group grid = cg::this_grid();
    Ptrs P;
#pragma unroll
    for (int i = 0; i < 31; ++i) P.in[i] = args.in[i];
    P.out = args.out; P.ws = args.ws;
    const int lo = args.ph_lo, hi_ = args.ph_hi;
    const int tid = threadIdx.x, lane = tid & 63, wid = __builtin_amdgcn_readfirstlane(tid >> 6);
    const int G = gridDim.x, gw = blockIdx.x * 8 + wid, NGW = G * 8;
#define IN(k) (lo <= (k) && (k) < hi_)
    { volatile LAS unsigned* st0 = (volatile LAS unsigned*)(lds_raw + LDS_MISC); if (tid < 64) st0[tid] = 0u; }
    __syncthreads();
    XcdBarrier xbar; xbar.bar = (unsigned*)(args.ws + CT_BAR); xbar.x = 0; xbar.st = (volatile LAS unsigned*)(lds_raw + LDS_MISC) + 8;
    const bool one_launch = (lo == 0 && hi_ == N_PHASES);
    if (one_launch) { if (blockIdx.x == 0) { for (int i = tid; i < 1024; i += 512) ((unsigned*)(args.ws + CT_CTR))[i] = 0u; for (int i = tid; i < 4096; i += 512) ((unsigned*)(args.ws + CT_BAR))[i] = 0u; } }
    else xbar = xcd_barrier_post((unsigned*)(args.ws + CT_BAR), (volatile LAS unsigned*)(lds_raw + LDS_MISC) + 8);
#define SEAM(k) do { if (IN(k) && IN((k) + 1)) { if ((k) == 0) { grid.sync(); if (one_launch) xbar = xcd_barrier_post((unsigned*)(args.ws + CT_BAR), (volatile LAS unsigned*)(lds_raw + LDS_MISC) + 8); } else xcd_barrier(xbar); } } while (0)
    LAS unsigned char* glds = (LAS unsigned char*)lds_raw;

    if (IN(0)) { pro::prologue(P, lds); }
    SEAM(0);
    if (IN(1)) {
        pg8::Gemm g{P.bf(WS_XB), P.bf(WS_WA), T, NA_PAD, DM}; pg8::StaticOrder S; S.init(T, NA_PAD, G, (int)blockIdx.x);
        const float* cosT = P.f32(CT_ROPE);
        pg8::EpiInA E{P.bf(WS_BIG), P.f32(CT_RSTD0), cosT, cosT + SEQ * 8, P.in[I_AQN], P.in[I_AKN], P.in[I_FQN], P.in[I_FKN], P.in[I_GBIAS], P.in[I_FFB], P.f32(CT_GATE), P.f32(CT_LOGF)};
        pg8::gemm_phase<pg8::EpiInA, pg8::StaticOrder, true, true>(glds, g, S, E);
    }
    SEAM(1);
    if (IN(2)) {
        if (gw < 64) pro::fox_cum(P, gw, lane);
        for (int it = blockIdx.x; it < 256; it += G) pro::compress_item(P, it, lds);
    }
    SEAM(2);
    if (IN(3)) {
        att::Tensors AT{P.bf(WS_BIG), P.bf(CT_KCMP), P.bf(CT_VCMP), P.f32(CT_GATE), P.f32(CT_CUM), P.bf(WS_O), P.in[I_FQN], P.in[I_FKN], P.in[I_AQN], P.in[I_AKN]};
        att::attn_phase(AT, (unsigned*)(P.ws + CT_CTR), lds);
    }
    SEAM(3);
    if (IN(4)) {
        pg8::Gemm g{P.bf(WS_O), P.bf(WS_WO), T, DM, DM}; pg8::StaticOrder S; S.init(T, DM, G, (int)blockIdx.x);
        pg8::EpiResid<true> E{P.in[I_X], P.bf(WS_XB), P.f32(CT_SS1)};
        pg8::gemm_phase<pg8::EpiResid<true>, pg8::StaticOrder, true, true>(glds, g, S, E);
    }
    SEAM(4);
    if (IN(5)) {
        pg8::Gemm g{P.bf(WS_XB), P.bf(WS_WFGU), T, 2 * DFF, DM}; pg8::StaticOrder S; S.init(T, 2 * DFF, G, (int)blockIdx.x);
        pg8::EpiSwiglu<false> E{P.bf(WS_BIG), P.f32(CT_SS1), 0};
        pg8::gemm_phase<pg8::EpiSwiglu<false>, pg8::StaticOrder, true, true>(glds, g, S, E);
    }
    SEAM(5);
    if (IN(6)) {
        pg8::Gemm g{P.bf(WS_BIG), P.bf(WS_WFD), T, DM, DFF}; pg8::StaticOrder S; S.init(T, DM, G, (int)blockIdx.x);
        pg8::EpiResid<false> E{P.bf(WS_XB), P.bf(WS_XB), P.f32(CT_SS2)};
        pg8::gemm_phase<pg8::EpiResid<false>, pg8::StaticOrder, true, true>(glds, g, S, E);
    }
    SEAM(6);
    if (IN(7)) {
        for (int it = blockIdx.x; it < T / 128; it += G) gla::gla_a1_item(P.bf(WS_XB), P.bf(WS_WC) + (size_t)LDC * DM, P.f32(CT_SS2), P.f32(CT_A1), it, lds);
        pg8::Gemm g{P.bf(WS_XB), P.bf(WS_WC), T, LDC, DM}; pg8::StaticOrder S; S.init(T, LDC, G, (int)blockIdx.x);
        pg8::EpiGlaIn E{P.bf(WS_BIG), P.f32(CT_SS2)};
        pg8::gemm_phase<pg8::EpiGlaIn, pg8::StaticOrder, true, true>(glds, g, S, E);
    }
    SEAM(7);
    if (IN(8)) {
        gla::GlaT GT{P.bf(WS_BIG), P.f32(CT_A1), P.in[I_CWA2], P.in[I_CBA], P.bf(WS_O), P.bf(WS_ATT), P.f32(CT_GATE)};
        {
            gla::PrepRegs Ra, Rb; int it = blockIdx.x;
            if (it < 2048) gla::prep_load(Ra, GT, it, tid);
            while (it < 2048) {
                const int i1 = it + G; if (i1 < 2048) gla::prep_load(Rb, GT, i1, tid);
                gla::gla_prep(GT, it, Ra, lds);
                if (i1 >= 2048) break;
                const int i2 = i1 + G; if (i2 < 2048) gla::prep_load(Ra, GT, i2, tid);
                gla::gla_prep(GT, i1, Rb, lds);
                it = i2;
            }
        }
        xcd_barrier(xbar);
        for (int u = blockIdx.x; u < 256; u += G) { const int bh = (u & 7) * 4 + (u >> 6), es = (u >> 3) & 7; gla::gla_unit(GT, bh >> 2, bh & 3, es, lds); }
    }
    SEAM(8);
    if (IN(9)) {
        for (int m = gw * 2; m < T; m += NGW * 2) gla::gla_gate_rows2(P.bf(WS_O), P.bf(WS_BIG) + PC_R, P.in[I_CONORM], m, lane);
    }
    SEAM(9);
    if (IN(10)) {
        pg8::Gemm g{P.bf(WS_O), P.bf(WS_WCO), T, DM, DM}; pg8::StaticOrder S; S.init(T, DM, G, (int)blockIdx.x);
        pg8::EpiResid<false> E{P.bf(WS_XB), P.bf(WS_HM), P.f32(CT_SS3)};
        pg8::gemm_phase<pg8::EpiResid<false>, pg8::StaticOrder, true, true>(glds, g, S, E);
    }
    SEAM(10);
    if (IN(11)) { for (int blk = blockIdx.x; blk < 256; blk += G) moe::route_block(P, blk, lds); }
    SEAM(11);
    if (IN(12)) { for (int blk = blockIdx.x; blk < 256; blk += G) moe::scatter_block(P, blk, lds); }
    SEAM(12);
#pragma unroll 1
    for (int pass = 0; pass < 2; ++pass) {
        const int tile0 = pass * MOE_PASS_TILES;
        if (IN(13 + 2 * pass)) {
            int ntp = __builtin_amdgcn_readfirstlane(P.i32(MO_TILEE)[271]) - tile0; { const int cap = pass == 0 ? MOE_PASS_TILES : MOE_PASS1_MAX; ntp = ntp < 0 ? 0 : (ntp > cap ? cap : ntp); }
            if (ntp > 0) {
                pg8::Gemm g{P.bf(WS_XY) + (size_t)tile0 * 256 * DM, P.bf(WS_WMGU), ntp * 256, 2 * DFF, DM};
                pg8::GroupedOrder S; S.so.init(ntp * 256, 2 * DFF, G, (int)blockIdx.x); S.tile_e = P.i32(MO_TILEE); S.tile0 = tile0; S.nN = 22;
                pg8::EpiSwiglu<true> E{P.bf(WS_HM), P.f32(MO_RSCALE), tile0 * 256};
                pg8::gemm_phase<pg8::EpiSwiglu<true>, pg8::GroupedOrder, true, true>(glds, g, S, E);
            }
        }
        SEAM(13 + 2 * pass);
        if (IN(14 + 2 * pass)) {
            int ntp = __builtin_amdgcn_readfirstlane(P.i32(MO_TILEE)[271]) - tile0; { const int cap = pass == 0 ? MOE_PASS_TILES : MOE_PASS1_MAX; ntp = ntp < 0 ? 0 : (ntp > cap ? cap : ntp); }
            if (ntp > 0) {
                pg8::Gemm g{P.bf(WS_HM), P.bf(WS_WMD), ntp * 256, DM, DFF};
                pg8::GroupedOrder S; S.so.init(ntp * 256, DM, G, (int)blockIdx.x); S.tile_e = P.i32(MO_TILEE); S.tile0 = tile0; S.nN = 4;
                pg8::EpiMoeDown E{P.bf(WS_XY), P.f32(MO_RGATE), P.f32(MO_RKEEP), tile0 * 256};
                pg8::gemm_phase<pg8::EpiMoeDown, pg8::GroupedOrder, true, true>(glds, g, S, E);
            }
        }
        SEAM(14 + 2 * pass);
    }
    if (IN(17)) { for (int m = gw * 2; m < T; m += NGW * 2) moe::combine_rows<2>(P, m, lane); }
#undef IN
#undef SEAM
}

extern "C" void kernel_launch(void* const* d_in, const int* in_sizes, int n_in, void* d_out, int out_size, void* d_ws, size_t ws_size, hipStream_t stream) {
    static int grid = 0;
    if (grid == 0) {
        if (n_in != 31 || out_size != T * DM || ws_size < WS_END) { fprintf(stderr, "kernel_launch: unexpected problem (n_in %d, out %d, ws %zu)\n", n_in, out_size, ws_size); grid = -1; return; }
        int dev = 0, cus = 0, per_cu = 0;
        hipGetDevice(&dev); hipDeviceGetAttribute(&cus, hipDeviceAttributeMultiprocessorCount, dev);
        if (hipFuncSetAttribute((const void*)mega_fwd, hipFuncAttributeMaxDynamicSharedMemorySize, LDS_BYTES) != hipSuccess) { fprintf(stderr, "kernel_launch: hipFuncSetAttribute failed\n"); grid = -1; return; }
        if (hipOccupancyMaxActiveBlocksPerMultiprocessor(&per_cu, (const void*)mega_fwd, 512, LDS_BYTES) != hipSuccess || per_cu < 1) { fprintf(stderr, "kernel_launch: occupancy query says %d\n", per_cu); per_cu = 1; }
        (void)hipGetLastError();
        grid = cus * 1;
        if (per_cu < 1) grid = -1;
    }
    if (grid < 0) return;
#if MK_N_LAUNCHES != 1
    hipMemsetAsync((char*)d_ws, 0, CT_ZERO_BYTES, stream);
#endif
    Args a{};
    for (int i = 0; i < 31; ++i) a.in[i] = (const float*)d_in[i];
    a.out = (float*)d_out; a.ws = (unsigned char*)d_ws;
#if MK_N_LAUNCHES == 1
    a.ph_lo = 0; a.ph_hi = N_PHASES;
    void* kargs[] = {&a};
    hipError_t e = hipLaunchCooperativeKernel((const void*)mega_fwd, dim3(grid), dim3(512), kargs, LDS_BYTES, stream);
    if (e != hipSuccess) fprintf(stderr, "cooperative launch failed: %s (grid %d)\n", hipGetErrorString(e), grid);
#else
    for (int ph = 0; ph < N_PHASES; ++ph) {
        a.ph_lo = ph; a.ph_hi = ph + 1;
        hipLaunchKernelGGL(mega_fwd, dim3(grid), dim3(512), LDS_BYTES, stream, a);
    }
#endif
}
```

```cpp
#include <hip/hip_runtime.h>
#include <hip/hip_cooperative_groups.h>
#include <cstdio>
#include <cstdint>
namespace cg = cooperative_groups;

#define DI __device__ __forceinline__
#define LAS __attribute__((address_space(3)))
#define GAS __attribute__((address_space(1)))
typedef unsigned short bf16_t;
typedef short bf16x8 __attribute__((ext_vector_type(8)));
typedef short s16x4 __attribute__((ext_vector_type(4)));
typedef float f32x2 __attribute__((ext_vector_type(2)));
typedef float f32x4 __attribute__((ext_vector_type(4)));
typedef float f32x16 __attribute__((ext_vector_type(16)));
typedef unsigned u32x2 __attribute__((ext_vector_type(2)));
typedef unsigned u32x4 __attribute__((ext_vector_type(4)));

constexpr int BATCH = 8, SEQ = 4096, DM = 1024, T = BATCH * SEQ;
constexpr int HD = 64;
constexpr int NSA_H = 8, NSA_G = 2, FOX_H = 8;
constexpr int NCMP = 255, NCMP_PAD = 256;
constexpr int IN_A = 2848, LDA = 2816  , NA_PAD = 3072;
constexpr int DFF = 2816;
constexpr int IN_C = 3088, LDC = 3072  , NC_PAD = 3328;
constexpr int NEXP = 8;
constexpr int MOE_TILES_MAX = 264, MOE_PASS_TILES = 128, MOE_PASS1_MAX = 136;
constexpr float EPS = 1e-6f;
constexpr float LOG2E = 1.4426950408889634f;
constexpr float QSCALE = 0.125f * LOG2E;
constexpr int PA_QA = 0, PA_KSL = 512, PA_KWN = 640, PA_VSL = 768, PA_VWN = 896, PA_KC = 1024, PA_VC = 1152, PA_QB = 1280, PA_KB = 1792, PA_VB = 2304;
constexpr int PC_Q = 0, PC_K = 512, PC_V = 1024, PC_R = 2048;

constexpr size_t MiB = 1u << 20;
constexpr size_t CT_CTR = 0;
constexpr size_t CT_BAR = 65536;
constexpr size_t CT_SS1 = 501 * MiB, CT_SS2 = 503 * MiB, CT_SS3 = 505 * MiB;
constexpr size_t CT_ZERO_BYTES = 1 * MiB;
static_assert(CT_BAR + 16384 <= CT_ZERO_BYTES, "zero region");
constexpr size_t CT_RSTD0 = 1 * MiB;
constexpr size_t CT_ROPE = CT_RSTD0 + (size_t)T * 4;
constexpr size_t CT_LOGF = 2 * MiB;
constexpr size_t CT_CUM = 3 * MiB;
constexpr size_t CT_GATE = 4 * MiB;
constexpr size_t CT_A1 = 7 * MiB;
constexpr size_t CT_KCMP = 9 * MiB, CT_VCMP = CT_KCMP + 512 * 1024;
constexpr size_t CT_CW = 10 * MiB;
constexpr size_t CT_MOE = 11 * MiB;
constexpr size_t WS_WA = 16 * MiB;
constexpr size_t WS_WO = WS_WA + 6 * MiB;
constexpr size_t WS_WFGU = WS_WO + 2 * MiB;
constexpr size_t WS_WFD = WS_WFGU + 11 * MiB;
constexpr size_t WS_WC = WS_WFD + 5632 * 1024;
constexpr size_t WS_WCO = WS_WC + 6656 * 1024;
constexpr size_t WS_WMGU = 49 * MiB;
constexpr size_t WS_WMD = WS_WMGU + 88 * MiB;
static_assert(WS_WCO + 2 * MiB <= WS_WMGU, "weights map");
constexpr size_t WS_XB = 181 * MiB;
constexpr size_t WS_O = 245 * MiB;
constexpr size_t WS_ATT = WS_WA;
constexpr size_t WS_BIG = 309 * MiB;
constexpr size_t WS_XY = 181 * MiB;
constexpr size_t WS_HM = 313 * MiB;
constexpr size_t WS_END = 512 * MiB;
static_assert(WS_WMD + 44 * MiB <= WS_XB && WS_BIG + (size_t)T * LDC * 2 <= WS_END && WS_XY + (size_t)MOE_TILES_MAX * 256 * 1024 * 2 <= WS_HM && WS_HM + (size_t)MOE_PASS1_MAX * 256 * DFF * 2 <= WS_END, "d_ws map");
constexpr size_t MO_TOKE = CT_MOE;
constexpr size_t MO_TOKW = MO_TOKE + (size_t)T * 4;
constexpr size_t MO_TOKR = MO_TOKW + (size_t)T * 8;
constexpr size_t MO_POS = MO_TOKR + (size_t)T * 4;
constexpr size_t MO_HIST = MO_POS + (size_t)T * 8;
constexpr size_t MO_RSCALE = MO_HIST + 8192;
constexpr size_t MO_RGATE = MO_RSCALE + (size_t)MOE_TILES_MAX * 256 * 4;
constexpr size_t MO_RKEEP = MO_RGATE + (size_t)MOE_TILES_MAX * 256 * 4;
constexpr size_t MO_TILEE = MO_RKEEP + (size_t)MOE_TILES_MAX * 256 * 4;
static_assert(MO_TILEE + 2048 <= WS_WA, "moe tables");

constexpr int LDS_BYTES = 163840;
constexpr int LDS_MISC = 163584;

DI unsigned cvtpk(float lo, float hi) { typedef __bf16 b2 __attribute__((ext_vector_type(2))); f32x2 v = {lo, hi}; b2 b = __builtin_convertvector(v, b2); return __builtin_bit_cast(unsigned, b); }
DI float bf2f(unsigned short h) { return __uint_as_float((unsigned)h << 16); }
DI float bflo(unsigned w) { return __uint_as_float(w << 16); }
DI float bfhi(unsigned w) { return __uint_as_float(w & 0xffff0000u); }
DI float wave_sum(float v) {
#pragma unroll
    for (int o = 1; o < 64; o <<= 1) v += __shfl_xor(v, o);
    return v;
}
DI float sigmoidf_(float z) { return 1.0f / (1.0f + __expf(-z)); }
DI float log_sigmoidf_(float z) { return fminf(z, 0.f) - __logf(1.0f + __expf(-fabsf(z))); }
DI float siluf_(float z) { return z * __builtin_amdgcn_rcpf(1.0f + __builtin_amdgcn_exp2f(-LOG2E * z)); }
DI float gelu_tanh(float x) { const float u = 0.7978845608028654f * (x + 0.044715f * x * x * x); const float e = __expf(2.f * u); const float t = 1.f - 2.f / (e + 1.f); return 0.5f * x * (1.f + t); }

struct Args {
    const float* in[31];
    float* out;
    unsigned char* ws;
    int ph_lo, ph_hi;
};
namespace pg8 {
#define PG8_LAS __attribute__((address_space(3)))
typedef unsigned short bf16_t;
typedef short bf16x8 __attribute__((ext_vector_type(8)));
typedef float f32x4 __attribute__((ext_vector_type(4)));
typedef unsigned u32x4 __attribute__((ext_vector_type(4)));
constexpr int BM = 256, BK = 64, HALF = 128, HTB = HALF * BK * 2  , STAGE_BYTES = 8 * HTB, NXCD = 8, WGM = 8;

__host__ __device__ __forceinline__ int lds_byte(int r, int c) { const int st = (r >> 4) * 2 + (c >> 5), rr = r & 15, cc = c & 31, ob = rr * 64 + cc * 2; return st * 1024 + (ob ^ (((ob >> 9) & 1) << 5)); }
__host__ __device__ __forceinline__ void stage_rc(int b, int& R, int& C) { const int st = b / 1024, sb = b % 1024, swz = sb ^ (((sb >> 9) & 1) << 5); R = (st >> 1) * 16 + swz / 64; C = (st & 1) * 32 + (swz % 64) / 2; }
__host__ __device__ __forceinline__ int perm32(int rho) { const int n = rho >> 4, i = rho & 15; return 8 * (i >> 2) + 4 * n + (i & 3); }

struct Unit { int pm, pn; };
struct Gemm { const bf16_t* A; const bf16_t* Bt; int M, N, K; };

struct StaticOrder {
    int nM, nN, nwg, G, c;
    __host__ __device__ void init(int M, int N, int G_, int c_) { nM = M / BM; nN = N / BM; nwg = nM * nN; G = G_; c = c_; }
    __host__ __device__ bool next(int i, Unit& u) const {
        const long L = (long)i * G + c; if (L >= nwg) return false;
        int wgid = (int)L; { const int q = nwg / NXCD, r = nwg % NXCD, xcd = wgid % NXCD, off = wgid / NXCD; wgid = (xcd < r ? xcd * (q + 1) : r * (q + 1) + (xcd - r) * q) + off; }
        const int nig = WGM * nN, gid = wgid / nig, fm = gid * WGM, gsz = (nM - fm) < WGM ? (nM - fm) : WGM;
        u.pm = fm + ((wgid % nig) % gsz); u.pn = (wgid % nig) / gsz; return true;
    }
    __device__ __forceinline__ void a_ready(const Unit&) const {}
    __device__ __forceinline__ void done(const Unit&) const {}
};


#define EPI_ROWS(...) _Pragma("unroll") for (int ai = 0; ai < 2; ++ai) _Pragma("unroll") for (int m = 0; m < 4; ++m) { const int rowl = u.pm * BM + ai * HALF + wr * 64 + m * 16 + fr; __VA_ARGS__ }

struct EpiInA {
    static constexpr bool PERM = true, AFTER_DRAIN = false;
    bf16_t* projA; const float* rstd0; const float* cosT; const float* sinT;
    const float *qn, *kn, *fqn, *fkn, *gbias, *fbias; float* gate; float* logf;
    __device__ __forceinline__ void operator()(const f32x4 (&acc)[2][2][4][2], const Unit& u, int wr, int wc, int fr, int fq) const {
        const int s = u.pn * 4 + wc;
        if (s > 44) return;
        int kind = 0; const float* gain = qn; float scale = 1.f;
        if (s < 8) { kind = 2; gain = qn; scale = QSCALE; }
        else if (s < 12) { kind = 2; gain = kn; }
        else if (s < 20) { kind = 0; }
        else if (s < 28) { kind = 1; gain = fqn; scale = QSCALE; }
        else if (s < 36) { kind = 1; gain = fkn; }
        else if (s < 44) { kind = 0; }
        else kind = 3;
        float rsv[8];
#pragma unroll
        for (int q = 0; q < 8; ++q) rsv[q] = rstd0[u.pm * BM + (q >> 2) * HALF + wr * 64 + (q & 3) * 16 + fr];
        if (kind == 3) {
            EPI_ROWS(
                const float rs = rsv[ai * 4 + m];
                float v[8];
                _Pragma("unroll") for (int n = 0; n < 2; ++n) _Pragma("unroll") for (int e = 0; e < 4; ++e) v[n * 4 + e] = acc[ai][0][m][n][e] * rs;
                if (fq < 3) { float o[8]; _Pragma("unroll") for (int j = 0; j < 8; ++j) o[j] = sigmoidf_(v[j] + gbias[8 * fq + j]);
                    *(f32x4*)(gate + (size_t)rowl * 24 + 8 * fq) = (f32x4){o[0], o[1], o[2], o[3]}; *(f32x4*)(gate + (size_t)rowl * 24 + 8 * fq + 4) = (f32x4){o[4], o[5], o[6], o[7]}; }
                else { float o[8]; _Pragma("unroll") for (int j = 0; j < 8; ++j) o[j] = log_sigmoidf_(v[j] + fbias[j]);
                    _Pragma("unroll") for (int j = 0; j < 8; ++j) logf[((size_t)(rowl >> 12) * 8 + j) * SEQ + (rowl & (SEQ - 1))] = o[j]; }
            )
            return;
        }
        const bool do_norm = kind >= 1, do_rope = kind == 2;
        float g[16];
#pragma unroll
        for (int i = 0; i < 16; ++i) g[i] = (do_norm ? gain[32 * (i >> 3) + 8 * fq + (i & 7)] : 1.f) * scale;
        const float ir[8] = {0.15915494309189535f, 0.03086376340470123f, 0.005985185712713705f, 0.001160663641240061f, 0.00022507907903927653f, 4.364795279280289e-05f, 8.464330808241401e-06f, 1.6414262627950345e-06f};
        const bool rope_lane = do_rope && fq < 2;
        EPI_ROWS(
            const float rs = rsv[ai * 4 + m];
            float v[16];
            _Pragma("unroll") for (int bj = 0; bj < 2; ++bj) _Pragma("unroll") for (int n = 0; n < 2; ++n) _Pragma("unroll") for (int e = 0; e < 4; ++e) v[bj * 8 + n * 4 + e] = acc[ai][bj][m][n][e] * rs;
            float ss = 0.f;
            _Pragma("unroll") for (int i = 0; i < 16; ++i) ss += v[i] * v[i];
            ss += __shfl_xor(ss, 16); ss += __shfl_xor(ss, 32);
            const float r = do_norm ? rsqrtf(ss * (1.0f / 64.0f) + EPS) : 1.f;
            _Pragma("unroll") for (int i = 0; i < 16; ++i) v[i] = v[i] * (r * g[i]);
            float oth[8];
            _Pragma("unroll") for (int j = 0; j < 8; ++j) oth[j] = __shfl_xor(v[j], 16);
            const float pos = rope_lane ? (float)(rowl & (SEQ - 1)) : 0.f;
            const float sgn = (fq == 0) ? -1.f : 1.f;
            _Pragma("unroll") for (int j = 0; j < 8; ++j) { const float rev = pos * ir[j]; const float fr_ = rev - floorf(rev); const float cc = __builtin_amdgcn_cosf(fr_), sn = __builtin_amdgcn_sinf(fr_) * sgn;
                v[j] = v[j] * cc + oth[j] * sn; }
            bf16_t* dst = projA + (size_t)rowl * LDA + s * 64 + 8 * fq;
            _Pragma("unroll") for (int bj = 0; bj < 2; ++bj) { u32x4 w; w.x = ::cvtpk(v[bj * 8 + 0], v[bj * 8 + 1]); w.y = ::cvtpk(v[bj * 8 + 2], v[bj * 8 + 3]);
                w.z = ::cvtpk(v[bj * 8 + 4], v[bj * 8 + 5]); w.w = ::cvtpk(v[bj * 8 + 6], v[bj * 8 + 7]); *(u32x4*)(dst + 32 * bj) = w; }
        )
    }
};

__device__ __forceinline__ float row_rstd(const float* ssp, int row) { const f32x4* q = (const f32x4*)(ssp + (size_t)row * 16); const f32x4 a = q[0], b = q[1], c = q[2], d = q[3];
    const float s = (((a[0] + a[1]) + (a[2] + a[3])) + ((b[0] + b[1]) + (b[2] + b[3]))) + (((c[0] + c[1]) + (c[2] + c[3])) + ((d[0] + d[1]) + (d[2] + d[3]))); return rsqrtf(s * (1.0f / 1024.0f) + EPS); }
template <bool RES_F32> struct EpiResid {
    static constexpr bool PERM = true, AFTER_DRAIN = false;
    const void* res; bf16_t* outb; float* ss;
    __device__ __forceinline__ void operator()(const f32x4 (&acc)[2][2][4][2], const Unit& u, int wr, int wc, int fr, int fq) const {
        constexpr int MB = RES_F32 ? 2 : 4;
#pragma unroll
        for (int ai = 0; ai < 2; ++ai)
#pragma unroll
            for (int m0 = 0; m0 < 4; m0 += MB) {
                f32x4 r0[MB][2], r1[MB][2];
#pragma unroll
                for (int mm = 0; mm < MB; ++mm) { const int rowl = u.pm * BM + ai * HALF + wr * 64 + (m0 + mm) * 16 + fr; const size_t off = (size_t)rowl * DM + u.pn * BM + wc * 32 + 8 * fq;
#pragma unroll
                    for (int bj = 0; bj < 2; ++bj) {
                        if (RES_F32) { r0[mm][bj] = *(const f32x4*)((const float*)res + off + bj * HALF); r1[mm][bj] = *(const f32x4*)((const float*)res + off + bj * HALF + 4); }
                        else { const u32x4 rw = *(const u32x4*)((const bf16_t*)res + off + bj * HALF); r0[mm][bj] = (f32x4){bflo(rw.x), bfhi(rw.x), bflo(rw.y), bfhi(rw.y)}; r1[mm][bj] = (f32x4){bflo(rw.z), bfhi(rw.z), bflo(rw.w), bfhi(rw.w)}; } } }
#pragma unroll
                for (int mm = 0; mm < MB; ++mm) { const int m = m0 + mm; const int rowl = u.pm * BM + ai * HALF + wr * 64 + m * 16 + fr; const size_t off = (size_t)rowl * DM + u.pn * BM + wc * 32 + 8 * fq; float part = 0.f;
#pragma unroll
                    for (int bj = 0; bj < 2; ++bj) {
                        const f32x4 x0 = r0[mm][bj] + acc[ai][bj][m][0], x1 = r1[mm][bj] + acc[ai][bj][m][1];
                        u32x4 w; w.x = ::cvtpk(x0[0], x0[1]); w.y = ::cvtpk(x0[2], x0[3]); w.z = ::cvtpk(x1[0], x1[1]); w.w = ::cvtpk(x1[2], x1[3]); *(u32x4*)(outb + off + bj * HALF) = w;
                        part += (x0[0] * x0[0] + x0[1] * x0[1]) + (x0[2] * x0[2] + x0[3] * x0[3]) + (x1[0] * x1[0] + x1[1] * x1[1]) + (x1[2] * x1[2] + x1[3] * x1[3]);
                    }
                    part += __shfl_xor(part, 16); part += __shfl_xor(part, 32);
                    if (fq == 0 && ss) ss[(size_t)rowl * 16 + u.pn * 4 + wc] = part; }
            }
    }
};

template <bool MOE> struct EpiSwiglu {
    static constexpr bool PERM = true, AFTER_DRAIN = false;
    bf16_t* h; const float* rsrc; int row_off;
    __device__ __forceinline__ void operator()(const f32x4 (&acc)[2][2][4][2], const Unit& u, int wr, int wc, int fr, int fq) const {
        const int pnl = MOE ? (u.pn % 22) : u.pn;
        float rsv[8];
#pragma unroll
        for (int q = 0; q < 8; ++q) { const int rl = u.pm * BM + (q >> 2) * HALF + wr * 64 + (q & 3) * 16 + fr; rsv[q] = MOE ? rsrc[row_off + rl] : row_rstd(rsrc, rl); }
        EPI_ROWS(
            const float rs = rsv[ai * 4 + m]; const float c1 = -LOG2E * rs, c2 = rs * rs;
            float o[8];
            _Pragma("unroll") for (int n = 0; n < 2; ++n) _Pragma("unroll") for (int e = 0; e < 4; ++e) { const float g = acc[ai][0][m][n][e], uu = acc[ai][1][m][n][e];
                o[n * 4 + e] = (g * uu) * (c2 * __builtin_amdgcn_rcpf(1.0f + __builtin_amdgcn_exp2f(g * c1))); }
            u32x4 w; w.x = ::cvtpk(o[0], o[1]); w.y = ::cvtpk(o[2], o[3]); w.z = ::cvtpk(o[4], o[5]); w.w = ::cvtpk(o[6], o[7]);
            *(u32x4*)(h + (size_t)rowl * DFF + pnl * 128 + wc * 32 + 8 * fq) = w;
        )
    }
};

struct EpiGlaIn {
    static constexpr bool PERM = true, AFTER_DRAIN = false;
    bf16_t* projC; const float* ss2;
    __device__ __forceinline__ void operator()(const f32x4 (&acc)[2][2][4][2], const Unit& u, int wr, int wc, int fr, int fq) const {
        float rsv[8];
#pragma unroll
        for (int q = 0; q < 8; ++q) rsv[q] = row_rstd(ss2, u.pm * BM + (q >> 2) * HALF + wr * 64 + (q & 3) * 16 + fr);
        EPI_ROWS(
            float rs = rsv[ai * 4 + m]; if (u.pn < 2) rs *= 0.08838834764831845f;
            _Pragma("unroll") for (int bj = 0; bj < 2; ++bj) { const f32x4 x0 = acc[ai][bj][m][0] * rs, x1 = acc[ai][bj][m][1] * rs;
                u32x4 w; w.x = ::cvtpk(x0[0], x0[1]); w.y = ::cvtpk(x0[2], x0[3]); w.z = ::cvtpk(x1[0], x1[1]); w.w = ::cvtpk(x1[2], x1[3]);
                *(u32x4*)(projC + (size_t)rowl * LDC + u.pn * BM + bj * HALF + wc * 32 + 8 * fq) = w; }
        )
    }
};

struct EpiMoeDown {
    static constexpr bool PERM = true, AFTER_DRAIN = false;
    bf16_t* xy; const float* rgate; const float* rkeep; int row_off;
    __device__ __forceinline__ void operator()(const f32x4 (&acc)[2][2][4][2], const Unit& u, int wr, int wc, int fr, int fq) const {
        const int pnl = u.pn & 3;
        float gv[8], kv[8];
#pragma unroll
        for (int q = 0; q < 8; ++q) { const int rg_ = row_off + u.pm * BM + (q >> 2) * HALF + wr * 64 + (q & 3) * 16 + fr; gv[q] = rgate[rg_]; kv[q] = rkeep[rg_]; }
#pragma unroll
        for (int ai = 0; ai < 2; ++ai) {
            u32x4 old4[4][2];
#pragma unroll
            for (int m = 0; m < 4; ++m) { const int rowg = row_off + u.pm * BM + ai * HALF + wr * 64 + m * 16 + fr;
#pragma unroll
                for (int bj = 0; bj < 2; ++bj) old4[m][bj] = *(const u32x4*)(xy + (size_t)rowg * DM + pnl * BM + bj * HALF + wc * 32 + 8 * fq); }
#pragma unroll
            for (int m = 0; m < 4; ++m) { const int rowg = row_off + u.pm * BM + ai * HALF + wr * 64 + m * 16 + fr; const float w8 = gv[ai * 4 + m], kp = kv[ai * 4 + m];
#pragma unroll
                for (int bj = 0; bj < 2; ++bj) {
                    bf16_t* dst = xy + (size_t)rowg * DM + pnl * BM + bj * HALF + wc * 32 + 8 * fq;
                    const u32x4 rw = old4[m][bj];
                    const f32x4 r0 = (f32x4){bflo(rw.x), bfhi(rw.x), bflo(rw.y), bfhi(rw.y)}, r1 = (f32x4){bflo(rw.z), bfhi(rw.z), bflo(rw.w), bfhi(rw.w)};
                    const f32x4 x0 = r0 * kp + acc[ai][bj][m][0] * w8, x1 = r1 * kp + acc[ai][bj][m][1] * w8;
                    u32x4 w; w.x = ::cvtpk(x0[0], x0[1]); w.y = ::cvtpk(x0[2], x0[3]); w.z = ::cvtpk(x1[0], x1[1]); w.w = ::cvtpk(x1[2], x1[3]);
                    *(u32x4*)dst = w; } }
        }
    }
};

struct GroupedOrder {
    StaticOrder so; const int* tile_e; int tile0, nN;
    __device__ __forceinline__ bool next(int i, Unit& u) const { if (!so.next(i, u)) return false; u.pn = __builtin_amdgcn_readfirstlane(tile_e[tile0 + u.pm]) * nN + u.pn; return true; }
    __device__ __forceinline__ void a_ready(const Unit&) const {}
    __device__ __forceinline__ void done(const Unit&) const {}
};
template <class Epi, class Sched, bool ALIGN_EPI = false, bool SP2 = false>
__device__ __forceinline__ void gemm_phase(PG8_LAS unsigned char* lds, const Gemm g, const Sched& S, const Epi& E) {
    int tid_l_ = threadIdx.x; asm volatile("" : "+v"(tid_l_)); const int tid = tid_l_, wid = __builtin_amdgcn_readfirstlane(tid >> 6), lane = tid & 63, wr = wid >> 2, wc = wid & 3, fr = lane & 15, fq = lane >> 4;
    const int K = g.K, nt = K / BK;
    unsigned voffA[2], voffB[2];
#pragma unroll
    for (int i = 0; i < 2; ++i) { int R, C; stage_rc(tid * 16 + i * 8192, R, C); const int Rb = Epi::PERM ? ((R & ~31) + perm32(R & 31)) : R;
        voffA[i] = (unsigned)(R * K + C) * 2u; voffB[i] = (unsigned)(Rb * K + C) * 2u; }
    const size_t kstep = (size_t)(BK * 2);
    const size_t hstep = (size_t)HALF * K * 2;
    const size_t tstep = 2 * hstep;
    const unsigned ldsw = (unsigned)wid * 1024u;
    const int aoff = lds_byte(wr * 64 + fr, fq * 8), boff = lds_byte(wc * 32 + fr, fq * 8);
#define PG8_SA(b, h) (((b) * 2 + (h)) * HTB)
#define PG8_SB(b, h) ((4 + (b) * 2 + (h)) * HTB)
#define PG8_STAGE(bufoff, gbase, voff) do { _Pragma("unroll") for (int _i = 0; _i < 2; ++_i) \
        __builtin_amdgcn_global_load_lds((const unsigned*)((const char*)(gbase) + (voff)[_i]), (PG8_LAS unsigned*)(lds + (bufoff) + ldsw + _i * 8192), 16, 0, 0); } while (0)
#define PG8_LDA(dst, b, h) do { _Pragma("unroll") for (int m = 0; m < 4; ++m) _Pragma("unroll") for (int k = 0; k < 2; ++k) dst[m][k] = *(const PG8_LAS bf16x8*)(lds + PG8_SA(b, h) + aoff + m * 2048 + k * 1024); } while (0)
#define PG8_LDB(dst, b, h) do { _Pragma("unroll") for (int n = 0; n < 2; ++n) _Pragma("unroll") for (int k = 0; k < 2; ++k) dst[n][k] = *(const PG8_LAS bf16x8*)(lds + PG8_SB(b, h) + boff + n * 2048 + k * 1024); } while (0)
#define PG8_MMA(ai, bj, At, Bt) do { __builtin_amdgcn_s_setprio(1); _Pragma("unroll") for (int m = 0; m < 4; ++m) _Pragma("unroll") for (int n = 0; n < 2; ++n) _Pragma("unroll") for (int k = 0; k < 2; ++k) \
        acc[ai][bj][m][n] = __builtin_amdgcn_mfma_f32_16x16x32_bf16(Bt[n][k], At[m][k], acc[ai][bj][m][n], 0, 0, 0); __builtin_amdgcn_s_setprio(0); } while (0)
#define PG8_WAIT_V(n) asm volatile("s_waitcnt vmcnt(" #n ")" ::: "memory")
#define PG8_WAIT_L(n) asm volatile("s_waitcnt lgkmcnt(" #n ")" ::: "memory")
#define PG8_BAR __builtin_amdgcn_s_barrier()
#define PG8_SCHED __builtin_amdgcn_sched_barrier(0)
    Unit cur, nxt; int ui = 0;
    if (!S.next(0, cur)) return;
    f32x4 acc[2][2][4][2];
#pragma unroll
    for (int a = 0; a < 2; ++a)
#pragma unroll
        for (int b = 0; b < 2; ++b)
#pragma unroll
            for (int m = 0; m < 4; ++m)
#pragma unroll
                for (int n = 0; n < 2; ++n) acc[a][b][m][n] = (f32x4){0.f, 0.f, 0.f, 0.f};
    bf16x8 At[4][2], B0[2][2], B1[2][2];
    const char* cA = (const char*)g.A + (size_t)cur.pm * tstep; const char* cB = (const char*)g.Bt + (size_t)cur.pn * tstep;
    S.a_ready(cur);
    if constexpr (SP2) {
        PG8_STAGE(PG8_SB(0, 0), cB, voffB); PG8_STAGE(PG8_SB(0, 1), cB + hstep, voffB); PG8_STAGE(PG8_SA(0, 0), cA, voffA); PG8_STAGE(PG8_SA(0, 1), cA + hstep, voffA);
        if (wr == 1) PG8_BAR;
        PG8_WAIT_V(2); PG8_BAR;
        PG8_STAGE(PG8_SB(1, 0), cB + kstep, voffB); PG8_STAGE(PG8_SA(1, 0), cA + kstep, voffA); PG8_STAGE(PG8_SB(1, 1), cB + hstep + kstep, voffB);
        PG8_WAIT_V(6); PG8_BAR;
    } else {
        PG8_STAGE(PG8_SB(0, 0), cB, voffB); PG8_STAGE(PG8_SA(0, 0), cA, voffA); PG8_STAGE(PG8_SB(0, 1), cB + hstep, voffB); PG8_STAGE(PG8_SA(0, 1), cA + hstep, voffA);
        if (wr == 1) PG8_BAR;
        PG8_WAIT_V(4); PG8_BAR;
        PG8_STAGE(PG8_SB(1, 0), cB + kstep, voffB); PG8_STAGE(PG8_SA(1, 0), cA + kstep, voffA); PG8_STAGE(PG8_SB(1, 1), cB + hstep + kstep, voffB);
        PG8_WAIT_V(6); PG8_BAR;
    }
    for (;;) {
        const bool has_next = S.next(ui + 1, nxt);
        const char* nA = has_next ? (const char*)g.A + (size_t)nxt.pm * tstep : cA; const char* nB = has_next ? (const char*)g.Bt + (size_t)nxt.pn * tstep : cB;
        for (int t = 0; t < nt; t += 2) {
            const bool last = (t == nt - 2);
            const char* a1 = cA + (size_t)(t + 1) * kstep;
            const char* a2 = last ? nA : cA + (size_t)(t + 2) * kstep; const char* b2 = last ? nB : cB + (size_t)(t + 2) * kstep;
            const char* a3 = a2 + kstep; const char* b3 = b2 + kstep;
            if (last && has_next) S.a_ready(nxt);
            if constexpr (SP2) {
            PG8_LDB(B0, 0, 0); PG8_LDB(B1, 0, 1); PG8_SCHED; PG8_LDA(At, 0, 0); PG8_STAGE(PG8_SA(1, 1), a1 + hstep, voffA);
            PG8_WAIT_V(8); PG8_WAIT_L(0); PG8_BAR; PG8_MMA(0, 0, At, B0); PG8_MMA(0, 1, At, B1); PG8_BAR; PG8_SCHED;
            PG8_LDA(At, 0, 1); PG8_STAGE(PG8_SB(0, 0), b2, voffB); PG8_STAGE(PG8_SB(0, 1), b2 + hstep, voffB); PG8_STAGE(PG8_SA(0, 0), a2, voffA);
            PG8_WAIT_V(8); PG8_WAIT_L(0); PG8_BAR; PG8_MMA(1, 0, At, B0); PG8_MMA(1, 1, At, B1); PG8_BAR; PG8_SCHED;
            PG8_LDB(B0, 1, 0); PG8_LDB(B1, 1, 1); PG8_SCHED; PG8_LDA(At, 1, 0); PG8_STAGE(PG8_SA(0, 1), a2 + hstep, voffA);
            PG8_WAIT_V(8); PG8_WAIT_L(0); PG8_BAR; PG8_MMA(0, 0, At, B0); PG8_MMA(0, 1, At, B1); PG8_BAR; PG8_SCHED;
            PG8_LDA(At, 1, 1); PG8_STAGE(PG8_SB(1, 0), b3, voffB); PG8_STAGE(PG8_SB(1, 1), b3 + hstep, voffB); PG8_STAGE(PG8_SA(1, 0), a3, voffA);
            PG8_WAIT_V(8); PG8_WAIT_L(0); PG8_BAR; PG8_MMA(1, 0, At, B0); PG8_MMA(1, 1, At, B1); PG8_BAR; PG8_SCHED;
            } else {
            PG8_LDB(B0, 0, 0); PG8_SCHED; PG8_LDA(At, 0, 0); PG8_STAGE(PG8_SA(1, 1), a1 + hstep, voffA);
            PG8_WAIT_L(8); PG8_BAR; PG8_WAIT_L(0); PG8_MMA(0, 0, At, B0); PG8_BAR; PG8_SCHED;
            PG8_LDB(B1, 0, 1); PG8_STAGE(PG8_SB(0, 0), b2, voffB);
            PG8_BAR; PG8_WAIT_L(0); PG8_MMA(0, 1, At, B1); PG8_BAR;
            PG8_LDA(At, 0, 1); PG8_STAGE(PG8_SA(0, 0), a2, voffA);
            PG8_BAR; PG8_WAIT_L(0); PG8_MMA(1, 0, At, B0); PG8_BAR; PG8_SCHED;
            PG8_STAGE(PG8_SB(0, 1), b2 + hstep, voffB);
            PG8_WAIT_V(6); PG8_BAR; PG8_MMA(1, 1, At, B1); PG8_BAR;
            PG8_LDB(B0, 1, 0); PG8_SCHED; PG8_LDA(At, 1, 0); PG8_STAGE(PG8_SA(0, 1), a2 + hstep, voffA);
            PG8_WAIT_L(8); PG8_BAR; PG8_WAIT_L(0); PG8_MMA(0, 0, At, B0); PG8_BAR; PG8_SCHED;
            PG8_LDB(B1, 1, 1); PG8_STAGE(PG8_SB(1, 0), b3, voffB);
            PG8_BAR; PG8_WAIT_L(0); PG8_MMA(0, 1, At, B1); PG8_BAR;
            PG8_LDA(At, 1, 1); PG8_STAGE(PG8_SA(1, 0), a3, voffA);
            PG8_BAR; PG8_WAIT_L(0); PG8_MMA(1, 0, At, B0); PG8_BAR; PG8_SCHED;
            PG8_STAGE(PG8_SB(1, 1), b3 + hstep, voffB);
            PG8_WAIT_V(6); PG8_BAR; PG8_MMA(1, 1, At, B1); PG8_BAR;
            }
        }
        if constexpr (ALIGN_EPI) { if (wr == 0) PG8_BAR; }
        if constexpr (!Epi::AFTER_DRAIN) { E(acc, cur, wr, wc, fr, fq);
            S.done(cur); }
        if (!has_next) break;
#pragma unroll
        for (int a = 0; a < 2; ++a)
#pragma unroll
            for (int b = 0; b < 2; ++b)
#pragma unroll
                for (int m = 0; m < 4; ++m)
#pragma unroll
                    for (int n = 0; n < 2; ++n) acc[a][b][m][n] = (f32x4){0.f, 0.f, 0.f, 0.f};
        cur = nxt; cA = nA; cB = nB; ++ui;
        if constexpr (ALIGN_EPI) { if (wr == 1) PG8_BAR; }
    }
    PG8_WAIT_V(0);
    if constexpr (!ALIGN_EPI) { if (wr == 0) PG8_BAR; }
    PG8_BAR;
    if constexpr (Epi::AFTER_DRAIN) { E.fused(acc, cur, wr, wc, fr, fq, lds, wid, lane); S.done(cur); }
#undef PG8_SA
#undef PG8_SB
#undef PG8_STAGE
#undef PG8_LDA
#undef PG8_LDB
#undef PG8_MMA
#undef PG8_WAIT_V
#undef PG8_WAIT_L
#undef PG8_BAR
#undef PG8_SCHED
}
}

namespace att {
constexpr int A_KV = 0, A_KB = 49152, A_WS = 49920, A_MASK = 51968, A_SHQ = 52480, A_IMP = 53248, A_OC = 119808, A_IVC = 152576;
DI constexpr int crc(int r) { return (r & 3) + 8 * (r >> 2); }
constexpr int IMP_LD = 65;
DI int crow(int r, int hi) { return (r & 3) + 8 * (r >> 2) + 4 * hi; }
#define MFMA32(a, b, c) __builtin_amdgcn_mfma_f32_32x32x16_bf16((a), (b), (c), 0, 0, 0)

struct KVRegs { u32x4 k, v; float kb; };
struct Sweep {
    const bf16_t* K; const bf16_t* V; int ld;
    const float* kbias;
};
DI void kv_issue(KVRegs& r, const Sweep& s, int tile, int tid) {
    const int key = tid & 63, ch = tid >> 6;
    const size_t row0 = (size_t)tile * 64;
    r.k = *(const u32x4*)(s.K + (row0 + key) * s.ld + ch * 8);
    const int p = tid >> 6, l = tid & 63; const int row = 16 * (p & 3) + (l >> 2), col = (p >> 2) * 32 + (l & 3) * 8;
    r.v = *(const u32x4*)(s.V + (row0 + row) * s.ld + col);
    r.kb = (s.kbias && tid < 64) ? s.kbias[row0 + tid] : 0.f;
}
DI void kv_commit(const KVRegs& r, LAS char* lds, int slot, int tid, bool has_kb) {
    LAS char* sl = lds + A_KV + slot * 16384;
    *(LAS u32x4*)(sl + (tid >> 6) * 1024 + (tid & 63) * 16) = r.k;
    *(LAS u32x4*)(sl + 8192 + tid * 16) = r.v;
    if (has_kb && tid < 64) *(LAS float*)(lds + A_KB + slot * 256 + tid * 4) = r.kb;
}
DI void glds16(const void* gsrc, unsigned lds_dst) { unsigned keep;
    asm volatile("s_mov_b32 %0, m0\n\ts_mov_b32 m0, %2\n\ts_nop 0\n\tglobal_load_lds_dwordx4 %1, off\n\ts_mov_b32 m0, %0" : "=&s"(keep) : "v"(gsrc), "s"(lds_dst) : "memory"); }
DI void glds4(const void* gsrc, unsigned lds_dst) { unsigned keep;
    asm volatile("s_mov_b32 %0, m0\n\ts_mov_b32 m0, %2\n\ts_nop 0\n\tglobal_load_lds_dword %1, off\n\ts_mov_b32 m0, %0" : "=&s"(keep) : "v"(gsrc), "s"(lds_dst) : "memory"); }
DI void kv_dma(const Sweep& s, int tile, LAS char* lds, int slot, int tid, int wid, bool has_kb) {
    const int l = tid & 63;
    const size_t row0 = (size_t)tile * 64;
    const bf16_t* ksrc = s.K + (row0 + l) * s.ld + wid * 8;
    const bf16_t* vsrc = s.V + (row0 + 16 * (wid & 3) + (l >> 2)) * s.ld + (wid >> 2) * 32 + (l & 3) * 8;
    const unsigned sl = (unsigned)__builtin_amdgcn_readfirstlane((int)(unsigned)(uintptr_t)(lds + A_KV + slot * 16384 + wid * 1024));
    glds16(ksrc, sl);
    glds16(vsrc, sl + 8192);
    if (has_kb) glds4(s.kbias + row0 + l, (unsigned)__builtin_amdgcn_readfirstlane((int)(unsigned)(uintptr_t)(lds + A_KB + slot * 256)));
}
struct FState { float m, l; f32x16 o0, o1, la, negm; };
DI float max3f(float a, float b, float c) { float r; asm("v_max3_f32 %0, %1, %2, %3" : "=v"(r) : "v"(a), "v"(b), "v"(c)); return r; }
DI void fs_init(FState& s) { s.m = 0.f; s.l = 0.f;

#pragma unroll
    for (int r = 0; r < 16; ++r) { s.o0[r] = 0.f; s.o1[r] = 0.f; s.la[r] = 0.f; s.negm[r] = 0.f; } }

DI void qk_tile(f32x16& p0, f32x16& p1, const f32x16& c0, const f32x16& c1, const LAS char* Ks, const bf16x8 (&qr)[4], int r32, int hi) {
    const LAS char* kb = Ks + hi * 1024 + r32 * 16;
    bf16x8 kf[8];
#pragma unroll
    for (int d0 = 0; d0 < 4; ++d0) { kf[2 * d0] = *(const LAS bf16x8*)(kb + d0 * 2048); kf[2 * d0 + 1] = *(const LAS bf16x8*)(kb + d0 * 2048 + 512); }
    __builtin_amdgcn_s_setprio(1);
#pragma unroll
    for (int d0 = 0; d0 < 4; ++d0) {
        if (d0 == 0) { p0 = MFMA32(kf[0], qr[0], c0); p1 = MFMA32(kf[1], qr[0], c1); }
        else { p0 = MFMA32(kf[2 * d0], qr[d0], p0); p1 = MFMA32(kf[2 * d0 + 1], qr[d0], p1); }
    }
    __builtin_amdgcn_s_setprio(0);
}
DI s16x4 vtr(const LAS char* p) { typedef short v4i16_t __attribute__((ext_vector_type(4))); return __builtin_bit_cast(s16x4, __builtin_amdgcn_ds_read_tr16_b64_v4i16((LAS v4i16_t*)p)); }

template <bool NOMAX, bool SUML> DI void softmax_pv(FState& s, f32x16& p0, f32x16& p1, const LAS char* Vs, LAS float* wsf, int lane, int r32, int hi) {
    if (!NOMAX) {
        asm volatile("s_nop 15\n\ts_nop 7" : "+v"(p0), "+v"(p1));
        float rm = max3f(p0[0], p0[1], p1[0]), rm2 = max3f(p0[2], p0[3], p1[1]);
        rm = max3f(rm, p1[2], p1[3]);
#pragma unroll
        for (int r = 4; r < 16; r += 4) { rm = max3f(rm, p0[r], p0[r + 1]); rm2 = max3f(rm2, p0[r + 2], p0[r + 3]); rm = max3f(rm, p1[r], p1[r + 1]); rm2 = max3f(rm2, p1[r + 2], p1[r + 3]); }
        rm = fmaxf(rm, rm2);
        rm = fmaxf(rm, __shfl_xor(rm, 32));
        if (__any(rm > 8.0f)) {
            const float dl = fmaxf(rm, 0.f);
            s.m += dl; const float alpha = __builtin_amdgcn_exp2f(-dl);
#pragma unroll
            for (int r = 0; r < 16; ++r) s.negm[r] = -s.m;
#pragma unroll
            for (int r = 0; r < 16; ++r) { p0[r] -= dl; p1[r] -= dl; }
            if (hi == 0) wsf[r32] = alpha;
#pragma unroll
            for (int r = 0; r < 16; ++r) { const float a = wsf[crow(r, hi)]; s.o0[r] *= a; s.o1[r] *= a; s.la[r] *= a; }
            if (SUML) s.l *= alpha;
        }
    }
#pragma unroll
    for (int r = 0; r < 16; ++r) { p0[r] = __builtin_amdgcn_exp2f(p0[r]); p1[r] = __builtin_amdgcn_exp2f(p1[r]); }
    if (SUML) { float sum = 0.f;
#pragma unroll
        for (int r = 0; r < 16; ++r) sum += p0[r] + p1[r];
        s.l += sum; }
    u32x4 pw[4];
    pw[0] = (u32x4){cvtpk(p0[0], p0[1]), cvtpk(p0[2], p0[3]), cvtpk(p0[4], p0[5]), cvtpk(p0[6], p0[7])};
    pw[1] = (u32x4){cvtpk(p0[8], p0[9]), cvtpk(p0[10], p0[11]), cvtpk(p0[12], p0[13]), cvtpk(p0[14], p0[15])};
    pw[2] = (u32x4){cvtpk(p1[0], p1[1]), cvtpk(p1[2], p1[3]), cvtpk(p1[4], p1[5]), cvtpk(p1[6], p1[7])};
    pw[3] = (u32x4){cvtpk(p1[8], p1[9]), cvtpk(p1[10], p1[11]), cvtpk(p1[12], p1[13]), cvtpk(p1[14], p1[15])};
    const bf16x8 ones = (bf16x8){0x3F80, 0x3F80, 0x3F80, 0x3F80, 0x3F80, 0x3F80, 0x3F80, 0x3F80};
    const LAS char* vp = Vs + ((lane >> 4) & 1) * 32 + (lane & 3) * 8 + (4 * hi + ((lane & 15) >> 2)) * 64;
#pragma unroll
    for (int ks = 0; ks < 4; ++ks) {
        const bf16x8 pa = __builtin_bit_cast(bf16x8, pw[ks]);
        { const s16x4 lo = vtr(vp + ks * 1024), hh = vtr(vp + ks * 1024 + 512); const bf16x8 vf = (bf16x8){lo[0], lo[1], lo[2], lo[3], hh[0], hh[1], hh[2], hh[3]}; s.o0 = MFMA32(pa, vf, s.o0); }
        { const s16x4 lo = vtr(vp + 4096 + ks * 1024), hh = vtr(vp + 4096 + ks * 1024 + 512); const bf16x8 vf = (bf16x8){lo[0], lo[1], lo[2], lo[3], hh[0], hh[1], hh[2], hh[3]}; s.o1 = MFMA32(pa, vf, s.o1); }
        s.la = MFMA32(pa, ones, s.la);
    }
}
template <int MODE> DI float fs_finish(const FState& s, const float (&gr)[16], LAS float* wsf, LAS char* stg_bf, LAS char* stg_f32, int r32, int hi) {
    LAS bf16_t* sb = (LAS bf16_t*)stg_bf; LAS float* sf = (LAS float*)stg_f32;
#pragma unroll
    for (int r = 0; r < 16; ++r) {
        const int orow = crow(r, hi); const float lt = s.la[r]; const float inv = lt > 0.f ? __builtin_amdgcn_rcpf(lt) : 0.f; const float f = inv * gr[r];
        float c0 = s.o0[r] * f, c1 = s.o1[r] * f;
        if (MODE == 1) { c0 += bf2f(sb[orow * 64 + r32]); c1 += bf2f(sb[orow * 64 + 32 + r32]); sf[orow * 64 + r32] = c0; sf[orow * 64 + 32 + r32] = c1; }
        else { if (MODE == 2) { c0 += sf[orow * 64 + r32]; c1 += sf[orow * 64 + 32 + r32]; }
            sb[orow * 64 + r32] = (bf16_t)(cvtpk(c0, 0.f) & 0xffffu); sb[orow * 64 + 32 + r32] = (bf16_t)(cvtpk(c1, 0.f) & 0xffffu); }
    }
    if (MODE == 0) { const float lt = s.l + __shfl_xor(s.l, 32); return lt > 0.f ? 1.0f / lt : 0.f; }
    return 0.f;
}
DI void store_o(bf16_t* Orow0  , int ldo, const LAS char* stg, int lane) {
#pragma unroll
    for (int i = 0; i < 4; ++i) { const int row = i * 8 + (lane >> 3), ch = lane & 7; const u32x4 v = *(const LAS u32x4*)(stg + row * 128 + ch * 16); *(u32x4*)(Orow0 + (size_t)row * ldo + ch * 8) = v; }
}

struct BrP { int cur; int tq; int tt; unsigned long long msk, anym; int jlo, jhi; int fox_lim, fox_lo; float m_c, inv_c; int head_l, tok_l; };
template <int BR> DI int next_tile(const BrP& b, int j) {
    ++j;
    if (BR == 1) { while (j <= b.jhi && !((b.anym >> j) & 1ull)) ++j; }
    return j <= b.jhi ? j : -1;
}
template <int BR, bool NOMAX> DI void sweep(FState& st, const Sweep& sw, const BrP& b, const bf16x8 (&qr)[4], LAS char* lds, LAS float* wsf, int tid, int lane, int r32, int hi, float& carry) {
    const int wid_ = __builtin_amdgcn_readfirstlane(tid >> 6);
#define ATT_WAIT_BAR(n) asm volatile("s_waitcnt vmcnt(" #n ") lgkmcnt(0)\n\ts_barrier" ::: "memory")
#define ATT_END_TILE(more) do { if (more) { if (BR == 3) ATT_WAIT_BAR(3); else ATT_WAIT_BAR(2); } else ATT_WAIT_BAR(0); } while (0)
    int j = next_tile<BR>(b, b.jlo - 1);
    if (j < 0) return;
    int jn = next_tile<BR>(b, j);
    kv_dma(sw, j, lds, 0, tid, wid_, BR == 3);
    if (jn >= 0) kv_dma(sw, jn, lds, 1, tid, wid_, BR == 3);
    ATT_END_TILE(jn >= 0);
    int slot = 0;
    while (j >= 0) {
        const int jn2 = jn >= 0 ? next_tile<BR>(b, jn) : -1;
        if (jn2 >= 0) kv_dma(sw, jn2, lds, slot >= 1 ? slot - 1 : 2, tid, wid_, BR == 3);
        const LAS char* Ks = lds + A_KV + slot * 16384; const LAS char* Vs = Ks + 8192;
        bool active = true;
        if (BR == 3) active = (j <= b.fox_lim) && (j >= b.fox_lo);
        if (active) {
            f32x16 p0, p1;
            const float NEG = -__builtin_inff();
            if (BR == 3) {
                f32x16 c0, c1;
                const LAS float* kb = (const LAS float*)(lds + A_KB + slot * 256);
#pragma unroll
                for (int i = 0; i < 4; ++i) { const f32x4 k0 = *(const LAS f32x4*)(kb + 8 * i + 4 * hi), k1 = *(const LAS f32x4*)(kb + 32 + 8 * i + 4 * hi);
#pragma unroll
                    for (int e = 0; e < 4; ++e) { c0[4 * i + e] = k0[e] + st.negm[4 * i + e]; c1[4 * i + e] = k1[e] + st.negm[4 * i + e]; } }
                qk_tile(p0, p1, c0, c1, Ks, qr, r32, hi);
            } else if (BR == 1) {
                f32x16 cs; const bool sel = (b.msk >> j) & 1ull;
#pragma unroll
                for (int r = 0; r < 16; ++r) cs[r] = sel ? (NOMAX ? 0.f : st.negm[r]) : NEG;
                qk_tile(p0, p1, cs, cs, Ks, qr, r32, hi);
            } else if (NOMAX) {
                f32x16 z;
#pragma unroll
                for (int r = 0; r < 16; ++r) z[r] = 0.f;
                qk_tile(p0, p1, z, z, Ks, qr, r32, hi);
            } else qk_tile(p0, p1, st.negm, st.negm, Ks, qr, r32, hi);
            int tth = b.tt - 4 * hi; asm volatile("" : "+v"(tth));
            if (BR == 0 || BR == 4) {
                int lim = ((b.tq - 31) >> 4) - 64 * j - 4 * hi; asm volatile("" : "+v"(lim));
#pragma unroll
                for (int r = 0; r < 16; ++r) { if (crc(r) > lim) p0[r] = NEG; if (crc(r) + 32 > lim) p1[r] = NEG; }
            } else if (BR == 1) {
                if (j == b.cur) {
#pragma unroll
                    for (int r = 0; r < 16; ++r) { if (crc(r) > tth) p0[r] = NEG; if (crc(r) + 32 > tth) p1[r] = NEG; }
                }
            } else if (BR == 2) {
                if (j == b.cur) {
#pragma unroll
                    for (int r = 0; r < 16; ++r) { if (crc(r) > tth) p0[r] = NEG; if (crc(r) + 32 > tth) p1[r] = NEG; }
                } else if (j == b.cur - 8) {
#pragma unroll
                    for (int r = 0; r < 16; ++r) { if (crc(r) <= tth) p0[r] = NEG; if (crc(r) + 32 <= tth) p1[r] = NEG; }
                }
            } else if (BR == 3) {
                if (j == b.fox_lim) {
#pragma unroll
                    for (int r = 0; r < 16; ++r) { if (crc(r) > tth) p0[r] = NEG; if (crc(r) + 32 > tth) p1[r] = NEG; }
                }
            }
            if (BR != 4) softmax_pv<NOMAX, BR == 0>(st, p0, p1, Vs, wsf, lane, r32, hi);
            if (BR == 4 || (BR == 0 && NOMAX)) {
                const float scl = (BR == 4) ? b.inv_c : 1.0f;
                float G[8], H[8];
#pragma unroll
                for (int i = 0; i < 4; ++i) {
                    float a[4], c[4];
#pragma unroll
                    for (int e = 0; e < 4; ++e) { a[e] = (BR == 4 ? __builtin_amdgcn_exp2f(p0[4 * i + e]) : p0[4 * i + e]) * scl; c[e] = (BR == 4 ? __builtin_amdgcn_exp2f(p1[4 * i + e]) : p1[4 * i + e]) * scl; }
                    H[i] = 0.5f * a[3]; G[i] = a[0] + a[1] + a[2] + H[i]; H[4 + i] = 0.5f * c[3]; G[4 + i] = c[0] + c[1] + c[2] + H[4 + i];
                }
                float Hp[8];
#pragma unroll
                for (int k = 0; k < 8; ++k) Hp[k] = __shfl_xor(H[k], 32);
                LAS float* imp = (LAS float*)(lds + A_IMP) + (b.head_l * 64 + b.tok_l) * IMP_LD + 16 * j;
#pragma unroll
                for (int k = 0; k < 8; ++k) {
                    const float prev = (hi == 1) ? Hp[k] : (k == 0 ? carry : Hp[k - 1]);
                    const int sidx = (k < 4) ? (2 * k + hi) : (8 + 2 * (k - 4) + hi);
                    imp[sidx] = G[k] + prev;
                }
                carry = Hp[7];
            }
        }
        ATT_END_TILE(jn2 >= 0);
        slot = slot == 2 ? 0 : slot + 1; j = jn; jn = jn2;
    }
#undef ATT_WAIT_BAR
#undef ATT_END_TILE
}

struct Tensors {
    const bf16_t* projA; const bf16_t* kcmp; const bf16_t* vcmp; const float* gate; const float* cumneg; bf16_t* O; const float* fqn; const float* fkn; const float* aqn; const float* akn;
};

template <bool NOMAX> DI void nsa_unit(const Tensors& T_, int b, int g, int qt, LAS char* lds) {
    int tid_ = threadIdx.x; asm volatile("" : "+v"(tid_));
    const int tid = tid_, lane = tid & 63, r32 = lane & 31, hi = lane >> 5, wid = __builtin_amdgcn_readfirstlane(tid >> 6);
    LAS float* wsf = (LAS float*)(lds + A_WS) + wid * 64;
    const int head_l = wid >> 1, head = 4 * g + head_l, tok_l = 32 * (wid & 1) + r32;
    const int tq = 64 * qt + tok_l;
    const size_t rowq = (size_t)b * SEQ + tq;
    bf16x8 qr[4];
#pragma unroll
    for (int d0 = 0; d0 < 4; ++d0) qr[d0] = *(const bf16x8*)(T_.projA + rowq * LDA + PA_QA + head * 64 + d0 * 16 + hi * 8);
    LAS char* stg_bf = lds + A_OC + wid * 4096; LAS char* stg_f32 = lds + A_IMP + wid * 8192;
    const size_t rowbase = (size_t)b * SEQ + 64 * qt + 32 * (wid & 1);
    float gr[16];
    BrP bp; bp.cur = qt; bp.tq = tq; bp.tt = tok_l; bp.msk = 0; bp.anym = 0; bp.fox_lim = 0; bp.fox_lo = 0; bp.head_l = head_l; bp.tok_l = tok_l; bp.m_c = 0.f; bp.inv_c = 0.f;
    float carry = 0.f;
    {
        Sweep sw; sw.K = T_.kcmp + ((size_t)b * NCMP_PAD * 2 + g) * 64; sw.V = T_.vcmp + ((size_t)b * NCMP_PAD * 2 + g) * 64; sw.ld = 128; sw.kbias = nullptr;
        const int ntc = (4 * qt + 2) / 64 + 1;
        bp.jlo = 0; bp.jhi = ntc - 1;
        FState st; fs_init(st);
        LAS float* imp = (LAS float*)(lds + A_IMP) + (head_l * 64 + tok_l) * IMP_LD;
        for (int s2 = 16 * ntc + hi; s2 < 64; s2 += 2) imp[s2] = 0.f;
        carry = 0.f;
        sweep<0, NOMAX>(st, sw, bp, qr, lds, wsf, tid, lane, r32, hi, carry);
#pragma unroll
        for (int r = 0; r < 16; ++r) gr[r] = T_.gate[(rowbase + crow(r, hi)) * 24 + 3 * head + 0];
        bp.inv_c = fs_finish<0>(st, gr, wsf, stg_bf, stg_f32, r32, hi); bp.m_c = st.m;
        if (hi == 0) ((LAS float*)(lds + A_IVC))[head_l * 64 + tok_l] = NOMAX ? bp.inv_c : 1.0f;
        if (!NOMAX) { carry = 0.f; sweep<4, NOMAX>(st, sw, bp, qr, lds, wsf, tid, lane, r32, hi, carry); }
    }
    __syncthreads();
    {
        LAS float* imp = (LAS float*)(lds + A_IMP); const LAS float* ivc = (const LAS float*)(lds + A_IVC);
        const int tok = tid >> 3, part = tid & 7;
        float v[8];
#pragma unroll
        for (int k = 0; k < 8; ++k) { const int s2 = 8 * part + k;
            float x = ((imp[(0 * 64 + tok) * IMP_LD + s2] * ivc[tok] + imp[(1 * 64 + tok) * IMP_LD + s2] * ivc[64 + tok]) + imp[(2 * 64 + tok) * IMP_LD + s2] * ivc[128 + tok]) + imp[(3 * 64 + tok) * IMP_LD + s2] * ivc[192 + tok];
            if (s2 == 0 || s2 == qt || s2 == qt - 1) x = 1e6f; else if (s2 > qt) x = -1e6f;
            v[k] = x; }
        __syncthreads();
#pragma unroll
        for (int k = 0; k < 8; ++k) imp[tok * IMP_LD + 8 * part + k] = v[k];
        __syncthreads();
        int rank[8];
#pragma unroll
        for (int k = 0; k < 8; ++k) rank[k] = 0;
        for (int s2 = 0; s2 < 64; ++s2) { const float x = imp[tok * IMP_LD + s2];
#pragma unroll
            for (int k = 0; k < 8; ++k) rank[k] += (x > v[k] || (x == v[k] && s2 < 8 * part + k)) ? 1 : 0; }
        unsigned byte = 0;
#pragma unroll
        for (int k = 0; k < 8; ++k) byte |= (rank[k] < 16 ? 1u : 0u) << k;
        ((LAS unsigned char*)(lds + A_MASK))[tok * 8 + part] = (unsigned char)byte;
        __syncthreads();
        const LAS unsigned long long* mk = (const LAS unsigned long long*)(lds + A_MASK);
        bp.msk = mk[tok_l];
        unsigned long long am = mk[lane];
        unsigned lo = (unsigned)am, hh = (unsigned)(am >> 32);
#pragma unroll
        for (int o = 1; o < 64; o <<= 1) { lo |= (unsigned)__shfl_xor((int)lo, o); hh |= (unsigned)__shfl_xor((int)hh, o); }
        bp.anym = ((unsigned long long)(unsigned)__builtin_amdgcn_readfirstlane((int)hh) << 32) | (unsigned)__builtin_amdgcn_readfirstlane((int)lo);
    }
    {
        Sweep sw; sw.K = T_.projA + (size_t)b * SEQ * LDA + PA_KSL + g * 64; sw.V = T_.projA + (size_t)b * SEQ * LDA + PA_VSL + g * 64; sw.ld = LDA; sw.kbias = nullptr;
        bp.jlo = 0; bp.jhi = qt;
        FState st; fs_init(st);
        sweep<1, NOMAX>(st, sw, bp, qr, lds, wsf, tid, lane, r32, hi, carry);
#pragma unroll
        for (int r = 0; r < 16; ++r) gr[r] = T_.gate[(rowbase + crow(r, hi)) * 24 + 3 * head + 1];
        fs_finish<1>(st, gr, wsf, stg_bf, stg_f32, r32, hi);
    }
    {
        Sweep sw; sw.K = T_.projA + (size_t)b * SEQ * LDA + PA_KWN + g * 64; sw.V = T_.projA + (size_t)b * SEQ * LDA + PA_VWN + g * 64; sw.ld = LDA; sw.kbias = nullptr;
        bp.jlo = qt - 8 < 0 ? 0 : qt - 8; bp.jhi = qt;
        FState st; fs_init(st);
        sweep<2, NOMAX>(st, sw, bp, qr, lds, wsf, tid, lane, r32, hi, carry);
#pragma unroll
        for (int r = 0; r < 16; ++r) gr[r] = T_.gate[(rowbase + crow(r, hi)) * 24 + 3 * head + 2];
        fs_finish<2>(st, gr, wsf, stg_bf, stg_f32, r32, hi);
    }
    store_o(T_.O + rowbase * DM + head * 64, DM, stg_bf, lane);
    __syncthreads();
}

DI void fox_unit(const Tensors& T_, int b, int h, int qb, LAS char* lds) {
    int tid_ = threadIdx.x; asm volatile("" : "+v"(tid_));
    const int tid = tid_, lane = tid & 63, r32 = lane & 31, hi = lane >> 5, wid = __builtin_amdgcn_readfirstlane(tid >> 6);
    LAS float* wsf = (LAS float*)(lds + A_WS) + wid * 64;
    const int tq = 256 * qb + 32 * wid + r32;
    const size_t rowq = (size_t)b * SEQ + tq;
    bf16x8 qr[4];
#pragma unroll
    for (int d0 = 0; d0 < 4; ++d0) qr[d0] = *(const bf16x8*)(T_.projA + rowq * LDA + PA_QB + h * 64 + d0 * 16 + hi * 8);
    LAS char* stg_bf = lds + A_OC + wid * 4096;
    BrP bp; bp.cur = 0; bp.tq = tq; bp.tt = 32 * (wid & 1) + r32; bp.msk = 0; bp.anym = 0; bp.head_l = 0; bp.tok_l = 0; bp.m_c = 0.f; bp.inv_c = 0.f;
    bp.jlo = 0; bp.jhi = 4 * qb + 3; bp.fox_lim = 4 * qb + (wid >> 1);
    {
        float gq = fabsf(T_.fqn[lane]), gk = fabsf(T_.fkn[lane]);
#pragma unroll
        for (int o = 1; o < 64; o <<= 1) { gq = fmaxf(gq, __shfl_xor(gq, o)); gk = fmaxf(gk, __shfl_xor(gk, o)); }
        const float need = 2.0f * 11.66f * gq * gk + 40.0f;
        const float* kbp = T_.cumneg + ((size_t)b * FOX_H + h) * SEQ;
        const float kb0 = kbp[256 * qb];
        const bool needed = (lane <= bp.jhi) && (kb0 - kbp[64 * lane + 63] <= need);
        const unsigned long long bal = __ballot(needed);
        bp.jlo = bal ? (int)__builtin_ctzll(bal) : 0;
        const bool needed_w = (lane <= bp.jhi) && (kbp[256 * qb + 32 * wid] - kbp[64 * lane + 63] <= need);
        const unsigned long long balw = __ballot(needed_w);
        bp.fox_lo = balw ? (int)__builtin_ctzll(balw) : 0;
    }
    Sweep sw; sw.K = T_.projA + (size_t)b * SEQ * LDA + PA_KB + h * 64; sw.V = T_.projA + (size_t)b * SEQ * LDA + PA_VB + h * 64; sw.ld = LDA;
    sw.kbias = T_.cumneg + ((size_t)b * FOX_H + h) * SEQ;
    FState st; fs_init(st);
    float carry = 0.f;
    sweep<3, false>(st, sw, bp, qr, lds, wsf, tid, lane, r32, hi, carry);
    float gr[16];
#pragma unroll
    for (int r = 0; r < 16; ++r) gr[r] = 1.f;
    fs_finish<3>(st, gr, wsf, stg_bf, stg_bf, r32, hi);
    const size_t rowbase = (size_t)b * SEQ + 256 * qb + 32 * wid;
    store_o(T_.O + rowbase * DM + 512 + h * 64, DM, stg_bf, lane);
    __syncthreads();
}

DI void attn_phase(const Tensors& T_, unsigned* ctr, LAS char* lds) {
    LAS int* shq = (LAS int*)(lds + A_SHQ);
    bool nomax;
    { const int lane = threadIdx.x & 63; float gq = fabsf(T_.aqn[lane]), gk = fabsf(T_.akn[lane]);
#pragma unroll
      for (int o = 1; o < 64; o <<= 1) { gq = fmaxf(gq, __shfl_xor(gq, o)); gk = fmaxf(gk, __shfl_xor(gk, o)); }
      nomax = __builtin_amdgcn_readfirstlane((int)(11.66f * gq * gk < 50.0f)) != 0; }
    for (;;) {
        if (threadIdx.x == 0) shq[0] = (int)__hip_atomic_fetch_add(ctr, 1u, __ATOMIC_RELAXED, __HIP_MEMORY_SCOPE_AGENT);
        __syncthreads();
        const int i = __builtin_amdgcn_readfirstlane(shq[0]);
        __syncthreads();
        if (i >= 2048) break;
        if (i < 1024) { if (nomax) nsa_unit<true>(T_, (i & 15) >> 1, i & 1, 63 - (i >> 4), lds); else nsa_unit<false>(T_, (i & 15) >> 1, i & 1, 63 - (i >> 4), lds); }
        else { const int r = i - 1024; fox_unit(T_, (r & 63) >> 3, r & 7, 15 - (r >> 6), lds); }
    }
}
}

namespace gla {
constexpr int G_A1 = 0, G_QI = 4096, G_QR = 20480, G_KR = 36864, G_KH = 53248, G_V = 69632, G_BQ = 73728, G_ST = 77824, G_DEC = 94208;
DI int swo(int row, int colbyte) { return row * 256 + (colbyte ^ ((row & 15) << 4)); }
using att::crow; using att::vtr;

struct GlaT { bf16_t* projC; const float* a1; const float* w_a2; const float* b_a; bf16_t* O; bf16_t* att; float* dec; };

DI void gla_a1_item(const bf16_t* xb, const bf16_t* wa1t  , const float* ss2, float* a1, int item, LAS char* lds) {
    int tid_l_ = threadIdx.x; asm volatile("" : "+v"(tid_l_)); const int tid = tid_l_, lane = tid & 63, r32 = lane & 31, hi = lane >> 5, wid = __builtin_amdgcn_readfirstlane(tid >> 6);
    const int rg = wid & 3, kh = wid >> 2;
    const size_t row0 = (size_t)item * 128 + 32 * rg;
    const bf16_t* ap = xb + (row0 + r32) * DM + 512 * kh + 8 * hi;
    const bf16_t* bp = wa1t + (size_t)(r32 & 15) * DM + 512 * kh + 8 * hi;
    f32x16 c;
#pragma unroll
    for (int r = 0; r < 16; ++r) c[r] = 0.f;
#pragma unroll 8
    for (int ks = 0; ks < 32; ++ks) {
        const bf16x8 A = *(const bf16x8*)(ap + 16 * ks);
        bf16x8 B = *(const bf16x8*)(bp + 16 * ks);
        if (r32 >= 16) B = (bf16x8){0, 0, 0, 0, 0, 0, 0, 0};
        c = MFMA32(A, B, c);
    }
    LAS float* red = (LAS float*)lds + rg * 1024;
    if (kh == 1) {
#pragma unroll
        for (int r = 0; r < 16; ++r) red[crow(r, hi) * 32 + r32] = c[r];
    }
    __syncthreads();
    if (kh == 0 && r32 < 16) {
#pragma unroll
        for (int r = 0; r < 16; ++r) { const int rw = crow(r, hi); const size_t grow = row0 + rw;
            a1[grow * 16 + r32] = (c[r] + red[rw * 32 + r32]) * pg8::row_rstd(ss2, (int)grow); }
    }
    __syncthreads();
}

constexpr int P_A1 = 0, P_QR = 4096, P_KR = 20480, P_BQ = 36864;
struct PrepRegs { unsigned q[8], k[8]; f32x4 a1; };
DI void prep_load(PrepRegs& R, const GlaT& G, int item, int tid) {
    const int ch = item & 63, h = (item >> 6) & 3, b = item >> 8, d0 = 2 * (tid & 63), tg = tid >> 6;
    const size_t rb = (size_t)b * SEQ + 64 * ch;
#pragma unroll
    for (int c8 = 0; c8 < 8; ++c8) { const size_t rw = rb + 8 * tg + c8; R.q[c8] = *(const unsigned*)(G.projC + rw * LDC + PC_Q + h * 128 + d0); R.k[c8] = *(const unsigned*)(G.projC + rw * LDC + PC_K + h * 128 + d0); }
    R.a1 = (tid < 256) ? *(const f32x4*)(G.a1 + (rb + (tid >> 2)) * 16 + (tid & 3) * 4) : (f32x4){0.f, 0.f, 0.f, 0.f};
}
DI void gla_prep(const GlaT& G, int item, const PrepRegs& R, LAS char* lds) {
    int tid_l_ = threadIdx.x; asm volatile("" : "+v"(tid_l_)); const int tid = tid_l_, lane = tid & 63, r32 = lane & 31, hi = lane >> 5, wid = __builtin_amdgcn_readfirstlane(tid >> 6);
    const int ch = item & 63, h = (item >> 6) & 3, b = item >> 8;
    const int dp = tid & 63, tg = wid, d0 = 2 * dp;
    const size_t rb = (size_t)b * SEQ + 64 * ch;
    unsigned qraw[8], kraw[8];
#pragma unroll
    for (int c8 = 0; c8 < 8; ++c8) { qraw[c8] = R.q[c8]; kraw[c8] = R.k[c8]; }
    if (tid < 256) *(LAS f32x4*)(lds + P_A1 + tid * 16) = R.a1;
    float w2a[16], w2b[16];
#pragma unroll
    for (int r = 0; r < 16; ++r) { const f32x2 w = *(const f32x2*)(G.w_a2 + r * 512 + h * 128 + d0); w2a[r] = w[0]; w2b[r] = w[1]; }
    const f32x2 bav = *(const f32x2*)(G.b_a + h * 128 + d0);
    __syncthreads();
    float lp0[8], lp1[8]; float run0 = 0.f, run1 = 0.f;
#pragma unroll
    for (int c8 = 0; c8 < 8; ++c8) {
        const LAS f32x4* ar = (const LAS f32x4*)(lds + P_A1 + (8 * tg + c8) * 64);
        float z0 = bav[0], z1 = bav[1];
#pragma unroll
        for (int q4 = 0; q4 < 4; ++q4) { const f32x4 a = ar[q4];
#pragma unroll
            for (int e = 0; e < 4; ++e) { z0 += a[e] * w2a[4 * q4 + e]; z1 += a[e] * w2b[4 * q4 + e]; } }
        const float l0 = fminf(z0, 0.f) - __logf(1.0f + __expf(-fabsf(z0))), l1 = fminf(z1, 0.f) - __logf(1.0f + __expf(-fabsf(z1)));
        run0 += l0 * (1.0f / 16.0f); run1 += l1 * (1.0f / 16.0f);
        lp0[c8] = run0; lp1[c8] = run1;
    }
    *(LAS f32x2*)(lds + P_BQ + tg * 512 + d0 * 4) = (f32x2){run0, run1};
    __syncthreads();
    {
        float off0 = 0.f, off1 = 0.f, ref0 = 0.f, ref1 = 0.f, last0 = 0.f, last1 = 0.f;
#pragma unroll
        for (int t8 = 0; t8 < 8; ++t8) { const f32x2 q = *(const LAS f32x2*)(lds + P_BQ + t8 * 512 + d0 * 4);
            if (t8 < tg) { off0 += q[0]; off1 += q[1]; } if (t8 < 4) { ref0 += q[0]; ref1 += q[1]; } last0 += q[0]; last1 += q[1]; }
        const float emr0 = __expf(-ref0), emr1 = __expf(-ref1), epr0 = __expf(ref0), epr1 = __expf(ref1), epl0 = __expf(last0), epl1 = __expf(last1);
#pragma unroll
        for (int c8 = 0; c8 < 8; ++c8) {
            const int c = 8 * tg + c8;
            const float eb0 = __expf(off0 + lp0[c8]), eb1 = __expf(off1 + lp1[c8]);
            const float ib0 = __builtin_amdgcn_rcpf(eb0), ib1 = __builtin_amdgcn_rcpf(eb1);
            const float q0 = bflo(qraw[c8]), q1 = bfhi(qraw[c8]), k0 = bflo(kraw[c8]), k1 = bfhi(kraw[c8]);
            const float qi0 = q0 * eb0, qi1 = q1 * eb1, kb0 = k0 * ib0, kb1 = k1 * ib1;
            const int o = swo(c, 4 * dp);
            *(LAS unsigned*)(lds + P_QR + o) = cvtpk(qi0 * emr0, qi1 * emr1);
            *(LAS unsigned*)(lds + P_KR + o) = cvtpk(kb0 * epr0, kb1 * epr1);
            const size_t rw = rb + c;
            *(unsigned*)(G.projC + rw * LDC + PC_Q + h * 128 + d0) = cvtpk(qi0, qi1);
            *(unsigned*)(G.projC + rw * LDC + PC_K + h * 128 + d0) = cvtpk(kb0 * epl0, kb1 * epl1);
        }
        if (tg == 0) *(f32x2*)(G.dec + (size_t)item * 128 + d0) = (f32x2){epl0, epl1};
    }
    __syncthreads();
    if (wid < 3) {
        const int jt = wid == 2 ? 1 : 0, it = wid == 0 ? 0 : 1;
        f32x16 X;
#pragma unroll
        for (int r = 0; r < 16; ++r) X[r] = 0.f;
#pragma unroll
        for (int ks = 0; ks < 8; ++ks) {
            const bf16x8 A = *(const LAS bf16x8*)(lds + P_KR + swo(32 * jt + r32, (16 * ks + 8 * hi) * 2));
            const bf16x8 B = *(const LAS bf16x8*)(lds + P_QR + swo(32 * it + r32, (16 * ks + 8 * hi) * 2));
            X = MFMA32(A, B, X);
        }
        if (jt == it) {
#pragma unroll
            for (int r = 0; r < 16; ++r) if (att::crc(r) > r32 - 4 * hi) X[r] = 0.f;
        }
        bf16_t* ap = G.att + (size_t)item * 4096 + (32 * it + r32) * 64 + 32 * jt + 4 * hi;
#pragma unroll
        for (int g4 = 0; g4 < 4; ++g4) *(u32x2*)(ap + 8 * g4) = (u32x2){cvtpk(X[4 * g4], X[4 * g4 + 1]), cvtpk(X[4 * g4 + 2], X[4 * g4 + 3])};
    }
    __syncthreads();
}

constexpr int R_QI = 0, R_KH = 16384, R_ATT = 32768, R_V = 40960, R_DEC = 45056, R_BUF = 45568, R_ST = 2 * R_BUF;
DI void gla_unit(const GlaT& G, int b, int h, int es, LAS char* lds) {
    int tid_l_ = threadIdx.x; asm volatile("" : "+v"(tid_l_)); const int tid = tid_l_, lane = tid & 63, r32 = lane & 31, hi = lane >> 5, wid = __builtin_amdgcn_readfirstlane(tid >> 6);
    f32x16 S;
#pragma unroll
    for (int r = 0; r < 16; ++r) S[r] = 0.f;
    *(LAS u32x4*)(lds + R_ST + tid * 16) = (u32x4){0u, 0u, 0u, 0u};
    const size_t row00 = (size_t)b * SEQ;
    const int lrow = tid >> 3, lc = tid & 7;
    u32x4 rq0, rq1, rk0, rk1, ra, rv;
#define GLA_LOAD(ch) do { const size_t rw_ = row00 + 64 * (ch) + lrow; const bf16_t* pq_ = G.projC + rw_ * LDC + h * 128 + lc * 8; \
        rq0 = *(const u32x4*)(pq_ + PC_Q); rq1 = *(const u32x4*)(pq_ + PC_Q + 64); rk0 = *(const u32x4*)(pq_ + PC_K); rk1 = *(const u32x4*)(pq_ + PC_K + 64); \
        ra = *(const u32x4*)(G.att + ((size_t)((b * 4 + h) * 64 + (ch))) * 4096 + tid * 8); \
        if (tid < 256) rv = *(const u32x4*)(G.projC + (row00 + 64 * (ch) + (tid >> 2)) * LDC + PC_V + h * 256 + 32 * es + (tid & 3) * 8); \
        else if (tid < 288) rv = *(const u32x4*)(G.dec + ((size_t)((b * 4 + h) * 64 + (ch))) * 128 + (tid - 256) * 4); } while (0)
#define GLA_COMMIT(buf) do { LAS char* bb_ = lds + (buf) * R_BUF; \
        *(LAS u32x4*)(bb_ + R_QI + swo(lrow, lc * 16)) = rq0; *(LAS u32x4*)(bb_ + R_QI + swo(lrow, (lc + 8) * 16)) = rq1; \
        *(LAS u32x4*)(bb_ + R_KH + swo(lrow, lc * 16)) = rk0; *(LAS u32x4*)(bb_ + R_KH + swo(lrow, (lc + 8) * 16)) = rk1; \
        *(LAS u32x4*)(bb_ + R_ATT + lrow * 128 + ((lc ^ (lrow & 7)) * 16)) = ra; \
        if (tid < 256) *(LAS u32x4*)(bb_ + R_V + tid * 16) = rv; else if (tid < 288) *(LAS u32x4*)(bb_ + R_DEC + (tid - 256) * 16) = rv; } while (0)
    GLA_LOAD(0); GLA_COMMIT(0);
    __syncthreads();
    for (int ch = 0; ch < 64; ++ch) {
        const int par = ch & 1;
        if (ch + 1 < 64) GLA_LOAD(ch + 1);
        const LAS char* bb = lds + par * R_BUF;
        const size_t rowc = row00 + 64 * ch;
        if (wid < 2) {
            const int it = wid;
            f32x16 oacc;
#pragma unroll
            for (int r = 0; r < 16; ++r) oacc[r] = 0.f;
#pragma unroll
            for (int s = 0; s < 4; ++s) {
                if (s < 2 || it == 1) {
                    const int i = 32 * it + r32;
                    const bf16x8 A = *(const LAS bf16x8*)(bb + R_ATT + i * 128 + (((2 * s + hi) ^ (i & 7)) * 16));
                    const LAS char* vb = bb + R_V + (16 * s + 8 * hi + ((lane & 15) >> 2)) * 64 + ((lane >> 4) & 1) * 32 + (lane & 3) * 8;
                    const s16x4 lo = vtr(vb), hh = vtr(vb + 256);
                    const bf16x8 vf = (bf16x8){lo[0], lo[1], lo[2], lo[3], hh[0], hh[1], hh[2], hh[3]};
                    oacc = MFMA32(A, vf, oacc);
                }
            }
#pragma unroll
            for (int ks = 0; ks < 8; ++ks) {
                const bf16x8 A = *(const LAS bf16x8*)(bb + R_QI + swo(32 * it + r32, (16 * ks + 8 * hi) * 2));
                const bf16x8 B = *(const LAS bf16x8*)(lds + R_ST + par * 8192 + swo(r32, (16 * ks + 8 * hi) * 2));
                oacc = MFMA32(A, B, oacc);
            }
            LAS bf16_t* stg = (LAS bf16_t*)(lds + R_ST + 16384) + it * 1024;
#pragma unroll
            for (int r = 0; r < 16; ++r) stg[crow(r, hi) * 32 + r32] = (bf16_t)(cvtpk(oacc[r], 0.f) & 0xffffu);
#pragma unroll
            for (int i = 0; i < 2; ++i) { const int pc = lane + 64 * i, row = pc >> 2, q4 = pc & 3; const u32x4 v = *(const LAS u32x4*)(stg + row * 32 + q4 * 8);
                *(u32x4*)(G.O + (rowc + 32 * it + row) * DM + h * 256 + 32 * es + q4 * 8) = v; }
        } else if (wid >= 4) {
            const int dt = wid - 4;
            const LAS float* dec = (const LAS float*)(bb + R_DEC) + 32 * dt;
#pragma unroll
            for (int i = 0; i < 4; ++i) { const f32x4 dv = *(const LAS f32x4*)(dec + 8 * i + 4 * hi);
#pragma unroll
                for (int e = 0; e < 4; ++e) S[4 * i + e] *= dv[e]; }
#pragma unroll
            for (int s = 0; s < 4; ++s) {
                const int cq = 16 * s + 4 * hi + ((lane & 15) >> 2), colb = (32 * dt + 16 * ((lane >> 4) & 1) + 4 * (lane & 3)) * 2;
                const s16x4 alo = vtr(bb + R_KH + swo(cq, colb)), ahh = vtr(bb + R_KH + swo(cq + 8, colb));
                const LAS char* vb = bb + R_V + cq * 64 + ((lane >> 4) & 1) * 32 + (lane & 3) * 8;
                const s16x4 lo = vtr(vb), hh = vtr(vb + 512);
                const bf16x8 af = (bf16x8){alo[0], alo[1], alo[2], alo[3], ahh[0], ahh[1], ahh[2], ahh[3]};
                const bf16x8 vf = (bf16x8){lo[0], lo[1], lo[2], lo[3], hh[0], hh[1], hh[2], hh[3]};
                S = MFMA32(af, vf, S);
            }
#pragma unroll
            for (int i = 0; i < 4; ++i)
                *(LAS u32x2*)(lds + R_ST + (par ^ 1) * 8192 + swo(r32, (32 * dt + 8 * i + 4 * hi) * 2)) = (u32x2){cvtpk(S[4 * i], S[4 * i + 1]), cvtpk(S[4 * i + 2], S[4 * i + 3])};
        }
        if (ch + 1 < 64) GLA_COMMIT(par ^ 1);
        __syncthreads();
    }
#undef GLA_LOAD
#undef GLA_COMMIT
}

DI void gla_gate_rows2(bf16_t* O, const bf16_t* R, const float* gain, int m0, int lane) {
    u32x4 o0[2], o1[2], r0[2], r1[2];
#pragma unroll
    for (int u = 0; u < 2; ++u) { const bf16_t* Orow = O + (size_t)(m0 + u) * DM; const bf16_t* Rrow = R + (size_t)(m0 + u) * LDC;
        o0[u] = *(const u32x4*)(Orow + lane * 16); o1[u] = *(const u32x4*)(Orow + lane * 16 + 8); r0[u] = *(const u32x4*)(Rrow + lane * 16); r1[u] = *(const u32x4*)(Rrow + lane * 16 + 8); }
    const int c0 = (lane & 15) * 16;
    float gn[16];
#pragma unroll
    for (int i = 0; i < 4; ++i) { const f32x4 g4 = *(const f32x4*)(gain + c0 + 4 * i); gn[4 * i] = g4[0]; gn[4 * i + 1] = g4[1]; gn[4 * i + 2] = g4[2]; gn[4 * i + 3] = g4[3]; }
#pragma unroll
    for (int u = 0; u < 2; ++u) {
        float o[16], rr[16];
#pragma unroll
        for (int i = 0; i < 4; ++i) { o[2 * i] = bflo(o0[u][i]); o[2 * i + 1] = bfhi(o0[u][i]); o[8 + 2 * i] = bflo(o1[u][i]); o[8 + 2 * i + 1] = bfhi(o1[u][i]);
            rr[2 * i] = bflo(r0[u][i]); rr[2 * i + 1] = bfhi(r0[u][i]); rr[8 + 2 * i] = bflo(r1[u][i]); rr[8 + 2 * i + 1] = bfhi(r1[u][i]); }
        float ss = 0.f;
#pragma unroll
        for (int i = 0; i < 16; ++i) ss += o[i] * o[i];
        ss += __shfl_xor(ss, 1); ss += __shfl_xor(ss, 2); ss += __shfl_xor(ss, 4); ss += __shfl_xor(ss, 8);
        const float rs = rsqrtf(ss * (1.0f / 256.0f) + EPS);
        unsigned w[8];
#pragma unroll
        for (int i = 0; i < 8; ++i) { const float x0 = o[2 * i] * rs * gn[2 * i] * siluf_(rr[2 * i]), x1 = o[2 * i + 1] * rs * gn[2 * i + 1] * siluf_(rr[2 * i + 1]); w[i] = cvtpk(x0, x1); }
        bf16_t* Orow = O + (size_t)(m0 + u) * DM;
        *(u32x4*)(Orow + lane * 16) = (u32x4){w[0], w[1], w[2], w[3]}; *(u32x4*)(Orow + lane * 16 + 8) = (u32x4){w[4], w[5], w[6], w[7]};
    }
}
}

struct Ptrs {
    const float* in[31]; float* out; unsigned char* ws;
    DI bf16_t* bf(size_t off) const { return (bf16_t*)(ws + off); }
    DI float* f32(size_t off) const { return (float*)(ws + off); }
    DI int* i32(size_t off) const { return (int*)(ws + off); }
};
enum { I_X = 0, I_ANORM, I_AWIN, I_AQN, I_AKN, I_APEK, I_APEV, I_CK1, I_CK2, I_CV1, I_CV2, I_GBIAS, I_FQN, I_FKN, I_FFB, I_AWOUT, I_FNORM, I_FWG, I_FWU, I_FWD,
       I_CNORM, I_CWIN, I_CWA2, I_CBA, I_CONORM, I_CWOUT, I_MNORM, I_MROUTER, I_MWG, I_MWU, I_MWD };

namespace pro {
struct ConvM { const float* src; const float* src2; const float* gain; bf16_t* dst; int K, Ns, Nd, mode; };
DI int srccolA(int n) {
    const int pn = n >> 8, bj = (n >> 7) & 1, wc = (n >> 5) & 3, j = n & 31, s = 4 * pn + wc, d = 32 * bj + j;
    if (s < 8) return 64 * s + d;
    if (s < 10) return 768 + 64 * (s - 8) + d;
    if (s < 12) return 1024 + 64 * (s - 10) + d;
    if (s < 14) return 896 + 64 * (s - 12) + d;
    if (s < 16) return 1152 + 64 * (s - 14) + d;
    if (s < 18) return 512 + 64 * (s - 16) + d;
    if (s < 20) return 640 + 64 * (s - 18) + d;
    if (s < 28) return 1304 + 64 * (s - 20) + d;
    if (s < 36) return 1816 + 64 * (s - 28) + d;
    if (s < 44) return 2328 + 64 * (s - 36) + d;
    if (s == 44) { if (d < 24) return 1280 + d; if (d < 32) return 2840 + d - 24; }
    return -1;
}
DI void conv_item(const ConvM& M, int item, LAS float* scr, int lane) {
    const int nblk = M.Nd / 32, kb = item / nblk, nb = item % nblk, k0 = 64 * kb, n0 = 32 * nb;
    const int n = n0 + (lane & 31);
    const float* sp = M.src; int col = n;
    if (M.mode == 0) { if (n >= M.Ns) col = -1; }
    else if (M.mode == 1) col = srccolA(n);
    else { const int pn = n >> 8, half = (n >> 7) & 1, j = n & 127; sp = half ? M.src2 : M.src; col = 128 * pn + j; }
#pragma unroll 8
    for (int i = 0; i < 32; ++i) { const int kk = 2 * i + (lane >> 5); float w = 0.f; if (col >= 0) w = sp[(size_t)(k0 + kk) * M.Ns + col]; if (M.gain) w *= M.gain[k0 + kk]; scr[kk * 33 + (lane & 31)] = w; }
    const int c = lane & 7;
#pragma unroll
    for (int j = 0; j < 4; ++j) { const int nn = (lane >> 3) + 8 * j; const LAS float* s = scr + (8 * c) * 33 + nn;
        u32x4 o; o.x = cvtpk(s[0 * 33], s[1 * 33]); o.y = cvtpk(s[2 * 33], s[3 * 33]); o.z = cvtpk(s[4 * 33], s[5 * 33]); o.w = cvtpk(s[6 * 33], s[7 * 33]);
        *(u32x4*)(M.dst + (size_t)(n0 + nn) * M.K + k0 + 8 * c) = o; }
}
struct ConvRegs { f32x4 v[8]; };
DI void conv_big_load(ConvRegs& R, const ConvM& M, int item, int wid, int lane) {
    const int nblk = M.Nd / 256, kb = item / nblk, nb = item % nblk;
    const int k0 = 64 * kb + 8 * wid, n = 256 * nb + 4 * lane;
    const float* sp = M.src; int col = n;
    if (M.mode == 0) { if (n >= M.Ns) col = -1; }
    else if (M.mode == 1) col = srccolA(n);
    else { const int pn = n >> 8, half = (n >> 7) & 1, j = n & 127; sp = half ? M.src2 : M.src; col = 128 * pn + j; }
#pragma unroll
    for (int j = 0; j < 8; ++j) R.v[j] = (col >= 0) ? *(const f32x4*)(sp + (size_t)(k0 + j) * M.Ns + col) : (f32x4){0.f, 0.f, 0.f, 0.f};
}
DI void conv_big_store(ConvRegs& R, const ConvM& M, int item, LAS char* tile, int tid, int wid, int lane) {
    const int nblk = M.Nd / 256, kb = item / nblk, nb = item % nblk;
    if (M.gain) { const int k0 = 64 * kb + 8 * wid;
#pragma unroll
        for (int j = 0; j < 8; ++j) R.v[j] = R.v[j] * M.gain[k0 + j]; }
#pragma unroll
    for (int c = 0; c < 4; ++c) { u32x4 o; o.x = cvtpk(R.v[0][c], R.v[1][c]); o.y = cvtpk(R.v[2][c], R.v[3][c]); o.z = cvtpk(R.v[4][c], R.v[5][c]); o.w = cvtpk(R.v[6][c], R.v[7][c]);
        const int nl = 4 * lane + c; *(LAS u32x4*)(tile + nl * 128 + ((wid ^ (lane & 7)) * 16)) = o; }
    __syncthreads();
#pragma unroll
    for (int i = 0; i < 4; ++i) { const int r = (tid >> 3) + 64 * i, ch = tid & 7; const u32x4 o = *(const LAS u32x4*)(tile + r * 128 + ((ch ^ ((r >> 2) & 7)) * 16));
        *(u32x4*)(M.dst + (size_t)(256 * nb + r) * M.K + 64 * kb + 8 * ch) = o; }
    __syncthreads();
}
DI ConvM conv_desc(const Ptrs& P, int mat) {
    ConvM M; M.src2 = nullptr; M.gain = nullptr; M.mode = 0;
    switch (mat) {
    case 0: M.src = P.in[I_AWIN]; M.gain = P.in[I_ANORM]; M.dst = P.bf(WS_WA); M.K = 1024; M.Ns = IN_A; M.Nd = NA_PAD; M.mode = 1; break;
    case 1: M.src = P.in[I_AWOUT]; M.dst = P.bf(WS_WO); M.K = 1024; M.Ns = 1024; M.Nd = 1024; break;
    case 2: M.src = P.in[I_FWG]; M.src2 = P.in[I_FWU]; M.gain = P.in[I_FNORM]; M.dst = P.bf(WS_WFGU); M.K = 1024; M.Ns = DFF; M.Nd = 2 * DFF; M.mode = 2; break;
    case 3: M.src = P.in[I_FWD]; M.dst = P.bf(WS_WFD); M.K = DFF; M.Ns = 1024; M.Nd = 1024; break;
    case 4: M.src = P.in[I_CWIN]; M.gain = P.in[I_CNORM]; M.dst = P.bf(WS_WC); M.K = 1024; M.Ns = IN_C; M.Nd = NC_PAD; break;
    case 5: M.src = P.in[I_CWOUT]; M.dst = P.bf(WS_WCO); M.K = 1024; M.Ns = 1024; M.Nd = 1024; break;
    case 6: M.src = P.in[I_CK1]; M.dst = P.bf(CT_CW); M.K = 2048; M.Ns = 64; M.Nd = 64; break;
    case 7: M.src = P.in[I_CV1]; M.dst = P.bf(CT_CW + 262144); M.K = 2048; M.Ns = 64; M.Nd = 64; break;
    case 8: M.src = P.in[I_CK2]; M.dst = P.bf(CT_CW + 524288); M.K = 64; M.Ns = 64; M.Nd = 64; break;
    case 9: M.src = P.in[I_CV2]; M.dst = P.bf(CT_CW + 524288 + 8192); M.K = 64; M.Ns = 64; M.Nd = 64; break;
    default:
        if (mat < 18) { const int e = mat - 10; M.src = P.in[I_MWG] + (size_t)e * 1024 * DFF; M.src2 = P.in[I_MWU] + (size_t)e * 1024 * DFF; M.gain = P.in[I_MNORM];
            M.dst = P.bf(WS_WMGU) + (size_t)e * 2 * DFF * 1024; M.K = 1024; M.Ns = DFF; M.Nd = 2 * DFF; M.mode = 2; }
        else { const int e = mat - 18; M.src = P.in[I_MWD] + (size_t)e * DFF * 1024; M.dst = P.bf(WS_WMD) + (size_t)e * 1024 * DFF; M.K = DFF; M.Ns = 1024; M.Nd = 1024; }
    }
    return M;
}
DI int conv_items(int mat) {
    switch (mat) { case 0: return 16 * 12; case 1: return 16 * 4; case 2: return 16 * 22; case 3: return 44 * 4; case 4: return 16 * 13; case 5: return 16 * 4;
                   case 6: case 7: return 32 * 2; case 8: case 9: return 2; default: return mat < 18 ? 16 * 22 : 44 * 4; }
}
DI void prologue(const Ptrs& P, LAS char* lds) {
    int tid_l_ = threadIdx.x; asm volatile("" : "+v"(tid_l_)); const int tid = tid_l_, lane = tid & 63, wid = __builtin_amdgcn_readfirstlane(tid >> 6);
    const int gw = blockIdx.x * 8 + wid, NGW = gridDim.x * 8;
    LAS float* scr = (LAS float*)(lds + wid * 16384);
    {
        ConvRegs Ra, Rb; ConvM Ma, Mb; int ia = -1, ib = -1;
        int g = blockIdx.x, mat = 25, base = 0;
        auto advance = [&](ConvM& M, int& it) {
            it = -1;
            while (mat >= 0) {
                if (mat >= 6 && mat <= 9) { --mat; continue; }
                const int ni = conv_items(mat);
                if (g - base < ni) { M = conv_desc(P, mat); it = g - base; g += gridDim.x; return; }
                base += ni; --mat;
            }
        };
        advance(Ma, ia); if (ia >= 0) conv_big_load(Ra, Ma, ia, wid, lane);
        while (ia >= 0) {
            advance(Mb, ib); if (ib >= 0) conv_big_load(Rb, Mb, ib, wid, lane);
            conv_big_store(Ra, Ma, ia, lds + 65536 + 2048, tid, wid, lane);
            if (ib < 0) break;
            advance(Ma, ia); if (ia >= 0) conv_big_load(Ra, Ma, ia, wid, lane);
            conv_big_store(Rb, Mb, ib, lds + 65536 + 2048, tid, wid, lane);
        }
        for (int m2 = 6; m2 <= 9; ++m2) { const ConvM M = conv_desc(P, m2); const int ni = conv_items(m2); for (int it = gw; it < ni; it += NGW) conv_item(M, it, scr, lane); }
    }
    const float* x = P.in[I_X]; bf16_t* xb = P.bf(WS_XB); float* rstd0 = P.f32(CT_RSTD0);
    for (int m0 = gw * 2; m0 < T; m0 += NGW * 2) {
        f32x4 v[2][4];
#pragma unroll
        for (int u = 0; u < 2; ++u) { const f32x4* xr = (const f32x4*)(x + (size_t)(m0 + u) * DM) + lane;
#pragma unroll
            for (int j = 0; j < 4; ++j) v[u][j] = xr[64 * j]; }
#pragma unroll
        for (int u = 0; u < 2; ++u) {
            float s = 0.f;
#pragma unroll
            for (int j = 0; j < 4; ++j) s += (v[u][j][0] * v[u][j][0] + v[u][j][1] * v[u][j][1]) + (v[u][j][2] * v[u][j][2] + v[u][j][3] * v[u][j][3]);
            s = wave_sum(s);
            if (lane == 0) rstd0[m0 + u] = rsqrtf(s * (1.0f / 1024.0f) + EPS);
            u32x2* o8 = (u32x2*)(xb + (size_t)(m0 + u) * DM) + lane;
#pragma unroll
            for (int j = 0; j < 4; ++j) o8[64 * j] = (u32x2){cvtpk(v[u][j][0], v[u][j][1]), cvtpk(v[u][j][2], v[u][j][3])};
        }
    }
    float* cosT = P.f32(CT_ROPE); float* sinT = cosT + SEQ * 8;
    for (int idx = blockIdx.x * 512 + tid; idx < SEQ * 8; idx += gridDim.x * 512) {
        const int pos = idx >> 3, i = idx & 7;
        const float inv = powf(500000.0f, -(float)(2 * i) / 16.0f);
        const float ang = (float)pos * inv;
        const double rev = (double)ang * 0.15915494309189535; const float fr = (float)(rev - floor(rev));
        cosT[idx] = __builtin_amdgcn_cosf(fr); sinT[idx] = __builtin_amdgcn_sinf(fr);
    }
}

DI void fox_cum(const Ptrs& P, int bh, int lane) {
    const f32x4* lf = (const f32x4*)(P.f32(CT_LOGF) + (size_t)bh * SEQ + 64 * lane); f32x4* dst = (f32x4*)(P.f32(CT_CUM) + (size_t)bh * SEQ + 64 * lane);
    f32x4 v[16]; float tot = 0.f;
#pragma unroll
    for (int i = 0; i < 16; ++i) { v[i] = lf[i]; }
#pragma unroll
    for (int i = 0; i < 16; ++i) { v[i][1] += v[i][0]; v[i][2] += v[i][1]; v[i][3] += v[i][2]; const float t = v[i][3]; v[i] = v[i] + tot; tot += t; }
    float inc = tot;
#pragma unroll
    for (int o = 1; o < 64; o <<= 1) { const float t = __shfl_up(inc, o); if (lane >= o) inc += t; }
    const float base = inc - tot;
#pragma unroll
    for (int i = 0; i < 16; ++i) dst[i] = (v[i] + base) * (-LOG2E);
}

DI void compress_item(const Ptrs& P, int item, LAS char* lds) {
    int tid_l_ = threadIdx.x; asm volatile("" : "+v"(tid_l_)); const int tid = tid_l_, lane = tid & 63, r32 = lane & 31, hi = lane >> 5, wid = __builtin_amdgcn_readfirstlane(tid >> 6);
    const int kv = item >> 7, b = (item >> 4) & 7, g = (item >> 3) & 1, nt = item & 7;
    const bf16_t* projA = P.bf(WS_BIG);
    const float* pe = (kv ? P.in[I_APEV] : P.in[I_APEK]);
    const bf16_t* w1t = P.bf(CT_CW + (kv ? 262144 : 0)); const bf16_t* w2t = P.bf(CT_CW + 524288 + (kv ? 8192 : 0));
    int n = 32 * nt + r32; if (n > 254) n = 254;
    f32x16 c0, c1;
#pragma unroll
    for (int r = 0; r < 16; ++r) { c0[r] = 0.f; c1[r] = 0.f; }
#pragma unroll 8
    for (int kk = 0; kk < 16; ++kk) { const int ks = 16 * wid + kk;
        const int l = ks >> 2, d = 16 * (ks & 3) + 8 * hi;
        const u32x4 raw = *(const u32x4*)(projA + ((size_t)b * SEQ + 16 * n + l) * LDA + (kv ? PA_VC : PA_KC) + g * 64 + d);
        const f32x4 p0 = *(const f32x4*)(pe + l * 64 + d), p1 = *(const f32x4*)(pe + l * 64 + d + 4);
        u32x4 aw; aw.x = cvtpk(bflo(raw.x) + p0[0], bfhi(raw.x) + p0[1]); aw.y = cvtpk(bflo(raw.y) + p0[2], bfhi(raw.y) + p0[3]);
        aw.z = cvtpk(bflo(raw.z) + p1[0], bfhi(raw.z) + p1[1]); aw.w = cvtpk(bflo(raw.w) + p1[2], bfhi(raw.w) + p1[3]);
        const bf16x8 A = __builtin_bit_cast(bf16x8, aw);
        const bf16x8 B0 = *(const bf16x8*)(w1t + (size_t)r32 * 2048 + 16 * ks + 8 * hi), B1 = *(const bf16x8*)(w1t + (size_t)(32 + r32) * 2048 + 16 * ks + 8 * hi);
        c0 = MFMA32(A, B0, c0); c1 = MFMA32(A, B1, c1);
    }
    LAS float* red = (LAS float*)lds + wid * 2048;
#pragma unroll
    for (int r = 0; r < 16; ++r) { const int nn = att::crow(r, hi); red[nn * 64 + r32] = c0[r]; red[nn * 64 + 32 + r32] = c1[r]; }
    __syncthreads();
    {
        LAS bf16_t* H1 = (LAS bf16_t*)(lds + 65536);
        const LAS float* rd = (const LAS float*)lds;
        float s4[4];
#pragma unroll
        for (int e = 0; e < 4; ++e) { float s = 0.f;
#pragma unroll
            for (int w = 0; w < 8; ++w) s += rd[w * 2048 + tid * 4 + e];
            s4[e] = gelu_tanh(s); }
        *(LAS u32x2*)(H1 + tid * 4) = (u32x2){cvtpk(s4[0], s4[1]), cvtpk(s4[2], s4[3])};
    }
    __syncthreads();
    if (wid == 0) {
        f32x16 o0, o1;
#pragma unroll
        for (int r = 0; r < 16; ++r) { o0[r] = 0.f; o1[r] = 0.f; }
#pragma unroll
        for (int ks = 0; ks < 4; ++ks) {
            const bf16x8 A = *(const LAS bf16x8*)(lds + 65536 + r32 * 128 + (16 * ks + 8 * hi) * 2);
            const bf16x8 B0 = *(const bf16x8*)(w2t + r32 * 64 + 16 * ks + 8 * hi), B1 = *(const bf16x8*)(w2t + (32 + r32) * 64 + 16 * ks + 8 * hi);
            o0 = MFMA32(A, B0, o0); o1 = MFMA32(A, B1, o1);
        }
        bf16_t* dst = P.bf(kv ? CT_VCMP : CT_KCMP);
        if (kv == 0) {
            const float* kn = P.in[I_AKN]; const float g0 = kn[r32], g1 = kn[32 + r32];
            const float* cosT = P.f32(CT_ROPE); const float* sinT = cosT + SEQ * 8;
#pragma unroll
            for (int r = 0; r < 16; ++r) {
                float ss = o0[r] * o0[r] + o1[r] * o1[r];
                ss += __shfl_xor(ss, 1); ss += __shfl_xor(ss, 2); ss += __shfl_xor(ss, 4); ss += __shfl_xor(ss, 8); ss += __shfl_xor(ss, 16);
                const float rs = rsqrtf(ss * (1.0f / 64.0f) + EPS);
                float y0 = o0[r] * rs * g0; const float y1 = o1[r] * rs * g1;
                const float oth = __shfl_xor(y0, 8);
                const int nn = 32 * nt + att::crow(r, hi); const int pos = (16 * nn + 31) & (SEQ - 1);
                const float cc = cosT[pos * 8 + (r32 & 7)], sn = sinT[pos * 8 + (r32 & 7)];
                if (r32 < 8) y0 = y0 * cc - oth * sn; else if (r32 < 16) y0 = oth * sn + y0 * cc;
                o0[r] = y0; o1[r] = y1;
            }
        }
#pragma unroll
        for (int r = 0; r < 16; ++r) {
            const int nn = 32 * nt + att::crow(r, hi);
            const bool pad = nn > 254;
            bf16_t* dp = dst + (((size_t)b * NCMP_PAD + nn) * 2 + g) * 64;
            dp[r32] = pad ? (bf16_t)0 : (bf16_t)(cvtpk(o0[r], 0.f) & 0xffffu); dp[32 + r32] = pad ? (bf16_t)0 : (bf16_t)(cvtpk(o1[r], 0.f) & 0xffffu);
        }
    }
    __syncthreads();
}
}

namespace moe {
DI void route_block(const Ptrs& P, int blk, LAS char* lds) {
    int tid_l_ = threadIdx.x; asm volatile("" : "+v"(tid_l_)); const int tid = tid_l_, lane = tid & 63, r32 = lane & 31, hi = lane >> 5, wid = __builtin_amdgcn_readfirstlane(tid >> 6);
    constexpr int RPITCH = 1032;
    LAS bf16_t* RBH = (LAS bf16_t*)lds; LAS bf16_t* RBL = RBH + 8 * RPITCH;
    LAS float* PART = (LAS float*)(lds + 36864); LAS float* LG = (LAS float*)(lds + 40960);
    LAS int* einfo = (LAS int*)(lds + 33280);
    const float* router = P.in[I_MROUTER]; const float* mg = P.in[I_MNORM];
    for (int i = tid; i < 8192; i += 512) { const int k = i >> 3, e = i & 7; const float v = router[i] * mg[k];
        const unsigned hb = cvtpk(v, 0.f) & 0xffffu; const float vh = __uint_as_float(hb << 16); const unsigned lb = cvtpk(v - vh, 0.f) & 0xffffu;
        RBH[e * RPITCH + k] = (bf16_t)hb; RBL[e * RPITCH + k] = (bf16_t)lb; }
    __syncthreads();
    const bf16_t* xb3 = P.bf(WS_HM);
    {
        const int rt = wid & 3, kh = wid >> 2;
        const bf16_t* ap = xb3 + ((size_t)blk * 128 + 32 * rt + r32) * DM + 512 * kh + 8 * hi;
        const LAS bf16_t* bh = RBH + (r32 & 7) * RPITCH + 512 * kh + 8 * hi; const LAS bf16_t* bl = RBL + (r32 & 7) * RPITCH + 512 * kh + 8 * hi;
        f32x16 c;
#pragma unroll
        for (int r = 0; r < 16; ++r) c[r] = 0.f;
#pragma unroll 8
        for (int ks = 0; ks < 32; ++ks) {
            const bf16x8 A = *(const bf16x8*)(ap + 16 * ks);
            c = MFMA32(A, *(const LAS bf16x8*)(bh + 16 * ks), c); c = MFMA32(A, *(const LAS bf16x8*)(bl + 16 * ks), c);
        }
        if (kh == 1 && r32 < 8) {
#pragma unroll
            for (int r = 0; r < 16; ++r) PART[(32 * rt + att::crow(r, hi)) * 8 + r32] = c[r];
        }
        __syncthreads();
        if (kh == 0 && r32 < 8) {
#pragma unroll
            for (int r = 0; r < 16; ++r) { const int tk = 32 * rt + att::crow(r, hi); LG[tk * 8 + r32] = c[r] + PART[tk * 8 + r32]; }
        }
        __syncthreads();
    }
    if (tid < 128) {
        const int tl = tid, t = blk * 128 + tl;
        const f32x4 la = *(const LAS f32x4*)(LG + tl * 8), lb = *(const LAS f32x4*)(LG + tl * 8 + 4);
        const float rs = pg8::row_rstd(P.f32(CT_SS3), t);
        const float acc[8] = {la[0], la[1], la[2], la[3], lb[0], lb[1], lb[2], lb[3]};
        int e1 = 0; float l1 = acc[0] * rs;
#pragma unroll
        for (int e = 1; e < 8; ++e) { const float l = acc[e] * rs; if (l > l1) { l1 = l; e1 = e; } }
        int e2 = -1; float l2 = -3.0e38f;
#pragma unroll
        for (int e = 0; e < 8; ++e) { const float l = acc[e] * rs; if (e != e1 && l > l2) { l2 = l; e2 = e; } }
        const float w1 = 1.0f / (1.0f + __expf(l2 - l1));
        einfo[tl * 2] = e1; einfo[tl * 2 + 1] = e2;
        P.f32(MO_TOKW)[(size_t)t * 2] = w1; P.f32(MO_TOKW)[(size_t)t * 2 + 1] = 1.0f - w1;
        P.f32(MO_TOKR)[t] = rs;
    }
    __syncthreads();
    LAS int* rk = (LAS int*)(lds + 34304);
    if (tid < 256) { const int e = einfo[tid]; int r = 0; for (int j = 0; j < tid; ++j) r += (einfo[j] == e) ? 1 : 0; rk[tid] = r; }
    if (tid >= 256 && tid < 264) { const int e = tid - 256; int c = 0; for (int j = 0; j < 256; ++j) c += (einfo[j] == e) ? 1 : 0; P.i32(MO_HIST)[blk * 8 + e] = c; }
    __syncthreads();
    if (tid < 128) { const int t = blk * 128 + tid; ((unsigned*)P.i32(MO_TOKE))[t] = (unsigned)einfo[2 * tid] | ((unsigned)einfo[2 * tid + 1] << 4) | ((unsigned)rk[2 * tid] << 8) | ((unsigned)rk[2 * tid + 1] << 20); }
    __syncthreads();
}
DI void scatter_block(const Ptrs& P, int blk, LAS char* lds) {
    int tid_l_ = threadIdx.x; asm volatile("" : "+v"(tid_l_)); const int tid = tid_l_, lane = tid & 63, wid = __builtin_amdgcn_readfirstlane(tid >> 6);
    LAS int* sh = (LAS int*)lds;
    const int* hist = P.i32(MO_HIST);
    { typedef int i32x4 __attribute__((ext_vector_type(4))); *(LAS i32x4*)(sh + 64 + tid * 4) = *(const i32x4*)(hist + tid * 4); }
    __syncthreads();
    if (tid < 8) { int c = 0, pre = 0; for (int j = 0; j < 256; ++j) { const int v = sh[64 + j * 8 + tid]; c += v; if (j < blk) pre += v; } sh[tid] = c; sh[8 + tid] = pre; }
    __syncthreads();
    if (tid == 0) { int acc = 0; for (int e = 0; e < 8; ++e) { sh[16 + e] = acc; acc += ((sh[e] + 255) >> 8) << 8; } sh[24] = acc; }
    __syncthreads();
    const bf16_t* xb3 = P.bf(WS_HM); bf16_t* xy = P.bf(WS_XY);
    for (int q0 = wid * 32; q0 < wid * 32 + 32; q0 += 4) {
        u32x4 a[4], c[4]; int rowv[4];
#pragma unroll
        for (int u = 0; u < 4; ++u) {
            const int q = q0 + u, tl = q >> 1, slot = q & 1, t = blk * 128 + tl;
            const unsigned info = ((const unsigned*)P.i32(MO_TOKE))[t];
            const int e = slot ? (info >> 4) & 15 : info & 15, lr = slot ? (info >> 20) & 4095 : (info >> 8) & 4095;
            rowv[u] = sh[16 + e] + sh[8 + e] + lr;
            const u32x4* src = (const u32x4*)(xb3 + (size_t)t * DM) + lane;
            a[u] = src[0]; c[u] = src[64];
            if (lane == 0) { P.f32(MO_RSCALE)[rowv[u]] = P.f32(MO_TOKR)[t]; P.f32(MO_RGATE)[rowv[u]] = P.f32(MO_TOKW)[(size_t)t * 2 + slot]; P.f32(MO_RKEEP)[rowv[u]] = slot ? 0.f : 1.f; P.i32(MO_POS)[(size_t)t * 2 + slot] = rowv[u]; }
        }
#pragma unroll
        for (int u = 0; u < 4; ++u) { u32x4* dst = (u32x4*)(xy + (size_t)rowv[u] * DM) + lane; dst[0] = a[u]; dst[64] = c[u]; }
    }
    if (blk < 8) {
        const int e = blk, r0 = sh[16 + e] + sh[e], r1 = sh[16 + e + 1];
        for (int row = r0 + wid; row < r1; row += 8) { u32x2* o8 = (u32x2*)(xy + (size_t)row * DM) + lane;
#pragma unroll
            for (int j = 0; j < 4; ++j) o8[64 * j] = (u32x2){0u, 0u};
            if (lane == 0) { P.f32(MO_RSCALE)[row] = 0.f; P.f32(MO_RGATE)[row] = 0.f; P.f32(MO_RKEEP)[row] = 0.f; } }
    }
    if (blk == 8) {
        int* te = P.i32(MO_TILEE); const int ntl = sh[24] >> 8;
        for (int tl = tid; tl < 271; tl += 512) { int e = 0; for (int k = 1; k < 8; ++k) if (tl * 256 >= sh[16 + k]) e = k; te[tl] = e; }
        if (tid == 0) te[271] = ntl;
    }
    __syncthreads();
}
template <int NR> DI void combine_rows(const Ptrs& P, int t0, int lane) {
    const bf16_t* y = P.bf(WS_XY);
    int p1[NR], p2[NR];
#pragma unroll
    for (int u = 0; u < NR; ++u) { p1[u] = P.i32(MO_POS)[(size_t)(t0 + u) * 2]; p2[u] = P.i32(MO_POS)[(size_t)(t0 + u) * 2 + 1]; }
    u32x2 a[NR][4], c[NR][4];
#pragma unroll
    for (int u = 0; u < NR; ++u) {
        const u32x2* y1 = (const u32x2*)(y + (size_t)p1[u] * DM) + lane; const u32x2* y2 = (const u32x2*)(y + (size_t)p2[u] * DM) + lane;
#pragma unroll
        for (int j = 0; j < 4; ++j) { a[u][j] = y1[64 * j]; c[u][j] = y2[64 * j]; }
    }
#pragma unroll
    for (int u = 0; u < NR; ++u) {
        f32x4* orow = (f32x4*)(P.out + (size_t)(t0 + u) * DM) + lane;
#pragma unroll
        for (int j = 0; j < 4; ++j) { f32x4 w; w[0] = bflo(a[u][j][0]) + bflo(c[u][j][0]); w[1] = bfhi(a[u][j][0]) + bfhi(c[u][j][0]); w[2] = bflo(a[u][j][1]) + bflo(c[u][j][1]); w[3] = bfhi(a[u][j][1]) + bfhi(c[u][j][1]); orow[64 * j] = w; }
    }
}
}
#define XB_TMO      128
#define XB_XCNT(j)  (256  + 64 * (j))
#define XB_XSUB(j)  (1280 + 64 * (j))
#define XB_XGEN(j)  (2304 + 64 * (j))
#define XB_TOP      3328
#define XB_TOPGEN   3392
#define XCD_BAR_WORDS 3456
#define XB_SPIN_CAP (1u << 18)

__device__ __forceinline__ unsigned xb_ld(unsigned* p)              { return __hip_atomic_load(p, __ATOMIC_RELAXED, __HIP_MEMORY_SCOPE_AGENT); }
__device__ __forceinline__ unsigned xb_add(unsigned* p, unsigned v) { return __hip_atomic_fetch_add(p, v, __ATOMIC_RELAXED, __HIP_MEMORY_SCOPE_AGENT); }
__device__ __forceinline__ unsigned xb_xcc_id() { return (unsigned)__builtin_amdgcn_s_getreg((3 << 11) | 20) & 0xFu; }
#define XB_SPIN(cond, bar) do { unsigned _sp = 0; while (cond) { __builtin_amdgcn_s_sleep(1); \
    if ((++_sp & 255u) == 0u) { if (xb_ld(&(bar)[XB_TMO])) break; if (_sp > XB_SPIN_CAP) { atomicAdd(&(bar)[XB_TMO], 1u); break; } } } } while (0)

struct XcdBarrier {
    unsigned* bar; unsigned x;
    volatile LAS unsigned* st;
};

__device__ __forceinline__ XcdBarrier xcd_barrier_post(unsigned* bar, volatile LAS unsigned* st) {
    XcdBarrier b; b.bar = bar; b.x = xb_xcc_id(); b.st = st;
    if (threadIdx.x == 0) (void)xb_add(&bar[XB_XCNT(b.x)], 1u);
    return b;
}
__device__ __forceinline__ void xcd_barrier_complete(unsigned* bar, unsigned x, unsigned& nloc, unsigned& nx) {
    const unsigned G = gridDim.x * gridDim.y * gridDim.z;
    unsigned sum, cnt, mine, sp = 0u;
    for (;;) {
        sum = 0u; cnt = 0u; mine = 0u;
#pragma unroll
        for (unsigned j = 0; j < 16; ++j) { const unsigned c = xb_ld(&bar[XB_XCNT(j)]); sum += c; cnt += (c > 0u) ? 1u : 0u; mine = (j == x) ? c : mine; }
        if (sum == G) break;
        __builtin_amdgcn_s_sleep(1);
        if ((++sp & 255u) == 0u) { if (xb_ld(&bar[XB_TMO])) break; if (sp > XB_SPIN_CAP) { atomicAdd(&bar[XB_TMO], 1u); break; } }
    }
    nloc = mine > 0u ? mine : 1u; nx = cnt > 0u ? cnt : 1u;
}

__device__ __forceinline__ void xcd_barrier(const XcdBarrier& b) {
    asm volatile("s_waitcnt vmcnt(0)" ::: "memory");
    __syncthreads();
    if (threadIdx.x == 0) {
        unsigned* bar = b.bar;
        __builtin_amdgcn_s_waitcnt(0);
        unsigned nloc = b.st[0], nx = b.st[1];
        if (nloc == 0u) { xcd_barrier_complete(bar, b.x, nloc, nx); b.st[0] = nloc; b.st[1] = nx; }
        const unsigned old = xb_add(&bar[XB_XSUB(b.x)], 1u);
        const unsigned gen = old / nloc;
        if (old + 1u == (gen + 1u) * nloc) {
            __builtin_amdgcn_fence(__ATOMIC_RELEASE, "agent");
            asm volatile("s_waitcnt vmcnt(0)" ::: "memory");
            const unsigned og = xb_add(&bar[XB_TOP], 1u);
            const unsigned tg = og / nx;
            if (og + 1u == (tg + 1u) * nx) xb_add(&bar[XB_TOPGEN], 1u);
            else XB_SPIN(xb_ld(&bar[XB_TOPGEN]) == tg, bar);
            __builtin_amdgcn_fence(__ATOMIC_ACQUIRE, "agent");
            xb_add(&bar[XB_XGEN(b.x)], 1u);
            asm volatile("s_waitcnt vmcnt(0)" ::: "memory");
        } else {
            XB_SPIN(xb_ld(&bar[XB_XGEN(b.x)]) == gen, bar);
            __builtin_amdgcn_fence(__ATOMIC_ACQUIRE, "agent");
            asm volatile("s_waitcnt vmcnt(0)" ::: "memory");
        }
    }
    __syncthreads();
}

#ifndef MK_N_LAUNCHES
#define MK_N_LAUNCHES 1
#endif
constexpr int N_PHASES = 18;

__global__ void __launch_bounds__(512, 2) mega_fwd(Args args) {
    extern __shared__ __attribute__((aligned(16))) unsigned char lds_raw[];
    LAS char* lds = (LAS char*)lds_raw;
    cg::grid_group grid = cg::this_grid();
    Ptrs P;
#pragma unroll
    for (int i = 0; i < 31; ++i) P.in[i] = args.in[i];
    P.out = args.out; P.ws = args.ws;
    const int lo = args.ph_lo, hi_ = args.ph_hi;
    const int tid = threadIdx.x, lane = tid & 63, wid = __builtin_amdgcn_readfirstlane(tid >> 6);
    const int G = gridDim.x, gw = blockIdx.x * 8 + wid, NGW = G * 8;
#define IN(k) (lo <= (k) && (k) < hi_)
    { volatile LAS unsigned* st0 = (volatile LAS unsigned*)(lds_raw + LDS_MISC); if (tid < 64) st0[tid] = 0u; }
    __syncthreads();
    XcdBarrier xbar; xbar.bar = (unsigned*)(args.ws + CT_BAR); xbar.x = 0; xbar.st = (volatile LAS unsigned*)(lds_raw + LDS_MISC) + 8;
    const bool one_launch = (lo == 0 && hi_ == N_PHASES);
    if (one_launch) { if (blockIdx.x == 0) { for (int i = tid; i < 1024; i += 512) ((unsigned*)(args.ws + CT_CTR))[i] = 0u; for (int i = tid; i < 4096; i += 512) ((unsigned*)(args.ws + CT_BAR))[i] = 0u; } }
    else xbar = xcd_barrier_post((unsigned*)(args.ws + CT_BAR), (volatile LAS unsigned*)(lds_raw + LDS_MISC) + 8);
#define SEAM(k) do { if (IN(k) && IN((k) + 1)) { if ((k) == 0) { grid.sync(); if (one_launch) xbar = xcd_barrier_post((unsigned*)(args.ws + CT_BAR), (volatile LAS unsigned*)(lds_raw + LDS_MISC) + 8); } else xcd_barrier(xbar); } } while (0)
    LAS unsigned char* glds = (LAS unsigned char*)lds_raw;

    if (IN(0)) { pro::prologue(P, lds); }
    SEAM(0);
    if (IN(1)) {
        pg8::Gemm g{P.bf(WS_XB), P.bf(WS_WA), T, NA_PAD, DM}; pg8::StaticOrder S; S.init(T, NA_PAD, G, (int)blockIdx.x);
        const float* cosT = P.f32(CT_ROPE);
        pg8::EpiInA E{P.bf(WS_BIG), P.f32(CT_RSTD0), cosT, cosT + SEQ * 8, P.in[I_AQN], P.in[I_AKN], P.in[I_FQN], P.in[I_FKN], P.in[I_GBIAS], P.in[I_FFB], P.f32(CT_GATE), P.f32(CT_LOGF)};
        pg8::gemm_phase<pg8::EpiInA, pg8::StaticOrder, true, true>(glds, g, S, E);
    }
    SEAM(1);
    if (IN(2)) {
        if (gw < 64) pro::fox_cum(P, gw, lane);
        for (int it = blockIdx.x; it < 256; it += G) pro::compress_item(P, it, lds);
    }
    SEAM(2);
    if (IN(3)) {
        att::Tensors AT{P.bf(WS_BIG), P.bf(CT_KCMP), P.bf(CT_VCMP), P.f32(CT_GATE), P.f32(CT_CUM), P.bf(WS_O), P.in[I_FQN], P.in[I_FKN], P.in[I_AQN], P.in[I_AKN]};
        att::attn_phase(AT, (unsigned*)(P.ws + CT_CTR), lds);
    }
    SEAM(3);
    if (IN(4)) {
        pg8::Gemm g{P.bf(WS_O), P.bf(WS_WO), T, DM, DM}; pg8::StaticOrder S; S.init(T, DM, G, (int)blockIdx.x);
        pg8::EpiResid<true> E{P.in[I_X], P.bf(WS_XB), P.f32(CT_SS1)};
        pg8::gemm_phase<pg8::EpiResid<true>, pg8::StaticOrder, true, true>(glds, g, S, E);
    }
    SEAM(4);
    if (IN(5)) {
        pg8::Gemm g{P.bf(WS_XB), P.bf(WS_WFGU), T, 2 * DFF, DM}; pg8::StaticOrder S; S.init(T, 2 * DFF, G, (int)blockIdx.x);
        pg8::EpiSwiglu<false> E{P.bf(WS_BIG), P.f32(CT_SS1), 0};
        pg8::gemm_phase<pg8::EpiSwiglu<false>, pg8::StaticOrder, true, true>(glds, g, S, E);
    }
    SEAM(5);
    if (IN(6)) {
        pg8::Gemm g{P.bf(WS_BIG), P.bf(WS_WFD), T, DM, DFF}; pg8::StaticOrder S; S.init(T, DM, G, (int)blockIdx.x);
        pg8::EpiResid<false> E{P.bf(WS_XB), P.bf(WS_XB), P.f32(CT_SS2)};
        pg8::gemm_phase<pg8::EpiResid<false>, pg8::StaticOrder, true, true>(glds, g, S, E);
    }
    SEAM(6);
    if (IN(7)) {
        for (int it = blockIdx.x; it < T / 128; it += G) gla::gla_a1_item(P.bf(WS_XB), P.bf(WS_WC) + (size_t)LDC * DM, P.f32(CT_SS2), P.f32(CT_A1), it, lds);
        pg8::Gemm g{P.bf(WS_XB), P.bf(WS_WC), T, LDC, DM}; pg8::StaticOrder S; S.init(T, LDC, G, (int)blockIdx.x);
        pg8::EpiGlaIn E{P.bf(WS_BIG), P.f32(CT_SS2)};
        pg8::gemm_phase<pg8::EpiGlaIn, pg8::StaticOrder, true, true>(glds, g, S, E);
    }
    SEAM(7);
    if (IN(8)) {
        gla::GlaT GT{P.bf(WS_BIG), P.f32(CT_A1), P.in[I_CWA2], P.in[I_CBA], P.bf(WS_O), P.bf(WS_ATT), P.f32(CT_GATE)};
        {
            gla::PrepRegs Ra, Rb; int it = blockIdx.x;
            if (it < 2048) gla::prep_load(Ra, GT, it, tid);
            while (it < 2048) {
                const int i1 = it + G; if (i1 < 2048) gla::prep_load(Rb, GT, i1, tid);
                gla::gla_prep(GT, it, Ra, lds);
                if (i1 >= 2048) break;
                const int i2 = i1 + G; if (i2 < 2048) gla::prep_load(Ra, GT, i2, tid);
                gla::gla_prep(GT, i1, Rb, lds);
                it = i2;
            }
        }
        xcd_barrier(xbar);
        for (int u = blockIdx.x; u < 256; u += G) { const int bh = (u & 7) * 4 + (u >> 6), es = (u >> 3) & 7; gla::gla_unit(GT, bh >> 2, bh & 3, es, lds); }
    }
    SEAM(8);
    if (IN(9)) {
        for (int m = gw * 2; m < T; m += NGW * 2) gla::gla_gate_rows2(P.bf(WS_O), P.bf(WS_BIG) + PC_R, P.in[I_CONORM], m, lane);
    }
    SEAM(9);
    if (IN(10)) {
        pg8::Gemm g{P.bf(WS_O), P.bf(WS_WCO), T, DM, DM}; pg8::StaticOrder S; S.init(T, DM, G, (int)blockIdx.x);
        pg8::EpiResid<false> E{P.bf(WS_XB), P.bf(WS_HM), P.f32(CT_SS3)};
        pg8::gemm_phase<pg8::EpiResid<false>, pg8::StaticOrder, true, true>(glds, g, S, E);
    }
    SEAM(10);
    if (IN(11)) { for (int blk = blockIdx.x; blk < 256; blk += G) moe::route_block(P, blk, lds); }
    SEAM(11);
    if (IN(12)) { for (int blk = blockIdx.x; blk < 256; blk += G) moe::scatter_block(P, blk, lds); }
    SEAM(12);
#pragma unroll 1
    for (int pass = 0; pass < 2; ++pass) {
        const int tile0 = pass * MOE_PASS_TILES;
        if (IN(13 + 2 * pass)) {
            int ntp = __builtin_amdgcn_readfirstlane(P.i32(MO_TILEE)[271]) - tile0; { const int cap = pass == 0 ? MOE_PASS_TILES : MOE_PASS1_MAX; ntp = ntp < 0 ? 0 : (ntp > cap ? cap : ntp); }
            if (ntp > 0) {
                pg8::Gemm g{P.bf(WS_XY) + (size_t)tile0 * 256 * DM, P.bf(WS_WMGU), ntp * 256, 2 * DFF, DM};
                pg8::GroupedOrder S; S.so.init(ntp * 256, 2 * DFF, G, (int)blockIdx.x); S.tile_e = P.i32(MO_TILEE); S.tile0 = tile0; S.nN = 22;
                pg8::EpiSwiglu<true> E{P.bf(WS_HM), P.f32(MO_RSCALE), tile0 * 256};
                pg8::gemm_phase<pg8::EpiSwiglu<true>, pg8::GroupedOrder, true, true>(glds, g, S, E);
            }
        }
        SEAM(13 + 2 * pass);
        if (IN(14 + 2 * pass)) {
            int ntp = __builtin_amdgcn_readfirstlane(P.i32(MO_TILEE)[271]) - tile0; { const int cap = pass == 0 ? MOE_PASS_TILES : MOE_PASS1_MAX; ntp = ntp < 0 ? 0 : (ntp > cap ? cap : ntp); }
            if (ntp > 0) {
                pg8::Gemm g{P.bf(WS_HM), P.bf(WS_WMD), ntp * 256, DM, DFF};
                pg8::GroupedOrder S; S.so.init(ntp * 256, DM, G, (int)blockIdx.x); S.tile_e = P.i32(MO_TILEE); S.tile0 = tile0; S.nN = 4;
                pg8::EpiMoeDown E{P.bf(WS_XY), P.f32(MO_RGATE), P.f32(MO_RKEEP), tile0 * 256};
                pg8::gemm_phase<pg8::EpiMoeDown, pg8::GroupedOrder, true, true>(glds, g, S, E);
            }
        }
        SEAM(14 + 2 * pass);
    }
    if (IN(17)) { for (int m = gw * 2; m < T; m += NGW * 2) moe::combine_rows<2>(P, m, lane); }
#undef IN
#undef SEAM
}

extern "C" void kernel_launch(void* const* d_in, const int* in_sizes, int n_in, void* d_out, int out_size, void* d_ws, size_t ws_size, hipStream_t stream) {
    static int grid = 0;
    if (grid == 0) {
        if (n_in != 31 || out_size != T * DM || ws_size < WS_END) { fprintf(stderr, "kernel_launch: unexpected problem (n_in %d, out %d, ws %zu)\n", n_in, out_size, ws_size); grid = -1; return; }
        int dev = 0, cus = 0, per_cu = 0;
        hipGetDevice(&dev); hipDeviceGetAttribute(&cus, hipDeviceAttributeMultiprocessorCount, dev);
        if (hipFuncSetAttribute((const void*)mega_fwd, hipFuncAttributeMaxDynamicSharedMemorySize, LDS_BYTES) != hipSuccess) { fprintf(stderr, "kernel_launch: hipFuncSetAttribute failed\n"); grid = -1; return; }
        if (hipOccupancyMaxActiveBlocksPerMultiprocessor(&per_cu, (const void*)mega_fwd, 512, LDS_BYTES) != hipSuccess || per_cu < 1) { fprintf(stderr, "kernel_launch: occupancy query says %d\n", per_cu); per_cu = 1; }
        (void)hipGetLastError();
        grid = cus * 1;
        if (per_cu < 1) grid = -1;
    }
    if (grid < 0) return;
#if MK_N_LAUNCHES != 1
    hipMemsetAsync((char*)d_ws, 0, CT_ZERO_BYTES, stream);
#endif
    Args a{};
    for (int i = 0; i < 31; ++i) a.in[i] = (const float*)d_in[i];
    a.out = (float*)d_out; a.ws = (unsigned char*)d_ws;
#if MK_N_LAUNCHES == 1
    a.ph_lo = 0; a.ph_hi = N_PHASES;
    void* kargs[] = {&a};
    hipError_t e = hipLaunchCooperativeKernel((const void*)mega_fwd, dim3(grid), dim3(512), kargs, LDS_BYTES, stream);
    if (e != hipSuccess) fprintf(stderr, "cooperative launch failed: %s (grid %d)\n", hipGetErrorString(e), grid);
#else
    for (int ph = 0; ph < N_PHASES; ++ph) {
        a.ph_lo = ph; a.ph_hi = ph + 1;
        hipLaunchKernelGGL(mega_fwd, dim3(grid), dim3(512), LDS_BYTES, stream, a);
    }
#endif
}
```

```cpp
#include <hip/hip_runtime.h>
#include <hip/hip_cooperative_groups.h>
#include <cstdio>
#include <cstdint>
namespace cg = cooperative_groups;

#define DI __device__ __forceinline__
#define LAS __attribute__((address_space(3)))
#define GAS __attribute__((address_space(1)))
typedef unsigned short bf16_t;
typedef short bf16x8 __attribute__((ext_vector_type(8)));
typedef short s16x4 __attribute__((ext_vector_type(4)));
typedef float f32x2 __attribute__((ext_vector_type(2)));
typedef float f32x4 __attribute__((ext_vector_type(4)));
typedef float f32x16 __attribute__((ext_vector_type(16)));
typedef unsigned u32x2 __attribute__((ext_vector_type(2)));
typedef unsigned u32x4 __attribute__((ext_vector_type(4)));

constexpr int BATCH = 8, SEQ = 4096, DM = 1024, T = BATCH * SEQ;
constexpr int HD = 64;
constexpr int NSA_H = 8, NSA_G = 2, FOX_H = 8;
constexpr int NCMP = 255, NCMP_PAD = 256;
constexpr int IN_A = 2848, LDA = 2816  , NA_PAD = 3072;
constexpr int DFF = 2816;
constexpr int IN_C = 3088, LDC = 3072  , NC_PAD = 3328;
constexpr int NEXP = 8;
constexpr int MOE_TILES_MAX = 264, MOE_PASS_TILES = 128, MOE_PASS1_MAX = 136;
constexpr float EPS = 1e-6f;
constexpr float LOG2E = 1.4426950408889634f;
constexpr float QSCALE = 0.125f * LOG2E;
constexpr int PA_QA = 0, PA_KSL = 512, PA_KWN = 640, PA_VSL = 768, PA_VWN = 896, PA_KC = 1024, PA_VC = 1152, PA_QB = 1280, PA_KB = 1792, PA_VB = 2304;
constexpr int PC_Q = 0, PC_K = 512, PC_V = 1024, PC_R = 2048;

constexpr size_t MiB = 1u << 20;
constexpr size_t CT_CTR = 0;
constexpr size_t CT_BAR = 65536;
constexpr size_t CT_SS1 = 501 * MiB, CT_SS2 = 503 * MiB, CT_SS3 = 505 * MiB;
constexpr size_t CT_ZERO_BYTES = 1 * MiB;
static_assert(CT_BAR + 16384 <= CT_ZERO_BYTES, "zero region");
constexpr size_t CT_RSTD0 = 1 * MiB;
constexpr size_t CT_ROPE = CT_RSTD0 + (size_t)T * 4;
constexpr size_t CT_LOGF = 2 * MiB;
constexpr size_t CT_CUM = 3 * MiB;
constexpr size_t CT_GATE = 4 * MiB;
constexpr size_t CT_A1 = 7 * MiB;
constexpr size_t CT_KCMP = 9 * MiB, CT_VCMP = CT_KCMP + 512 * 1024;
constexpr size_t CT_CW = 10 * MiB;
constexpr size_t CT_MOE = 11 * MiB;
constexpr size_t WS_WA = 16 * MiB;
constexpr size_t WS_WO = WS_WA + 6 * MiB;
constexpr size_t WS_WFGU = WS_WO + 2 * MiB;
constexpr size_t WS_WFD = WS_WFGU + 11 * MiB;
constexpr size_t WS_WC = WS_WFD + 5632 * 1024;
constexpr size_t WS_WCO = WS_WC + 6656 * 1024;
constexpr size_t WS_WMGU = 49 * MiB;
constexpr size_t WS_WMD = WS_WMGU + 88 * MiB;
static_assert(WS_WCO + 2 * MiB <= WS_WMGU, "weights map");
constexpr size_t WS_XB = 181 * MiB;
constexpr size_t WS_O = 245 * MiB;
constexpr size_t WS_ATT = WS_WA;
constexpr size_t WS_BIG = 309 * MiB;
constexpr size_t WS_XY = 181 * MiB;
constexpr size_t WS_HM = 313 * MiB;
constexpr size_t WS_PART = 16 * MiB;
constexpr int MOE_XROW0 = 2 * MOE_PASS_TILES * 256;
constexpr size_t WS_END = 512 * MiB;
static_assert(WS_PART + (size_t)8 * 256 * 11 * 1024 * 4 <= WS_WMD, "partials map");
static_assert(WS_WMD + 44 * MiB <= WS_XB && WS_BIG + (size_t)T * LDC * 2 <= WS_END && WS_XY + (size_t)MOE_TILES_MAX * 256 * 1024 * 2 <= WS_HM && WS_HM + (size_t)MOE_PASS1_MAX * 256 * DFF * 2 <= WS_END, "d_ws map");
constexpr size_t MO_TOKE = CT_MOE;
constexpr size_t MO_TOKW = MO_TOKE + (size_t)T * 4;
constexpr size_t MO_TOKR = MO_TOKW + (size_t)T * 8;
constexpr size_t MO_POS = MO_TOKR + (size_t)T * 4;
constexpr size_t MO_HIST = MO_POS + (size_t)T * 8;
constexpr size_t MO_RSCALE = MO_HIST + 8192;
constexpr size_t MO_RGATE = MO_RSCALE + (size_t)MOE_TILES_MAX * 256 * 4;
constexpr size_t MO_RKEEP = MO_RGATE + (size_t)MOE_TILES_MAX * 256 * 4;
constexpr size_t MO_TILEE = MO_RKEEP + (size_t)MOE_TILES_MAX * 256 * 4;
constexpr size_t MO_ROWTOK = MO_TILEE + 2048;
static_assert(MO_ROWTOK + 8192 <= WS_WA, "moe tables");

constexpr int LDS_BYTES = 163840;
constexpr int LDS_MISC = 163584;

DI unsigned cvtpk(float lo, float hi) { typedef __bf16 b2 __attribute__((ext_vector_type(2))); f32x2 v = {lo, hi}; b2 b = __builtin_convertvector(v, b2); return __builtin_bit_cast(unsigned, b); }
DI float bf2f(unsigned short h) { return __uint_as_float((unsigned)h << 16); }
DI float bflo(unsigned w) { return __uint_as_float(w << 16); }
DI float bfhi(unsigned w) { return __uint_as_float(w & 0xffff0000u); }
DI float wave_sum(float v) {
#pragma unroll
    for (int o = 1; o < 64; o <<= 1) v += __shfl_xor(v, o);
    return v;
}
DI float sigmoidf_(float z) { return 1.0f / (1.0f + __expf(-z)); }
DI float log_sigmoidf_(float z) { return fminf(z, 0.f) - __logf(1.0f + __expf(-fabsf(z))); }
DI float siluf_(float z) { return z * __builtin_amdgcn_rcpf(1.0f + __builtin_amdgcn_exp2f(-LOG2E * z)); }
DI float gelu_tanh(float x) { const float u = 0.7978845608028654f * (x + 0.044715f * x * x * x); const float e = __expf(2.f * u); const float t = 1.f - 2.f / (e + 1.f); return 0.5f * x * (1.f + t); }

struct Args {
    const float* in[31];
    float* out;
    unsigned char* ws;
    int ph_lo, ph_hi;
};
namespace pg8 {
#define PG8_LAS __attribute__((address_space(3)))
typedef unsigned short bf16_t;
typedef short bf16x8 __attribute__((ext_vector_type(8)));
typedef float f32x4 __attribute__((ext_vector_type(4)));
typedef unsigned u32x4 __attribute__((ext_vector_type(4)));
constexpr int BM = 256, BK = 64, HALF = 128, HTB = HALF * BK * 2  , STAGE_BYTES = 8 * HTB, NXCD = 8, WGM = 8;

__host__ __device__ __forceinline__ int lds_byte(int r, int c) { const int st = (r >> 4) * 2 + (c >> 5), rr = r & 15, cc = c & 31, ob = rr * 64 + cc * 2; return st * 1024 + (ob ^ (((ob >> 9) & 1) << 5)); }
__host__ __device__ __forceinline__ void stage_rc(int b, int& R, int& C) { const int st = b / 1024, sb = b % 1024, swz = sb ^ (((sb >> 9) & 1) << 5); R = (st >> 1) * 16 + swz / 64; C = (st & 1) * 32 + (swz % 64) / 2; }
__host__ __device__ __forceinline__ int perm32(int rho) { const int n = rho >> 4, i = rho & 15; return 8 * (i >> 2) + 4 * n + (i & 3); }

struct Unit { int pm, pn, ko; };
struct Gemm { const bf16_t* A; const bf16_t* Bt; int M, N, K; int ld = 0; };

struct StaticOrder {
    static constexpr bool SLICED = false;
    int nM, nN, nwg, G, c;
    __host__ __device__ void init(int M, int N, int G_, int c_) { nM = M / BM; nN = N / BM; nwg = nM * nN; G = G_; c = c_; }
    __host__ __device__ bool next(int i, Unit& u) const {
        const long L = (long)i * G + c; if (L >= nwg) return false;
        int wgid = (int)L; { const int q = nwg / NXCD, r = nwg % NXCD, xcd = wgid % NXCD, off = wgid / NXCD; wgid = (xcd < r ? xcd * (q + 1) : r * (q + 1) + (xcd - r) * q) + off; }
        const int nig = WGM * nN, gid = wgid / nig, fm = gid * WGM, gsz = (nM - fm) < WGM ? (nM - fm) : WGM;
        u.pm = fm + ((wgid % nig) % gsz); u.pn = (wgid % nig) / gsz; return true;
    }
    __device__ __forceinline__ void a_ready(const Unit&) const {}
    __device__ __forceinline__ void done(const Unit&) const {}
};


#define EPI_ROWS(...) _Pragma("unroll") for (int ai = 0; ai < 2; ++ai) _Pragma("unroll") for (int m = 0; m < 4; ++m) { const int rowl = u.pm * BM + ai * HALF + wr * 64 + m * 16 + fr; __VA_ARGS__ }

struct EpiInA {
    static constexpr bool PERM = true, AFTER_DRAIN = false;
    bf16_t* projA; const float* rstd0; const float* cosT; const float* sinT;
    const float *qn, *kn, *fqn, *fkn, *gbias, *fbias; float* gate; float* logf;
    __device__ __forceinline__ void operator()(const f32x4 (&acc)[2][2][4][2], const Unit& u, int wr, int wc, int fr, int fq) const {
        const int s = u.pn * 4 + wc;
        if (s > 44) return;
        int kind = 0; const float* gain = qn; float scale = 1.f;
        if (s < 8) { kind = 2; gain = qn; scale = QSCALE; }
        else if (s < 12) { kind = 2; gain = kn; }
        else if (s < 20) { kind = 0; }
        else if (s < 28) { kind = 1; gain = fqn; scale = QSCALE; }
        else if (s < 36) { kind = 1; gain = fkn; }
        else if (s < 44) { kind = 0; }
        else kind = 3;
        float rsv[8];
#pragma unroll
        for (int q = 0; q < 8; ++q) rsv[q] = rstd0[u.pm * BM + (q >> 2) * HALF + wr * 64 + (q & 3) * 16 + fr];
        if (kind == 3) {
            EPI_ROWS(
                const float rs = rsv[ai * 4 + m];
                float v[8];
                _Pragma("unroll") for (int n = 0; n < 2; ++n) _Pragma("unroll") for (int e = 0; e < 4; ++e) v[n * 4 + e] = acc[ai][0][m][n][e] * rs;
                if (fq < 3) { float o[8]; _Pragma("unroll") for (int j = 0; j < 8; ++j) o[j] = sigmoidf_(v[j] + gbias[8 * fq + j]);
                    *(f32x4*)(gate + (size_t)rowl * 24 + 8 * fq) = (f32x4){o[0], o[1], o[2], o[3]}; *(f32x4*)(gate + (size_t)rowl * 24 + 8 * fq + 4) = (f32x4){o[4], o[5], o[6], o[7]}; }
                else { float o[8]; _Pragma("unroll") for (int j = 0; j < 8; ++j) o[j] = log_sigmoidf_(v[j] + fbias[j]);
                    _Pragma("unroll") for (int j = 0; j < 8; ++j) logf[((size_t)(rowl >> 12) * 8 + j) * SEQ + (rowl & (SEQ - 1))] = o[j]; }
            )
            return;
        }
        const bool do_norm = kind >= 1, do_rope = kind == 2;
        float g[16];
#pragma unroll
        for (int i = 0; i < 16; ++i) g[i] = (do_norm ? gain[32 * (i >> 3) + 8 * fq + (i & 7)] : 1.f) * scale;
        const float ir[8] = {0.15915494309189535f, 0.03086376340470123f, 0.005985185712713705f, 0.001160663641240061f, 0.00022507907903927653f, 4.364795279280289e-05f, 8.464330808241401e-06f, 1.6414262627950345e-06f};
        const bool rope_lane = do_rope && fq < 2;
        EPI_ROWS(
            const float rs = rsv[ai * 4 + m];
            float v[16];
            _Pragma("unroll") for (int bj = 0; bj < 2; ++bj) _Pragma("unroll") for (int n = 0; n < 2; ++n) _Pragma("unroll") for (int e = 0; e < 4; ++e) v[bj * 8 + n * 4 + e] = acc[ai][bj][m][n][e] * rs;
            float ss = 0.f;
            _Pragma("unroll") for (int i = 0; i < 16; ++i) ss += v[i] * v[i];
            ss += __shfl_xor(ss, 16); ss += __shfl_xor(ss, 32);
            const float r = do_norm ? rsqrtf(ss * (1.0f / 64.0f) + EPS) : 1.f;
            _Pragma("unroll") for (int i = 0; i < 16; ++i) v[i] = v[i] * (r * g[i]);
            if (do_rope) {
            float oth[8];
            _Pragma("unroll") for (int j = 0; j < 8; ++j) oth[j] = __shfl_xor(v[j], 16);
            const float pos = rope_lane ? (float)(rowl & (SEQ - 1)) : 0.f;
            const float sgn = (fq == 0) ? -1.f : 1.f;
            _Pragma("unroll") for (int j = 0; j < 8; ++j) { const float rev = pos * ir[j]; const float fr_ = rev - floorf(rev); const float cc = __builtin_amdgcn_cosf(fr_), sn = __builtin_amdgcn_sinf(fr_) * sgn;
                v[j] = v[j] * cc + oth[j] * sn; }
            }
            bf16_t* dst = projA + (size_t)rowl * LDA + s * 64 + 8 * fq;
            _Pragma("unroll") for (int bj = 0; bj < 2; ++bj) { u32x4 w; w.x = ::cvtpk(v[bj * 8 + 0], v[bj * 8 + 1]); w.y = ::cvtpk(v[bj * 8 + 2], v[bj * 8 + 3]);
                w.z = ::cvtpk(v[bj * 8 + 4], v[bj * 8 + 5]); w.w = ::cvtpk(v[bj * 8 + 6], v[bj * 8 + 7]); *(u32x4*)(dst + 32 * bj) = w; }
        )
    }
};

__device__ __forceinline__ float row_rstd(const float* ssp, int row) { const f32x4* q = (const f32x4*)(ssp + (size_t)row * 16); const f32x4 a = q[0], b = q[1], c = q[2], d = q[3];
    const float s = (((a[0] + a[1]) + (a[2] + a[3])) + ((b[0] + b[1]) + (b[2] + b[3]))) + (((c[0] + c[1]) + (c[2] + c[3])) + ((d[0] + d[1]) + (d[2] + d[3]))); return rsqrtf(s * (1.0f / 1024.0f) + EPS); }
template <bool RES_F32> struct EpiResid {
    static constexpr bool PERM = true, AFTER_DRAIN = false;
    const void* res; bf16_t* outb; float* ss;
    __device__ __forceinline__ void operator()(const f32x4 (&acc)[2][2][4][2], const Unit& u, int wr, int wc, int fr, int fq) const {
        constexpr int MB = RES_F32 ? 2 : 4;
#pragma unroll
        for (int ai = 0; ai < 2; ++ai)
#pragma unroll
            for (int m0 = 0; m0 < 4; m0 += MB) {
                f32x4 r0[MB][2], r1[MB][2];
#pragma unroll
                for (int mm = 0; mm < MB; ++mm) { const int rowl = u.pm * BM + ai * HALF + wr * 64 + (m0 + mm) * 16 + fr; const size_t off = (size_t)rowl * DM + u.pn * BM + wc * 32 + 8 * fq;
#pragma unroll
                    for (int bj = 0; bj < 2; ++bj) {
                        if (RES_F32) { r0[mm][bj] = *(const f32x4*)((const float*)res + off + bj * HALF); r1[mm][bj] = *(const f32x4*)((const float*)res + off + bj * HALF + 4); }
                        else { const u32x4 rw = *(const u32x4*)((const bf16_t*)res + off + bj * HALF); r0[mm][bj] = (f32x4){bflo(rw.x), bfhi(rw.x), bflo(rw.y), bfhi(rw.y)}; r1[mm][bj] = (f32x4){bflo(rw.z), bfhi(rw.z), bflo(rw.w), bfhi(rw.w)}; } } }
#pragma unroll
                for (int mm = 0; mm < MB; ++mm) { const int m = m0 + mm; const int rowl = u.pm * BM + ai * HALF + wr * 64 + m * 16 + fr; const size_t off = (size_t)rowl * DM + u.pn * BM + wc * 32 + 8 * fq; float part = 0.f;
#pragma unroll
                    for (int bj = 0; bj < 2; ++bj) {
                        const f32x4 x0 = r0[mm][bj] + acc[ai][bj][m][0], x1 = r1[mm][bj] + acc[ai][bj][m][1];
                        u32x4 w; w.x = ::cvtpk(x0[0], x0[1]); w.y = ::cvtpk(x0[2], x0[3]); w.z = ::cvtpk(x1[0], x1[1]); w.w = ::cvtpk(x1[2], x1[3]); *(u32x4*)(outb + off + bj * HALF) = w;
                        part += (x0[0] * x0[0] + x0[1] * x0[1]) + (x0[2] * x0[2] + x0[3] * x0[3]) + (x1[0] * x1[0] + x1[1] * x1[1]) + (x1[2] * x1[2] + x1[3] * x1[3]);
                    }
                    part += __shfl_xor(part, 16); part += __shfl_xor(part, 32);
                    if (fq == 0 && ss) ss[(size_t)rowl * 16 + u.pn * 4 + wc] = part; }
            }
    }
};

template <bool MOE> struct EpiSwiglu {
    static constexpr bool PERM = true, AFTER_DRAIN = false;
    bf16_t* h; const float* rsrc; int row_off;
    __device__ __forceinline__ void operator()(const f32x4 (&acc)[2][2][4][2], const Unit& u, int wr, int wc, int fr, int fq) const {
        const int pnl = MOE ? (u.pn % 22) : u.pn;
        float rsv[8];
#pragma unroll
        for (int q = 0; q < 8; ++q) { const int rl = u.pm * BM + (q >> 2) * HALF + wr * 64 + (q & 3) * 16 + fr; rsv[q] = MOE ? rsrc[row_off + rl] : row_rstd(rsrc, rl); }
        EPI_ROWS(
            const float rs = rsv[ai * 4 + m]; const float c1 = -LOG2E * rs, kq = __builtin_amdgcn_rcpf(rs * rs);
            f32x4 o4[2];
            _Pragma("unroll") for (int n = 0; n < 2; ++n) { const f32x4 gg = acc[ai][0][m][n], uu = acc[ai][1][m][n]; const f32x4 a = gg * c1;
                const f32x4 ex = {__builtin_amdgcn_exp2f(a[0]), __builtin_amdgcn_exp2f(a[1]), __builtin_amdgcn_exp2f(a[2]), __builtin_amdgcn_exp2f(a[3])};
                const f32x4 d = ex * kq + kq;
                const f32x4 r = {__builtin_amdgcn_rcpf(d[0]), __builtin_amdgcn_rcpf(d[1]), __builtin_amdgcn_rcpf(d[2]), __builtin_amdgcn_rcpf(d[3])};
                o4[n] = (gg * uu) * r; }
            u32x4 w; w.x = ::cvtpk(o4[0][0], o4[0][1]); w.y = ::cvtpk(o4[0][2], o4[0][3]); w.z = ::cvtpk(o4[1][0], o4[1][1]); w.w = ::cvtpk(o4[1][2], o4[1][3]);
            *(u32x4*)(h + (size_t)rowl * DFF + pnl * 128 + wc * 32 + 8 * fq) = w;
        )
    }
};

struct EpiGlaIn {
    static constexpr bool PERM = true, AFTER_DRAIN = false;
    bf16_t* projC; const float* rstd2;
    __device__ __forceinline__ void operator()(const f32x4 (&acc)[2][2][4][2], const Unit& u, int wr, int wc, int fr, int fq) const {
        float rsv[8];
#pragma unroll
        for (int q = 0; q < 8; ++q) rsv[q] = rstd2[u.pm * BM + (q >> 2) * HALF + wr * 64 + (q & 3) * 16 + fr];
        EPI_ROWS(
            float rs = rsv[ai * 4 + m]; if (u.pn < 2) rs *= 0.08838834764831845f;
            _Pragma("unroll") for (int bj = 0; bj < 2; ++bj) { const f32x4 x0 = acc[ai][bj][m][0] * rs, x1 = acc[ai][bj][m][1] * rs;
                u32x4 w; w.x = ::cvtpk(x0[0], x0[1]); w.y = ::cvtpk(x0[2], x0[3]); w.z = ::cvtpk(x1[0], x1[1]); w.w = ::cvtpk(x1[2], x1[3]);
                *(u32x4*)(projC + (size_t)rowl * LDC + u.pn * BM + bj * HALF + wc * 32 + 8 * fq) = w; }
        )
    }
};

struct EpiMoeDown {
    static constexpr bool PERM = true, AFTER_DRAIN = false;
    bf16_t* xy; const float* rgate; const float* rkeep; int row_off;
    __device__ __forceinline__ void operator()(const f32x4 (&acc)[2][2][4][2], const Unit& u, int wr, int wc, int fr, int fq) const {
        const int pnl = u.pn & 3;
        float gv[8], kv[8];
#pragma unroll
        for (int q = 0; q < 8; ++q) { const int rg_ = row_off + u.pm * BM + (q >> 2) * HALF + wr * 64 + (q & 3) * 16 + fr; gv[q] = rgate[rg_]; kv[q] = rkeep[rg_]; }
#pragma unroll
        for (int ai = 0; ai < 2; ++ai) {
            u32x4 old4[4][2];
#pragma unroll
            for (int m = 0; m < 4; ++m) { const int rowg = row_off + u.pm * BM + ai * HALF + wr * 64 + m * 16 + fr;
#pragma unroll
                for (int bj = 0; bj < 2; ++bj) old4[m][bj] = *(const u32x4*)(xy + (size_t)rowg * DM + pnl * BM + bj * HALF + wc * 32 + 8 * fq); }
#pragma unroll
            for (int m = 0; m < 4; ++m) { const int rowg = row_off + u.pm * BM + ai * HALF + wr * 64 + m * 16 + fr; const float w8 = gv[ai * 4 + m], kp = kv[ai * 4 + m];
#pragma unroll
                for (int bj = 0; bj < 2; ++bj) {
                    bf16_t* dst = xy + (size_t)rowg * DM + pnl * BM + bj * HALF + wc * 32 + 8 * fq;
                    const u32x4 rw = old4[m][bj];
                    const f32x4 r0 = (f32x4){bflo(rw.x), bfhi(rw.x), bflo(rw.y), bfhi(rw.y)}, r1 = (f32x4){bflo(rw.z), bfhi(rw.z), bflo(rw.w), bfhi(rw.w)};
                    const f32x4 x0 = r0 * kp + acc[ai][bj][m][0] * w8, x1 = r1 * kp + acc[ai][bj][m][1] * w8;
                    u32x4 w; w.x = ::cvtpk(x0[0], x0[1]); w.y = ::cvtpk(x0[2], x0[3]); w.z = ::cvtpk(x1[0], x1[1]); w.w = ::cvtpk(x1[2], x1[3]);
                    *(u32x4*)dst = w; } }
        }
    }
};

struct GroupedOrder {
    static constexpr bool SLICED = false;
    StaticOrder so; const int* tile_e; int tile0, nN;
    __device__ __forceinline__ bool next(int i, Unit& u) const { if (!so.next(i, u)) return false; u.pn = __builtin_amdgcn_readfirstlane(tile_e[tile0 + u.pm]) * nN + u.pn; return true; }
    __device__ __forceinline__ void a_ready(const Unit&) const {}
    __device__ __forceinline__ void done(const Unit&) const {}
};

struct SliceOrder {
    static constexpr bool SLICED = true;
    const int* tile_e; int tile0  , xt0  , nunits, G, c;
    __device__ __forceinline__ bool next(int i, Unit& u) const { const int j = i * G + c; if (j >= nunits) return false;
        const int xt = j / 44, rem = j - xt * 44; u.pm = xt0 + xt; u.pn = __builtin_amdgcn_readfirstlane(tile_e[tile0 + u.pm]) * 4 + (rem & 3); u.ko = (rem >> 2) * 256; return true; }
    __device__ __forceinline__ void a_ready(const Unit&) const {}
    __device__ __forceinline__ void done(const Unit&) const {}
};
struct EpiMoePart {
    static constexpr bool PERM = true, AFTER_DRAIN = false;
    float* part; int xt0;
    __device__ __forceinline__ void operator()(const f32x4 (&acc)[2][2][4][2], const Unit& u, int wr, int wc, int fr, int fq) const {
        const int pnl = u.pn & 3, sl = u.ko >> 8;
#pragma unroll
        for (int ai = 0; ai < 2; ++ai)
#pragma unroll
            for (int m = 0; m < 4; ++m) { const int xr = (u.pm - xt0) * BM + ai * HALF + wr * 64 + m * 16 + fr;
                float* dst = part + ((size_t)xr * 11 + sl) * DM + pnl * BM + wc * 32 + 8 * fq;
#pragma unroll
                for (int bj = 0; bj < 2; ++bj) { *(f32x4*)(dst + bj * HALF) = acc[ai][bj][m][0]; *(f32x4*)(dst + bj * HALF + 4) = acc[ai][bj][m][1]; } }
    }
};
template <class Epi, class Sched, bool ALIGN_EPI = false, bool SP2 = false>
__device__ __forceinline__ void gemm_phase(PG8_LAS unsigned char* lds, const Gemm g, const Sched& S, const Epi& E) {
    int tid_l_ = threadIdx.x; asm volatile("" : "+v"(tid_l_)); const int tid = tid_l_, wid = __builtin_amdgcn_readfirstlane(tid >> 6), lane = tid & 63, wr = wid >> 2, wc = wid & 3, fr = lane & 15, fq = lane >> 4;
    const int K = g.ld ? g.ld : g.K  , nt = g.K / BK;
    unsigned voffA[2], voffB[2];
#pragma unroll
    for (int i = 0; i < 2; ++i) { int R, C; stage_rc(tid * 16 + i * 8192, R, C); const int Rb = Epi::PERM ? ((R & ~31) + perm32(R & 31)) : R;
        voffA[i] = (unsigned)(R * K + C) * 2u; voffB[i] = (unsigned)(Rb * K + C) * 2u; }
    const size_t kstep = (size_t)(BK * 2);
    const size_t hstep = (size_t)HALF * K * 2;
    const size_t tstep = 2 * hstep;
    const unsigned ldsw = (unsigned)wid * 1024u;
    const int aoff = lds_byte(wr * 64 + fr, fq * 8), boff = lds_byte(wc * 32 + fr, fq * 8);
#define PG8_SA(b, h) (((b) * 2 + (h)) * HTB)
#define PG8_SB(b, h) ((4 + (b) * 2 + (h)) * HTB)
#define PG8_STAGE(bufoff, gbase, voff) do { _Pragma("unroll") for (int _i = 0; _i < 2; ++_i) \
        __builtin_amdgcn_global_load_lds((const unsigned*)((const char*)(gbase) + (voff)[_i]), (PG8_LAS unsigned*)(lds + (bufoff) + ldsw + _i * 8192), 16, 0, 0); } while (0)
#define PG8_LDA(dst, b, h) do { _Pragma("unroll") for (int m = 0; m < 4; ++m) _Pragma("unroll") for (int k = 0; k < 2; ++k) dst[m][k] = *(const PG8_LAS bf16x8*)(lds + PG8_SA(b, h) + aoff + m * 2048 + k * 1024); } while (0)
#define PG8_LDB(dst, b, h) do { _Pragma("unroll") for (int n = 0; n < 2; ++n) _Pragma("unroll") for (int k = 0; k < 2; ++k) dst[n][k] = *(const PG8_LAS bf16x8*)(lds + PG8_SB(b, h) + boff + n * 2048 + k * 1024); } while (0)
#define PG8_MMA(ai, bj, At, Bt) do { __builtin_amdgcn_s_setprio(1); _Pragma("unroll") for (int m = 0; m < 4; ++m) _Pragma("unroll") for (int n = 0; n < 2; ++n) _Pragma("unroll") for (int k = 0; k < 2; ++k) \
        acc[ai][bj][m][n] = __builtin_amdgcn_mfma_f32_16x16x32_bf16(Bt[n][k], At[m][k], acc[ai][bj][m][n], 0, 0, 0); __builtin_amdgcn_s_setprio(0); } while (0)
#define PG8_WAIT_V(n) asm volatile("s_waitcnt vmcnt(" #n ")" ::: "memory")
#define PG8_WAIT_L(n) asm volatile("s_waitcnt lgkmcnt(" #n ")" ::: "memory")
#define PG8_BAR __builtin_amdgcn_s_barrier()
#define PG8_SCHED __builtin_amdgcn_sched_barrier(0)
    Unit cur, nxt; int ui = 0;
    if (!S.next(0, cur)) return;
    f32x4 acc[2][2][4][2];
#pragma unroll
    for (int a = 0; a < 2; ++a)
#pragma unroll
        for (int b = 0; b < 2; ++b)
#pragma unroll
            for (int m = 0; m < 4; ++m)
#pragma unroll
                for (int n = 0; n < 2; ++n) acc[a][b][m][n] = (f32x4){0.f, 0.f, 0.f, 0.f};
    bf16x8 At[4][2], B0[2][2], B1[2][2];
    const char* cA = (const char*)g.A + (size_t)cur.pm * tstep; const char* cB = (const char*)g.Bt + (size_t)cur.pn * tstep;
    if constexpr (Sched::SLICED) { cA += (size_t)cur.ko * 2; cB += (size_t)cur.ko * 2; }
    S.a_ready(cur);
    if constexpr (SP2) {
        PG8_STAGE(PG8_SB(0, 0), cB, voffB); PG8_STAGE(PG8_SB(0, 1), cB + hstep, voffB); PG8_STAGE(PG8_SA(0, 0), cA, voffA); PG8_STAGE(PG8_SA(0, 1), cA + hstep, voffA);
        if (wr == 1) PG8_BAR;
        PG8_WAIT_V(2); PG8_BAR;
        PG8_STAGE(PG8_SB(1, 0), cB + kstep, voffB); PG8_STAGE(PG8_SA(1, 0), cA + kstep, voffA); PG8_STAGE(PG8_SB(1, 1), cB + hstep + kstep, voffB);
        PG8_WAIT_V(6); PG8_BAR;
    } else {
        PG8_STAGE(PG8_SB(0, 0), cB, voffB); PG8_STAGE(PG8_SA(0, 0), cA, voffA); PG8_STAGE(PG8_SB(0, 1), cB + hstep, voffB); PG8_STAGE(PG8_SA(0, 1), cA + hstep, voffA);
        if (wr == 1) PG8_BAR;
        PG8_WAIT_V(4); PG8_BAR;
        PG8_STAGE(PG8_SB(1, 0), cB + kstep, voffB); PG8_STAGE(PG8_SA(1, 0), cA + kstep, voffA); PG8_STAGE(PG8_SB(1, 1), cB + hstep + kstep, voffB);
        PG8_WAIT_V(6); PG8_BAR;
    }
    for (;;) {
        const bool has_next = S.next(ui + 1, nxt);
        const char* nA = has_next ? (const char*)g.A + (size_t)nxt.pm * tstep + (Sched::SLICED ? (size_t)nxt.ko * 2 : (size_t)0) : cA; const char* nB = has_next ? (const char*)g.Bt + (size_t)nxt.pn * tstep + (Sched::SLICED ? (size_t)nxt.ko * 2 : (size_t)0) : cB;
        for (int t = 0; t < nt; t += 2) {
            const bool last = (t == nt - 2);
            const char* a1 = cA + (size_t)(t + 1) * kstep;
            const char* a2 = last ? nA : cA + (size_t)(t + 2) * kstep; const char* b2 = last ? nB : cB + (size_t)(t + 2) * kstep;
            const char* a3 = a2 + kstep; const char* b3 = b2 + kstep;
            if (last && has_next) S.a_ready(nxt);
            if constexpr (SP2) {
            PG8_LDB(B0, 0, 0); PG8_LDB(B1, 0, 1); PG8_SCHED; PG8_LDA(At, 0, 0); PG8_STAGE(PG8_SA(1, 1), a1 + hstep, voffA);
            PG8_WAIT_V(8); PG8_WAIT_L(0); PG8_BAR; PG8_MMA(0, 0, At, B0); PG8_MMA(0, 1, At, B1); PG8_BAR; PG8_SCHED;
            PG8_LDA(At, 0, 1); PG8_STAGE(PG8_SB(0, 0), b2, voffB); PG8_STAGE(PG8_SB(0, 1), b2 + hstep, voffB); PG8_STAGE(PG8_SA(0, 0), a2, voffA);
            PG8_WAIT_V(8); PG8_WAIT_L(0); PG8_BAR; PG8_MMA(1, 0, At, B0); PG8_MMA(1, 1, At, B1); PG8_BAR; PG8_SCHED;
            PG8_LDB(B0, 1, 0); PG8_LDB(B1, 1, 1); PG8_SCHED; PG8_LDA(At, 1, 0); PG8_STAGE(PG8_SA(0, 1), a2 + hstep, voffA);
            PG8_WAIT_V(8); PG8_WAIT_L(0); PG8_BAR; PG8_MMA(0, 0, At, B0); PG8_MMA(0, 1, At, B1); PG8_BAR; PG8_SCHED;
            PG8_LDA(At, 1, 1); PG8_STAGE(PG8_SB(1, 0), b3, voffB); PG8_STAGE(PG8_SB(1, 1), b3 + hstep, voffB); PG8_STAGE(PG8_SA(1, 0), a3, voffA);
            PG8_WAIT_V(8); PG8_WAIT_L(0); PG8_BAR; PG8_MMA(1, 0, At, B0); PG8_MMA(1, 1, At, B1); PG8_BAR; PG8_SCHED;
            } else {
            PG8_LDB(B0, 0, 0); PG8_SCHED; PG8_LDA(At, 0, 0); PG8_STAGE(PG8_SA(1, 1), a1 + hstep, voffA);
            PG8_WAIT_L(8); PG8_BAR; PG8_WAIT_L(0); PG8_MMA(0, 0, At, B0); PG8_BAR; PG8_SCHED;
            PG8_LDB(B1, 0, 1); PG8_STAGE(PG8_SB(0, 0), b2, voffB);
            PG8_BAR; PG8_WAIT_L(0); PG8_MMA(0, 1, At, B1); PG8_BAR;
            PG8_LDA(At, 0, 1); PG8_STAGE(PG8_SA(0, 0), a2, voffA);
            PG8_BAR; PG8_WAIT_L(0); PG8_MMA(1, 0, At, B0); PG8_BAR; PG8_SCHED;
            PG8_STAGE(PG8_SB(0, 1), b2 + hstep, voffB);
            PG8_WAIT_V(6); PG8_BAR; PG8_MMA(1, 1, At, B1); PG8_BAR;
            PG8_LDB(B0, 1, 0); PG8_SCHED; PG8_LDA(At, 1, 0); PG8_STAGE(PG8_SA(0, 1), a2 + hstep, voffA);
            PG8_WAIT_L(8); PG8_BAR; PG8_WAIT_L(0); PG8_MMA(0, 0, At, B0); PG8_BAR; PG8_SCHED;
            PG8_LDB(B1, 1, 1); PG8_STAGE(PG8_SB(1, 0), b3, voffB);
            PG8_BAR; PG8_WAIT_L(0); PG8_MMA(0, 1, At, B1); PG8_BAR;
            PG8_LDA(At, 1, 1); PG8_STAGE(PG8_SA(1, 0), a3, voffA);
            PG8_BAR; PG8_WAIT_L(0); PG8_MMA(1, 0, At, B0); PG8_BAR; PG8_SCHED;
            PG8_STAGE(PG8_SB(1, 1), b3 + hstep, voffB);
            PG8_WAIT_V(6); PG8_BAR; PG8_MMA(1, 1, At, B1); PG8_BAR;
            }
        }
        if constexpr (ALIGN_EPI) { if (wr == 0) PG8_BAR; }
        if constexpr (!Epi::AFTER_DRAIN) { E(acc, cur, wr, wc, fr, fq);
            S.done(cur); }
        if (!has_next) break;
#pragma unroll
        for (int a = 0; a < 2; ++a)
#pragma unroll
            for (int b = 0; b < 2; ++b)
#pragma unroll
                for (int m = 0; m < 4; ++m)
#pragma unroll
                    for (int n = 0; n < 2; ++n) acc[a][b][m][n] = (f32x4){0.f, 0.f, 0.f, 0.f};
        cur = nxt; cA = nA; cB = nB; ++ui;
        if constexpr (ALIGN_EPI) { if (wr == 1) PG8_BAR; }
    }
    PG8_WAIT_V(0);
    if constexpr (!ALIGN_EPI) { if (wr == 0) PG8_BAR; }
    PG8_BAR;
    if constexpr (Epi::AFTER_DRAIN) { E.fused(acc, cur, wr, wc, fr, fq, lds, wid, lane); S.done(cur); }
#undef PG8_SA
#undef PG8_SB
#undef PG8_STAGE
#undef PG8_LDA
#undef PG8_LDB
#undef PG8_MMA
#undef PG8_WAIT_V
#undef PG8_WAIT_L
#undef PG8_BAR
#undef PG8_SCHED
}
}

namespace att {
constexpr int A_KV = 0, A_KB = 49152, A_WS = 49920, A_MASK = 51968, A_SHQ = 52480, A_IMP = 53248, A_OC = 119808, A_IVC = 152576;
DI constexpr int crc(int r) { return (r & 3) + 8 * (r >> 2); }
constexpr int IMP_LD = 65;
DI int crow(int r, int hi) { return (r & 3) + 8 * (r >> 2) + 4 * hi; }
#define MFMA32(a, b, c) __builtin_amdgcn_mfma_f32_32x32x16_bf16((a), (b), (c), 0, 0, 0)

struct KVRegs { u32x4 k, v; float kb; };
struct Sweep {
    const bf16_t* K; const bf16_t* V; int ld;
    const float* kbias;
};
DI void kv_issue(KVRegs& r, const Sweep& s, int tile, int tid) {
    const int key = tid & 63, ch = tid >> 6;
    const size_t row0 = (size_t)tile * 64;
    r.k = *(const u32x4*)(s.K + (row0 + key) * s.ld + ch * 8);
    const int p = tid >> 6, l = tid & 63; const int row = 16 * (p & 3) + (l >> 2), col = (p >> 2) * 32 + (l & 3) * 8;
    r.v = *(const u32x4*)(s.V + (row0 + row) * s.ld + col);
    r.kb = (s.kbias && tid < 64) ? s.kbias[row0 + tid] : 0.f;
}
DI void kv_commit(const KVRegs& r, LAS char* lds, int slot, int tid, bool has_kb) {
    LAS char* sl = lds + A_KV + slot * 16384;
    *(LAS u32x4*)(sl + (tid >> 6) * 1024 + (tid & 63) * 16) = r.k;
    *(LAS u32x4*)(sl + 8192 + tid * 16) = r.v;
    if (has_kb && tid < 64) *(LAS float*)(lds + A_KB + slot * 256 + tid * 4) = r.kb;
}
DI void glds16(const void* gsrc, unsigned lds_dst) { unsigned keep;
    asm volatile("s_mov_b32 %0, m0\n\ts_mov_b32 m0, %2\n\ts_nop 0\n\tglobal_load_lds_dwordx4 %1, off\n\ts_mov_b32 m0, %0" : "=&s"(keep) : "v"(gsrc), "s"(lds_dst) : "memory"); }
DI void glds4(const void* gsrc, unsigned lds_dst) { unsigned keep;
    asm volatile("s_mov_b32 %0, m0\n\ts_mov_b32 m0, %2\n\ts_nop 0\n\tglobal_load_lds_dword %1, off\n\ts_mov_b32 m0, %0" : "=&s"(keep) : "v"(gsrc), "s"(lds_dst) : "memory"); }
DI void kv_dma(const Sweep& s, int tile, LAS char* lds, int slot, int tid, int wid, bool has_kb) {
    const int l = tid & 63;
    const size_t row0 = (size_t)tile * 64;
    const bf16_t* ksrc = s.K + (row0 + l) * s.ld + wid * 8;
    const bf16_t* vsrc = s.V + (row0 + 16 * (wid & 3) + (l >> 2)) * s.ld + (wid >> 2) * 32 + (l & 3) * 8;
    const unsigned sl = (unsigned)__builtin_amdgcn_readfirstlane((int)(unsigned)(uintptr_t)(lds + A_KV + slot * 16384 + wid * 1024));
    glds16(ksrc, sl);
    glds16(vsrc, sl + 8192);
    if (has_kb) glds4(s.kbias + row0 + l, (unsigned)__builtin_amdgcn_readfirstlane((int)(unsigned)(uintptr_t)(lds + A_KB + slot * 256)));
}
struct FState { float m, l; f32x16 o0, o1, la, negm; };
DI float max3f(float a, float b, float c) { float r; asm("v_max3_f32 %0, %1, %2, %3" : "=v"(r) : "v"(a), "v"(b), "v"(c)); return r; }
DI void fs_init(FState& s) { s.m = 0.f; s.l = 0.f;

#pragma unroll
    for (int r = 0; r < 16; ++r) { s.o0[r] = 0.f; s.o1[r] = 0.f; s.la[r] = 0.f; s.negm[r] = 0.f; } }

DI void qk_tile(f32x16& p0, f32x16& p1, const f32x16& c0, const f32x16& c1, const LAS char* Ks, const bf16x8 (&qr)[4], int r32, int hi) {
    const LAS char* kb = Ks + hi * 1024 + r32 * 16;
    bf16x8 kf[8];
#pragma unroll
    for (int d0 = 0; d0 < 4; ++d0) { kf[2 * d0] = *(const LAS bf16x8*)(kb + d0 * 2048); kf[2 * d0 + 1] = *(const LAS bf16x8*)(kb + d0 * 2048 + 512); }
    __builtin_amdgcn_s_setprio(1);
#pragma unroll
    for (int d0 = 0; d0 < 4; ++d0) {
        if (d0 == 0) { p0 = MFMA32(kf[0], qr[0], c0); p1 = MFMA32(kf[1], qr[0], c1); }
        else { p0 = MFMA32(kf[2 * d0], qr[d0], p0); p1 = MFMA32(kf[2 * d0 + 1], qr[d0], p1); }
    }
    __builtin_amdgcn_s_setprio(0);
}
DI s16x4 vtr(const LAS char* p) { typedef short v4i16_t __attribute__((ext_vector_type(4))); return __builtin_bit_cast(s16x4, __builtin_amdgcn_ds_read_tr16_b64_v4i16((LAS v4i16_t*)p)); }

template <bool NOMAX, bool SUML> DI void softmax_pv(FState& s, f32x16& p0, f32x16& p1, const LAS char* Vs, LAS float* wsf, int lane, int r32, int hi) {
    if (!NOMAX) {
        asm volatile("s_nop 15\n\ts_nop 7" : "+v"(p0), "+v"(p1));
        float rm = max3f(p0[0], p0[1], p1[0]), rm2 = max3f(p0[2], p0[3], p1[1]);
        rm = max3f(rm, p1[2], p1[3]);
#pragma unroll
        for (int r = 4; r < 16; r += 4) { rm = max3f(rm, p0[r], p0[r + 1]); rm2 = max3f(rm2, p0[r + 2], p0[r + 3]); rm = max3f(rm, p1[r], p1[r + 1]); rm2 = max3f(rm2, p1[r + 2], p1[r + 3]); }
        rm = fmaxf(rm, rm2);
        rm = fmaxf(rm, __shfl_xor(rm, 32));
        if (__any(rm > 8.0f)) {
            const float dl = fmaxf(rm, 0.f);
            s.m += dl; const float alpha = __builtin_amdgcn_exp2f(-dl);
#pragma unroll
            for (int r = 0; r < 16; ++r) s.negm[r] = -s.m;
#pragma unroll
            for (int r = 0; r < 16; ++r) { p0[r] -= dl; p1[r] -= dl; }
            if (hi == 0) wsf[r32] = alpha;
#pragma unroll
            for (int r = 0; r < 16; ++r) { const float a = wsf[crow(r, hi)]; s.o0[r] *= a; s.o1[r] *= a; s.la[r] *= a; }
            if (SUML) s.l *= alpha;
        }
    }
#pragma unroll
    for (int r = 0; r < 16; ++r) { p0[r] = __builtin_amdgcn_exp2f(p0[r]); p1[r] = __builtin_amdgcn_exp2f(p1[r]); }
    if (SUML) { float sum = 0.f;
#pragma unroll
        for (int r = 0; r < 16; ++r) sum += p0[r] + p1[r];
        s.l += sum; }
    u32x4 pw[4];
    pw[0] = (u32x4){cvtpk(p0[0], p0[1]), cvtpk(p0[2], p0[3]), cvtpk(p0[4], p0[5]), cvtpk(p0[6], p0[7])};
    pw[1] = (u32x4){cvtpk(p0[8], p0[9]), cvtpk(p0[10], p0[11]), cvtpk(p0[12], p0[13]), cvtpk(p0[14], p0[15])};
    pw[2] = (u32x4){cvtpk(p1[0], p1[1]), cvtpk(p1[2], p1[3]), cvtpk(p1[4], p1[5]), cvtpk(p1[6], p1[7])};
    pw[3] = (u32x4){cvtpk(p1[8], p1[9]), cvtpk(p1[10], p1[11]), cvtpk(p1[12], p1[13]), cvtpk(p1[14], p1[15])};
    const bf16x8 ones = (bf16x8){0x3F80, 0x3F80, 0x3F80, 0x3F80, 0x3F80, 0x3F80, 0x3F80, 0x3F80};
    const LAS char* vp = Vs + ((lane >> 4) & 1) * 32 + (lane & 3) * 8 + (4 * hi + ((lane & 15) >> 2)) * 64;
#pragma unroll
    for (int ks = 0; ks < 4; ++ks) {
        const bf16x8 pa = __builtin_bit_cast(bf16x8, pw[ks]);
        { const s16x4 lo = vtr(vp + ks * 1024), hh = vtr(vp + ks * 1024 + 512); const bf16x8 vf = (bf16x8){lo[0], lo[1], lo[2], lo[3], hh[0], hh[1], hh[2], hh[3]}; s.o0 = MFMA32(pa, vf, s.o0); }
        { const s16x4 lo = vtr(vp + 4096 + ks * 1024), hh = vtr(vp + 4096 + ks * 1024 + 512); const bf16x8 vf = (bf16x8){lo[0], lo[1], lo[2], lo[3], hh[0], hh[1], hh[2], hh[3]}; s.o1 = MFMA32(pa, vf, s.o1); }
        s.la = MFMA32(pa, ones, s.la);
    }
}
template <int MODE> DI float fs_finish(const FState& s, const float (&gr)[16], LAS float* wsf, LAS char* stg_bf, LAS char* stg_f32, int r32, int hi) {
    LAS bf16_t* sb = (LAS bf16_t*)stg_bf; LAS float* sf = (LAS float*)stg_f32;
#pragma unroll
    for (int r = 0; r < 16; ++r) {
        const int orow = crow(r, hi); const float lt = s.la[r]; const float inv = lt > 0.f ? __builtin_amdgcn_rcpf(lt) : 0.f; const float f = inv * gr[r];
        float c0 = s.o0[r] * f, c1 = s.o1[r] * f;
        if (MODE == 1) { c0 += bf2f(sb[orow * 64 + r32]); c1 += bf2f(sb[orow * 64 + 32 + r32]); sf[orow * 64 + r32] = c0; sf[orow * 64 + 32 + r32] = c1; }
        else { if (MODE == 2) { c0 += sf[orow * 64 + r32]; c1 += sf[orow * 64 + 32 + r32]; }
            sb[orow * 64 + r32] = (bf16_t)(cvtpk(c0, 0.f) & 0xffffu); sb[orow * 64 + 32 + r32] = (bf16_t)(cvtpk(c1, 0.f) & 0xffffu); }
    }
    if (MODE == 0) { const float lt = s.l + __shfl_xor(s.l, 32); return lt > 0.f ? 1.0f / lt : 0.f; }
    return 0.f;
}
DI void store_o(bf16_t* Orow0  , int ldo, const LAS char* stg, int lane) {
#pragma unroll
    for (int i = 0; i < 4; ++i) { const int row = i * 8 + (lane >> 3), ch = lane & 7; const u32x4 v = *(const LAS u32x4*)(stg + row * 128 + ch * 16); *(u32x4*)(Orow0 + (size_t)row * ldo + ch * 8) = v; }
}

struct BrP { int cur; int tq; int tt; unsigned long long msk, anym; int jlo, jhi; int fox_lim, fox_lo; float m_c, inv_c; int head_l, tok_l; };
template <int BR> DI int next_tile(const BrP& b, int j) {
    ++j;
    if (BR == 1) { while (j <= b.jhi && !((b.anym >> j) & 1ull)) ++j; }
    return j <= b.jhi ? j : -1;
}
template <int BR, bool NOMAX> DI void sweep(FState& st, const Sweep& sw, const BrP& b, const bf16x8 (&qr)[4], LAS char* lds, LAS float* wsf, int tid, int lane, int r32, int hi, float& carry) {
    const int wid_ = __builtin_amdgcn_readfirstlane(tid >> 6);
#define ATT_WAIT_BAR(n) asm volatile("s_waitcnt vmcnt(" #n ") lgkmcnt(0)\n\ts_barrier" ::: "memory")
#define ATT_END_TILE(more) do { if (more) { if (BR == 3) ATT_WAIT_BAR(3); else ATT_WAIT_BAR(2); } else ATT_WAIT_BAR(0); } while (0)
    int j = next_tile<BR>(b, b.jlo - 1);
    if (j < 0) return;
    int jn = next_tile<BR>(b, j);
    kv_dma(sw, j, lds, 0, tid, wid_, BR == 3);
    if (jn >= 0) kv_dma(sw, jn, lds, 1, tid, wid_, BR == 3);
    ATT_END_TILE(jn >= 0);
    int slot = 0;
    while (j >= 0) {
        const int jn2 = jn >= 0 ? next_tile<BR>(b, jn) : -1;
        if (jn2 >= 0) kv_dma(sw, jn2, lds, slot >= 1 ? slot - 1 : 2, tid, wid_, BR == 3);
        const LAS char* Ks = lds + A_KV + slot * 16384; const LAS char* Vs = Ks + 8192;
        bool active = true;
        if (BR == 3) active = (j <= b.fox_lim) && (j >= b.fox_lo);
        if (active) {
            f32x16 p0, p1;
            const float NEG = -__builtin_inff();
            if (BR == 3) {
                f32x16 c0, c1;
                const LAS float* kb = (const LAS float*)(lds + A_KB + slot * 256);
#pragma unroll
                for (int i = 0; i < 4; ++i) { const f32x4 k0 = *(const LAS f32x4*)(kb + 8 * i + 4 * hi), k1 = *(const LAS f32x4*)(kb + 32 + 8 * i + 4 * hi);
#pragma unroll
                    for (int e = 0; e < 4; ++e) { c0[4 * i + e] = k0[e] + st.negm[4 * i + e]; c1[4 * i + e] = k1[e] + st.negm[4 * i + e]; } }
                qk_tile(p0, p1, c0, c1, Ks, qr, r32, hi);
            } else if (BR == 1) {
                f32x16 cs; const bool sel = (b.msk >> j) & 1ull;
#pragma unroll
                for (int r = 0; r < 16; ++r) cs[r] = sel ? (NOMAX ? 0.f : st.negm[r]) : NEG;
                qk_tile(p0, p1, cs, cs, Ks, qr, r32, hi);
            } else if (NOMAX) {
                f32x16 z;
#pragma unroll
                for (int r = 0; r < 16; ++r) z[r] = 0.f;
                qk_tile(p0, p1, z, z, Ks, qr, r32, hi);
            } else qk_tile(p0, p1, st.negm, st.negm, Ks, qr, r32, hi);
            int tth = b.tt - 4 * hi; asm volatile("" : "+v"(tth));
            if (BR == 0 || BR == 4) {
                int lim = ((b.tq - 31) >> 4) - 64 * j - 4 * hi; asm volatile("" : "+v"(lim));
#pragma unroll
                for (int r = 0; r < 16; ++r) { if (crc(r) > lim) p0[r] = NEG; if (crc(r) + 32 > lim) p1[r] = NEG; }
            } else if (BR == 1) {
                if (j == b.cur) {
#pragma unroll
                    for (int r = 0; r < 16; ++r) { if (crc(r) > tth) p0[r] = NEG; if (crc(r) + 32 > tth) p1[r] = NEG; }
                }
            } else if (BR == 2) {
                if (j == b.cur) {
#pragma unroll
                    for (int r = 0; r < 16; ++r) { if (crc(r) > tth) p0[r] = NEG; if (crc(r) + 32 > tth) p1[r] = NEG; }
                } else if (j == b.cur - 8) {
#pragma unroll
                    for (int r = 0; r < 16; ++r) { if (crc(r) <= tth) p0[r] = NEG; if (crc(r) + 32 <= tth) p1[r] = NEG; }
                }
            } else if (BR == 3) {
                if (j == b.fox_lim) {
#pragma unroll
                    for (int r = 0; r < 16; ++r) { if (crc(r) > tth) p0[r] = NEG; if (crc(r) + 32 > tth) p1[r] = NEG; }
                }
            }
            if (BR != 4) softmax_pv<NOMAX, BR == 0>(st, p0, p1, Vs, wsf, lane, r32, hi);
            if (BR == 4 || (BR == 0 && NOMAX)) {
                const float scl = (BR == 4) ? b.inv_c : 1.0f;
                float G[8], H[8];
#pragma unroll
                for (int i = 0; i < 4; ++i) {
                    float a[4], c[4];
#pragma unroll
                    for (int e = 0; e < 4; ++e) { a[e] = (BR == 4 ? __builtin_amdgcn_exp2f(p0[4 * i + e]) : p0[4 * i + e]) * scl; c[e] = (BR == 4 ? __builtin_amdgcn_exp2f(p1[4 * i + e]) : p1[4 * i + e]) * scl; }
                    H[i] = 0.5f * a[3]; G[i] = a[0] + a[1] + a[2] + H[i]; H[4 + i] = 0.5f * c[3]; G[4 + i] = c[0] + c[1] + c[2] + H[4 + i];
                }
                float Hp[8];
#pragma unroll
                for (int k = 0; k < 8; ++k) Hp[k] = __shfl_xor(H[k], 32);
                LAS float* imp = (LAS float*)(lds + A_IMP) + (b.head_l * 64 + b.tok_l) * IMP_LD + 16 * j;
#pragma unroll
                for (int k = 0; k < 8; ++k) {
                    const float prev = (hi == 1) ? Hp[k] : (k == 0 ? carry : Hp[k - 1]);
                    const int sidx = (k < 4) ? (2 * k + hi) : (8 + 2 * (k - 4) + hi);
                    imp[sidx] = G[k] + prev;
                }
                carry = Hp[7];
            }
        }
        ATT_END_TILE(jn2 >= 0);
        slot = slot == 2 ? 0 : slot + 1; j = jn; jn = jn2;
    }
#undef ATT_WAIT_BAR
#undef ATT_END_TILE
}

struct Tensors {
    const bf16_t* projA; const bf16_t* kcmp; const bf16_t* vcmp; const float* gate; const float* cumneg; bf16_t* O; const float* fqn; const float* fkn; const float* aqn; const float* akn;
};

template <bool NOMAX> DI void nsa_unit(const Tensors& T_, int b, int g, int qt, LAS char* lds) {
    int tid_ = threadIdx.x; asm volatile("" : "+v"(tid_));
    const int tid = tid_, lane = tid & 63, r32 = lane & 31, hi = lane >> 5, wid = __builtin_amdgcn_readfirstlane(tid >> 6);
    LAS float* wsf = (LAS float*)(lds + A_WS) + wid * 64;
    const int head_l = wid >> 1, head = 4 * g + head_l, tok_l = 32 * (wid & 1) + r32;
    const int tq = 64 * qt + tok_l;
    const size_t rowq = (size_t)b * SEQ + tq;
    bf16x8 qr[4];
#pragma unroll
    for (int d0 = 0; d0 < 4; ++d0) qr[d0] = *(const bf16x8*)(T_.projA + rowq * LDA + PA_QA + head * 64 + d0 * 16 + hi * 8);
    LAS char* stg_bf = lds + A_OC + wid * 4096; LAS char* stg_f32 = lds + A_IMP + wid * 8192;
    const size_t rowbase = (size_t)b * SEQ + 64 * qt + 32 * (wid & 1);
    float gr[16];
    BrP bp; bp.cur = qt; bp.tq = tq; bp.tt = tok_l; bp.msk = 0; bp.anym = 0; bp.fox_lim = 0; bp.fox_lo = 0; bp.head_l = head_l; bp.tok_l = tok_l; bp.m_c = 0.f; bp.inv_c = 0.f;
    float carry = 0.f;
    {
        Sweep sw; sw.K = T_.kcmp + ((size_t)b * NCMP_PAD * 2 + g) * 64; sw.V = T_.vcmp + ((size_t)b * NCMP_PAD * 2 + g) * 64; sw.ld = 128; sw.kbias = nullptr;
        const int ntc = (4 * qt + 2) / 64 + 1;
        bp.jlo = 0; bp.jhi = ntc - 1;
        FState st; fs_init(st);
        LAS float* imp = (LAS float*)(lds + A_IMP) + (head_l * 64 + tok_l) * IMP_LD;
        for (int s2 = 16 * ntc + hi; s2 < 64; s2 += 2) imp[s2] = 0.f;
        carry = 0.f;
#pragma unroll
        for (int r = 0; r < 16; ++r) gr[r] = T_.gate[(rowbase + crow(r, hi)) * 24 + 3 * head + 0];
        sweep<0, NOMAX>(st, sw, bp, qr, lds, wsf, tid, lane, r32, hi, carry);
        bp.inv_c = fs_finish<0>(st, gr, wsf, stg_bf, stg_f32, r32, hi); bp.m_c = st.m;
        if (hi == 0) ((LAS float*)(lds + A_IVC))[head_l * 64 + tok_l] = NOMAX ? bp.inv_c : 1.0f;
        if (!NOMAX) { carry = 0.f; sweep<4, NOMAX>(st, sw, bp, qr, lds, wsf, tid, lane, r32, hi, carry); }
    }
    __syncthreads();
    {
        LAS float* imp = (LAS float*)(lds + A_IMP); const LAS float* ivc = (const LAS float*)(lds + A_IVC);
        const int tok = tid >> 3, part = tid & 7;
        float v[8];
#pragma unroll
        for (int k = 0; k < 8; ++k) { const int s2 = 8 * part + k;
            float x = ((imp[(0 * 64 + tok) * IMP_LD + s2] * ivc[tok] + imp[(1 * 64 + tok) * IMP_LD + s2] * ivc[64 + tok]) + imp[(2 * 64 + tok) * IMP_LD + s2] * ivc[128 + tok]) + imp[(3 * 64 + tok) * IMP_LD + s2] * ivc[192 + tok];
            if (s2 == 0 || s2 == qt || s2 == qt - 1) x = 1e6f; else if (s2 > qt) x = -1e6f;
            v[k] = x; }
        __syncthreads();
#pragma unroll
        for (int k = 0; k < 8; ++k) imp[tok * IMP_LD + 8 * part + k] = v[k];
        __syncthreads();
        int rank[8];
#pragma unroll
        for (int k = 0; k < 8; ++k) rank[k] = 0;
        for (int s2 = 0; s2 < 64; ++s2) { const float x = imp[tok * IMP_LD + s2];
#pragma unroll
            for (int k = 0; k < 8; ++k) rank[k] += (x > v[k] || (x == v[k] && s2 < 8 * part + k)) ? 1 : 0; }
        unsigned byte = 0;
#pragma unroll
        for (int k = 0; k < 8; ++k) byte |= (rank[k] < 16 ? 1u : 0u) << k;
        ((LAS unsigned char*)(lds + A_MASK))[tok * 8 + part] = (unsigned char)byte;
        __syncthreads();
        const LAS unsigned long long* mk = (const LAS unsigned long long*)(lds + A_MASK);
        bp.msk = mk[tok_l];
        unsigned long long am = mk[lane];
        unsigned lo = (unsigned)am, hh = (unsigned)(am >> 32);
#pragma unroll
        for (int o = 1; o < 64; o <<= 1) { lo |= (unsigned)__shfl_xor((int)lo, o); hh |= (unsigned)__shfl_xor((int)hh, o); }
        bp.anym = ((unsigned long long)(unsigned)__builtin_amdgcn_readfirstlane((int)hh) << 32) | (unsigned)__builtin_amdgcn_readfirstlane((int)lo);
    }
    {
        Sweep sw; sw.K = T_.projA + (size_t)b * SEQ * LDA + PA_KSL + g * 64; sw.V = T_.projA + (size_t)b * SEQ * LDA + PA_VSL + g * 64; sw.ld = LDA; sw.kbias = nullptr;
        bp.jlo = 0; bp.jhi = qt;
        FState st; fs_init(st);
#pragma unroll
        for (int r = 0; r < 16; ++r) gr[r] = T_.gate[(rowbase + crow(r, hi)) * 24 + 3 * head + 1];
        sweep<1, NOMAX>(st, sw, bp, qr, lds, wsf, tid, lane, r32, hi, carry);
        fs_finish<1>(st, gr, wsf, stg_bf, stg_f32, r32, hi);
    }
    {
        Sweep sw; sw.K = T_.projA + (size_t)b * SEQ * LDA + PA_KWN + g * 64; sw.V = T_.projA + (size_t)b * SEQ * LDA + PA_VWN + g * 64; sw.ld = LDA; sw.kbias = nullptr;
        bp.jlo = qt - 8 < 0 ? 0 : qt - 8; bp.jhi = qt;
        FState st; fs_init(st);
#pragma unroll
        for (int r = 0; r < 16; ++r) gr[r] = T_.gate[(rowbase + crow(r, hi)) * 24 + 3 * head + 2];
        sweep<2, NOMAX>(st, sw, bp, qr, lds, wsf, tid, lane, r32, hi, carry);
        fs_finish<2>(st, gr, wsf, stg_bf, stg_f32, r32, hi);
    }
    store_o(T_.O + rowbase * DM + head * 64, DM, stg_bf, lane);
    __syncthreads();
}

DI void fox_unit(const Tensors& T_, int b, int h, int qb, LAS char* lds) {
    int tid_ = threadIdx.x; asm volatile("" : "+v"(tid_));
    const int tid = tid_, lane = tid & 63, r32 = lane & 31, hi = lane >> 5, wid = __builtin_amdgcn_readfirstlane(tid >> 6);
    LAS float* wsf = (LAS float*)(lds + A_WS) + wid * 64;
    const int tq = 256 * qb + 32 * wid + r32;
    const size_t rowq = (size_t)b * SEQ + tq;
    bf16x8 qr[4];
#pragma unroll
    for (int d0 = 0; d0 < 4; ++d0) qr[d0] = *(const bf16x8*)(T_.projA + rowq * LDA + PA_QB + h * 64 + d0 * 16 + hi * 8);
    LAS char* stg_bf = lds + A_OC + wid * 4096;
    BrP bp; bp.cur = 0; bp.tq = tq; bp.tt = 32 * (wid & 1) + r32; bp.msk = 0; bp.anym = 0; bp.head_l = 0; bp.tok_l = 0; bp.m_c = 0.f; bp.inv_c = 0.f;
    bp.jlo = 0; bp.jhi = 4 * qb + 3; bp.fox_lim = 4 * qb + (wid >> 1);
    {
        float gq = fabsf(T_.fqn[lane]), gk = fabsf(T_.fkn[lane]);
#pragma unroll
        for (int o = 1; o < 64; o <<= 1) { gq = fmaxf(gq, __shfl_xor(gq, o)); gk = fmaxf(gk, __shfl_xor(gk, o)); }
        const float need = 2.0f * 11.66f * gq * gk + 40.0f;
        const float* kbp = T_.cumneg + ((size_t)b * FOX_H + h) * SEQ;
        const float kb0 = kbp[256 * qb];
        const bool needed = (lane <= bp.jhi) && (kb0 - kbp[64 * lane + 63] <= need);
        const unsigned long long bal = __ballot(needed);
        bp.jlo = bal ? (int)__builtin_ctzll(bal) : 0;
        const bool needed_w = (lane <= bp.jhi) && (kbp[256 * qb + 32 * wid] - kbp[64 * lane + 63] <= need);
        const unsigned long long balw = __ballot(needed_w);
        bp.fox_lo = balw ? (int)__builtin_ctzll(balw) : 0;
    }
    Sweep sw; sw.K = T_.projA + (size_t)b * SEQ * LDA + PA_KB + h * 64; sw.V = T_.projA + (size_t)b * SEQ * LDA + PA_VB + h * 64; sw.ld = LDA;
    sw.kbias = T_.cumneg + ((size_t)b * FOX_H + h) * SEQ;
    FState st; fs_init(st);
    float carry = 0.f;
    sweep<3, false>(st, sw, bp, qr, lds, wsf, tid, lane, r32, hi, carry);
    float gr[16];
#pragma unroll
    for (int r = 0; r < 16; ++r) gr[r] = 1.f;
    fs_finish<3>(st, gr, wsf, stg_bf, stg_bf, r32, hi);
    const size_t rowbase = (size_t)b * SEQ + 256 * qb + 32 * wid;
    store_o(T_.O + rowbase * DM + 512 + h * 64, DM, stg_bf, lane);
    __syncthreads();
}

DI void attn_phase(const Tensors& T_, unsigned* ctr, LAS char* lds) {
    LAS int* shq = (LAS int*)(lds + A_SHQ);
    bool nomax;
    { const int lane = threadIdx.x & 63; float gq = fabsf(T_.aqn[lane]), gk = fabsf(T_.akn[lane]);
#pragma unroll
      for (int o = 1; o < 64; o <<= 1) { gq = fmaxf(gq, __shfl_xor(gq, o)); gk = fmaxf(gk, __shfl_xor(gk, o)); }
      nomax = __builtin_amdgcn_readfirstlane((int)(11.66f * gq * gk < 50.0f)) != 0; }
    for (;;) {
        if (threadIdx.x == 0) shq[0] = (int)__hip_atomic_fetch_add(ctr, 1u, __ATOMIC_RELAXED, __HIP_MEMORY_SCOPE_AGENT);
        __syncthreads();
        const int i = __builtin_amdgcn_readfirstlane(shq[0]);
        __syncthreads();
        if (i >= 2048) break;
        if (i < 1024) { if (nomax) nsa_unit<true>(T_, (i & 15) >> 1, i & 1, 63 - (i >> 4), lds); else nsa_unit<false>(T_, (i & 15) >> 1, i & 1, 63 - (i >> 4), lds); }
        else { const int r = i - 1024; fox_unit(T_, (r & 63) >> 3, r & 7, 15 - (r >> 6), lds); }
    }
}
}

namespace gla {
constexpr int G_A1 = 0, G_QI = 4096, G_QR = 20480, G_KR = 36864, G_KH = 53248, G_V = 69632, G_BQ = 73728, G_ST = 77824, G_DEC = 94208;
DI int swo(int row, int colbyte) { return row * 256 + (colbyte ^ ((row & 15) << 4)); }
using att::crow; using att::vtr;

struct GlaT { bf16_t* projC; const float* a1; const float* w_a2; const float* b_a; bf16_t* O; bf16_t* att; float* dec; };

DI void gla_a1_item(const bf16_t* xb, const bf16_t* wa1t  , const float* ss2, float* a1, int item, LAS char* lds) {
    int tid_l_ = threadIdx.x; asm volatile("" : "+v"(tid_l_)); const int tid = tid_l_, lane = tid & 63, r32 = lane & 31, hi = lane >> 5, wid = __builtin_amdgcn_readfirstlane(tid >> 6);
    const int rg = wid & 3, kh = wid >> 2;
    const size_t row0 = (size_t)item * 128 + 32 * rg;
    const bf16_t* ap = xb + (row0 + r32) * DM + 512 * kh + 8 * hi;
    const bf16_t* bp = wa1t + (size_t)(r32 & 15) * DM + 512 * kh + 8 * hi;
    f32x16 c;
#pragma unroll
    for (int r = 0; r < 16; ++r) c[r] = 0.f;
#pragma unroll 8
    for (int ks = 0; ks < 32; ++ks) {
        const bf16x8 A = *(const bf16x8*)(ap + 16 * ks);
        bf16x8 B = *(const bf16x8*)(bp + 16 * ks);
        if (r32 >= 16) B = (bf16x8){0, 0, 0, 0, 0, 0, 0, 0};
        c = MFMA32(A, B, c);
    }
    LAS float* red = (LAS float*)lds + rg * 1024;
    if (kh == 1) {
#pragma unroll
        for (int r = 0; r < 16; ++r) red[crow(r, hi) * 32 + r32] = c[r];
    }
    __syncthreads();
    if (kh == 0 && r32 < 16) {
#pragma unroll
        for (int r = 0; r < 16; ++r) { const int rw = crow(r, hi); const size_t grow = row0 + rw;
            a1[grow * 16 + r32] = (c[r] + red[rw * 32 + r32]) * pg8::row_rstd(ss2, (int)grow); }
    }
    __syncthreads();
}

constexpr int P_A1 = 0, P_QR = 4096, P_KR = 20480, P_BQ = 36864;
struct PrepRegs { unsigned q[8], k[8]; f32x4 a1; };
DI void prep_load(PrepRegs& R, const GlaT& G, int item, int tid) {
    const int ch = item & 63, h = (item >> 6) & 3, b = item >> 8, d0 = 2 * (tid & 63), tg = tid >> 6;
    const size_t rb = (size_t)b * SEQ + 64 * ch;
#pragma unroll
    for (int c8 = 0; c8 < 8; ++c8) { const size_t rw = rb + 8 * tg + c8; R.q[c8] = *(const unsigned*)(G.projC + rw * LDC + PC_Q + h * 128 + d0); R.k[c8] = *(const unsigned*)(G.projC + rw * LDC + PC_K + h * 128 + d0); }
    R.a1 = (tid < 256) ? *(const f32x4*)(G.a1 + (rb + (tid >> 2)) * 16 + (tid & 3) * 4) : (f32x4){0.f, 0.f, 0.f, 0.f};
}
DI void gla_prep(const GlaT& G, int item, const PrepRegs& R, LAS char* lds) {
    int tid_l_ = threadIdx.x; asm volatile("" : "+v"(tid_l_)); const int tid = tid_l_, lane = tid & 63, r32 = lane & 31, hi = lane >> 5, wid = __builtin_amdgcn_readfirstlane(tid >> 6);
    const int ch = item & 63, h = (item >> 6) & 3, b = item >> 8;
    const int dp = tid & 63, tg = wid, d0 = 2 * dp;
    const size_t rb = (size_t)b * SEQ + 64 * ch;
    unsigned qraw[8], kraw[8];
#pragma unroll
    for (int c8 = 0; c8 < 8; ++c8) { qraw[c8] = R.q[c8]; kraw[c8] = R.k[c8]; }
    if (tid < 256) *(LAS f32x4*)(lds + P_A1 + tid * 16) = R.a1;
    float w2a[16], w2b[16];
#pragma unroll
    for (int r = 0; r < 16; ++r) { const f32x2 w = *(const f32x2*)(G.w_a2 + r * 512 + h * 128 + d0); w2a[r] = w[0]; w2b[r] = w[1]; }
    const f32x2 bav = *(const f32x2*)(G.b_a + h * 128 + d0);
    __syncthreads();
    float lp0[8], lp1[8]; float run0 = 0.f, run1 = 0.f;
#pragma unroll
    for (int c8 = 0; c8 < 8; ++c8) {
        const LAS f32x4* ar = (const LAS f32x4*)(lds + P_A1 + (8 * tg + c8) * 64);
        float z0 = bav[0], z1 = bav[1];
#pragma unroll
        for (int q4 = 0; q4 < 4; ++q4) { const f32x4 a = ar[q4];
#pragma unroll
            for (int e = 0; e < 4; ++e) { z0 += a[e] * w2a[4 * q4 + e]; z1 += a[e] * w2b[4 * q4 + e]; } }
        const float l0 = fminf(z0, 0.f) - __logf(1.0f + __expf(-fabsf(z0))), l1 = fminf(z1, 0.f) - __logf(1.0f + __expf(-fabsf(z1)));
        run0 += l0 * (1.0f / 16.0f); run1 += l1 * (1.0f / 16.0f);
        lp0[c8] = run0; lp1[c8] = run1;
    }
    *(LAS f32x2*)(lds + P_BQ + tg * 512 + d0 * 4) = (f32x2){run0, run1};
    __syncthreads();
    {
        float off0 = 0.f, off1 = 0.f, ref0 = 0.f, ref1 = 0.f, last0 = 0.f, last1 = 0.f;
#pragma unroll
        for (int t8 = 0; t8 < 8; ++t8) { const f32x2 q = *(const LAS f32x2*)(lds + P_BQ + t8 * 512 + d0 * 4);
            if (t8 < tg) { off0 += q[0]; off1 += q[1]; } if (t8 < 4) { ref0 += q[0]; ref1 += q[1]; } last0 += q[0]; last1 += q[1]; }
        const float emr0 = __expf(-ref0), emr1 = __expf(-ref1), epr0 = __expf(ref0), epr1 = __expf(ref1), epl0 = __expf(last0), epl1 = __expf(last1);
#pragma unroll
        for (int c8 = 0; c8 < 8; ++c8) {
            const int c = 8 * tg + c8;
            const float eb0 = __expf(off0 + lp0[c8]), eb1 = __expf(off1 + lp1[c8]);
            const float ib0 = __builtin_amdgcn_rcpf(eb0), ib1 = __builtin_amdgcn_rcpf(eb1);
            const float q0 = bflo(qraw[c8]), q1 = bfhi(qraw[c8]), k0 = bflo(kraw[c8]), k1 = bfhi(kraw[c8]);
            const float qi0 = q0 * eb0, qi1 = q1 * eb1, kb0 = k0 * ib0, kb1 = k1 * ib1;
            const int o = swo(c, 4 * dp);
            *(LAS unsigned*)(lds + P_QR + o) = cvtpk(qi0 * emr0, qi1 * emr1);
            *(LAS unsigned*)(lds + P_KR + o) = cvtpk(kb0 * epr0, kb1 * epr1);
            const size_t rw = rb + c;
            *(unsigned*)(G.projC + rw * LDC + PC_Q + h * 128 + d0) = cvtpk(qi0, qi1);
            *(unsigned*)(G.projC + rw * LDC + PC_K + h * 128 + d0) = cvtpk(kb0 * epl0, kb1 * epl1);
        }
        if (tg == 0) *(f32x2*)(G.dec + (size_t)item * 128 + d0) = (f32x2){epl0, epl1};
    }
    __syncthreads();
    if (wid < 3) {
        const int jt = wid == 2 ? 1 : 0, it = wid == 0 ? 0 : 1;
        f32x16 X;
#pragma unroll
        for (int r = 0; r < 16; ++r) X[r] = 0.f;
#pragma unroll
        for (int ks = 0; ks < 8; ++ks) {
            const bf16x8 A = *(const LAS bf16x8*)(lds + P_KR + swo(32 * jt + r32, (16 * ks + 8 * hi) * 2));
            const bf16x8 B = *(const LAS bf16x8*)(lds + P_QR + swo(32 * it + r32, (16 * ks + 8 * hi) * 2));
            X = MFMA32(A, B, X);
        }
        if (jt == it) {
#pragma unroll
            for (int r = 0; r < 16; ++r) if (att::crc(r) > r32 - 4 * hi) X[r] = 0.f;
        }
        bf16_t* ap = G.att + (size_t)item * 4096 + (32 * it + r32) * 64 + 32 * jt + 4 * hi;
#pragma unroll
        for (int g4 = 0; g4 < 4; ++g4) *(u32x2*)(ap + 8 * g4) = (u32x2){cvtpk(X[4 * g4], X[4 * g4 + 1]), cvtpk(X[4 * g4 + 2], X[4 * g4 + 3])};
    }
    __syncthreads();
}

constexpr int R_QI = 0, R_KH = 16384, R_ATT = 32768, R_V = 40960, R_DEC = 45056, R_BUF = 45568, R_ST = 2 * R_BUF;
DI void gla_unit(const GlaT& G, int b, int h, int es, LAS char* lds) {
    int tid_l_ = threadIdx.x; asm volatile("" : "+v"(tid_l_)); const int tid = tid_l_, lane = tid & 63, r32 = lane & 31, hi = lane >> 5, wid = __builtin_amdgcn_readfirstlane(tid >> 6);
    f32x16 S;
#pragma unroll
    for (int r = 0; r < 16; ++r) S[r] = 0.f;
    *(LAS u32x4*)(lds + R_ST + tid * 16) = (u32x4){0u, 0u, 0u, 0u};
    const size_t row00 = (size_t)b * SEQ;
    const int lrow = tid >> 3, lc = tid & 7;
    u32x4 rq0, rq1, rk0, rk1, ra, rv;
#define GLA_LOAD(ch) do { const size_t rw_ = row00 + 64 * (ch) + lrow; const bf16_t* pq_ = G.projC + rw_ * LDC + h * 128 + lc * 8; \
        rq0 = *(const u32x4*)(pq_ + PC_Q); rq1 = *(const u32x4*)(pq_ + PC_Q + 64); rk0 = *(const u32x4*)(pq_ + PC_K); rk1 = *(const u32x4*)(pq_ + PC_K + 64); \
        ra = *(const u32x4*)(G.att + ((size_t)((b * 4 + h) * 64 + (ch))) * 4096 + tid * 8); \
        if (tid < 256) rv = *(const u32x4*)(G.projC + (row00 + 64 * (ch) + (tid >> 2)) * LDC + PC_V + h * 256 + 32 * es + (tid & 3) * 8); \
        else if (tid < 288) rv = *(const u32x4*)(G.dec + ((size_t)((b * 4 + h) * 64 + (ch))) * 128 + (tid - 256) * 4); } while (0)
#define GLA_COMMIT(buf) do { LAS char* bb_ = lds + (buf) * R_BUF; \
        *(LAS u32x4*)(bb_ + R_QI + swo(lrow, lc * 16)) = rq0; *(LAS u32x4*)(bb_ + R_QI + swo(lrow, (lc + 8) * 16)) = rq1; \
        *(LAS u32x4*)(bb_ + R_KH + swo(lrow, lc * 16)) = rk0; *(LAS u32x4*)(bb_ + R_KH + swo(lrow, (lc + 8) * 16)) = rk1; \
        *(LAS u32x4*)(bb_ + R_ATT + lrow * 128 + ((lc ^ (lrow & 7)) * 16)) = ra; \
        if (tid < 256) *(LAS u32x4*)(bb_ + R_V + tid * 16) = rv; else if (tid < 288) *(LAS u32x4*)(bb_ + R_DEC + (tid - 256) * 16) = rv; } while (0)
    GLA_LOAD(0); GLA_COMMIT(0);
    __syncthreads();
    for (int ch = 0; ch < 64; ++ch) {
        const int par = ch & 1;
        if (ch + 1 < 64) GLA_LOAD(ch + 1);
        const LAS char* bb = lds + par * R_BUF;
        const size_t rowc = row00 + 64 * ch;
        if (wid < 2) {
            const int it = wid;
            f32x16 oacc;
#pragma unroll
            for (int r = 0; r < 16; ++r) oacc[r] = 0.f;
#pragma unroll
            for (int s = 0; s < 4; ++s) {
                if (s < 2 || it == 1) {
                    const int i = 32 * it + r32;
                    const bf16x8 A = *(const LAS bf16x8*)(bb + R_ATT + i * 128 + (((2 * s + hi) ^ (i & 7)) * 16));
                    const LAS char* vb = bb + R_V + (16 * s + 8 * hi + ((lane & 15) >> 2)) * 64 + ((lane >> 4) & 1) * 32 + (lane & 3) * 8;
                    const s16x4 lo = vtr(vb), hh = vtr(vb + 256);
                    const bf16x8 vf = (bf16x8){lo[0], lo[1], lo[2], lo[3], hh[0], hh[1], hh[2], hh[3]};
                    oacc = MFMA32(A, vf, oacc);
                }
            }
#pragma unroll
            for (int ks = 0; ks < 8; ++ks) {
                const bf16x8 A = *(const LAS bf16x8*)(bb + R_QI + swo(32 * it + r32, (16 * ks + 8 * hi) * 2));
                const bf16x8 B = *(const LAS bf16x8*)(lds + R_ST + par * 8192 + swo(r32, (16 * ks + 8 * hi) * 2));
                oacc = MFMA32(A, B, oacc);
            }
            LAS bf16_t* stg = (LAS bf16_t*)(lds + R_ST + 16384) + it * 1024;
#pragma unroll
            for (int r = 0; r < 16; ++r) stg[crow(r, hi) * 32 + r32] = (bf16_t)(cvtpk(oacc[r], 0.f) & 0xffffu);
#pragma unroll
            for (int i = 0; i < 2; ++i) { const int pc = lane + 64 * i, row = pc >> 2, q4 = pc & 3; const u32x4 v = *(const LAS u32x4*)(stg + row * 32 + q4 * 8);
                *(u32x4*)(G.O + (rowc + 32 * it + row) * DM + h * 256 + 32 * es + q4 * 8) = v; }
        } else if (wid >= 4) {
            const int dt = wid - 4;
            const LAS float* dec = (const LAS float*)(bb + R_DEC) + 32 * dt;
#pragma unroll
            for (int i = 0; i < 4; ++i) { const f32x4 dv = *(const LAS f32x4*)(dec + 8 * i + 4 * hi);
#pragma unroll
                for (int e = 0; e < 4; ++e) S[4 * i + e] *= dv[e]; }
#pragma unroll
            for (int s = 0; s < 4; ++s) {
                const int cq = 16 * s + 4 * hi + ((lane & 15) >> 2), colb = (32 * dt + 16 * ((lane >> 4) & 1) + 4 * (lane & 3)) * 2;
                const s16x4 alo = vtr(bb + R_KH + swo(cq, colb)), ahh = vtr(bb + R_KH + swo(cq + 8, colb));
                const LAS char* vb = bb + R_V + cq * 64 + ((lane >> 4) & 1) * 32 + (lane & 3) * 8;
                const s16x4 lo = vtr(vb), hh = vtr(vb + 512);
                const bf16x8 af = (bf16x8){alo[0], alo[1], alo[2], alo[3], ahh[0], ahh[1], ahh[2], ahh[3]};
                const bf16x8 vf = (bf16x8){lo[0], lo[1], lo[2], lo[3], hh[0], hh[1], hh[2], hh[3]};
                S = MFMA32(af, vf, S);
            }
#pragma unroll
            for (int i = 0; i < 4; ++i)
                *(LAS u32x2*)(lds + R_ST + (par ^ 1) * 8192 + swo(r32, (32 * dt + 8 * i + 4 * hi) * 2)) = (u32x2){cvtpk(S[4 * i], S[4 * i + 1]), cvtpk(S[4 * i + 2], S[4 * i + 3])};
        }
        if (ch + 1 < 64) GLA_COMMIT(par ^ 1);
        __syncthreads();
    }
#undef GLA_LOAD
#undef GLA_COMMIT
}

DI void gla_gate_rows2(bf16_t* O, const bf16_t* R, const float* gain, int m0, int lane) {
    u32x4 o0[2], o1[2], r0[2], r1[2];
#pragma unroll
    for (int u = 0; u < 2; ++u) { const bf16_t* Orow = O + (size_t)(m0 + u) * DM; const bf16_t* Rrow = R + (size_t)(m0 + u) * LDC;
        o0[u] = *(const u32x4*)(Orow + lane * 16); o1[u] = *(const u32x4*)(Orow + lane * 16 + 8); r0[u] = *(const u32x4*)(Rrow + lane * 16); r1[u] = *(const u32x4*)(Rrow + lane * 16 + 8); }
    const int c0 = (lane & 15) * 16;
    float gn[16];
#pragma unroll
    for (int i = 0; i < 4; ++i) { const f32x4 g4 = *(const f32x4*)(gain + c0 + 4 * i); gn[4 * i] = g4[0]; gn[4 * i + 1] = g4[1]; gn[4 * i + 2] = g4[2]; gn[4 * i + 3] = g4[3]; }
#pragma unroll
    for (int u = 0; u < 2; ++u) {
        float o[16], rr[16];
#pragma unroll
        for (int i = 0; i < 4; ++i) { o[2 * i] = bflo(o0[u][i]); o[2 * i + 1] = bfhi(o0[u][i]); o[8 + 2 * i] = bflo(o1[u][i]); o[8 + 2 * i + 1] = bfhi(o1[u][i]);
            rr[2 * i] = bflo(r0[u][i]); rr[2 * i + 1] = bfhi(r0[u][i]); rr[8 + 2 * i] = bflo(r1[u][i]); rr[8 + 2 * i + 1] = bfhi(r1[u][i]); }
        float ss = 0.f;
#pragma unroll
        for (int i = 0; i < 16; ++i) ss += o[i] * o[i];
        ss += __shfl_xor(ss, 1); ss += __shfl_xor(ss, 2); ss += __shfl_xor(ss, 4); ss += __shfl_xor(ss, 8);
        const float rs = rsqrtf(ss * (1.0f / 256.0f) + EPS);
        unsigned w[8];
#pragma unroll
        for (int i = 0; i < 8; ++i) { const float x0 = o[2 * i] * rs * gn[2 * i] * siluf_(rr[2 * i]), x1 = o[2 * i + 1] * rs * gn[2 * i + 1] * siluf_(rr[2 * i + 1]); w[i] = cvtpk(x0, x1); }
        bf16_t* Orow = O + (size_t)(m0 + u) * DM;
        *(u32x4*)(Orow + lane * 16) = (u32x4){w[0], w[1], w[2], w[3]}; *(u32x4*)(Orow + lane * 16 + 8) = (u32x4){w[4], w[5], w[6], w[7]};
    }
}
}

struct Ptrs {
    const float* in[31]; float* out; unsigned char* ws;
    DI bf16_t* bf(size_t off) const { return (bf16_t*)(ws + off); }
    DI float* f32(size_t off) const { return (float*)(ws + off); }
    DI int* i32(size_t off) const { return (int*)(ws + off); }
};
enum { I_X = 0, I_ANORM, I_AWIN, I_AQN, I_AKN, I_APEK, I_APEV, I_CK1, I_CK2, I_CV1, I_CV2, I_GBIAS, I_FQN, I_FKN, I_FFB, I_AWOUT, I_FNORM, I_FWG, I_FWU, I_FWD,
       I_CNORM, I_CWIN, I_CWA2, I_CBA, I_CONORM, I_CWOUT, I_MNORM, I_MROUTER, I_MWG, I_MWU, I_MWD };

namespace pro {
struct ConvM { const float* src; const float* src2; const float* gain; bf16_t* dst; int K, Ns, Nd, mode; };
DI int srccolA(int n) {
    const int pn = n >> 8, bj = (n >> 7) & 1, wc = (n >> 5) & 3, j = n & 31, s = 4 * pn + wc, d = 32 * bj + j;
    if (s < 8) return 64 * s + d;
    if (s < 10) return 768 + 64 * (s - 8) + d;
    if (s < 12) return 1024 + 64 * (s - 10) + d;
    if (s < 14) return 896 + 64 * (s - 12) + d;
    if (s < 16) return 1152 + 64 * (s - 14) + d;
    if (s < 18) return 512 + 64 * (s - 16) + d;
    if (s < 20) return 640 + 64 * (s - 18) + d;
    if (s < 28) return 1304 + 64 * (s - 20) + d;
    if (s < 36) return 1816 + 64 * (s - 28) + d;
    if (s < 44) return 2328 + 64 * (s - 36) + d;
    if (s == 44) { if (d < 24) return 1280 + d; if (d < 32) return 2840 + d - 24; }
    return -1;
}
DI void conv_item(const ConvM& M, int item, LAS float* scr, int lane) {
    const int nblk = M.Nd / 32, kb = item / nblk, nb = item % nblk, k0 = 64 * kb, n0 = 32 * nb;
    const int n = n0 + (lane & 31);
    const float* sp = M.src; int col = n;
    if (M.mode == 0) { if (n >= M.Ns) col = -1; }
    else if (M.mode == 1) col = srccolA(n);
    else { const int pn = n >> 8, half = (n >> 7) & 1, j = n & 127; sp = half ? M.src2 : M.src; col = 128 * pn + j; }
#pragma unroll 8
    for (int i = 0; i < 32; ++i) { const int kk = 2 * i + (lane >> 5); float w = 0.f; if (col >= 0) w = sp[(size_t)(k0 + kk) * M.Ns + col]; if (M.gain) w *= M.gain[k0 + kk]; scr[kk * 33 + (lane & 31)] = w; }
    const int c = lane & 7;
#pragma unroll
    for (int j = 0; j < 4; ++j) { const int nn = (lane >> 3) + 8 * j; const LAS float* s = scr + (8 * c) * 33 + nn;
        u32x4 o; o.x = cvtpk(s[0 * 33], s[1 * 33]); o.y = cvtpk(s[2 * 33], s[3 * 33]); o.z = cvtpk(s[4 * 33], s[5 * 33]); o.w = cvtpk(s[6 * 33], s[7 * 33]);
        *(u32x4*)(M.dst + (size_t)(n0 + nn) * M.K + k0 + 8 * c) = o; }
}
struct ConvRegs { f32x4 v[8]; };
DI void conv_big_load(ConvRegs& R, const ConvM& M, int item, int wid, int lane) {
    const int nblk = M.Nd / 256, kb = item / nblk, nb = item % nblk;
    const int k0 = 64 * kb + 8 * wid, n = 256 * nb + 4 * lane;
    const float* sp = M.src; int col = n;
    if (M.mode == 0) { if (n >= M.Ns) col = -1; }
    else if (M.mode == 1) col = srccolA(n);
    else { const int pn = n >> 8, half = (n >> 7) & 1, j = n & 127; sp = half ? M.src2 : M.src; col = 128 * pn + j; }
#pragma unroll
    for (int j = 0; j < 8; ++j) R.v[j] = (col >= 0) ? *(const f32x4*)(sp + (size_t)(k0 + j) * M.Ns + col) : (f32x4){0.f, 0.f, 0.f, 0.f};
}
DI void conv_big_store(ConvRegs& R, const ConvM& M, int item, LAS char* tile, int tid, int wid, int lane) {
    const int nblk = M.Nd / 256, kb = item / nblk, nb = item % nblk;
    if (M.gain) { const int k0 = 64 * kb + 8 * wid;
#pragma unroll
        for (int j = 0; j < 8; ++j) R.v[j] = R.v[j] * M.gain[k0 + j]; }
#pragma unroll
    for (int c = 0; c < 4; ++c) { u32x4 o; o.x = cvtpk(R.v[0][c], R.v[1][c]); o.y = cvtpk(R.v[2][c], R.v[3][c]); o.z = cvtpk(R.v[4][c], R.v[5][c]); o.w = cvtpk(R.v[6][c], R.v[7][c]);
        const int nl = 4 * lane + c; *(LAS u32x4*)(tile + nl * 128 + ((wid ^ (lane & 7)) * 16)) = o; }
    __syncthreads();
#pragma unroll
    for (int i = 0; i < 4; ++i) { const int r = (tid >> 3) + 64 * i, ch = tid & 7; const u32x4 o = *(const LAS u32x4*)(tile + r * 128 + ((ch ^ ((r >> 2) & 7)) * 16));
        *(u32x4*)(M.dst + (size_t)(256 * nb + r) * M.K + 64 * kb + 8 * ch) = o; }
    __syncthreads();
}
DI ConvM conv_desc(const Ptrs& P, int mat) {
    ConvM M; M.src2 = nullptr; M.gain = nullptr; M.mode = 0;
    switch (mat) {
    case 0: M.src = P.in[I_AWIN]; M.gain = P.in[I_ANORM]; M.dst = P.bf(WS_WA); M.K = 1024; M.Ns = IN_A; M.Nd = NA_PAD; M.mode = 1; break;
    case 1: M.src = P.in[I_AWOUT]; M.dst = P.bf(WS_WO); M.K = 1024; M.Ns = 1024; M.Nd = 1024; break;
    case 2: M.src = P.in[I_FWG]; M.src2 = P.in[I_FWU]; M.gain = P.in[I_FNORM]; M.dst = P.bf(WS_WFGU); M.K = 1024; M.Ns = DFF; M.Nd = 2 * DFF; M.mode = 2; break;
    case 3: M.src = P.in[I_FWD]; M.dst = P.bf(WS_WFD); M.K = DFF; M.Ns = 1024; M.Nd = 1024; break;
    case 4: M.src = P.in[I_CWIN]; M.gain = P.in[I_CNORM]; M.dst = P.bf(WS_WC); M.K = 1024; M.Ns = IN_C; M.Nd = NC_PAD; break;
    case 5: M.src = P.in[I_CWOUT]; M.dst = P.bf(WS_WCO); M.K = 1024; M.Ns = 1024; M.Nd = 1024; break;
    case 6: M.src = P.in[I_CK1]; M.dst = P.bf(CT_CW); M.K = 2048; M.Ns = 64; M.Nd = 64; break;
    case 7: M.src = P.in[I_CV1]; M.dst = P.bf(CT_CW + 262144); M.K = 2048; M.Ns = 64; M.Nd = 64; break;
    case 8: M.src = P.in[I_CK2]; M.dst = P.bf(CT_CW + 524288); M.K = 64; M.Ns = 64; M.Nd = 64; break;
    case 9: M.src = P.in[I_CV2]; M.dst = P.bf(CT_CW + 524288 + 8192); M.K = 64; M.Ns = 64; M.Nd = 64; break;
    default:
        if (mat < 18) { const int e = mat - 10; M.src = P.in[I_MWG] + (size_t)e * 1024 * DFF; M.src2 = P.in[I_MWU] + (size_t)e * 1024 * DFF; M.gain = P.in[I_MNORM];
            M.dst = P.bf(WS_WMGU) + (size_t)e * 2 * DFF * 1024; M.K = 1024; M.Ns = DFF; M.Nd = 2 * DFF; M.mode = 2; }
        else { const int e = mat - 18; M.src = P.in[I_MWD] + (size_t)e * DFF * 1024; M.dst = P.bf(WS_WMD) + (size_t)e * 1024 * DFF; M.K = DFF; M.Ns = 1024; M.Nd = 1024; }
    }
    return M;
}
DI int conv_items(int mat) {
    switch (mat) { case 0: return 16 * 12; case 1: return 16 * 4; case 2: return 16 * 22; case 3: return 44 * 4; case 4: return 16 * 13; case 5: return 16 * 4;
                   case 6: case 7: return 32 * 2; case 8: case 9: return 2; default: return mat < 18 ? 16 * 22 : 44 * 4; }
}
DI void prologue(const Ptrs& P, LAS char* lds) {
    int tid_l_ = threadIdx.x; asm volatile("" : "+v"(tid_l_)); const int tid = tid_l_, lane = tid & 63, wid = __builtin_amdgcn_readfirstlane(tid >> 6);
    const int gw = blockIdx.x * 8 + wid, NGW = gridDim.x * 8;
    LAS float* scr = (LAS float*)(lds + wid * 16384);
    {
        ConvRegs Ra, Rb; ConvM Ma, Mb; int ia = -1, ib = -1;
        int g = blockIdx.x, mat = 25, base = 0;
        auto advance = [&](ConvM& M, int& it) {
            it = -1;
            while (mat >= 0) {
                if (mat >= 6 && mat <= 9) { --mat; continue; }
                const int ni = conv_items(mat);
                if (g - base < ni) { M = conv_desc(P, mat); it = g - base; g += gridDim.x; return; }
                base += ni; --mat;
            }
        };
        advance(Ma, ia); if (ia >= 0) conv_big_load(Ra, Ma, ia, wid, lane);
        while (ia >= 0) {
            advance(Mb, ib); if (ib >= 0) conv_big_load(Rb, Mb, ib, wid, lane);
            conv_big_store(Ra, Ma, ia, lds + 65536 + 2048, tid, wid, lane);
            if (ib < 0) break;
            advance(Ma, ia); if (ia >= 0) conv_big_load(Ra, Ma, ia, wid, lane);
            conv_big_store(Rb, Mb, ib, lds + 65536 + 2048, tid, wid, lane);
        }
        for (int m2 = 6; m2 <= 9; ++m2) { const ConvM M = conv_desc(P, m2); const int ni = conv_items(m2); for (int it = gw; it < ni; it += NGW) conv_item(M, it, scr, lane); }
    }
    const float* x = P.in[I_X]; bf16_t* xb = P.bf(WS_XB); float* rstd0 = P.f32(CT_RSTD0);
    for (int m0 = gw * 2; m0 < T; m0 += NGW * 2) {
        f32x4 v[2][4];
#pragma unroll
        for (int u = 0; u < 2; ++u) { const f32x4* xr = (const f32x4*)(x + (size_t)(m0 + u) * DM) + lane;
#pragma unroll
            for (int j = 0; j < 4; ++j) v[u][j] = xr[64 * j]; }
#pragma unroll
        for (int u = 0; u < 2; ++u) {
            float s = 0.f;
#pragma unroll
            for (int j = 0; j < 4; ++j) s += (v[u][j][0] * v[u][j][0] + v[u][j][1] * v[u][j][1]) + (v[u][j][2] * v[u][j][2] + v[u][j][3] * v[u][j][3]);
            s = wave_sum(s);
            if (lane == 0) rstd0[m0 + u] = rsqrtf(s * (1.0f / 1024.0f) + EPS);
            u32x2* o8 = (u32x2*)(xb + (size_t)(m0 + u) * DM) + lane;
#pragma unroll
            for (int j = 0; j < 4; ++j) o8[64 * j] = (u32x2){cvtpk(v[u][j][0], v[u][j][1]), cvtpk(v[u][j][2], v[u][j][3])};
        }
    }
    float* cosT = P.f32(CT_ROPE); float* sinT = cosT + SEQ * 8;
    for (int idx = blockIdx.x * 512 + tid; idx < SEQ * 8; idx += gridDim.x * 512) {
        const int pos = idx >> 3, i = idx & 7;
        const float inv = powf(500000.0f, -(float)(2 * i) / 16.0f);
        const float ang = (float)pos * inv;
        const double rev = (double)ang * 0.15915494309189535; const float fr = (float)(rev - floor(rev));
        cosT[idx] = __builtin_amdgcn_cosf(fr); sinT[idx] = __builtin_amdgcn_sinf(fr);
    }
}

DI void fox_cum(const Ptrs& P, int bh, int lane) {
    const f32x4* lf = (const f32x4*)(P.f32(CT_LOGF) + (size_t)bh * SEQ + 64 * lane); f32x4* dst = (f32x4*)(P.f32(CT_CUM) + (size_t)bh * SEQ + 64 * lane);
    f32x4 v[16]; float tot = 0.f;
#pragma unroll
    for (int i = 0; i < 16; ++i) { v[i] = lf[i]; }
#pragma unroll
    for (int i = 0; i < 16; ++i) { v[i][1] += v[i][0]; v[i][2] += v[i][1]; v[i][3] += v[i][2]; const float t = v[i][3]; v[i] = v[i] + tot; tot += t; }
    float inc = tot;
#pragma unroll
    for (int o = 1; o < 64; o <<= 1) { const float t = __shfl_up(inc, o); if (lane >= o) inc += t; }
    const float base = inc - tot;
#pragma unroll
    for (int i = 0; i < 16; ++i) dst[i] = (v[i] + base) * (-LOG2E);
}

DI void compress_item(const Ptrs& P, int item, LAS char* lds) {
    int tid_l_ = threadIdx.x; asm volatile("" : "+v"(tid_l_)); const int tid = tid_l_, lane = tid & 63, r32 = lane & 31, hi = lane >> 5, wid = __builtin_amdgcn_readfirstlane(tid >> 6);
    const int kv = item >> 7, b = (item >> 4) & 7, g = (item >> 3) & 1, nt = item & 7;
    const bf16_t* projA = P.bf(WS_BIG);
    const float* pe = (kv ? P.in[I_APEV] : P.in[I_APEK]);
    const bf16_t* w1t = P.bf(CT_CW + (kv ? 262144 : 0)); const bf16_t* w2t = P.bf(CT_CW + 524288 + (kv ? 8192 : 0));
    int n = 32 * nt + r32; if (n > 254) n = 254;
    f32x16 c0, c1;
#pragma unroll
    for (int r = 0; r < 16; ++r) { c0[r] = 0.f; c1[r] = 0.f; }
#pragma unroll 8
    for (int kk = 0; kk < 16; ++kk) { const int ks = 16 * wid + kk;
        const int l = ks >> 2, d = 16 * (ks & 3) + 8 * hi;
        const u32x4 raw = *(const u32x4*)(projA + ((size_t)b * SEQ + 16 * n + l) * LDA + (kv ? PA_VC : PA_KC) + g * 64 + d);
        const f32x4 p0 = *(const f32x4*)(pe + l * 64 + d), p1 = *(const f32x4*)(pe + l * 64 + d + 4);
        u32x4 aw; aw.x = cvtpk(bflo(raw.x) + p0[0], bfhi(raw.x) + p0[1]); aw.y = cvtpk(bflo(raw.y) + p0[2], bfhi(raw.y) + p0[3]);
        aw.z = cvtpk(bflo(raw.z) + p1[0], bfhi(raw.z) + p1[1]); aw.w = cvtpk(bflo(raw.w) + p1[2], bfhi(raw.w) + p1[3]);
        const bf16x8 A = __builtin_bit_cast(bf16x8, aw);
        const bf16x8 B0 = *(const bf16x8*)(w1t + (size_t)r32 * 2048 + 16 * ks + 8 * hi), B1 = *(const bf16x8*)(w1t + (size_t)(32 + r32) * 2048 + 16 * ks + 8 * hi);
        c0 = MFMA32(A, B0, c0); c1 = MFMA32(A, B1, c1);
    }
    LAS float* red = (LAS float*)lds + wid * 2048;
#pragma unroll
    for (int r = 0; r < 16; ++r) { const int nn = att::crow(r, hi); red[nn * 64 + r32] = c0[r]; red[nn * 64 + 32 + r32] = c1[r]; }
    __syncthreads();
    {
        LAS bf16_t* H1 = (LAS bf16_t*)(lds + 65536);
        const LAS float* rd = (const LAS float*)lds;
        float s4[4];
#pragma unroll
        for (int e = 0; e < 4; ++e) { float s = 0.f;
#pragma unroll
            for (int w = 0; w < 8; ++w) s += rd[w * 2048 + tid * 4 + e];
            s4[e] = gelu_tanh(s); }
        *(LAS u32x2*)(H1 + tid * 4) = (u32x2){cvtpk(s4[0], s4[1]), cvtpk(s4[2], s4[3])};
    }
    __syncthreads();
    if (wid == 0) {
        f32x16 o0, o1;
#pragma unroll
        for (int r = 0; r < 16; ++r) { o0[r] = 0.f; o1[r] = 0.f; }
#pragma unroll
        for (int ks = 0; ks < 4; ++ks) {
            const bf16x8 A = *(const LAS bf16x8*)(lds + 65536 + r32 * 128 + (16 * ks + 8 * hi) * 2);
            const bf16x8 B0 = *(const bf16x8*)(w2t + r32 * 64 + 16 * ks + 8 * hi), B1 = *(const bf16x8*)(w2t + (32 + r32) * 64 + 16 * ks + 8 * hi);
            o0 = MFMA32(A, B0, o0); o1 = MFMA32(A, B1, o1);
        }
        bf16_t* dst = P.bf(kv ? CT_VCMP : CT_KCMP);
        if (kv == 0) {
            const float* kn = P.in[I_AKN]; const float g0 = kn[r32], g1 = kn[32 + r32];
            const float* cosT = P.f32(CT_ROPE); const float* sinT = cosT + SEQ * 8;
#pragma unroll
            for (int r = 0; r < 16; ++r) {
                float ss = o0[r] * o0[r] + o1[r] * o1[r];
                ss += __shfl_xor(ss, 1); ss += __shfl_xor(ss, 2); ss += __shfl_xor(ss, 4); ss += __shfl_xor(ss, 8); ss += __shfl_xor(ss, 16);
                const float rs = rsqrtf(ss * (1.0f / 64.0f) + EPS);
                float y0 = o0[r] * rs * g0; const float y1 = o1[r] * rs * g1;
                const float oth = __shfl_xor(y0, 8);
                const int nn = 32 * nt + att::crow(r, hi); const int pos = (16 * nn + 31) & (SEQ - 1);
                const float cc = cosT[pos * 8 + (r32 & 7)], sn = sinT[pos * 8 + (r32 & 7)];
                if (r32 < 8) y0 = y0 * cc - oth * sn; else if (r32 < 16) y0 = oth * sn + y0 * cc;
                o0[r] = y0; o1[r] = y1;
            }
        }
#pragma unroll
        for (int r = 0; r < 16; ++r) {
            const int nn = 32 * nt + att::crow(r, hi);
            const bool pad = nn > 254;
            bf16_t* dp = dst + (((size_t)b * NCMP_PAD + nn) * 2 + g) * 64;
            dp[r32] = pad ? (bf16_t)0 : (bf16_t)(cvtpk(o0[r], 0.f) & 0xffffu); dp[32 + r32] = pad ? (bf16_t)0 : (bf16_t)(cvtpk(o1[r], 0.f) & 0xffffu);
        }
    }
    __syncthreads();
}
}

namespace moe {
DI void route_block(const Ptrs& P, int blk, LAS char* lds) {
    int tid_l_ = threadIdx.x; asm volatile("" : "+v"(tid_l_)); const int tid = tid_l_, lane = tid & 63, r32 = lane & 31, hi = lane >> 5, wid = __builtin_amdgcn_readfirstlane(tid >> 6);
    constexpr int RPITCH = 1032;
    LAS bf16_t* RBH = (LAS bf16_t*)lds; LAS bf16_t* RBL = RBH + 8 * RPITCH;
    LAS float* PART = (LAS float*)(lds + 36864); LAS float* LG = (LAS float*)(lds + 40960);
    LAS int* einfo = (LAS int*)(lds + 33280);
    const float* router = P.in[I_MROUTER]; const float* mg = P.in[I_MNORM];
    for (int i = tid; i < 8192; i += 512) { const int k = i >> 3, e = i & 7; const float v = router[i] * mg[k];
        const unsigned hb = cvtpk(v, 0.f) & 0xffffu; const float vh = __uint_as_float(hb << 16); const unsigned lb = cvtpk(v - vh, 0.f) & 0xffffu;
        RBH[e * RPITCH + k] = (bf16_t)hb; RBL[e * RPITCH + k] = (bf16_t)lb; }
    __syncthreads();
    const bf16_t* xb3 = P.bf(WS_HM);
    {
        const int rt = wid & 3, kh = wid >> 2;
        const bf16_t* ap = xb3 + ((size_t)blk * 128 + 32 * rt + r32) * DM + 512 * kh + 8 * hi;
        const LAS bf16_t* bh = RBH + (r32 & 7) * RPITCH + 512 * kh + 8 * hi; const LAS bf16_t* bl = RBL + (r32 & 7) * RPITCH + 512 * kh + 8 * hi;
        f32x16 c;
#pragma unroll
        for (int r = 0; r < 16; ++r) c[r] = 0.f;
#pragma unroll 8
        for (int ks = 0; ks < 32; ++ks) {
            const bf16x8 A = *(const bf16x8*)(ap + 16 * ks);
            c = MFMA32(A, *(const LAS bf16x8*)(bh + 16 * ks), c); c = MFMA32(A, *(const LAS bf16x8*)(bl + 16 * ks), c);
        }
        if (kh == 1 && r32 < 8) {
#pragma unroll
            for (int r = 0; r < 16; ++r) PART[(32 * rt + att::crow(r, hi)) * 8 + r32] = c[r];
        }
        __syncthreads();
        if (kh == 0 && r32 < 8) {
#pragma unroll
            for (int r = 0; r < 16; ++r) { const int tk = 32 * rt + att::crow(r, hi); LG[tk * 8 + r32] = c[r] + PART[tk * 8 + r32]; }
        }
        __syncthreads();
    }
    if (tid < 128) {
        const int tl = tid, t = blk * 128 + tl;
        const f32x4 la = *(const LAS f32x4*)(LG + tl * 8), lb = *(const LAS f32x4*)(LG + tl * 8 + 4);
        const float rs = pg8::row_rstd(P.f32(CT_SS3), t);
        const float acc[8] = {la[0], la[1], la[2], la[3], lb[0], lb[1], lb[2], lb[3]};
        int e1 = 0; float l1 = acc[0] * rs;
#pragma unroll
        for (int e = 1; e < 8; ++e) { const float l = acc[e] * rs; if (l > l1) { l1 = l; e1 = e; } }
        int e2 = -1; float l2 = -3.0e38f;
#pragma unroll
        for (int e = 0; e < 8; ++e) { const float l = acc[e] * rs; if (e != e1 && l > l2) { l2 = l; e2 = e; } }
        const float w1 = 1.0f / (1.0f + __expf(l2 - l1));
        einfo[tl * 2] = e1; einfo[tl * 2 + 1] = e2;
        P.f32(MO_TOKW)[(size_t)t * 2] = w1; P.f32(MO_TOKW)[(size_t)t * 2 + 1] = 1.0f - w1;
        P.f32(MO_TOKR)[t] = rs;
    }
    __syncthreads();
    LAS int* rk = (LAS int*)(lds + 34304);
    if (tid < 256) { const int e = einfo[tid]; int r = 0; for (int j = 0; j < tid; ++j) r += (einfo[j] == e) ? 1 : 0; rk[tid] = r; }
    if (tid >= 256 && tid < 264) { const int e = tid - 256; int c = 0; for (int j = 0; j < 256; ++j) c += (einfo[j] == e) ? 1 : 0; P.i32(MO_HIST)[blk * 8 + e] = c; }
    __syncthreads();
    if (tid < 128) { const int t = blk * 128 + tid; ((unsigned*)P.i32(MO_TOKE))[t] = (unsigned)einfo[2 * tid] | ((unsigned)einfo[2 * tid + 1] << 4) | ((unsigned)rk[2 * tid] << 8) | ((unsigned)rk[2 * tid + 1] << 20); }
    __syncthreads();
}
DI void scatter_block(const Ptrs& P, int blk, LAS char* lds) {
    int tid_l_ = threadIdx.x; asm volatile("" : "+v"(tid_l_)); const int tid = tid_l_, lane = tid & 63, wid = __builtin_amdgcn_readfirstlane(tid >> 6);
    LAS int* sh = (LAS int*)lds;
    const int* hist = P.i32(MO_HIST);
    { typedef int i32x4 __attribute__((ext_vector_type(4))); *(LAS i32x4*)(sh + 64 + tid * 4) = *(const i32x4*)(hist + tid * 4); }
    __syncthreads();
    if (tid < 8) { int c = 0, pre = 0; for (int j = 0; j < 256; ++j) { const int v = sh[64 + j * 8 + tid]; c += v; if (j < blk) pre += v; } sh[tid] = c; sh[8 + tid] = pre; }
    __syncthreads();
    if (tid == 0) { int acc = 0; for (int e = 0; e < 8; ++e) { sh[16 + e] = acc; acc += ((sh[e] + 255) >> 8) << 8; } sh[24] = acc; }
    __syncthreads();
    const bf16_t* xb3 = P.bf(WS_HM); bf16_t* xy = P.bf(WS_XY);
    for (int q0 = wid * 32; q0 < wid * 32 + 32; q0 += 4) {
        u32x4 a[4], c[4]; int rowv[4];
#pragma unroll
        for (int u = 0; u < 4; ++u) {
            const int q = q0 + u, tl = q >> 1, slot = q & 1, t = blk * 128 + tl;
            const unsigned info = ((const unsigned*)P.i32(MO_TOKE))[t];
            const int e = slot ? (info >> 4) & 15 : info & 15, lr = slot ? (info >> 20) & 4095 : (info >> 8) & 4095;
            rowv[u] = sh[16 + e] + sh[8 + e] + lr;
            const u32x4* src = (const u32x4*)(xb3 + (size_t)t * DM) + lane;
            a[u] = src[0]; c[u] = src[64];
            if (lane == 0) { P.f32(MO_RSCALE)[rowv[u]] = P.f32(MO_TOKR)[t]; P.f32(MO_RGATE)[rowv[u]] = P.f32(MO_TOKW)[(size_t)t * 2 + slot]; P.f32(MO_RKEEP)[rowv[u]] = slot ? 0.f : 1.f; P.i32(MO_POS)[(size_t)t * 2 + slot] = rowv[u];
                if (rowv[u] >= MOE_XROW0) P.i32(MO_ROWTOK)[rowv[u] - MOE_XROW0] = t; }
        }
#pragma unroll
        for (int u = 0; u < 4; ++u) { u32x4* dst = (u32x4*)(xy + (size_t)rowv[u] * DM) + lane; dst[0] = a[u]; dst[64] = c[u]; }
    }
    if (blk < 8) {
        const int e = blk, r0 = sh[16 + e] + sh[e], r1 = sh[16 + e + 1];
        for (int row = r0 + wid; row < r1; row += 8) { u32x2* o8 = (u32x2*)(xy + (size_t)row * DM) + lane;
#pragma unroll
            for (int j = 0; j < 4; ++j) o8[64 * j] = (u32x2){0u, 0u};
            if (lane == 0) { P.f32(MO_RSCALE)[row] = 0.f; P.f32(MO_RGATE)[row] = 0.f; P.f32(MO_RKEEP)[row] = 0.f; if (row >= MOE_XROW0) P.i32(MO_ROWTOK)[row - MOE_XROW0] = -1; } }
    }
    if (blk == 8) {
        int* te = P.i32(MO_TILEE); const int ntl = sh[24] >> 8;
        for (int tl = tid; tl < 271; tl += 512) { int e = 0; for (int k = 1; k < 8; ++k) if (tl * 256 >= sh[16 + k]) e = k; te[tl] = e; }
        if (tid == 0) te[271] = ntl;
    }
    __syncthreads();
}
DI f32x4 moe_row_piece(const Ptrs& P, int p, int lane, int j) {
    const u32x2 w = ((const u32x2*)(P.bf(WS_XY) + (size_t)p * DM) + lane)[64 * j];
    const f32x4 old = {bflo(w[0]), bfhi(w[0]), bflo(w[1]), bfhi(w[1])};
    if (p < MOE_XROW0) return old;
    const f32x4* pp = (const f32x4*)(P.f32(WS_PART) + (size_t)(p - MOE_XROW0) * 11 * DM) + 64 * j + lane;
    f32x4 s = pp[0];
#pragma unroll
    for (int k = 1; k < 11; ++k) s += pp[k * (DM / 4)];
    return old * P.f32(MO_RKEEP)[p] + s * P.f32(MO_RGATE)[p];
}
DI void combine_tail_row(const Ptrs& P, int xr, int lane) {
    const int t = __builtin_amdgcn_readfirstlane(P.i32(MO_ROWTOK)[xr]);
    if (t < 0) return;
    const int p1 = __builtin_amdgcn_readfirstlane(P.i32(MO_POS)[(size_t)t * 2]), p2 = __builtin_amdgcn_readfirstlane(P.i32(MO_POS)[(size_t)t * 2 + 1]);
    if (p1 >= MOE_XROW0 && p2 >= MOE_XROW0 && (p1 < p2 ? p1 : p2) != MOE_XROW0 + xr) return;
    f32x4* orow = (f32x4*)(P.out + (size_t)t * DM) + lane;
#pragma unroll 2
    for (int j = 0; j < 4; ++j) orow[64 * j] = moe_row_piece(P, p1, lane, j) + moe_row_piece(P, p2, lane, j);
}
template <int NR> DI void combine_rows(const Ptrs& P, int t0, int lane) {
    const bf16_t* y = P.bf(WS_XY);
    int p1[NR], p2[NR];
#pragma unroll
    for (int u = 0; u < NR; ++u) { p1[u] = P.i32(MO_POS)[(size_t)(t0 + u) * 2]; p2[u] = P.i32(MO_POS)[(size_t)(t0 + u) * 2 + 1]; }
    { bool tail = false;
#pragma unroll
      for (int u = 0; u < NR; ++u) tail = tail || p1[u] >= MOE_XROW0 || p2[u] >= MOE_XROW0;
      if (tail) {
#pragma unroll 1
        for (int u = 0; u < NR; ++u) { if (p1[u] >= MOE_XROW0 || p2[u] >= MOE_XROW0) continue;
            f32x4* orow = (f32x4*)(P.out + (size_t)(t0 + u) * DM) + lane;
#pragma unroll 1
            for (int j = 0; j < 4; ++j) orow[64 * j] = moe_row_piece(P, p1[u], lane, j) + moe_row_piece(P, p2[u], lane, j); }
        return; } }
    u32x2 a[NR][4], c[NR][4];
#pragma unroll
    for (int u = 0; u < NR; ++u) {
        const u32x2* y1 = (const u32x2*)(y + (size_t)p1[u] * DM) + lane; const u32x2* y2 = (const u32x2*)(y + (size_t)p2[u] * DM) + lane;
#pragma unroll
        for (int j = 0; j < 4; ++j) { a[u][j] = y1[64 * j]; c[u][j] = y2[64 * j]; }
    }
#pragma unroll
    for (int u = 0; u < NR; ++u) {
        f32x4* orow = (f32x4*)(P.out + (size_t)(t0 + u) * DM) + lane;
#pragma unroll
        for (int j = 0; j < 4; ++j) { f32x4 w; w[0] = bflo(a[u][j][0]) + bflo(c[u][j][0]); w[1] = bfhi(a[u][j][0]) + bfhi(c[u][j][0]); w[2] = bflo(a[u][j][1]) + bflo(c[u][j][1]); w[3] = bfhi(a[u][j][1]) + bfhi(c[u][j][1]); orow[64 * j] = w; }
    }
}
}
#define XB_TMO      128
#define XB_XCNT(j)  (256  + 64 * (j))
#define XB_XSUB(j)  (1280 + 64 * (j))
#define XB_XGEN(j)  (2304 + 64 * (j))
#define XB_TOP      3328
#define XB_TOPGEN   3392
#define XCD_BAR_WORDS 3456
#define XB_SPIN_CAP (1u << 18)

__device__ __forceinline__ unsigned xb_ld(unsigned* p)              { return __hip_atomic_load(p, __ATOMIC_RELAXED, __HIP_MEMORY_SCOPE_AGENT); }
__device__ __forceinline__ unsigned xb_add(unsigned* p, unsigned v) { return __hip_atomic_fetch_add(p, v, __ATOMIC_RELAXED, __HIP_MEMORY_SCOPE_AGENT); }
__device__ __forceinline__ unsigned xb_xcc_id() { return (unsigned)__builtin_amdgcn_s_getreg((3 << 11) | 20) & 0xFu; }
#define XB_SPIN(cond, bar) do { unsigned _sp = 0; while (cond) { __builtin_amdgcn_s_sleep(1); \
    if ((++_sp & 255u) == 0u) { if (xb_ld(&(bar)[XB_TMO])) break; if (_sp > XB_SPIN_CAP) { atomicAdd(&(bar)[XB_TMO], 1u); break; } } } } while (0)

struct XcdBarrier {
    unsigned* bar; unsigned x;
    volatile LAS unsigned* st;
};

__device__ __forceinline__ XcdBarrier xcd_barrier_post(unsigned* bar, volatile LAS unsigned* st) {
    XcdBarrier b; b.bar = bar; b.x = xb_xcc_id(); b.st = st;
    if (threadIdx.x == 0) (void)xb_add(&bar[XB_XCNT(b.x)], 1u);
    return b;
}
__device__ __forceinline__ void xcd_barrier_complete(unsigned* bar, unsigned x, unsigned& nloc, unsigned& nx) {
    const unsigned G = gridDim.x * gridDim.y * gridDim.z;
    unsigned sum, cnt, mine, sp = 0u;
    for (;;) {
        sum = 0u; cnt = 0u; mine = 0u;
#pragma unroll
        for (unsigned j = 0; j < 16; ++j) { const unsigned c = xb_ld(&bar[XB_XCNT(j)]); sum += c; cnt += (c > 0u) ? 1u : 0u; mine = (j == x) ? c : mine; }
        if (sum == G) break;
        __builtin_amdgcn_s_sleep(1);
        if ((++sp & 255u) == 0u) { if (xb_ld(&bar[XB_TMO])) break; if (sp > XB_SPIN_CAP) { atomicAdd(&bar[XB_TMO], 1u); break; } }
    }
    nloc = mine > 0u ? mine : 1u; nx = cnt > 0u ? cnt : 1u;
}

__device__ __forceinline__ void xcd_barrier(const XcdBarrier& b) {
    asm volatile("s_waitcnt vmcnt(0)" ::: "memory");
    __syncthreads();
    if (threadIdx.x == 0) {
        unsigned* bar = b.bar;
        __builtin_amdgcn_s_waitcnt(0);
        unsigned nloc = b.st[0], nx = b.st[1];
        if (nloc == 0u) { xcd_barrier_complete(bar, b.x, nloc, nx); b.st[0] = nloc; b.st[1] = nx; }
        const unsigned old = xb_add(&bar[XB_XSUB(b.x)], 1u);
        const unsigned gen = old / nloc;
        if (old + 1u == (gen + 1u) * nloc) {
            __builtin_amdgcn_fence(__ATOMIC_RELEASE, "agent");
            asm volatile("s_waitcnt vmcnt(0)" ::: "memory");
            const unsigned og = xb_add(&bar[XB_TOP], 1u);
            const unsigned tg = og / nx;
            if (og + 1u == (tg + 1u) * nx) xb_add(&bar[XB_TOPGEN], 1u);
            else XB_SPIN(xb_ld(&bar[XB_TOPGEN]) == tg, bar);
            __builtin_amdgcn_fence(__ATOMIC_ACQUIRE, "agent");
            xb_add(&bar[XB_XGEN(b.x)], 1u);
            asm volatile("s_waitcnt vmcnt(0)" ::: "memory");
        } else {
            XB_SPIN(xb_ld(&bar[XB_XGEN(b.x)]) == gen, bar);
            __builtin_amdgcn_fence(__ATOMIC_ACQUIRE, "agent");
            asm volatile("s_waitcnt vmcnt(0)" ::: "memory");
        }
    }
    __syncthreads();
}

#ifndef MK_N_LAUNCHES
#define MK_N_LAUNCHES 1
#endif
constexpr int N_PHASES = 18;

__global__ void __launch_bounds__(512, 2) mega_fwd(Args args) {
    extern __shared__ __attribute__((aligned(16))) unsigned char lds_raw[];
    LAS char* lds = (LAS char*)lds_raw;
    cg::grid_group grid = cg::this_grid();
    Ptrs P;
#pragma unroll
    for (int i = 0; i < 31; ++i) P.in[i] = args.in[i];
    P.out = args.out; P.ws = args.ws;
    const int lo = args.ph_lo, hi_ = args.ph_hi;
    const int tid = threadIdx.x, lane = tid & 63, wid = __builtin_amdgcn_readfirstlane(tid >> 6);
    const int G = gridDim.x, gw = blockIdx.x * 8 + wid, NGW = G * 8;
#define IN(k) (lo <= (k) && (k) < hi_)
    { volatile LAS unsigned* st0 = (volatile LAS unsigned*)(lds_raw + LDS_MISC); if (tid < 64) st0[tid] = 0u; }
    __syncthreads();
    XcdBarrier xbar; xbar.bar = (unsigned*)(args.ws + CT_BAR); xbar.x = 0; xbar.st = (volatile LAS unsigned*)(lds_raw + LDS_MISC) + 8;
    const bool one_launch = (lo == 0 && hi_ == N_PHASES);
    if (one_launch) { if (blockIdx.x == 0) { for (int i = tid; i < 1024; i += 512) ((unsigned*)(args.ws + CT_CTR))[i] = 0u; for (int i = tid; i < 4096; i += 512) ((unsigned*)(args.ws + CT_BAR))[i] = 0u; } }
    else xbar = xcd_barrier_post((unsigned*)(args.ws + CT_BAR), (volatile LAS unsigned*)(lds_raw + LDS_MISC) + 8);
#define SEAM(k) do { if (IN(k) && IN((k) + 1)) { if ((k) == 0) { grid.sync(); if (one_launch) xbar = xcd_barrier_post((unsigned*)(args.ws + CT_BAR), (volatile LAS unsigned*)(lds_raw + LDS_MISC) + 8); } else xcd_barrier(xbar); } } while (0)
    LAS unsigned char* glds = (LAS unsigned char*)lds_raw;

    if (IN(0)) { pro::prologue(P, lds); }
    SEAM(0);
    if (IN(1)) {
        pg8::Gemm g{P.bf(WS_XB), P.bf(WS_WA), T, NA_PAD, DM}; pg8::StaticOrder S; S.init(T, NA_PAD, G, (int)blockIdx.x);
        const float* cosT = P.f32(CT_ROPE);
        pg8::EpiInA E{P.bf(WS_BIG), P.f32(CT_RSTD0), cosT, cosT + SEQ * 8, P.in[I_AQN], P.in[I_AKN], P.in[I_FQN], P.in[I_FKN], P.in[I_GBIAS], P.in[I_FFB], P.f32(CT_GATE), P.f32(CT_LOGF)};
        pg8::gemm_phase<pg8::EpiInA, pg8::StaticOrder, true, true>(glds, g, S, E);
    }
    SEAM(1);
    if (IN(2)) {
        if (gw < 64) pro::fox_cum(P, gw, lane);
        for (int it = blockIdx.x; it < 256; it += G) pro::compress_item(P, it, lds);
    }
    SEAM(2);
    if (IN(3)) {
        att::Tensors AT{P.bf(WS_BIG), P.bf(CT_KCMP), P.bf(CT_VCMP), P.f32(CT_GATE), P.f32(CT_CUM), P.bf(WS_O), P.in[I_FQN], P.in[I_FKN], P.in[I_AQN], P.in[I_AKN]};
        att::attn_phase(AT, (unsigned*)(P.ws + CT_CTR), lds);
    }
    SEAM(3);
    if (IN(4)) {
        pg8::Gemm g{P.bf(WS_O), P.bf(WS_WO), T, DM, DM}; pg8::StaticOrder S; S.init(T, DM, G, (int)blockIdx.x);
        pg8::EpiResid<true> E{P.in[I_X], P.bf(WS_XB), P.f32(CT_SS1)};
        pg8::gemm_phase<pg8::EpiResid<true>, pg8::StaticOrder, true, true>(glds, g, S, E);
    }
    SEAM(4);
    if (IN(5)) {
        pg8::Gemm g{P.bf(WS_XB), P.bf(WS_WFGU), T, 2 * DFF, DM}; pg8::StaticOrder S; S.init(T, 2 * DFF, G, (int)blockIdx.x);
        for (int blk = blockIdx.x; blk < 256; blk += G) if (tid < 128) { const int row = blk * 128 + tid; P.f32(CT_RSTD0)[row] = pg8::row_rstd(P.f32(CT_SS1), row); }
        xcd_barrier(xbar);
        pg8::EpiSwiglu<true> E{P.bf(WS_BIG), P.f32(CT_RSTD0), 0};
        pg8::gemm_phase<pg8::EpiSwiglu<true>, pg8::StaticOrder, true, true>(glds, g, S, E);
    }
    SEAM(5);
    if (IN(6)) {
        pg8::Gemm g{P.bf(WS_BIG), P.bf(WS_WFD), T, DM, DFF}; pg8::StaticOrder S; S.init(T, DM, G, (int)blockIdx.x);
        pg8::EpiResid<false> E{P.bf(WS_XB), P.bf(WS_XB), P.f32(CT_SS2)};
        pg8::gemm_phase<pg8::EpiResid<false>, pg8::StaticOrder, true, true>(glds, g, S, E);
    }
    SEAM(6);
    if (IN(7)) {
        for (int blk = blockIdx.x; blk < 256; blk += G) if (tid < 128) { const int row = blk * 128 + tid; P.f32(CT_RSTD0)[row] = pg8::row_rstd(P.f32(CT_SS2), row); }
        for (int it = blockIdx.x; it < T / 128; it += G) gla::gla_a1_item(P.bf(WS_XB), P.bf(WS_WC) + (size_t)LDC * DM, P.f32(CT_SS2), P.f32(CT_A1), it, lds);
        xcd_barrier(xbar);
        pg8::Gemm g{P.bf(WS_XB), P.bf(WS_WC), T, LDC, DM}; pg8::StaticOrder S; S.init(T, LDC, G, (int)blockIdx.x);
        pg8::EpiGlaIn E{P.bf(WS_BIG), P.f32(CT_RSTD0)};
        pg8::gemm_phase<pg8::EpiGlaIn, pg8::StaticOrder, true, true>(glds, g, S, E);
    }
    SEAM(7);
    if (IN(8)) {
        gla::GlaT GT{P.bf(WS_BIG), P.f32(CT_A1), P.in[I_CWA2], P.in[I_CBA], P.bf(WS_O), P.bf(WS_ATT), P.f32(CT_GATE)};
        {
            gla::PrepRegs Ra, Rb; int it = blockIdx.x;
            if (it < 2048) gla::prep_load(Ra, GT, it, tid);
            while (it < 2048) {
                const int i1 = it + G; if (i1 < 2048) gla::prep_load(Rb, GT, i1, tid);
                gla::gla_prep(GT, it, Ra, lds);
                if (i1 >= 2048) break;
                const int i2 = i1 + G; if (i2 < 2048) gla::prep_load(Ra, GT, i2, tid);
                gla::gla_prep(GT, i1, Rb, lds);
                it = i2;
            }
        }
        xcd_barrier(xbar);
        for (int u = blockIdx.x; u < 256; u += G) { const int bh = (u & 7) * 4 + (u >> 6), es = (u >> 3) & 7; gla::gla_unit(GT, bh >> 2, bh & 3, es, lds); }
    }
    SEAM(8);
    if (IN(9)) {
        for (int m = gw * 2; m < T; m += NGW * 2) gla::gla_gate_rows2(P.bf(WS_O), P.bf(WS_BIG) + PC_R, P.in[I_CONORM], m, lane);
    }
    SEAM(9);
    if (IN(10)) {
        pg8::Gemm g{P.bf(WS_O), P.bf(WS_WCO), T, DM, DM}; pg8::StaticOrder S; S.init(T, DM, G, (int)blockIdx.x);
        pg8::EpiResid<false> E{P.bf(WS_XB), P.bf(WS_HM), P.f32(CT_SS3)};
        pg8::gemm_phase<pg8::EpiResid<false>, pg8::StaticOrder, true, true>(glds, g, S, E);
    }
    SEAM(10);
    if (IN(11)) { for (int blk = blockIdx.x; blk < 256; blk += G) moe::route_block(P, blk, lds); }
    SEAM(11);
    if (IN(12)) { for (int blk = blockIdx.x; blk < 256; blk += G) moe::scatter_block(P, blk, lds); }
    SEAM(12);
#pragma unroll 1
    for (int pass = 0; pass < 2; ++pass) {
        const int tile0 = pass * MOE_PASS_TILES;
        if (IN(13 + 2 * pass)) {
            int ntp = __builtin_amdgcn_readfirstlane(P.i32(MO_TILEE)[271]) - tile0; { const int cap = pass == 0 ? MOE_PASS_TILES : MOE_PASS1_MAX; ntp = ntp < 0 ? 0 : (ntp > cap ? cap : ntp); }
            if (ntp > 0) {
                pg8::Gemm g{P.bf(WS_XY) + (size_t)tile0 * 256 * DM, P.bf(WS_WMGU), ntp * 256, 2 * DFF, DM};
                pg8::GroupedOrder S; S.so.init(ntp * 256, 2 * DFF, G, (int)blockIdx.x); S.tile_e = P.i32(MO_TILEE); S.tile0 = tile0; S.nN = 22;
                pg8::EpiSwiglu<true> E{P.bf(WS_HM), P.f32(MO_RSCALE), tile0 * 256};
                pg8::gemm_phase<pg8::EpiSwiglu<true>, pg8::GroupedOrder, true, true>(glds, g, S, E);
            }
        }
        SEAM(13 + 2 * pass);
        if (IN(14 + 2 * pass)) {
            int ntp = __builtin_amdgcn_readfirstlane(P.i32(MO_TILEE)[271]) - tile0; { const int cap = pass == 0 ? MOE_PASS_TILES : MOE_PASS1_MAX; ntp = ntp < 0 ? 0 : (ntp > cap ? cap : ntp); }
            const int ntm = ntp < MOE_PASS_TILES ? ntp : MOE_PASS_TILES, nx = ntp - ntm;
            if (ntm > 0) {
                pg8::Gemm g{P.bf(WS_HM), P.bf(WS_WMD), ntm * 256, DM, DFF};
                pg8::GroupedOrder S; S.so.init(ntm * 256, DM, G, (int)blockIdx.x); S.tile_e = P.i32(MO_TILEE); S.tile0 = tile0; S.nN = 4;
                pg8::EpiMoeDown E{P.bf(WS_XY), P.f32(MO_RGATE), P.f32(MO_RKEEP), tile0 * 256};
                pg8::gemm_phase<pg8::EpiMoeDown, pg8::GroupedOrder, true, true>(glds, g, S, E);
            }
            if (nx > 0) {
                pg8::Gemm g{P.bf(WS_HM), P.bf(WS_WMD), ntp * 256, DM, 256, DFF};
                pg8::SliceOrder S{P.i32(MO_TILEE), tile0, ntm, nx * 44, G, (int)blockIdx.x};
                pg8::EpiMoePart E{P.f32(WS_PART), ntm};
                pg8::gemm_phase<pg8::EpiMoePart, pg8::SliceOrder, true, true>(glds, g, S, E);
            }
        }
        SEAM(14 + 2 * pass);
    }
    if (IN(17)) { int t17 = tid; asm volatile("" : "+v"(t17)); const int lane17 = t17 & 63;
        { const int nxr = (__builtin_amdgcn_readfirstlane(P.i32(MO_TILEE)[271]) - 2 * MOE_PASS_TILES) * 256;
          for (int xr = gw; xr < nxr; xr += NGW) moe::combine_tail_row(P, xr, lane17); }
        for (int m = gw * 2; m < T; m += NGW * 2) moe::combine_rows<2>(P, m, lane17); }
#undef IN
#undef SEAM
}

extern "C" void kernel_launch(void* const* d_in, const int* in_sizes, int n_in, void* d_out, int out_size, void* d_ws, size_t ws_size, hipStream_t stream) {
    static int grid = 0;
    if (grid == 0) {
        if (n_in != 31 || out_size != T * DM || ws_size < WS_END) { fprintf(stderr, "kernel_launch: unexpected problem (n_in %d, out %d, ws %zu)\n", n_in, out_size, ws_size); grid = -1; return; }
        int dev = 0, cus = 0, per_cu = 0;
        hipGetDevice(&dev); hipDeviceGetAttribute(&cus, hipDeviceAttributeMultiprocessorCount, dev);
        if (hipFuncSetAttribute((const void*)mega_fwd, hipFuncAttributeMaxDynamicSharedMemorySize, LDS_BYTES) != hipSuccess) { fprintf(stderr, "kernel_launch: hipFuncSetAttribute failed\n"); grid = -1; return; }
        if (hipOccupancyMaxActiveBlocksPerMultiprocessor(&per_cu, (const void*)mega_fwd, 512, LDS_BYTES) != hipSuccess || per_cu < 1) { fprintf(stderr, "kernel_launch: occupancy query says %d\n", per_cu); per_cu = 1; }
        (void)hipGetLastError();
        grid = cus * 1;
        if (per_cu < 1) grid = -1;
    }
    if (grid < 0) return;
#if MK_N_LAUNCHES != 1
    hipMemsetAsync((char*)d_ws, 0, CT_ZERO_BYTES, stream);
#endif
    Args a{};
    for (int i = 0; i < 31; ++i) a.in[i] = (const float*)d_in[i];
    a.out = (float*)d_out; a.ws = (unsigned char*)d_ws;
#if MK_N_LAUNCHES == 1
    a.ph_lo = 0; a.ph_hi = N_PHASES;
    void* kargs[] = {&a};
    hipError_t e = hipLaunchCooperativeKernel((const void*)mega_fwd, dim3(grid), dim3(512), kargs, LDS_BYTES, stream);
    if (e != hipSuccess) fprintf(stderr, "cooperative launch failed: %s (grid %d)\n", hipGetErrorString(e), grid);
#else
    for (int ph = 0; ph < N_PHASES; ++ph) {
        a.ph_lo = ph; a.ph_hi = ph + 1;
        hipLaunchKernelGGL(mega_fwd, dim3(grid), dim3(512), LDS_BYTES, stream, a);
    }
#endif
}
```

```cpp
#include <hip/hip_runtime.h>
#include <hip/hip_cooperative_groups.h>
#include <cstdio>
#include <cstdint>
namespace cg = cooperative_groups;

#define DI __device__ __forceinline__
#define LAS __attribute__((address_space(3)))
#define GAS __attribute__((address_space(1)))
typedef unsigned short bf16_t;
typedef short bf16x8 __attribute__((ext_vector_type(8)));
typedef short s16x4 __attribute__((ext_vector_type(4)));
typedef float f32x2 __attribute__((ext_vector_type(2)));
typedef float f32x4 __attribute__((ext_vector_type(4)));
typedef float f32x16 __attribute__((ext_vector_type(16)));
typedef unsigned u32x2 __attribute__((ext_vector_type(2)));
typedef unsigned u32x4 __attribute__((ext_vector_type(4)));

constexpr int BATCH = 8, SEQ = 4096, DM = 1024, T = BATCH * SEQ;
constexpr int HD = 64;
constexpr int NSA_H = 8, NSA_G = 2, FOX_H = 8;
constexpr int NCMP = 255, NCMP_PAD = 256;
constexpr int IN_A = 2848, LDA = 2816  , NA_PAD = 3072;
constexpr int DFF = 2816;
constexpr int IN_C = 3088, LDC = 3072  , NC_PAD = 3328;
constexpr int NEXP = 8;
constexpr int MOE_TILES_MAX = 264, MOE_PASS_TILES = 128, MOE_PASS1_MAX = 136;
constexpr float EPS = 1e-6f;
constexpr float LOG2E = 1.4426950408889634f;
constexpr float QSCALE = 0.125f * LOG2E;
constexpr int PA_QA = 0, PA_KSL = 512, PA_KWN = 640, PA_VSL = 768, PA_VWN = 896, PA_KC = 1024, PA_VC = 1152, PA_QB = 1280, PA_KB = 1792, PA_VB = 2304;
constexpr int PC_Q = 0, PC_K = 512, PC_V = 1024, PC_R = 2048;

constexpr size_t MiB = 1u << 20;
constexpr size_t CT_CTR = 0;
constexpr size_t CT_BAR = 65536;
constexpr size_t CT_SS1 = 501 * MiB, CT_SS2 = 503 * MiB, CT_SS3 = 505 * MiB;
constexpr size_t CT_ZERO_BYTES = 1 * MiB;
static_assert(CT_BAR + 16384 <= CT_ZERO_BYTES, "zero region");
constexpr size_t CT_RSTD0 = 1 * MiB;
constexpr size_t CT_ROPE = CT_RSTD0 + (size_t)T * 4;
constexpr size_t CT_LOGF = 2 * MiB;
constexpr size_t CT_CUM = 3 * MiB;
constexpr size_t CT_GATE = 4 * MiB;
constexpr size_t CT_A1 = 7 * MiB;
constexpr size_t CT_KCMP = 9 * MiB, CT_VCMP = CT_KCMP + 512 * 1024;
constexpr size_t CT_CW = 10 * MiB;
constexpr size_t CT_MOE = 11 * MiB;
constexpr size_t WS_WA = 16 * MiB;
constexpr size_t WS_WO = WS_WA + 6 * MiB;
constexpr size_t WS_WFGU = WS_WO + 2 * MiB;
constexpr size_t WS_WFD = WS_WFGU + 11 * MiB;
constexpr size_t WS_WC = WS_WFD + 5632 * 1024;
constexpr size_t WS_WCO = WS_WC + 6656 * 1024;
constexpr size_t WS_WMGU = 49 * MiB;
constexpr size_t WS_WMD = WS_WMGU + 88 * MiB;
static_assert(WS_WCO + 2 * MiB <= WS_WMGU, "weights map");
constexpr size_t WS_XB = 181 * MiB;
constexpr size_t WS_O = 245 * MiB;
constexpr size_t WS_ATT = WS_WA;
constexpr size_t WS_BIG = 309 * MiB;
constexpr size_t WS_XY = 181 * MiB;
constexpr size_t WS_HM = 313 * MiB;
constexpr size_t WS_PART = 16 * MiB;
constexpr int MOE_XROW0 = 2 * MOE_PASS_TILES * 256;
constexpr size_t WS_END = 512 * MiB;
static_assert(WS_PART + (size_t)8 * 256 * 11 * 1024 * 4 <= WS_WMD, "partials map");
static_assert(WS_WMD + 44 * MiB <= WS_XB && WS_BIG + (size_t)T * LDC * 2 <= WS_END && WS_XY + (size_t)MOE_TILES_MAX * 256 * 1024 * 2 <= WS_HM && WS_HM + (size_t)MOE_PASS1_MAX * 256 * DFF * 2 <= WS_END, "d_ws map");
constexpr size_t MO_TOKE = CT_MOE;
constexpr size_t MO_TOKW = MO_TOKE + (size_t)T * 4;
constexpr size_t MO_TOKR = MO_TOKW + (size_t)T * 8;
constexpr size_t MO_POS = MO_TOKR + (size_t)T * 4;
constexpr size_t MO_HIST = MO_POS + (size_t)T * 8;
constexpr size_t MO_RSCALE = MO_HIST + 8192;
constexpr size_t MO_RGATE = MO_RSCALE + (size_t)MOE_TILES_MAX * 256 * 4;
constexpr size_t MO_RKEEP = MO_RGATE + (size_t)MOE_TILES_MAX * 256 * 4;
constexpr size_t MO_TILEE = MO_RKEEP + (size_t)MOE_TILES_MAX * 256 * 4;
constexpr size_t MO_ROWTOK = MO_TILEE + 2048;
static_assert(MO_ROWTOK + 8192 <= WS_WA, "moe tables");

constexpr int LDS_BYTES = 163840;
constexpr int LDS_MISC = 163584;

DI unsigned cvtpk(float lo, float hi) { typedef __bf16 b2 __attribute__((ext_vector_type(2))); f32x2 v = {lo, hi}; b2 b = __builtin_convertvector(v, b2); return __builtin_bit_cast(unsigned, b); }
DI float bf2f(unsigned short h) { return __uint_as_float((unsigned)h << 16); }
DI float bflo(unsigned w) { return __uint_as_float(w << 16); }
DI float bfhi(unsigned w) { return __uint_as_float(w & 0xffff0000u); }
DI float wave_sum(float v) {
#pragma unroll
    for (int o = 1; o < 64; o <<= 1) v += __shfl_xor(v, o);
    return v;
}
DI float xsum16(float x) { const unsigned u = __float_as_uint(x); const u32x2 r = __builtin_amdgcn_permlane16_swap(u, u, false, false); return __uint_as_float(r[0]) + __uint_as_float(r[1]); }
DI float xsum32(float x) { const unsigned u = __float_as_uint(x); const u32x2 r = __builtin_amdgcn_permlane32_swap(u, u, false, false); return __uint_as_float(r[0]) + __uint_as_float(r[1]); }
DI float xchg16(float x, bool odd_row) { const unsigned u = __float_as_uint(x); const u32x2 r = __builtin_amdgcn_permlane16_swap(u, u, false, false); return __uint_as_float(odd_row ? r[0] : r[1]); }
DI float sigmoidf_(float z) { return 1.0f / (1.0f + __expf(-z)); }
DI float log_sigmoidf_(float z) { return fminf(z, 0.f) - __logf(1.0f + __expf(-fabsf(z))); }
DI float siluf_(float z) { return z * __builtin_amdgcn_rcpf(1.0f + __builtin_amdgcn_exp2f(-LOG2E * z)); }
DI float gelu_tanh(float x) { const float u = 0.7978845608028654f * (x + 0.044715f * x * x * x); const float e = __expf(2.f * u); const float t = 1.f - 2.f / (e + 1.f); return 0.5f * x * (1.f + t); }

struct Args {
    const float* in[31];
    float* out;
    unsigned char* ws;
    int ph_lo, ph_hi;
};
namespace pg8 {
#define PG8_LAS __attribute__((address_space(3)))
typedef unsigned short bf16_t;
typedef short bf16x8 __attribute__((ext_vector_type(8)));
typedef float f32x4 __attribute__((ext_vector_type(4)));
typedef unsigned u32x4 __attribute__((ext_vector_type(4)));
constexpr int BM = 256, BK = 64, HALF = 128, HTB = HALF * BK * 2  , STAGE_BYTES = 8 * HTB, NXCD = 8, WGM = 8;

__host__ __device__ __forceinline__ int lds_byte(int r, int c) { const int st = (r >> 4) * 2 + (c >> 5), rr = r & 15, cc = c & 31, ob = rr * 64 + cc * 2; return st * 1024 + (ob ^ (((ob >> 9) & 1) << 5)); }
__host__ __device__ __forceinline__ void stage_rc(int b, int& R, int& C) { const int st = b / 1024, sb = b % 1024, swz = sb ^ (((sb >> 9) & 1) << 5); R = (st >> 1) * 16 + swz / 64; C = (st & 1) * 32 + (swz % 64) / 2; }
__host__ __device__ __forceinline__ int perm32(int rho) { const int n = rho >> 4, i = rho & 15; return 8 * (i >> 2) + 4 * n + (i & 3); }

struct Unit { int pm, pn, ko; };
struct Gemm { const bf16_t* A; const bf16_t* Bt; int M, N, K; int ld = 0; };

struct StaticOrder {
    static constexpr bool SLICED = false;
    int nM, nN, nwg, G, c;
    __host__ __device__ void init(int M, int N, int G_, int c_) { nM = M / BM; nN = N / BM; nwg = nM * nN; G = G_; c = c_; }
    __host__ __device__ bool next(int i, Unit& u) const {
        const long L = (long)i * G + c; if (L >= nwg) return false;
        int wgid = (int)L; { const int q = nwg / NXCD, r = nwg % NXCD, xcd = wgid % NXCD, off = wgid / NXCD; wgid = (xcd < r ? xcd * (q + 1) : r * (q + 1) + (xcd - r) * q) + off; }
        const int nig = WGM * nN, gid = wgid / nig, fm = gid * WGM, gsz = (nM - fm) < WGM ? (nM - fm) : WGM;
        u.pm = fm + ((wgid % nig) % gsz); u.pn = (wgid % nig) / gsz; return true;
    }
    __device__ __forceinline__ void a_ready(const Unit&) const {}
    __device__ __forceinline__ void done(const Unit&) const {}
};


#define EPI_ROWS(...) _Pragma("unroll") for (int ai = 0; ai < 2; ++ai) _Pragma("unroll") for (int m = 0; m < 4; ++m) { const int rowl = u.pm * BM + ai * HALF + wr * 64 + m * 16 + fr; __VA_ARGS__ }

struct EpiInA {
    static constexpr bool PERM = true, AFTER_DRAIN = false;
    bf16_t* projA; const float* rstd0; const float* cosT; const float* sinT;
    const float *qn, *kn, *fqn, *fkn, *gbias, *fbias; float* gate; float* logf;
    __device__ __forceinline__ void operator()(const f32x4 (&acc)[2][2][4][2], const Unit& u, int wr, int wc, int fr, int fq) const {
        const int s = u.pn * 4 + wc;
        if (s > 44) return;
        int kind = 0; const float* gain = qn; float scale = 1.f;
        if (s < 8) { kind = 2; gain = qn; scale = QSCALE; }
        else if (s < 12) { kind = 2; gain = kn; }
        else if (s < 20) { kind = 0; }
        else if (s < 28) { kind = 1; gain = fqn; scale = QSCALE; }
        else if (s < 36) { kind = 1; gain = fkn; }
        else if (s < 44) { kind = 0; }
        else kind = 3;
        float rsv[8];
#pragma unroll
        for (int q = 0; q < 8; ++q) rsv[q] = rstd0[u.pm * BM + (q >> 2) * HALF + wr * 64 + (q & 3) * 16 + fr];
        if (kind == 3) {
            EPI_ROWS(
                const float rs = rsv[ai * 4 + m];
                float v[8];
                _Pragma("unroll") for (int n = 0; n < 2; ++n) _Pragma("unroll") for (int e = 0; e < 4; ++e) v[n * 4 + e] = acc[ai][0][m][n][e] * rs;
                if (fq < 3) { float o[8]; _Pragma("unroll") for (int j = 0; j < 8; ++j) o[j] = sigmoidf_(v[j] + gbias[8 * fq + j]);
                    *(f32x4*)(gate + (size_t)rowl * 24 + 8 * fq) = (f32x4){o[0], o[1], o[2], o[3]}; *(f32x4*)(gate + (size_t)rowl * 24 + 8 * fq + 4) = (f32x4){o[4], o[5], o[6], o[7]}; }
                else { float o[8]; _Pragma("unroll") for (int j = 0; j < 8; ++j) o[j] = log_sigmoidf_(v[j] + fbias[j]);
                    _Pragma("unroll") for (int j = 0; j < 8; ++j) logf[((size_t)(rowl >> 12) * 8 + j) * SEQ + (rowl & (SEQ - 1))] = o[j]; }
            )
            return;
        }
        const bool do_norm = kind >= 1, do_rope = kind == 2;
        float g[16];
        { const float* gp = gain + 8 * fq; const f32x4 g0 = *(const f32x4*)gp, g1 = *(const f32x4*)(gp + 4), g2 = *(const f32x4*)(gp + 32), g3 = *(const f32x4*)(gp + 36);
#pragma unroll
          for (int i = 0; i < 4; ++i) { g[i] = do_norm ? g0[i] * scale : scale; g[4 + i] = do_norm ? g1[i] * scale : scale; g[8 + i] = do_norm ? g2[i] * scale : scale; g[12 + i] = do_norm ? g3[i] * scale : scale; } }
        const float ir[8] = {0.15915494309189535f, 0.03086376340470123f, 0.005985185712713705f, 0.001160663641240061f, 0.00022507907903927653f, 4.364795279280289e-05f, 8.464330808241401e-06f, 1.6414262627950345e-06f};
        const bool rope_lane = do_rope && fq < 2;
        EPI_ROWS(
            const float rs = rsv[ai * 4 + m];
            float v[16];
            _Pragma("unroll") for (int bj = 0; bj < 2; ++bj) _Pragma("unroll") for (int n = 0; n < 2; ++n) _Pragma("unroll") for (int e = 0; e < 4; ++e) v[bj * 8 + n * 4 + e] = acc[ai][bj][m][n][e];
            float sc = rs;
            if (do_norm) { float s0 = 0.f, s1 = 0.f;
                _Pragma("unroll") for (int i = 0; i < 16; i += 2) { s0 += v[i] * v[i]; s1 += v[i + 1] * v[i + 1]; }
                float ss = xsum32(xsum16(s0 + s1));
                sc = rs * rsqrtf(ss * (rs * rs) * (1.0f / 64.0f) + EPS); }
            _Pragma("unroll") for (int i = 0; i < 16; ++i) v[i] = v[i] * (sc * g[i]);
            if (do_rope) {
            float oth[8];
            _Pragma("unroll") for (int j = 0; j < 8; ++j) oth[j] = xchg16(v[j], (fq & 1) != 0);
            const float pos = rope_lane ? (float)(rowl & (SEQ - 1)) : 0.f;
            const float sgn = (fq == 0) ? -1.f : 1.f;
            _Pragma("unroll") for (int j = 0; j < 8; ++j) { const float rev = pos * ir[j]; const float fr_ = rev - floorf(rev); const float cc = __builtin_amdgcn_cosf(fr_), sn = __builtin_amdgcn_sinf(fr_) * sgn;
                v[j] = v[j] * cc + oth[j] * sn; }
            }
            bf16_t* dst = projA + (size_t)rowl * LDA + s * 64 + 8 * fq;
            _Pragma("unroll") for (int bj = 0; bj < 2; ++bj) { u32x4 w; w.x = ::cvtpk(v[bj * 8 + 0], v[bj * 8 + 1]); w.y = ::cvtpk(v[bj * 8 + 2], v[bj * 8 + 3]);
                w.z = ::cvtpk(v[bj * 8 + 4], v[bj * 8 + 5]); w.w = ::cvtpk(v[bj * 8 + 6], v[bj * 8 + 7]); *(u32x4*)(dst + 32 * bj) = w; }
        )
    }
};

__device__ __forceinline__ float row_rstd(const float* ssp, int row) { const f32x4* q = (const f32x4*)(ssp + (size_t)row * 16); const f32x4 a = q[0], b = q[1], c = q[2], d = q[3];
    const float s = (((a[0] + a[1]) + (a[2] + a[3])) + ((b[0] + b[1]) + (b[2] + b[3]))) + (((c[0] + c[1]) + (c[2] + c[3])) + ((d[0] + d[1]) + (d[2] + d[3]))); return rsqrtf(s * (1.0f / 1024.0f) + EPS); }
template <bool RES_F32> struct EpiResid {
    static constexpr bool PERM = true, AFTER_DRAIN = false;
    const void* res; bf16_t* outb; float* ss;
    __device__ __forceinline__ void operator()(const f32x4 (&acc)[2][2][4][2], const Unit& u, int wr, int wc, int fr, int fq) const {
        constexpr int MB = RES_F32 ? 2 : 4;
#pragma unroll
        for (int ai = 0; ai < 2; ++ai)
#pragma unroll
            for (int m0 = 0; m0 < 4; m0 += MB) {
                f32x4 r0[MB][2], r1[MB][2];
#pragma unroll
                for (int mm = 0; mm < MB; ++mm) { const int rowl = u.pm * BM + ai * HALF + wr * 64 + (m0 + mm) * 16 + fr; const size_t off = (size_t)rowl * DM + u.pn * BM + wc * 32 + 8 * fq;
#pragma unroll
                    for (int bj = 0; bj < 2; ++bj) {
                        if (RES_F32) { r0[mm][bj] = *(const f32x4*)((const float*)res + off + bj * HALF); r1[mm][bj] = *(const f32x4*)((const float*)res + off + bj * HALF + 4); }
                        else { const u32x4 rw = *(const u32x4*)((const bf16_t*)res + off + bj * HALF); r0[mm][bj] = (f32x4){bflo(rw.x), bfhi(rw.x), bflo(rw.y), bfhi(rw.y)}; r1[mm][bj] = (f32x4){bflo(rw.z), bfhi(rw.z), bflo(rw.w), bfhi(rw.w)}; } } }
#pragma unroll
                for (int mm = 0; mm < MB; ++mm) { const int m = m0 + mm; const int rowl = u.pm * BM + ai * HALF + wr * 64 + m * 16 + fr; const size_t off = (size_t)rowl * DM + u.pn * BM + wc * 32 + 8 * fq; float part = 0.f;
#pragma unroll
                    for (int bj = 0; bj < 2; ++bj) {
                        const f32x4 x0 = r0[mm][bj] + acc[ai][bj][m][0], x1 = r1[mm][bj] + acc[ai][bj][m][1];
                        u32x4 w; w.x = ::cvtpk(x0[0], x0[1]); w.y = ::cvtpk(x0[2], x0[3]); w.z = ::cvtpk(x1[0], x1[1]); w.w = ::cvtpk(x1[2], x1[3]); *(u32x4*)(outb + off + bj * HALF) = w;
                        part += (x0[0] * x0[0] + x0[1] * x0[1]) + (x0[2] * x0[2] + x0[3] * x0[3]) + (x1[0] * x1[0] + x1[1] * x1[1]) + (x1[2] * x1[2] + x1[3] * x1[3]);
                    }
                    part = xsum32(xsum16(part));
                    if (fq == 0 && ss) ss[(size_t)rowl * 16 + u.pn * 4 + wc] = part; }
            }
    }
};

template <bool MOE> struct EpiSwiglu {
    static constexpr bool PERM = true, AFTER_DRAIN = false;
    bf16_t* h; const float* rsrc; int row_off;
    __device__ __forceinline__ void operator()(const f32x4 (&acc)[2][2][4][2], const Unit& u, int wr, int wc, int fr, int fq) const {
        const int pnl = MOE ? (u.pn % 22) : u.pn;
        float rsv[8];
#pragma unroll
        for (int q = 0; q < 8; ++q) { const int rl = u.pm * BM + (q >> 2) * HALF + wr * 64 + (q & 3) * 16 + fr; rsv[q] = MOE ? rsrc[row_off + rl] : row_rstd(rsrc, rl); }
        EPI_ROWS(
            const float rs = rsv[ai * 4 + m]; const float c1 = -LOG2E * rs, kq = __builtin_amdgcn_rcpf(rs * rs);
            f32x4 o4[2];
            _Pragma("unroll") for (int n = 0; n < 2; ++n) { const f32x4 gg = acc[ai][0][m][n], uu = acc[ai][1][m][n]; const f32x4 a = gg * c1;
                const f32x4 ex = {__builtin_amdgcn_exp2f(a[0]), __builtin_amdgcn_exp2f(a[1]), __builtin_amdgcn_exp2f(a[2]), __builtin_amdgcn_exp2f(a[3])};
                const f32x4 d = ex * kq + kq;
                const f32x4 r = {__builtin_amdgcn_rcpf(d[0]), __builtin_amdgcn_rcpf(d[1]), __builtin_amdgcn_rcpf(d[2]), __builtin_amdgcn_rcpf(d[3])};
                o4[n] = (gg * uu) * r; }
            u32x4 w; w.x = ::cvtpk(o4[0][0], o4[0][1]); w.y = ::cvtpk(o4[0][2], o4[0][3]); w.z = ::cvtpk(o4[1][0], o4[1][1]); w.w = ::cvtpk(o4[1][2], o4[1][3]);
            *(u32x4*)(h + (size_t)rowl * DFF + pnl * 128 + wc * 32 + 8 * fq) = w;
        )
    }
};

struct EpiGlaIn {
    static constexpr bool PERM = true, AFTER_DRAIN = false;
    bf16_t* projC; const float* rstd2;
    __device__ __forceinline__ void operator()(const f32x4 (&acc)[2][2][4][2], const Unit& u, int wr, int wc, int fr, int fq) const {
        float rsv[8];
#pragma unroll
        for (int q = 0; q < 8; ++q) rsv[q] = rstd2[u.pm * BM + (q >> 2) * HALF + wr * 64 + (q & 3) * 16 + fr];
        EPI_ROWS(
            float rs = rsv[ai * 4 + m]; if (u.pn < 2) rs *= 0.08838834764831845f;
            _Pragma("unroll") for (int bj = 0; bj < 2; ++bj) { const f32x4 x0 = acc[ai][bj][m][0] * rs, x1 = acc[ai][bj][m][1] * rs;
                u32x4 w; w.x = ::cvtpk(x0[0], x0[1]); w.y = ::cvtpk(x0[2], x0[3]); w.z = ::cvtpk(x1[0], x1[1]); w.w = ::cvtpk(x1[2], x1[3]);
                *(u32x4*)(projC + (size_t)rowl * LDC + u.pn * BM + bj * HALF + wc * 32 + 8 * fq) = w; }
        )
    }
};

struct EpiMoeDown {
    static constexpr bool PERM = true, AFTER_DRAIN = false;
    bf16_t* xy; const float* rgate; const float* rkeep; int row_off;
    __device__ __forceinline__ void operator()(const f32x4 (&acc)[2][2][4][2], const Unit& u, int wr, int wc, int fr, int fq) const {
        const int pnl = u.pn & 3;
        float gv[8], kv[8];
#pragma unroll
        for (int q = 0; q < 8; ++q) { const int rg_ = row_off + u.pm * BM + (q >> 2) * HALF + wr * 64 + (q & 3) * 16 + fr; gv[q] = rgate[rg_]; kv[q] = rkeep[rg_]; }
#pragma unroll
        for (int ai = 0; ai < 2; ++ai) {
            u32x4 old4[4][2];
#pragma unroll
            for (int m = 0; m < 4; ++m) { const int rowg = row_off + u.pm * BM + ai * HALF + wr * 64 + m * 16 + fr;
#pragma unroll
                for (int bj = 0; bj < 2; ++bj) old4[m][bj] = *(const u32x4*)(xy + (size_t)rowg * DM + pnl * BM + bj * HALF + wc * 32 + 8 * fq); }
#pragma unroll
            for (int m = 0; m < 4; ++m) { const int rowg = row_off + u.pm * BM + ai * HALF + wr * 64 + m * 16 + fr; const float w8 = gv[ai * 4 + m], kp = kv[ai * 4 + m];
#pragma unroll
                for (int bj = 0; bj < 2; ++bj) {
                    bf16_t* dst = xy + (size_t)rowg * DM + pnl * BM + bj * HALF + wc * 32 + 8 * fq;
                    const u32x4 rw = old4[m][bj];
                    const f32x4 r0 = (f32x4){bflo(rw.x), bfhi(rw.x), bflo(rw.y), bfhi(rw.y)}, r1 = (f32x4){bflo(rw.z), bfhi(rw.z), bflo(rw.w), bfhi(rw.w)};
                    const f32x4 x0 = r0 * kp + acc[ai][bj][m][0] * w8, x1 = r1 * kp + acc[ai][bj][m][1] * w8;
                    u32x4 w; w.x = ::cvtpk(x0[0], x0[1]); w.y = ::cvtpk(x0[2], x0[3]); w.z = ::cvtpk(x1[0], x1[1]); w.w = ::cvtpk(x1[2], x1[3]);
                    *(u32x4*)dst = w; } }
        }
    }
};

struct GroupedOrder {
    static constexpr bool SLICED = false;
    StaticOrder so; const int* tile_e; int tile0, nN;
    __device__ __forceinline__ bool next(int i, Unit& u) const { if (!so.next(i, u)) return false; u.pn = __builtin_amdgcn_readfirstlane(tile_e[tile0 + u.pm]) * nN + u.pn; return true; }
    __device__ __forceinline__ void a_ready(const Unit&) const {}
    __device__ __forceinline__ void done(const Unit&) const {}
};

struct SliceOrder {
    static constexpr bool SLICED = true;
    const int* tile_e; int tile0  , xt0  , nunits, G, c;
    __device__ __forceinline__ bool next(int i, Unit& u) const { const int j = i * G + c; if (j >= nunits) return false;
        const int xt = j / 44, rem = j - xt * 44; u.pm = xt0 + xt; u.pn = __builtin_amdgcn_readfirstlane(tile_e[tile0 + u.pm]) * 4 + (rem & 3); u.ko = (rem >> 2) * 256; return true; }
    __device__ __forceinline__ void a_ready(const Unit&) const {}
    __device__ __forceinline__ void done(const Unit&) const {}
};
struct EpiMoePart {
    static constexpr bool PERM = true, AFTER_DRAIN = false;
    float* part; int xt0;
    __device__ __forceinline__ void operator()(const f32x4 (&acc)[2][2][4][2], const Unit& u, int wr, int wc, int fr, int fq) const {
        const int pnl = u.pn & 3, sl = u.ko >> 8;
#pragma unroll
        for (int ai = 0; ai < 2; ++ai)
#pragma unroll
            for (int m = 0; m < 4; ++m) { const int xr = (u.pm - xt0) * BM + ai * HALF + wr * 64 + m * 16 + fr;
                float* dst = part + ((size_t)xr * 11 + sl) * DM + pnl * BM + wc * 32 + 8 * fq;
#pragma unroll
                for (int bj = 0; bj < 2; ++bj) { *(f32x4*)(dst + bj * HALF) = acc[ai][bj][m][0]; *(f32x4*)(dst + bj * HALF + 4) = acc[ai][bj][m][1]; } }
    }
};
template <class Epi, class Sched, bool ALIGN_EPI = false, bool SP2 = false>
__device__ __forceinline__ void gemm_phase(PG8_LAS unsigned char* lds, const Gemm g, const Sched& S, const Epi& E) {
    int tid_l_ = threadIdx.x; asm volatile("" : "+v"(tid_l_)); const int tid = tid_l_, wid = __builtin_amdgcn_readfirstlane(tid >> 6), lane = tid & 63, wr = wid >> 2, wc = wid & 3, fr = lane & 15, fq = lane >> 4;
    const int K = g.ld ? g.ld : g.K  , nt = g.K / BK;
    unsigned voffA[2], voffB[2];
#pragma unroll
    for (int i = 0; i < 2; ++i) { int R, C; stage_rc(tid * 16 + i * 8192, R, C); const int Rb = Epi::PERM ? ((R & ~31) + perm32(R & 31)) : R;
        voffA[i] = (unsigned)(R * K + C) * 2u; voffB[i] = (unsigned)(Rb * K + C) * 2u; }
    const size_t kstep = (size_t)(BK * 2);
    const size_t hstep = (size_t)HALF * K * 2;
    const size_t tstep = 2 * hstep;
    const unsigned ldsw = (unsigned)wid * 1024u;
    const int aoff = lds_byte(wr * 64 + fr, fq * 8), boff = lds_byte(wc * 32 + fr, fq * 8);
#define PG8_SA(b, h) (((b) * 2 + (h)) * HTB)
#define PG8_SB(b, h) ((4 + (b) * 2 + (h)) * HTB)
#define PG8_STAGE(bufoff, gbase, voff) do { _Pragma("unroll") for (int _i = 0; _i < 2; ++_i) \
        __builtin_amdgcn_global_load_lds((const unsigned*)((const char*)(gbase) + (voff)[_i]), (PG8_LAS unsigned*)(lds + (bufoff) + ldsw + _i * 8192), 16, 0, 0); } while (0)
#define PG8_LDA(dst, b, h) do { _Pragma("unroll") for (int m = 0; m < 4; ++m) _Pragma("unroll") for (int k = 0; k < 2; ++k) dst[m][k] = *(const PG8_LAS bf16x8*)(lds + PG8_SA(b, h) + aoff + m * 2048 + k * 1024); } while (0)
#define PG8_LDB(dst, b, h) do { _Pragma("unroll") for (int n = 0; n < 2; ++n) _Pragma("unroll") for (int k = 0; k < 2; ++k) dst[n][k] = *(const PG8_LAS bf16x8*)(lds + PG8_SB(b, h) + boff + n * 2048 + k * 1024); } while (0)
#define PG8_MMA(ai, bj, At, Bt) do { __builtin_amdgcn_s_setprio(1); _Pragma("unroll") for (int m = 0; m < 4; ++m) _Pragma("unroll") for (int n = 0; n < 2; ++n) _Pragma("unroll") for (int k = 0; k < 2; ++k) \
        acc[ai][bj][m][n] = __builtin_amdgcn_mfma_f32_16x16x32_bf16(Bt[n][k], At[m][k], acc[ai][bj][m][n], 0, 0, 0); __builtin_amdgcn_s_setprio(0); } while (0)
#define PG8_WAIT_V(n) asm volatile("s_waitcnt vmcnt(" #n ")" ::: "memory")
#define PG8_WAIT_L(n) asm volatile("s_waitcnt lgkmcnt(" #n ")" ::: "memory")
#define PG8_BAR __builtin_amdgcn_s_barrier()
#define PG8_SCHED __builtin_amdgcn_sched_barrier(0)
    Unit cur, nxt; int ui = 0;
    if (!S.next(0, cur)) return;
    f32x4 acc[2][2][4][2];
#pragma unroll
    for (int a = 0; a < 2; ++a)
#pragma unroll
        for (int b = 0; b < 2; ++b)
#pragma unroll
            for (int m = 0; m < 4; ++m)
#pragma unroll
                for (int n = 0; n < 2; ++n) acc[a][b][m][n] = (f32x4){0.f, 0.f, 0.f, 0.f};
    bf16x8 At[4][2], B0[2][2], B1[2][2];
    const char* cA = (const char*)g.A + (size_t)cur.pm * tstep; const char* cB = (const char*)g.Bt + (size_t)cur.pn * tstep;
    if constexpr (Sched::SLICED) { cA += (size_t)cur.ko * 2; cB += (size_t)cur.ko * 2; }
    S.a_ready(cur);
    if constexpr (SP2) {
        PG8_STAGE(PG8_SB(0, 0), cB, voffB); PG8_STAGE(PG8_SB(0, 1), cB + hstep, voffB); PG8_STAGE(PG8_SA(0, 0), cA, voffA); PG8_STAGE(PG8_SA(0, 1), cA + hstep, voffA);
        if (wr == 1) PG8_BAR;
        PG8_WAIT_V(2); PG8_BAR;
        PG8_STAGE(PG8_SB(1, 0), cB + kstep, voffB); PG8_STAGE(PG8_SA(1, 0), cA + kstep, voffA); PG8_STAGE(PG8_SB(1, 1), cB + hstep + kstep, voffB);
        PG8_WAIT_V(6); PG8_BAR;
    } else {
        PG8_STAGE(PG8_SB(0, 0), cB, voffB); PG8_STAGE(PG8_SA(0, 0), cA, voffA); PG8_STAGE(PG8_SB(0, 1), cB + hstep, voffB); PG8_STAGE(PG8_SA(0, 1), cA + hstep, voffA);
        if (wr == 1) PG8_BAR;
        PG8_WAIT_V(4); PG8_BAR;
        PG8_STAGE(PG8_SB(1, 0), cB + kstep, voffB); PG8_STAGE(PG8_SA(1, 0), cA + kstep, voffA); PG8_STAGE(PG8_SB(1, 1), cB + hstep + kstep, voffB);
        PG8_WAIT_V(6); PG8_BAR;
    }
    for (;;) {
        const bool has_next = S.next(ui + 1, nxt);
        const char* nA = has_next ? (const char*)g.A + (size_t)nxt.pm * tstep + (Sched::SLICED ? (size_t)nxt.ko * 2 : (size_t)0) : cA; const char* nB = has_next ? (const char*)g.Bt + (size_t)nxt.pn * tstep + (Sched::SLICED ? (size_t)nxt.ko * 2 : (size_t)0) : cB;
        for (int t = 0; t < nt; t += 2) {
            const bool last = (t == nt - 2);
            const char* a1 = cA + (size_t)(t + 1) * kstep;
            const char* a2 = last ? nA : cA + (size_t)(t + 2) * kstep; const char* b2 = last ? nB : cB + (size_t)(t + 2) * kstep;
            const char* a3 = a2 + kstep; const char* b3 = b2 + kstep;
            if (last && has_next) S.a_ready(nxt);
            if constexpr (SP2) {
            PG8_LDB(B0, 0, 0); PG8_LDB(B1, 0, 1); PG8_SCHED; PG8_LDA(At, 0, 0); PG8_STAGE(PG8_SA(1, 1), a1 + hstep, voffA);
            PG8_WAIT_V(8); PG8_WAIT_L(0); PG8_BAR; PG8_MMA(0, 0, At, B0); PG8_MMA(0, 1, At, B1); PG8_BAR; PG8_SCHED;
            PG8_LDA(At, 0, 1); PG8_STAGE(PG8_SB(0, 0), b2, voffB); PG8_STAGE(PG8_SB(0, 1), b2 + hstep, voffB); PG8_STAGE(PG8_SA(0, 0), a2, voffA);
            PG8_WAIT_V(8); PG8_WAIT_L(0); PG8_BAR; PG8_MMA(1, 0, At, B0); PG8_MMA(1, 1, At, B1); PG8_BAR; PG8_SCHED;
            PG8_LDB(B0, 1, 0); PG8_LDB(B1, 1, 1); PG8_SCHED; PG8_LDA(At, 1, 0); PG8_STAGE(PG8_SA(0, 1), a2 + hstep, voffA);
            PG8_WAIT_V(8); PG8_WAIT_L(0); PG8_BAR; PG8_MMA(0, 0, At, B0); PG8_MMA(0, 1, At, B1); PG8_BAR; PG8_SCHED;
            PG8_LDA(At, 1, 1); PG8_STAGE(PG8_SB(1, 0), b3, voffB); PG8_STAGE(PG8_SB(1, 1), b3 + hstep, voffB); PG8_STAGE(PG8_SA(1, 0), a3, voffA);
            PG8_WAIT_V(8); PG8_WAIT_L(0); PG8_BAR; PG8_MMA(1, 0, At, B0); PG8_MMA(1, 1, At, B1); PG8_BAR; PG8_SCHED;
            } else {
            PG8_LDB(B0, 0, 0); PG8_SCHED; PG8_LDA(At, 0, 0); PG8_STAGE(PG8_SA(1, 1), a1 + hstep, voffA);
            PG8_WAIT_L(8); PG8_BAR; PG8_WAIT_L(0); PG8_MMA(0, 0, At, B0); PG8_BAR; PG8_SCHED;
            PG8_LDB(B1, 0, 1); PG8_STAGE(PG8_SB(0, 0), b2, voffB);
            PG8_BAR; PG8_WAIT_L(0); PG8_MMA(0, 1, At, B1); PG8_BAR;
            PG8_LDA(At, 0, 1); PG8_STAGE(PG8_SA(0, 0), a2, voffA);
            PG8_BAR; PG8_WAIT_L(0); PG8_MMA(1, 0, At, B0); PG8_BAR; PG8_SCHED;
            PG8_STAGE(PG8_SB(0, 1), b2 + hstep, voffB);
            PG8_WAIT_V(6); PG8_BAR; PG8_MMA(1, 1, At, B1); PG8_BAR;
            PG8_LDB(B0, 1, 0); PG8_SCHED; PG8_LDA(At, 1, 0); PG8_STAGE(PG8_SA(0, 1), a2 + hstep, voffA);
            PG8_WAIT_L(8); PG8_BAR; PG8_WAIT_L(0); PG8_MMA(0, 0, At, B0); PG8_BAR; PG8_SCHED;
            PG8_LDB(B1, 1, 1); PG8_STAGE(PG8_SB(1, 0), b3, voffB);
            PG8_BAR; PG8_WAIT_L(0); PG8_MMA(0, 1, At, B1); PG8_BAR;
            PG8_LDA(At, 1, 1); PG8_STAGE(PG8_SA(1, 0), a3, voffA);
            PG8_BAR; PG8_WAIT_L(0); PG8_MMA(1, 0, At, B0); PG8_BAR; PG8_SCHED;
            PG8_STAGE(PG8_SB(1, 1), b3 + hstep, voffB);
            PG8_WAIT_V(6); PG8_BAR; PG8_MMA(1, 1, At, B1); PG8_BAR;
            }
        }
        if constexpr (ALIGN_EPI) { if (wr == 0) PG8_BAR; }
        if constexpr (!Epi::AFTER_DRAIN) { E(acc, cur, wr, wc, fr, fq);
            S.done(cur); }
        if (!has_next) break;
#pragma unroll
        for (int a = 0; a < 2; ++a)
#pragma unroll
            for (int b = 0; b < 2; ++b)
#pragma unroll
                for (int m = 0; m < 4; ++m)
#pragma unroll
                    for (int n = 0; n < 2; ++n) acc[a][b][m][n] = (f32x4){0.f, 0.f, 0.f, 0.f};
        cur = nxt; cA = nA; cB = nB; ++ui;
        if constexpr (ALIGN_EPI) { if (wr == 1) PG8_BAR; }
    }
    PG8_WAIT_V(0);
    if constexpr (!ALIGN_EPI) { if (wr == 0) PG8_BAR; }
    PG8_BAR;
    if constexpr (Epi::AFTER_DRAIN) { E.fused(acc, cur, wr, wc, fr, fq, lds, wid, lane); S.done(cur); }
#undef PG8_SA
#undef PG8_SB
#undef PG8_STAGE
#undef PG8_LDA
#undef PG8_LDB
#undef PG8_MMA
#undef PG8_WAIT_V
#undef PG8_WAIT_L
#undef PG8_BAR
#undef PG8_SCHED
}
}

namespace att {
constexpr int A_KV = 0, A_KB = 49152, A_WS = 49920, A_MASK = 51968, A_SHQ = 52480, A_IMP = 53248, A_OC = 119808, A_IVC = 152576;
DI constexpr int crc(int r) { return (r & 3) + 8 * (r >> 2); }
constexpr int IMP_LD = 65;
DI int crow(int r, int hi) { return (r & 3) + 8 * (r >> 2) + 4 * hi; }
#define MFMA32(a, b, c) __builtin_amdgcn_mfma_f32_32x32x16_bf16((a), (b), (c), 0, 0, 0)

struct KVRegs { u32x4 k, v; float kb; };
struct Sweep {
    const bf16_t* K; const bf16_t* V; int ld;
    const float* kbias;
};
DI void kv_issue(KVRegs& r, const Sweep& s, int tile, int tid) {
    const int key = tid & 63, ch = tid >> 6;
    const size_t row0 = (size_t)tile * 64;
    r.k = *(const u32x4*)(s.K + (row0 + key) * s.ld + ch * 8);
    const int p = tid >> 6, l = tid & 63; const int row = 16 * (p & 3) + (l >> 2), col = (p >> 2) * 32 + (l & 3) * 8;
    r.v = *(const u32x4*)(s.V + (row0 + row) * s.ld + col);
    r.kb = (s.kbias && tid < 64) ? s.kbias[row0 + tid] : 0.f;
}
DI void kv_commit(const KVRegs& r, LAS char* lds, int slot, int tid, bool has_kb) {
    LAS char* sl = lds + A_KV + slot * 16384;
    *(LAS u32x4*)(sl + (tid >> 6) * 1024 + (tid & 63) * 16) = r.k;
    *(LAS u32x4*)(sl + 8192 + tid * 16) = r.v;
    if (has_kb && tid < 64) *(LAS float*)(lds + A_KB + slot * 256 + tid * 4) = r.kb;
}
DI void glds16(const void* gsrc, unsigned lds_dst) { unsigned keep;
    asm volatile("s_mov_b32 %0, m0\n\ts_mov_b32 m0, %2\n\ts_nop 0\n\tglobal_load_lds_dwordx4 %1, off\n\ts_mov_b32 m0, %0" : "=&s"(keep) : "v"(gsrc), "s"(lds_dst) : "memory"); }
DI void glds4(const void* gsrc, unsigned lds_dst) { unsigned keep;
    asm volatile("s_mov_b32 %0, m0\n\ts_mov_b32 m0, %2\n\ts_nop 0\n\tglobal_load_lds_dword %1, off\n\ts_mov_b32 m0, %0" : "=&s"(keep) : "v"(gsrc), "s"(lds_dst) : "memory"); }
DI void kv_dma(const Sweep& s, int tile, LAS char* lds, int slot, int tid, int wid, bool has_kb) {
    const int l = tid & 63;
    const size_t row0 = (size_t)tile * 64;
    const bf16_t* ksrc = s.K + (row0 + l) * s.ld + wid * 8;
    const bf16_t* vsrc = s.V + (row0 + 16 * (wid & 3) + (l >> 2)) * s.ld + (wid >> 2) * 32 + (l & 3) * 8;
    const unsigned sl = (unsigned)__builtin_amdgcn_readfirstlane((int)(unsigned)(uintptr_t)(lds + A_KV + slot * 16384 + wid * 1024));
    glds16(ksrc, sl);
    glds16(vsrc, sl + 8192);
    if (has_kb) glds4(s.kbias + row0 + l, (unsigned)__builtin_amdgcn_readfirstlane((int)(unsigned)(uintptr_t)(lds + A_KB + slot * 256)));
}
struct FState { float m, l; f32x16 o0, o1, la, negm; };
DI float max3f(float a, float b, float c) { float r; asm("v_max3_f32 %0, %1, %2, %3" : "=v"(r) : "v"(a), "v"(b), "v"(c)); return r; }
DI void fs_init(FState& s) { s.m = 0.f; s.l = 0.f;

#pragma unroll
    for (int r = 0; r < 16; ++r) { s.o0[r] = 0.f; s.o1[r] = 0.f; s.la[r] = 0.f; s.negm[r] = 0.f; } }

DI void qk_tile(f32x16& p0, f32x16& p1, const f32x16& c0, const f32x16& c1, const LAS char* Ks, const bf16x8 (&qr)[4], int r32, int hi) {
    const LAS char* kb = Ks + hi * 1024 + r32 * 16;
    bf16x8 kf[8];
#pragma unroll
    for (int d0 = 0; d0 < 4; ++d0) { kf[2 * d0] = *(const LAS bf16x8*)(kb + d0 * 2048); kf[2 * d0 + 1] = *(const LAS bf16x8*)(kb + d0 * 2048 + 512); }
    __builtin_amdgcn_s_setprio(1);
#pragma unroll
    for (int d0 = 0; d0 < 4; ++d0) {
        if (d0 == 0) { p0 = MFMA32(kf[0], qr[0], c0); p1 = MFMA32(kf[1], qr[0], c1); }
        else { p0 = MFMA32(kf[2 * d0], qr[d0], p0); p1 = MFMA32(kf[2 * d0 + 1], qr[d0], p1); }
    }
    __builtin_amdgcn_s_setprio(0);
}
DI s16x4 vtr(const LAS char* p) { typedef short v4i16_t __attribute__((ext_vector_type(4))); return __builtin_bit_cast(s16x4, __builtin_amdgcn_ds_read_tr16_b64_v4i16((LAS v4i16_t*)p)); }

template <bool NOMAX, bool SUML> DI void softmax_pv(FState& s, f32x16& p0, f32x16& p1, const LAS char* Vs, LAS float* wsf, int lane, int r32, int hi) {
    if (!NOMAX) {
        asm volatile("s_nop 15\n\ts_nop 7" : "+v"(p0), "+v"(p1));
        float rm = max3f(p0[0], p0[1], p1[0]), rm2 = max3f(p0[2], p0[3], p1[1]);
        rm = max3f(rm, p1[2], p1[3]);
#pragma unroll
        for (int r = 4; r < 16; r += 4) { rm = max3f(rm, p0[r], p0[r + 1]); rm2 = max3f(rm2, p0[r + 2], p0[r + 3]); rm = max3f(rm, p1[r], p1[r + 1]); rm2 = max3f(rm2, p1[r + 2], p1[r + 3]); }
        rm = fmaxf(rm, rm2);
        rm = fmaxf(rm, __shfl_xor(rm, 32));
        if (__any(rm > 8.0f)) {
            const float dl = fmaxf(rm, 0.f);
            s.m += dl; const float alpha = __builtin_amdgcn_exp2f(-dl);
#pragma unroll
            for (int r = 0; r < 16; ++r) s.negm[r] = -s.m;
#pragma unroll
            for (int r = 0; r < 16; ++r) { p0[r] -= dl; p1[r] -= dl; }
            if (hi == 0) wsf[r32] = alpha;
#pragma unroll
            for (int r = 0; r < 16; ++r) { const float a = wsf[crow(r, hi)]; s.o0[r] *= a; s.o1[r] *= a; s.la[r] *= a; }
            if (SUML) s.l *= alpha;
        }
    }
#pragma unroll
    for (int r = 0; r < 16; ++r) { p0[r] = __builtin_amdgcn_exp2f(p0[r]); p1[r] = __builtin_amdgcn_exp2f(p1[r]); }
    if (SUML) { float sum = 0.f;
#pragma unroll
        for (int r = 0; r < 16; ++r) sum += p0[r] + p1[r];
        s.l += sum; }
    u32x4 pw[4];
    pw[0] = (u32x4){cvtpk(p0[0], p0[1]), cvtpk(p0[2], p0[3]), cvtpk(p0[4], p0[5]), cvtpk(p0[6], p0[7])};
    pw[1] = (u32x4){cvtpk(p0[8], p0[9]), cvtpk(p0[10], p0[11]), cvtpk(p0[12], p0[13]), cvtpk(p0[14], p0[15])};
    pw[2] = (u32x4){cvtpk(p1[0], p1[1]), cvtpk(p1[2], p1[3]), cvtpk(p1[4], p1[5]), cvtpk(p1[6], p1[7])};
    pw[3] = (u32x4){cvtpk(p1[8], p1[9]), cvtpk(p1[10], p1[11]), cvtpk(p1[12], p1[13]), cvtpk(p1[14], p1[15])};
    const bf16x8 ones = (bf16x8){0x3F80, 0x3F80, 0x3F80, 0x3F80, 0x3F80, 0x3F80, 0x3F80, 0x3F80};
    const LAS char* vp = Vs + ((lane >> 4) & 1) * 32 + (lane & 3) * 8 + (4 * hi + ((lane & 15) >> 2)) * 64;
#pragma unroll
    for (int ks = 0; ks < 4; ++ks) {
        const bf16x8 pa = __builtin_bit_cast(bf16x8, pw[ks]);
        { const s16x4 lo = vtr(vp + ks * 1024), hh = vtr(vp + ks * 1024 + 512); const bf16x8 vf = (bf16x8){lo[0], lo[1], lo[2], lo[3], hh[0], hh[1], hh[2], hh[3]}; s.o0 = MFMA32(pa, vf, s.o0); }
        { const s16x4 lo = vtr(vp + 4096 + ks * 1024), hh = vtr(vp + 4096 + ks * 1024 + 512); const bf16x8 vf = (bf16x8){lo[0], lo[1], lo[2], lo[3], hh[0], hh[1], hh[2], hh[3]}; s.o1 = MFMA32(pa, vf, s.o1); }
        s.la = MFMA32(pa, ones, s.la);
    }
}
template <int MODE> DI float fs_finish(const FState& s, const float (&gr)[16], LAS float* wsf, LAS char* stg_bf, LAS char* stg_f32, int r32, int hi) {
    LAS bf16_t* sb = (LAS bf16_t*)stg_bf; LAS float* sf = (LAS float*)stg_f32;
#pragma unroll
    for (int r = 0; r < 16; ++r) {
        const int orow = crow(r, hi); const float lt = s.la[r]; const float inv = lt > 0.f ? __builtin_amdgcn_rcpf(lt) : 0.f; const float f = inv * gr[r];
        float c0 = s.o0[r] * f, c1 = s.o1[r] * f;
        if (MODE == 1) { c0 += bf2f(sb[orow * 64 + r32]); c1 += bf2f(sb[orow * 64 + 32 + r32]); sf[orow * 64 + r32] = c0; sf[orow * 64 + 32 + r32] = c1; }
        else { if (MODE == 2) { c0 += sf[orow * 64 + r32]; c1 += sf[orow * 64 + 32 + r32]; }
            sb[orow * 64 + r32] = (bf16_t)(cvtpk(c0, 0.f) & 0xffffu); sb[orow * 64 + 32 + r32] = (bf16_t)(cvtpk(c1, 0.f) & 0xffffu); }
    }
    if (MODE == 0) { const float lt = s.l + __shfl_xor(s.l, 32); return lt > 0.f ? 1.0f / lt : 0.f; }
    return 0.f;
}
DI void store_o(bf16_t* Orow0  , int ldo, const LAS char* stg, int lane) {
#pragma unroll
    for (int i = 0; i < 4; ++i) { const int row = i * 8 + (lane >> 3), ch = lane & 7; const u32x4 v = *(const LAS u32x4*)(stg + row * 128 + ch * 16); *(u32x4*)(Orow0 + (size_t)row * ldo + ch * 8) = v; }
}

struct BrP { int cur; int tq; int tt; unsigned long long msk, anym; int jlo, jhi; int fox_lim, fox_lo; float m_c, inv_c; int head_l, tok_l; };
template <int BR> DI int next_tile(const BrP& b, int j) {
    ++j;
    if (BR == 1) { while (j <= b.jhi && !((b.anym >> j) & 1ull)) ++j; }
    return j <= b.jhi ? j : -1;
}
template <int BR, bool NOMAX> DI void sweep(FState& st, const Sweep& sw, const BrP& b, const bf16x8 (&qr)[4], LAS char* lds, LAS float* wsf, int tid, int lane, int r32, int hi, float& carry) {
    const int wid_ = __builtin_amdgcn_readfirstlane(tid >> 6);
#define ATT_WAIT_BAR(n) asm volatile("s_waitcnt vmcnt(" #n ") lgkmcnt(0)\n\ts_barrier" ::: "memory")
#define ATT_END_TILE(more) do { if (more) { if (BR == 3) ATT_WAIT_BAR(3); else ATT_WAIT_BAR(2); } else ATT_WAIT_BAR(0); } while (0)
    int j = next_tile<BR>(b, b.jlo - 1);
    if (j < 0) return;
    int jn = next_tile<BR>(b, j);
    kv_dma(sw, j, lds, 0, tid, wid_, BR == 3);
    if (jn >= 0) kv_dma(sw, jn, lds, 1, tid, wid_, BR == 3);
    ATT_END_TILE(jn >= 0);
    int slot = 0;
    while (j >= 0) {
        const int jn2 = jn >= 0 ? next_tile<BR>(b, jn) : -1;
        if (jn2 >= 0) kv_dma(sw, jn2, lds, slot >= 1 ? slot - 1 : 2, tid, wid_, BR == 3);
        const LAS char* Ks = lds + A_KV + slot * 16384; const LAS char* Vs = Ks + 8192;
        bool active = true;
        if (BR == 3) active = (j <= b.fox_lim) && (j >= b.fox_lo);
        if (active) {
            f32x16 p0, p1;
            const float NEG = -__builtin_inff();
            if (BR == 3) {
                f32x16 c0, c1;
                const LAS float* kb = (const LAS float*)(lds + A_KB + slot * 256);
#pragma unroll
                for (int i = 0; i < 4; ++i) { const f32x4 k0 = *(const LAS f32x4*)(kb + 8 * i + 4 * hi), k1 = *(const LAS f32x4*)(kb + 32 + 8 * i + 4 * hi);
#pragma unroll
                    for (int e = 0; e < 4; ++e) { c0[4 * i + e] = k0[e] + st.negm[4 * i + e]; c1[4 * i + e] = k1[e] + st.negm[4 * i + e]; } }
                qk_tile(p0, p1, c0, c1, Ks, qr, r32, hi);
            } else if (BR == 1) {
                f32x16 cs; const bool sel = (b.msk >> j) & 1ull;
#pragma unroll
                for (int r = 0; r < 16; ++r) cs[r] = sel ? (NOMAX ? 0.f : st.negm[r]) : NEG;
                qk_tile(p0, p1, cs, cs, Ks, qr, r32, hi);
            } else if (NOMAX) {
                f32x16 z;
#pragma unroll
                for (int r = 0; r < 16; ++r) z[r] = 0.f;
                qk_tile(p0, p1, z, z, Ks, qr, r32, hi);
            } else qk_tile(p0, p1, st.negm, st.negm, Ks, qr, r32, hi);
            int tth = b.tt - 4 * hi; asm volatile("" : "+v"(tth));
            if (BR == 0 || BR == 4) {
                int lim = ((b.tq - 31) >> 4) - 64 * j - 4 * hi; asm volatile("" : "+v"(lim));
#pragma unroll
                for (int r = 0; r < 16; ++r) { if (crc(r) > lim) p0[r] = NEG; if (crc(r) + 32 > lim) p1[r] = NEG; }
            } else if (BR == 1) {
                if (j == b.cur) {
#pragma unroll
                    for (int r = 0; r < 16; ++r) { if (crc(r) > tth) p0[r] = NEG; if (crc(r) + 32 > tth) p1[r] = NEG; }
                }
            } else if (BR == 2) {
                if (j == b.cur) {
#pragma unroll
                    for (int r = 0; r < 16; ++r) { if (crc(r) > tth) p0[r] = NEG; if (crc(r) + 32 > tth) p1[r] = NEG; }
                } else if (j == b.cur - 8) {
#pragma unroll
                    for (int r = 0; r < 16; ++r) { if (crc(r) <= tth) p0[r] = NEG; if (crc(r) + 32 <= tth) p1[r] = NEG; }
                }
            } else if (BR == 3) {
                if (j == b.fox_lim) {
#pragma unroll
                    for (int r = 0; r < 16; ++r) { if (crc(r) > tth) p0[r] = NEG; if (crc(r) + 32 > tth) p1[r] = NEG; }
                }
            }
            if (BR != 4) softmax_pv<NOMAX, BR == 0>(st, p0, p1, Vs, wsf, lane, r32, hi);
            if (BR == 4 || (BR == 0 && NOMAX)) {
                const float scl = (BR == 4) ? b.inv_c : 1.0f;
                float G[8], H[8];
#pragma unroll
                for (int i = 0; i < 4; ++i) {
                    float a[4], c[4];
#pragma unroll
                    for (int e = 0; e < 4; ++e) { a[e] = (BR == 4 ? __builtin_amdgcn_exp2f(p0[4 * i + e]) : p0[4 * i + e]) * scl; c[e] = (BR == 4 ? __builtin_amdgcn_exp2f(p1[4 * i + e]) : p1[4 * i + e]) * scl; }
                    H[i] = 0.5f * a[3]; G[i] = a[0] + a[1] + a[2] + H[i]; H[4 + i] = 0.5f * c[3]; G[4 + i] = c[0] + c[1] + c[2] + H[4 + i];
                }
                float Hp[8];
#pragma unroll
                for (int k = 0; k < 8; ++k) Hp[k] = __shfl_xor(H[k], 32);
                LAS float* imp = (LAS float*)(lds + A_IMP) + (b.head_l * 64 + b.tok_l) * IMP_LD + 16 * j;
#pragma unroll
                for (int k = 0; k < 8; ++k) {
                    const float prev = (hi == 1) ? Hp[k] : (k == 0 ? carry : Hp[k - 1]);
                    const int sidx = (k < 4) ? (2 * k + hi) : (8 + 2 * (k - 4) + hi);
                    imp[sidx] = G[k] + prev;
                }
                carry = Hp[7];
            }
        }
        ATT_END_TILE(jn2 >= 0);
        slot = slot == 2 ? 0 : slot + 1; j = jn; jn = jn2;
    }
#undef ATT_WAIT_BAR
#undef ATT_END_TILE
}

struct Tensors {
    const bf16_t* projA; const bf16_t* kcmp; const bf16_t* vcmp; const float* gate; const float* cumneg; bf16_t* O; const float* fqn; const float* fkn; const float* aqn; const float* akn;
};

template <bool NOMAX> DI void nsa_unit(const Tensors& T_, int b, int g, int qt, LAS char* lds) {
    int tid_ = threadIdx.x; asm volatile("" : "+v"(tid_));
    const int tid = tid_, lane = tid & 63, r32 = lane & 31, hi = lane >> 5, wid = __builtin_amdgcn_readfirstlane(tid >> 6);
    LAS float* wsf = (LAS float*)(lds + A_WS) + wid * 64;
    const int head_l = wid >> 1, head = 4 * g + head_l, tok_l = 32 * (wid & 1) + r32;
    const int tq = 64 * qt + tok_l;
    const size_t rowq = (size_t)b * SEQ + tq;
    bf16x8 qr[4];
#pragma unroll
    for (int d0 = 0; d0 < 4; ++d0) qr[d0] = *(const bf16x8*)(T_.projA + rowq * LDA + PA_QA + head * 64 + d0 * 16 + hi * 8);
    LAS char* stg_bf = lds + A_OC + wid * 4096; LAS char* stg_f32 = lds + A_IMP + wid * 8192;
    const size_t rowbase = (size_t)b * SEQ + 64 * qt + 32 * (wid & 1);
    float gr[16];
    BrP bp; bp.cur = qt; bp.tq = tq; bp.tt = tok_l; bp.msk = 0; bp.anym = 0; bp.fox_lim = 0; bp.fox_lo = 0; bp.head_l = head_l; bp.tok_l = tok_l; bp.m_c = 0.f; bp.inv_c = 0.f;
    float carry = 0.f;
    {
        Sweep sw; sw.K = T_.kcmp + ((size_t)b * NCMP_PAD * 2 + g) * 64; sw.V = T_.vcmp + ((size_t)b * NCMP_PAD * 2 + g) * 64; sw.ld = 128; sw.kbias = nullptr;
        const int ntc = (4 * qt + 2) / 64 + 1;
        bp.jlo = 0; bp.jhi = ntc - 1;
        FState st; fs_init(st);
        LAS float* imp = (LAS float*)(lds + A_IMP) + (head_l * 64 + tok_l) * IMP_LD;
        for (int s2 = 16 * ntc + hi; s2 < 64; s2 += 2) imp[s2] = 0.f;
        carry = 0.f;
#pragma unroll
        for (int r = 0; r < 16; ++r) gr[r] = T_.gate[(rowbase + crow(r, hi)) * 24 + 3 * head + 0];
        sweep<0, NOMAX>(st, sw, bp, qr, lds, wsf, tid, lane, r32, hi, carry);
        bp.inv_c = fs_finish<0>(st, gr, wsf, stg_bf, stg_f32, r32, hi); bp.m_c = st.m;
        if (hi == 0) ((LAS float*)(lds + A_IVC))[head_l * 64 + tok_l] = NOMAX ? bp.inv_c : 1.0f;
        if (!NOMAX) { carry = 0.f; sweep<4, NOMAX>(st, sw, bp, qr, lds, wsf, tid, lane, r32, hi, carry); }
    }
    __syncthreads();
    {
        LAS float* imp = (LAS float*)(lds + A_IMP); const LAS float* ivc = (const LAS float*)(lds + A_IVC);
        const int tok = tid >> 3, part = tid & 7;
        float v[8];
#pragma unroll
        for (int k = 0; k < 8; ++k) { const int s2 = 8 * part + k;
            float x = ((imp[(0 * 64 + tok) * IMP_LD + s2] * ivc[tok] + imp[(1 * 64 + tok) * IMP_LD + s2] * ivc[64 + tok]) + imp[(2 * 64 + tok) * IMP_LD + s2] * ivc[128 + tok]) + imp[(3 * 64 + tok) * IMP_LD + s2] * ivc[192 + tok];
            if (s2 == 0 || s2 == qt || s2 == qt - 1) x = 1e6f; else if (s2 > qt) x = -1e6f;
            v[k] = x; }
        __syncthreads();
#pragma unroll
        for (int k = 0; k < 8; ++k) imp[tok * IMP_LD + 8 * part + k] = v[k];
        __syncthreads();
        int rank[8];
#pragma unroll
        for (int k = 0; k < 8; ++k) rank[k] = 0;
        for (int s2 = 0; s2 < 64; ++s2) { const float x = imp[tok * IMP_LD + s2];
#pragma unroll
            for (int k = 0; k < 8; ++k) rank[k] += (x > v[k] || (x == v[k] && s2 < 8 * part + k)) ? 1 : 0; }
        unsigned byte = 0;
#pragma unroll
        for (int k = 0; k < 8; ++k) byte |= (rank[k] < 16 ? 1u : 0u) << k;
        ((LAS unsigned char*)(lds + A_MASK))[tok * 8 + part] = (unsigned char)byte;
        __syncthreads();
        const LAS unsigned long long* mk = (const LAS unsigned long long*)(lds + A_MASK);
        bp.msk = mk[tok_l];
        unsigned long long am = mk[lane];
        unsigned lo = (unsigned)am, hh = (unsigned)(am >> 32);
#pragma unroll
        for (int o = 1; o < 64; o <<= 1) { lo |= (unsigned)__shfl_xor((int)lo, o); hh |= (unsigned)__shfl_xor((int)hh, o); }
        bp.anym = ((unsigned long long)(unsigned)__builtin_amdgcn_readfirstlane((int)hh) << 32) | (unsigned)__builtin_amdgcn_readfirstlane((int)lo);
    }
    {
        Sweep sw; sw.K = T_.projA + (size_t)b * SEQ * LDA + PA_KSL + g * 64; sw.V = T_.projA + (size_t)b * SEQ * LDA + PA_VSL + g * 64; sw.ld = LDA; sw.kbias = nullptr;
        bp.jlo = 0; bp.jhi = qt;
        FState st; fs_init(st);
#pragma unroll
        for (int r = 0; r < 16; ++r) gr[r] = T_.gate[(rowbase + crow(r, hi)) * 24 + 3 * head + 1];
        sweep<1, NOMAX>(st, sw, bp, qr, lds, wsf, tid, lane, r32, hi, carry);
        fs_finish<1>(st, gr, wsf, stg_bf, stg_f32, r32, hi);
    }
    {
        Sweep sw; sw.K = T_.projA + (size_t)b * SEQ * LDA + PA_KWN + g * 64; sw.V = T_.projA + (size_t)b * SEQ * LDA + PA_VWN + g * 64; sw.ld = LDA; sw.kbias = nullptr;
        bp.jlo = qt - 8 < 0 ? 0 : qt - 8; bp.jhi = qt;
        FState st; fs_init(st);
#pragma unroll
        for (int r = 0; r < 16; ++r) gr[r] = T_.gate[(rowbase + crow(r, hi)) * 24 + 3 * head + 2];
        sweep<2, NOMAX>(st, sw, bp, qr, lds, wsf, tid, lane, r32, hi, carry);
        fs_finish<2>(st, gr, wsf, stg_bf, stg_f32, r32, hi);
    }
    store_o(T_.O + rowbase * DM + head * 64, DM, stg_bf, lane);
    __syncthreads();
}

DI void fox_unit(const Tensors& T_, int b, int h, int qb, LAS char* lds) {
    int tid_ = threadIdx.x; asm volatile("" : "+v"(tid_));
    const int tid = tid_, lane = tid & 63, r32 = lane & 31, hi = lane >> 5, wid = __builtin_amdgcn_readfirstlane(tid >> 6);
    LAS float* wsf = (LAS float*)(lds + A_WS) + wid * 64;
    const int tq = 256 * qb + 32 * wid + r32;
    const size_t rowq = (size_t)b * SEQ + tq;
    bf16x8 qr[4];
#pragma unroll
    for (int d0 = 0; d0 < 4; ++d0) qr[d0] = *(const bf16x8*)(T_.projA + rowq * LDA + PA_QB + h * 64 + d0 * 16 + hi * 8);
    LAS char* stg_bf = lds + A_OC + wid * 4096;
    BrP bp; bp.cur = 0; bp.tq = tq; bp.tt = 32 * (wid & 1) + r32; bp.msk = 0; bp.anym = 0; bp.head_l = 0; bp.tok_l = 0; bp.m_c = 0.f; bp.inv_c = 0.f;
    bp.jlo = 0; bp.jhi = 4 * qb + 3; bp.fox_lim = 4 * qb + (wid >> 1);
    {
        float gq = fabsf(T_.fqn[lane]), gk = fabsf(T_.fkn[lane]);
#pragma unroll
        for (int o = 1; o < 64; o <<= 1) { gq = fmaxf(gq, __shfl_xor(gq, o)); gk = fmaxf(gk, __shfl_xor(gk, o)); }
        const float need = 2.0f * 11.66f * gq * gk + 40.0f;
        const float* kbp = T_.cumneg + ((size_t)b * FOX_H + h) * SEQ;
        const float kb0 = kbp[256 * qb];
        const bool needed = (lane <= bp.jhi) && (kb0 - kbp[64 * lane + 63] <= need);
        const unsigned long long bal = __ballot(needed);
        bp.jlo = bal ? (int)__builtin_ctzll(bal) : 0;
        const bool needed_w = (lane <= bp.jhi) && (kbp[256 * qb + 32 * wid] - kbp[64 * lane + 63] <= need);
        const unsigned long long balw = __ballot(needed_w);
        bp.fox_lo = balw ? (int)__builtin_ctzll(balw) : 0;
    }
    Sweep sw; sw.K = T_.projA + (size_t)b * SEQ * LDA + PA_KB + h * 64; sw.V = T_.projA + (size_t)b * SEQ * LDA + PA_VB + h * 64; sw.ld = LDA;
    sw.kbias = T_.cumneg + ((size_t)b * FOX_H + h) * SEQ;
    FState st; fs_init(st);
    float carry = 0.f;
    sweep<3, false>(st, sw, bp, qr, lds, wsf, tid, lane, r32, hi, carry);
    float gr[16];
#pragma unroll
    for (int r = 0; r < 16; ++r) gr[r] = 1.f;
    fs_finish<3>(st, gr, wsf, stg_bf, stg_bf, r32, hi);
    const size_t rowbase = (size_t)b * SEQ + 256 * qb + 32 * wid;
    store_o(T_.O + rowbase * DM + 512 + h * 64, DM, stg_bf, lane);
    __syncthreads();
}

DI void attn_phase(const Tensors& T_, unsigned* ctr, LAS char* lds) {
    LAS int* shq = (LAS int*)(lds + A_SHQ);
    bool nomax;
    { const int lane = threadIdx.x & 63; float gq = fabsf(T_.aqn[lane]), gk = fabsf(T_.akn[lane]);
#pragma unroll
      for (int o = 1; o < 64; o <<= 1) { gq = fmaxf(gq, __shfl_xor(gq, o)); gk = fmaxf(gk, __shfl_xor(gk, o)); }
      nomax = __builtin_amdgcn_readfirstlane((int)(11.66f * gq * gk < 50.0f)) != 0; }
    for (;;) {
        if (threadIdx.x == 0) shq[0] = (int)__hip_atomic_fetch_add(ctr, 1u, __ATOMIC_RELAXED, __HIP_MEMORY_SCOPE_AGENT);
        __syncthreads();
        const int i = __builtin_amdgcn_readfirstlane(shq[0]);
        __syncthreads();
        if (i >= 2048) break;
        if (i < 1024) { if (nomax) nsa_unit<true>(T_, (i & 15) >> 1, i & 1, 63 - (i >> 4), lds); else nsa_unit<false>(T_, (i & 15) >> 1, i & 1, 63 - (i >> 4), lds); }
        else { const int r = i - 1024; fox_unit(T_, (r & 63) >> 3, r & 7, 15 - (r >> 6), lds); }
    }
}
}

namespace gla {
constexpr int G_A1 = 0, G_QI = 4096, G_QR = 20480, G_KR = 36864, G_KH = 53248, G_V = 69632, G_BQ = 73728, G_ST = 77824, G_DEC = 94208;
DI int swo(int row, int colbyte) { return row * 256 + (colbyte ^ ((row & 15) << 4)); }
using att::crow; using att::vtr;

struct GlaT { bf16_t* projC; const float* a1; const float* w_a2; const float* b_a; bf16_t* O; bf16_t* att; float* dec; };

DI void gla_a1_item(const bf16_t* xb, const bf16_t* wa1t  , const float* ss2, float* a1, int item, LAS char* lds) {
    int tid_l_ = threadIdx.x; asm volatile("" : "+v"(tid_l_)); const int tid = tid_l_, lane = tid & 63, r32 = lane & 31, hi = lane >> 5, wid = __builtin_amdgcn_readfirstlane(tid >> 6);
    const int rg = wid & 3, kh = wid >> 2;
    const size_t row0 = (size_t)item * 128 + 32 * rg;
    const bf16_t* ap = xb + (row0 + r32) * DM + 512 * kh + 8 * hi;
    const bf16_t* bp = wa1t + (size_t)(r32 & 15) * DM + 512 * kh + 8 * hi;
    f32x16 c;
#pragma unroll
    for (int r = 0; r < 16; ++r) c[r] = 0.f;
#pragma unroll 8
    for (int ks = 0; ks < 32; ++ks) {
        const bf16x8 A = *(const bf16x8*)(ap + 16 * ks);
        bf16x8 B = *(const bf16x8*)(bp + 16 * ks);
        if (r32 >= 16) B = (bf16x8){0, 0, 0, 0, 0, 0, 0, 0};
        c = MFMA32(A, B, c);
    }
    LAS float* red = (LAS float*)lds + rg * 1024;
    if (kh == 1) {
#pragma unroll
        for (int r = 0; r < 16; ++r) red[crow(r, hi) * 32 + r32] = c[r];
    }
    __syncthreads();
    if (kh == 0 && r32 < 16) {
#pragma unroll
        for (int r = 0; r < 16; ++r) { const int rw = crow(r, hi); const size_t grow = row0 + rw;
            a1[grow * 16 + r32] = (c[r] + red[rw * 32 + r32]) * pg8::row_rstd(ss2, (int)grow); }
    }
    __syncthreads();
}

constexpr int P_A1 = 0, P_QR = 4096, P_KR = 20480, P_BQ = 36864;
struct PrepRegs { unsigned q[8], k[8]; f32x4 a1; };
DI void prep_load(PrepRegs& R, const GlaT& G, int item, int tid) {
    const int ch = item & 63, h = (item >> 6) & 3, b = item >> 8, d0 = 2 * (tid & 63), tg = tid >> 6;
    const size_t rb = (size_t)b * SEQ + 64 * ch;
#pragma unroll
    for (int c8 = 0; c8 < 8; ++c8) { const size_t rw = rb + 8 * tg + c8; R.q[c8] = *(const unsigned*)(G.projC + rw * LDC + PC_Q + h * 128 + d0); R.k[c8] = *(const unsigned*)(G.projC + rw * LDC + PC_K + h * 128 + d0); }
    R.a1 = (tid < 256) ? *(const f32x4*)(G.a1 + (rb + (tid >> 2)) * 16 + (tid & 3) * 4) : (f32x4){0.f, 0.f, 0.f, 0.f};
}
DI void gla_prep(const GlaT& G, int item, const PrepRegs& R, LAS char* lds) {
    int tid_l_ = threadIdx.x; asm volatile("" : "+v"(tid_l_)); const int tid = tid_l_, lane = tid & 63, r32 = lane & 31, hi = lane >> 5, wid = __builtin_amdgcn_readfirstlane(tid >> 6);
    const int ch = item & 63, h = (item >> 6) & 3, b = item >> 8;
    const int dp = tid & 63, tg = wid, d0 = 2 * dp;
    const size_t rb = (size_t)b * SEQ + 64 * ch;
    unsigned qraw[8], kraw[8];
#pragma unroll
    for (int c8 = 0; c8 < 8; ++c8) { qraw[c8] = R.q[c8]; kraw[c8] = R.k[c8]; }
    if (tid < 256) *(LAS f32x4*)(lds + P_A1 + tid * 16) = R.a1;
    float w2a[16], w2b[16];
#pragma unroll
    for (int r = 0; r < 16; ++r) { const f32x2 w = *(const f32x2*)(G.w_a2 + r * 512 + h * 128 + d0); w2a[r] = w[0]; w2b[r] = w[1]; }
    const f32x2 bav = *(const f32x2*)(G.b_a + h * 128 + d0);
    __syncthreads();
    float lp0[8], lp1[8]; float run0 = 0.f, run1 = 0.f;
#pragma unroll
    for (int c8 = 0; c8 < 8; ++c8) {
        const LAS f32x4* ar = (const LAS f32x4*)(lds + P_A1 + (8 * tg + c8) * 64);
        float z0 = bav[0], z1 = bav[1];
#pragma unroll
        for (int q4 = 0; q4 < 4; ++q4) { const f32x4 a = ar[q4];
#pragma unroll
            for (int e = 0; e < 4; ++e) { z0 += a[e] * w2a[4 * q4 + e]; z1 += a[e] * w2b[4 * q4 + e]; } }
        const float l0 = fminf(z0, 0.f) - __logf(1.0f + __expf(-fabsf(z0))), l1 = fminf(z1, 0.f) - __logf(1.0f + __expf(-fabsf(z1)));
        run0 += l0 * (1.0f / 16.0f); run1 += l1 * (1.0f / 16.0f);
        lp0[c8] = run0; lp1[c8] = run1;
    }
    *(LAS f32x2*)(lds + P_BQ + tg * 512 + d0 * 4) = (f32x2){run0, run1};
    __syncthreads();
    {
        float off0 = 0.f, off1 = 0.f, ref0 = 0.f, ref1 = 0.f, last0 = 0.f, last1 = 0.f;
#pragma unroll
        for (int t8 = 0; t8 < 8; ++t8) { const f32x2 q = *(const LAS f32x2*)(lds + P_BQ + t8 * 512 + d0 * 4);
            if (t8 < tg) { off0 += q[0]; off1 += q[1]; } if (t8 < 4) { ref0 += q[0]; ref1 += q[1]; } last0 += q[0]; last1 += q[1]; }
        const float emr0 = __expf(-ref0), emr1 = __expf(-ref1), epr0 = __expf(ref0), epr1 = __expf(ref1), epl0 = __expf(last0), epl1 = __expf(last1);
#pragma unroll
        for (int c8 = 0; c8 < 8; ++c8) {
            const int c = 8 * tg + c8;
            const float eb0 = __expf(off0 + lp0[c8]), eb1 = __expf(off1 + lp1[c8]);
            const float ib0 = __builtin_amdgcn_rcpf(eb0), ib1 = __builtin_amdgcn_rcpf(eb1);
            const float q0 = bflo(qraw[c8]), q1 = bfhi(qraw[c8]), k0 = bflo(kraw[c8]), k1 = bfhi(kraw[c8]);
            const float qi0 = q0 * eb0, qi1 = q1 * eb1, kb0 = k0 * ib0, kb1 = k1 * ib1;
            const int o = swo(c, 4 * dp);
            *(LAS unsigned*)(lds + P_QR + o) = cvtpk(qi0 * emr0, qi1 * emr1);
            *(LAS unsigned*)(lds + P_KR + o) = cvtpk(kb0 * epr0, kb1 * epr1);
            const size_t rw = rb + c;
            *(unsigned*)(G.projC + rw * LDC + PC_Q + h * 128 + d0) = cvtpk(qi0, qi1);
            *(unsigned*)(G.projC + rw * LDC + PC_K + h * 128 + d0) = cvtpk(kb0 * epl0, kb1 * epl1);
        }
        if (tg == 0) *(f32x2*)(G.dec + (size_t)item * 128 + d0) = (f32x2){epl0, epl1};
    }
    __syncthreads();
    if (wid < 3) {
        const int jt = wid == 2 ? 1 : 0, it = wid == 0 ? 0 : 1;
        f32x16 X;
#pragma unroll
        for (int r = 0; r < 16; ++r) X[r] = 0.f;
#pragma unroll
        for (int ks = 0; ks < 8; ++ks) {
            const bf16x8 A = *(const LAS bf16x8*)(lds + P_KR + swo(32 * jt + r32, (16 * ks + 8 * hi) * 2));
            const bf16x8 B = *(const LAS bf16x8*)(lds + P_QR + swo(32 * it + r32, (16 * ks + 8 * hi) * 2));
            X = MFMA32(A, B, X);
        }
        if (jt == it) {
#pragma unroll
            for (int r = 0; r < 16; ++r) if (att::crc(r) > r32 - 4 * hi) X[r] = 0.f;
        }
        bf16_t* ap = G.att + (size_t)item * 4096 + (32 * it + r32) * 64 + 32 * jt + 4 * hi;
#pragma unroll
        for (int g4 = 0; g4 < 4; ++g4) *(u32x2*)(ap + 8 * g4) = (u32x2){cvtpk(X[4 * g4], X[4 * g4 + 1]), cvtpk(X[4 * g4 + 2], X[4 * g4 + 3])};
    }
    __syncthreads();
}

constexpr int R_QI = 0, R_KH = 16384, R_ATT = 32768, R_V = 40960, R_DEC = 45056, R_BUF = 45568, R_ST = 2 * R_BUF;
DI void gla_unit(const GlaT& G, int b, int h, int es, LAS char* lds) {
    int tid_l_ = threadIdx.x; asm volatile("" : "+v"(tid_l_)); const int tid = tid_l_, lane = tid & 63, r32 = lane & 31, hi = lane >> 5, wid = __builtin_amdgcn_readfirstlane(tid >> 6);
    f32x16 S;
#pragma unroll
    for (int r = 0; r < 16; ++r) S[r] = 0.f;
    *(LAS u32x4*)(lds + R_ST + tid * 16) = (u32x4){0u, 0u, 0u, 0u};
    const size_t row00 = (size_t)b * SEQ;
    const int lrow = tid >> 3, lc = tid & 7;
    struct GlaRegs { u32x4 q0, q1, k0, k1, a, v; };
    GlaRegs RA, RB;
#define GLA_LOAD(R_, ch) do { const size_t rw_ = row00 + 64 * (ch) + lrow; const bf16_t* pq_ = G.projC + rw_ * LDC + h * 128 + lc * 8; \
        R_.q0 = *(const u32x4*)(pq_ + PC_Q); R_.q1 = *(const u32x4*)(pq_ + PC_Q + 64); R_.k0 = *(const u32x4*)(pq_ + PC_K); R_.k1 = *(const u32x4*)(pq_ + PC_K + 64); \
        R_.a = *(const u32x4*)(G.att + ((size_t)((b * 4 + h) * 64 + (ch))) * 4096 + tid * 8); \
        if (tid < 256) R_.v = *(const u32x4*)(G.projC + (row00 + 64 * (ch) + (tid >> 2)) * LDC + PC_V + h * 256 + 32 * es + (tid & 3) * 8); \
        else if (tid < 288) R_.v = *(const u32x4*)(G.dec + ((size_t)((b * 4 + h) * 64 + (ch))) * 128 + (tid - 256) * 4); } while (0)
#define GLA_COMMIT(R_, buf) do { LAS char* bb_ = lds + (buf) * R_BUF; \
        *(LAS u32x4*)(bb_ + R_QI + swo(lrow, lc * 16)) = R_.q0; *(LAS u32x4*)(bb_ + R_QI + swo(lrow, (lc + 8) * 16)) = R_.q1; \
        *(LAS u32x4*)(bb_ + R_KH + swo(lrow, lc * 16)) = R_.k0; *(LAS u32x4*)(bb_ + R_KH + swo(lrow, (lc + 8) * 16)) = R_.k1; \
        *(LAS u32x4*)(bb_ + R_ATT + lrow * 128 + ((lc ^ (lrow & 7)) * 16)) = R_.a; \
        if (tid < 256) *(LAS u32x4*)(bb_ + R_V + tid * 16) = R_.v; else if (tid < 288) *(LAS u32x4*)(bb_ + R_DEC + (tid - 256) * 16) = R_.v; } while (0)
    auto step = [&](const int ch, const int par) __attribute__((always_inline)) {
        const LAS char* bb = lds + par * R_BUF;
        const size_t rowc = row00 + 64 * ch;
        if (wid < 2) {
            const int it = wid;
            f32x16 oacc;
#pragma unroll
            for (int r = 0; r < 16; ++r) oacc[r] = 0.f;
#pragma unroll
            for (int s = 0; s < 4; ++s) {
                if (s < 2 || it == 1) {
                    const int i = 32 * it + r32;
                    const bf16x8 A = *(const LAS bf16x8*)(bb + R_ATT + i * 128 + (((2 * s + hi) ^ (i & 7)) * 16));
                    const LAS char* vb = bb + R_V + (16 * s + 8 * hi + ((lane & 15) >> 2)) * 64 + ((lane >> 4) & 1) * 32 + (lane & 3) * 8;
                    const s16x4 lo = vtr(vb), hh = vtr(vb + 256);
                    const bf16x8 vf = (bf16x8){lo[0], lo[1], lo[2], lo[3], hh[0], hh[1], hh[2], hh[3]};
                    oacc = MFMA32(A, vf, oacc);
                }
            }
#pragma unroll
            for (int ks = 0; ks < 8; ++ks) {
                const bf16x8 A = *(const LAS bf16x8*)(bb + R_QI + swo(32 * it + r32, (16 * ks + 8 * hi) * 2));
                const bf16x8 B = *(const LAS bf16x8*)(lds + R_ST + par * 8192 + swo(r32, (16 * ks + 8 * hi) * 2));
                oacc = MFMA32(A, B, oacc);
            }
            LAS bf16_t* stg = (LAS bf16_t*)(lds + R_ST + 16384) + it * 1024;
#pragma unroll
            for (int r = 0; r < 16; ++r) stg[crow(r, hi) * 32 + r32] = (bf16_t)(cvtpk(oacc[r], 0.f) & 0xffffu);
#pragma unroll
            for (int i = 0; i < 2; ++i) { const int pc = lane + 64 * i, row = pc >> 2, q4 = pc & 3; const u32x4 v = *(const LAS u32x4*)(stg + row * 32 + q4 * 8);
                *(u32x4*)(G.O + (rowc + 32 * it + row) * DM + h * 256 + 32 * es + q4 * 8) = v; }
        } else if (wid >= 4) {
            const int dt = wid - 4;
            const LAS float* dec = (const LAS float*)(bb + R_DEC) + 32 * dt;
#pragma unroll
            for (int i = 0; i < 4; ++i) { const f32x4 dv = *(const LAS f32x4*)(dec + 8 * i + 4 * hi);
#pragma unroll
                for (int e = 0; e < 4; ++e) S[4 * i + e] *= dv[e]; }
#pragma unroll
            for (int s = 0; s < 4; ++s) {
                const int cq = 16 * s + 4 * hi + ((lane & 15) >> 2), colb = (32 * dt + 16 * ((lane >> 4) & 1) + 4 * (lane & 3)) * 2;
                const s16x4 alo = vtr(bb + R_KH + swo(cq, colb)), ahh = vtr(bb + R_KH + swo(cq + 8, colb));
                const LAS char* vb = bb + R_V + cq * 64 + ((lane >> 4) & 1) * 32 + (lane & 3) * 8;
                const s16x4 lo = vtr(vb), hh = vtr(vb + 512);
                const bf16x8 af = (bf16x8){alo[0], alo[1], alo[2], alo[3], ahh[0], ahh[1], ahh[2], ahh[3]};
                const bf16x8 vf = (bf16x8){lo[0], lo[1], lo[2], lo[3], hh[0], hh[1], hh[2], hh[3]};
                S = MFMA32(af, vf, S);
            }
#pragma unroll
            for (int i = 0; i < 4; ++i)
                *(LAS u32x2*)(lds + R_ST + (par ^ 1) * 8192 + swo(r32, (32 * dt + 8 * i + 4 * hi) * 2)) = (u32x2){cvtpk(S[4 * i], S[4 * i + 1]), cvtpk(S[4 * i + 2], S[4 * i + 3])};
        }
    };
    GLA_LOAD(RA, 0); GLA_COMMIT(RA, 0); GLA_LOAD(RA, 1); GLA_LOAD(RB, 2);
    __syncthreads();
#pragma unroll 1
    for (int ch = 0; ch < 64; ch += 2) {
        step(ch, 0);
        GLA_COMMIT(RA, 1);
        { const int c3 = ch + 3 < 64 ? ch + 3 : 63; GLA_LOAD(RA, c3); }
        asm volatile("s_waitcnt lgkmcnt(0)" ::: "memory"); __builtin_amdgcn_s_barrier();
        step(ch + 1, 1);
        GLA_COMMIT(RB, 0);
        { const int c4 = ch + 4 < 64 ? ch + 4 : 63; GLA_LOAD(RB, c4); }
        asm volatile("s_waitcnt lgkmcnt(0)" ::: "memory"); __builtin_amdgcn_s_barrier();
    }
#undef GLA_LOAD
#undef GLA_COMMIT
}

DI void gla_gate_rows2(bf16_t* O, const bf16_t* R, const float* gain, int m0, int lane) {
    u32x4 o0[2], o1[2], r0[2], r1[2];
#pragma unroll
    for (int u = 0; u < 2; ++u) { const bf16_t* Orow = O + (size_t)(m0 + u) * DM; const bf16_t* Rrow = R + (size_t)(m0 + u) * LDC;
        o0[u] = *(const u32x4*)(Orow + lane * 16); o1[u] = *(const u32x4*)(Orow + lane * 16 + 8); r0[u] = *(const u32x4*)(Rrow + lane * 16); r1[u] = *(const u32x4*)(Rrow + lane * 16 + 8); }
    const int c0 = (lane & 15) * 16;
    float gn[16];
#pragma unroll
    for (int i = 0; i < 4; ++i) { const f32x4 g4 = *(const f32x4*)(gain + c0 + 4 * i); gn[4 * i] = g4[0]; gn[4 * i + 1] = g4[1]; gn[4 * i + 2] = g4[2]; gn[4 * i + 3] = g4[3]; }
#pragma unroll
    for (int u = 0; u < 2; ++u) {
        float o[16], rr[16];
#pragma unroll
        for (int i = 0; i < 4; ++i) { o[2 * i] = bflo(o0[u][i]); o[2 * i + 1] = bfhi(o0[u][i]); o[8 + 2 * i] = bflo(o1[u][i]); o[8 + 2 * i + 1] = bfhi(o1[u][i]);
            rr[2 * i] = bflo(r0[u][i]); rr[2 * i + 1] = bfhi(r0[u][i]); rr[8 + 2 * i] = bflo(r1[u][i]); rr[8 + 2 * i + 1] = bfhi(r1[u][i]); }
        float ss = 0.f;
#pragma unroll
        for (int i = 0; i < 16; ++i) ss += o[i] * o[i];
        ss += __shfl_xor(ss, 1); ss += __shfl_xor(ss, 2); ss += __shfl_xor(ss, 4); ss += __shfl_xor(ss, 8);
        const float rs = rsqrtf(ss * (1.0f / 256.0f) + EPS);
        unsigned w[8];
#pragma unroll
        for (int i = 0; i < 8; ++i) { const float x0 = o[2 * i] * rs * gn[2 * i] * siluf_(rr[2 * i]), x1 = o[2 * i + 1] * rs * gn[2 * i + 1] * siluf_(rr[2 * i + 1]); w[i] = cvtpk(x0, x1); }
        bf16_t* Orow = O + (size_t)(m0 + u) * DM;
        *(u32x4*)(Orow + lane * 16) = (u32x4){w[0], w[1], w[2], w[3]}; *(u32x4*)(Orow + lane * 16 + 8) = (u32x4){w[4], w[5], w[6], w[7]};
    }
}
}

struct Ptrs {
    const float* in[31]; float* out; unsigned char* ws;
    DI bf16_t* bf(size_t off) const { return (bf16_t*)(ws + off); }
    DI float* f32(size_t off) const { return (float*)(ws + off); }
    DI int* i32(size_t off) const { return (int*)(ws + off); }
};
enum { I_X = 0, I_ANORM, I_AWIN, I_AQN, I_AKN, I_APEK, I_APEV, I_CK1, I_CK2, I_CV1, I_CV2, I_GBIAS, I_FQN, I_FKN, I_FFB, I_AWOUT, I_FNORM, I_FWG, I_FWU, I_FWD,
       I_CNORM, I_CWIN, I_CWA2, I_CBA, I_CONORM, I_CWOUT, I_MNORM, I_MROUTER, I_MWG, I_MWU, I_MWD };

namespace pro {
struct ConvM { const float* src; const float* src2; const float* gain; bf16_t* dst; int K, Ns, Nd, mode; };
DI int srccolA(int n) {
    const int pn = n >> 8, bj = (n >> 7) & 1, wc = (n >> 5) & 3, j = n & 31, s = 4 * pn + wc, d = 32 * bj + j;
    if (s < 8) return 64 * s + d;
    if (s < 10) return 768 + 64 * (s - 8) + d;
    if (s < 12) return 1024 + 64 * (s - 10) + d;
    if (s < 14) return 896 + 64 * (s - 12) + d;
    if (s < 16) return 1152 + 64 * (s - 14) + d;
    if (s < 18) return 512 + 64 * (s - 16) + d;
    if (s < 20) return 640 + 64 * (s - 18) + d;
    if (s < 28) return 1304 + 64 * (s - 20) + d;
    if (s < 36) return 1816 + 64 * (s - 28) + d;
    if (s < 44) return 2328 + 64 * (s - 36) + d;
    if (s == 44) { if (d < 24) return 1280 + d; if (d < 32) return 2840 + d - 24; }
    return -1;
}
DI void conv_item(const ConvM& M, int item, LAS float* scr, int lane) {
    const int nblk = M.Nd / 32, kb = item / nblk, nb = item % nblk, k0 = 64 * kb, n0 = 32 * nb;
    const int n = n0 + (lane & 31);
    const float* sp = M.src; int col = n;
    if (M.mode == 0) { if (n >= M.Ns) col = -1; }
    else if (M.mode == 1) col = srccolA(n);
    else { const int pn = n >> 8, half = (n >> 7) & 1, j = n & 127; sp = half ? M.src2 : M.src; col = 128 * pn + j; }
#pragma unroll 8
    for (int i = 0; i < 32; ++i) { const int kk = 2 * i + (lane >> 5); float w = 0.f; if (col >= 0) w = sp[(size_t)(k0 + kk) * M.Ns + col]; if (M.gain) w *= M.gain[k0 + kk]; scr[kk * 33 + (lane & 31)] = w; }
    const int c = lane & 7;
#pragma unroll
    for (int j = 0; j < 4; ++j) { const int nn = (lane >> 3) + 8 * j; const LAS float* s = scr + (8 * c) * 33 + nn;
        u32x4 o; o.x = cvtpk(s[0 * 33], s[1 * 33]); o.y = cvtpk(s[2 * 33], s[3 * 33]); o.z = cvtpk(s[4 * 33], s[5 * 33]); o.w = cvtpk(s[6 * 33], s[7 * 33]);
        *(u32x4*)(M.dst + (size_t)(n0 + nn) * M.K + k0 + 8 * c) = o; }
}
struct ConvRegs { f32x4 v[8]; };
DI void conv_big_load(ConvRegs& R, const ConvM& M, int item, int wid, int lane) {
    const int nblk = M.Nd / 256, kb = item / nblk, nb = item % nblk;
    const int k0 = 64 * kb + 8 * wid, n = 256 * nb + 4 * lane;
    const float* sp = M.src; int col = n;
    if (M.mode == 0) { if (n >= M.Ns) col = -1; }
    else if (M.mode == 1) col = srccolA(n);
    else { const int pn = n >> 8, half = (n >> 7) & 1, j = n & 127; sp = half ? M.src2 : M.src; col = 128 * pn + j; }
#pragma unroll
    for (int j = 0; j < 8; ++j) R.v[j] = (col >= 0) ? *(const f32x4*)(sp + (size_t)(k0 + j) * M.Ns + col) : (f32x4){0.f, 0.f, 0.f, 0.f};
}
DI void conv_big_store(ConvRegs& R, const ConvM& M, int item, LAS char* tile, int tid, int wid, int lane) {
    const int nblk = M.Nd / 256, kb = item / nblk, nb = item % nblk;
    if (M.gain) { const int k0 = 64 * kb + 8 * wid;
#pragma unroll
        for (int j = 0; j < 8; ++j) R.v[j] = R.v[j] * M.gain[k0 + j]; }
#pragma unroll
    for (int c = 0; c < 4; ++c) { u32x4 o; o.x = cvtpk(R.v[0][c], R.v[1][c]); o.y = cvtpk(R.v[2][c], R.v[3][c]); o.z = cvtpk(R.v[4][c], R.v[5][c]); o.w = cvtpk(R.v[6][c], R.v[7][c]);
        const int nl = 4 * lane + c; *(LAS u32x4*)(tile + nl * 128 + ((wid ^ (lane & 7)) * 16)) = o; }
    __syncthreads();
#pragma unroll
    for (int i = 0; i < 4; ++i) { const int r = (tid >> 3) + 64 * i, ch = tid & 7; const u32x4 o = *(const LAS u32x4*)(tile + r * 128 + ((ch ^ ((r >> 2) & 7)) * 16));
        *(u32x4*)(M.dst + (size_t)(256 * nb + r) * M.K + 64 * kb + 8 * ch) = o; }
    __syncthreads();
}
DI ConvM conv_desc(const Ptrs& P, int mat) {
    ConvM M; M.src2 = nullptr; M.gain = nullptr; M.mode = 0;
    switch (mat) {
    case 0: M.src = P.in[I_AWIN]; M.gain = P.in[I_ANORM]; M.dst = P.bf(WS_WA); M.K = 1024; M.Ns = IN_A; M.Nd = NA_PAD; M.mode = 1; break;
    case 1: M.src = P.in[I_AWOUT]; M.dst = P.bf(WS_WO); M.K = 1024; M.Ns = 1024; M.Nd = 1024; break;
    case 2: M.src = P.in[I_FWG]; M.src2 = P.in[I_FWU]; M.gain = P.in[I_FNORM]; M.dst = P.bf(WS_WFGU); M.K = 1024; M.Ns = DFF; M.Nd = 2 * DFF; M.mode = 2; break;
    case 3: M.src = P.in[I_FWD]; M.dst = P.bf(WS_WFD); M.K = DFF; M.Ns = 1024; M.Nd = 1024; break;
    case 4: M.src = P.in[I_CWIN]; M.gain = P.in[I_CNORM]; M.dst = P.bf(WS_WC); M.K = 1024; M.Ns = IN_C; M.Nd = NC_PAD; break;
    case 5: M.src = P.in[I_CWOUT]; M.dst = P.bf(WS_WCO); M.K = 1024; M.Ns = 1024; M.Nd = 1024; break;
    case 6: M.src = P.in[I_CK1]; M.dst = P.bf(CT_CW); M.K = 2048; M.Ns = 64; M.Nd = 64; break;
    case 7: M.src = P.in[I_CV1]; M.dst = P.bf(CT_CW + 262144); M.K = 2048; M.Ns = 64; M.Nd = 64; break;
    case 8: M.src = P.in[I_CK2]; M.dst = P.bf(CT_CW + 524288); M.K = 64; M.Ns = 64; M.Nd = 64; break;
    case 9: M.src = P.in[I_CV2]; M.dst = P.bf(CT_CW + 524288 + 8192); M.K = 64; M.Ns = 64; M.Nd = 64; break;
    default:
        if (mat < 18) { const int e = mat - 10; M.src = P.in[I_MWG] + (size_t)e * 1024 * DFF; M.src2 = P.in[I_MWU] + (size_t)e * 1024 * DFF; M.gain = P.in[I_MNORM];
            M.dst = P.bf(WS_WMGU) + (size_t)e * 2 * DFF * 1024; M.K = 1024; M.Ns = DFF; M.Nd = 2 * DFF; M.mode = 2; }
        else { const int e = mat - 18; M.src = P.in[I_MWD] + (size_t)e * DFF * 1024; M.dst = P.bf(WS_WMD) + (size_t)e * 1024 * DFF; M.K = DFF; M.Ns = 1024; M.Nd = 1024; }
    }
    return M;
}
DI int conv_items(int mat) {
    switch (mat) { case 0: return 16 * 12; case 1: return 16 * 4; case 2: return 16 * 22; case 3: return 44 * 4; case 4: return 16 * 13; case 5: return 16 * 4;
                   case 6: case 7: return 32 * 2; case 8: case 9: return 2; default: return mat < 18 ? 16 * 22 : 44 * 4; }
}
DI void prologue(const Ptrs& P, LAS char* lds) {
    int tid_l_ = threadIdx.x; asm volatile("" : "+v"(tid_l_)); const int tid = tid_l_, lane = tid & 63, wid = __builtin_amdgcn_readfirstlane(tid >> 6);
    const int gw = blockIdx.x * 8 + wid, NGW = gridDim.x * 8;
    LAS float* scr = (LAS float*)(lds + wid * 16384);
    {
        ConvRegs Ra, Rb; ConvM Ma, Mb; int ia = -1, ib = -1;
        int g = blockIdx.x, mat = 25, base = 0;
        auto advance = [&](ConvM& M, int& it) {
            it = -1;
            while (mat >= 0) {
                if (mat >= 6 && mat <= 9) { --mat; continue; }
                const int ni = conv_items(mat);
                if (g - base < ni) { M = conv_desc(P, mat); it = g - base; g += gridDim.x; return; }
                base += ni; --mat;
            }
        };
        advance(Ma, ia); if (ia >= 0) conv_big_load(Ra, Ma, ia, wid, lane);
        while (ia >= 0) {
            advance(Mb, ib); if (ib >= 0) conv_big_load(Rb, Mb, ib, wid, lane);
            conv_big_store(Ra, Ma, ia, lds + 65536 + 2048, tid, wid, lane);
            if (ib < 0) break;
            advance(Ma, ia); if (ia >= 0) conv_big_load(Ra, Ma, ia, wid, lane);
            conv_big_store(Rb, Mb, ib, lds + 65536 + 2048, tid, wid, lane);
        }
        for (int m2 = 6; m2 <= 9; ++m2) { const ConvM M = conv_desc(P, m2); const int ni = conv_items(m2); for (int it = gw; it < ni; it += NGW) conv_item(M, it, scr, lane); }
    }
    const float* x = P.in[I_X]; bf16_t* xb = P.bf(WS_XB); float* rstd0 = P.f32(CT_RSTD0);
    for (int m0 = gw * 2; m0 < T; m0 += NGW * 2) {
        f32x4 v[2][4];
#pragma unroll
        for (int u = 0; u < 2; ++u) { const f32x4* xr = (const f32x4*)(x + (size_t)(m0 + u) * DM) + lane;
#pragma unroll
            for (int j = 0; j < 4; ++j) v[u][j] = xr[64 * j]; }
#pragma unroll
        for (int u = 0; u < 2; ++u) {
            float s = 0.f;
#pragma unroll
            for (int j = 0; j < 4; ++j) s += (v[u][j][0] * v[u][j][0] + v[u][j][1] * v[u][j][1]) + (v[u][j][2] * v[u][j][2] + v[u][j][3] * v[u][j][3]);
            s = wave_sum(s);
            if (lane == 0) rstd0[m0 + u] = rsqrtf(s * (1.0f / 1024.0f) + EPS);
            u32x2* o8 = (u32x2*)(xb + (size_t)(m0 + u) * DM) + lane;
#pragma unroll
            for (int j = 0; j < 4; ++j) o8[64 * j] = (u32x2){cvtpk(v[u][j][0], v[u][j][1]), cvtpk(v[u][j][2], v[u][j][3])};
        }
    }
    float* cosT = P.f32(CT_ROPE); float* sinT = cosT + SEQ * 8;
    for (int idx = blockIdx.x * 512 + tid; idx < SEQ * 8; idx += gridDim.x * 512) {
        const int pos = idx >> 3, i = idx & 7;
        const float inv = powf(500000.0f, -(float)(2 * i) / 16.0f);
        const float ang = (float)pos * inv;
        const double rev = (double)ang * 0.15915494309189535; const float fr = (float)(rev - floor(rev));
        cosT[idx] = __builtin_amdgcn_cosf(fr); sinT[idx] = __builtin_amdgcn_sinf(fr);
    }
}

DI void fox_cum(const Ptrs& P, int bh, int lane) {
    const f32x4* lf = (const f32x4*)(P.f32(CT_LOGF) + (size_t)bh * SEQ + 64 * lane); f32x4* dst = (f32x4*)(P.f32(CT_CUM) + (size_t)bh * SEQ + 64 * lane);
    f32x4 v[16]; float tot = 0.f;
#pragma unroll
    for (int i = 0; i < 16; ++i) { v[i] = lf[i]; }
#pragma unroll
    for (int i = 0; i < 16; ++i) { v[i][1] += v[i][0]; v[i][2] += v[i][1]; v[i][3] += v[i][2]; const float t = v[i][3]; v[i] = v[i] + tot; tot += t; }
    float inc = tot;
#pragma unroll
    for (int o = 1; o < 64; o <<= 1) { const float t = __shfl_up(inc, o); if (lane >= o) inc += t; }
    const float base = inc - tot;
#pragma unroll
    for (int i = 0; i < 16; ++i) dst[i] = (v[i] + base) * (-LOG2E);
}

DI void compress_item(const Ptrs& P, int item, LAS char* lds) {
    int tid_l_ = threadIdx.x; asm volatile("" : "+v"(tid_l_)); const int tid = tid_l_, lane = tid & 63, r32 = lane & 31, hi = lane >> 5, wid = __builtin_amdgcn_readfirstlane(tid >> 6);
    const int kv = item >> 7, b = (item >> 4) & 7, g = (item >> 3) & 1, nt = item & 7;
    const bf16_t* projA = P.bf(WS_BIG);
    const float* pe = (kv ? P.in[I_APEV] : P.in[I_APEK]);
    const bf16_t* w1t = P.bf(CT_CW + (kv ? 262144 : 0)); const bf16_t* w2t = P.bf(CT_CW + 524288 + (kv ? 8192 : 0));
    int n = 32 * nt + r32; if (n > 254) n = 254;
    f32x16 c0, c1;
#pragma unroll
    for (int r = 0; r < 16; ++r) { c0[r] = 0.f; c1[r] = 0.f; }
#pragma unroll 8
    for (int kk = 0; kk < 16; ++kk) { const int ks = 16 * wid + kk;
        const int l = ks >> 2, d = 16 * (ks & 3) + 8 * hi;
        const u32x4 raw = *(const u32x4*)(projA + ((size_t)b * SEQ + 16 * n + l) * LDA + (kv ? PA_VC : PA_KC) + g * 64 + d);
        const f32x4 p0 = *(const f32x4*)(pe + l * 64 + d), p1 = *(const f32x4*)(pe + l * 64 + d + 4);
        u32x4 aw; aw.x = cvtpk(bflo(raw.x) + p0[0], bfhi(raw.x) + p0[1]); aw.y = cvtpk(bflo(raw.y) + p0[2], bfhi(raw.y) + p0[3]);
        aw.z = cvtpk(bflo(raw.z) + p1[0], bfhi(raw.z) + p1[1]); aw.w = cvtpk(bflo(raw.w) + p1[2], bfhi(raw.w) + p1[3]);
        const bf16x8 A = __builtin_bit_cast(bf16x8, aw);
        const bf16x8 B0 = *(const bf16x8*)(w1t + (size_t)r32 * 2048 + 16 * ks + 8 * hi), B1 = *(const bf16x8*)(w1t + (size_t)(32 + r32) * 2048 + 16 * ks + 8 * hi);
        c0 = MFMA32(A, B0, c0); c1 = MFMA32(A, B1, c1);
    }
    LAS float* red = (LAS float*)lds + wid * 2048;
#pragma unroll
    for (int r = 0; r < 16; ++r) { const int nn = att::crow(r, hi); red[nn * 64 + r32] = c0[r]; red[nn * 64 + 32 + r32] = c1[r]; }
    __syncthreads();
    {
        LAS bf16_t* H1 = (LAS bf16_t*)(lds + 65536);
        const LAS float* rd = (const LAS float*)lds;
        float s4[4];
#pragma unroll
        for (int e = 0; e < 4; ++e) { float s = 0.f;
#pragma unroll
            for (int w = 0; w < 8; ++w) s += rd[w * 2048 + tid * 4 + e];
            s4[e] = gelu_tanh(s); }
        *(LAS u32x2*)(H1 + tid * 4) = (u32x2){cvtpk(s4[0], s4[1]), cvtpk(s4[2], s4[3])};
    }
    __syncthreads();
    if (wid == 0) {
        f32x16 o0, o1;
#pragma unroll
        for (int r = 0; r < 16; ++r) { o0[r] = 0.f; o1[r] = 0.f; }
#pragma unroll
        for (int ks = 0; ks < 4; ++ks) {
            const bf16x8 A = *(const LAS bf16x8*)(lds + 65536 + r32 * 128 + (16 * ks + 8 * hi) * 2);
            const bf16x8 B0 = *(const bf16x8*)(w2t + r32 * 64 + 16 * ks + 8 * hi), B1 = *(const bf16x8*)(w2t + (32 + r32) * 64 + 16 * ks + 8 * hi);
            o0 = MFMA32(A, B0, o0); o1 = MFMA32(A, B1, o1);
        }
        bf16_t* dst = P.bf(kv ? CT_VCMP : CT_KCMP);
        if (kv == 0) {
            const float* kn = P.in[I_AKN]; const float g0 = kn[r32], g1 = kn[32 + r32];
            const float* cosT = P.f32(CT_ROPE); const float* sinT = cosT + SEQ * 8;
#pragma unroll
            for (int r = 0; r < 16; ++r) {
                float ss = o0[r] * o0[r] + o1[r] * o1[r];
                ss += __shfl_xor(ss, 1); ss += __shfl_xor(ss, 2); ss += __shfl_xor(ss, 4); ss += __shfl_xor(ss, 8); ss += __shfl_xor(ss, 16);
                const float rs = rsqrtf(ss * (1.0f / 64.0f) + EPS);
                float y0 = o0[r] * rs * g0; const float y1 = o1[r] * rs * g1;
                const float oth = __shfl_xor(y0, 8);
                const int nn = 32 * nt + att::crow(r, hi); const int pos = (16 * nn + 31) & (SEQ - 1);
                const float cc = cosT[pos * 8 + (r32 & 7)], sn = sinT[pos * 8 + (r32 & 7)];
                if (r32 < 8) y0 = y0 * cc - oth * sn; else if (r32 < 16) y0 = oth * sn + y0 * cc;
                o0[r] = y0; o1[r] = y1;
            }
        }
#pragma unroll
        for (int r = 0; r < 16; ++r) {
            const int nn = 32 * nt + att::crow(r, hi);
            const bool pad = nn > 254;
            bf16_t* dp = dst + (((size_t)b * NCMP_PAD + nn) * 2 + g) * 64;
            dp[r32] = pad ? (bf16_t)0 : (bf16_t)(cvtpk(o0[r], 0.f) & 0xffffu); dp[32 + r32] = pad ? (bf16_t)0 : (bf16_t)(cvtpk(o1[r], 0.f) & 0xffffu);
        }
    }
    __syncthreads();
}
}

namespace moe {
DI void route_block(const Ptrs& P, int blk, LAS char* lds) {
    int tid_l_ = threadIdx.x; asm volatile("" : "+v"(tid_l_)); const int tid = tid_l_, lane = tid & 63, r32 = lane & 31, hi = lane >> 5, wid = __builtin_amdgcn_readfirstlane(tid >> 6);
    constexpr int RPITCH = 1032;
    LAS bf16_t* RBH = (LAS bf16_t*)lds; LAS bf16_t* RBL = RBH + 8 * RPITCH;
    LAS float* PART = (LAS float*)(lds + 36864); LAS float* LG = (LAS float*)(lds + 40960);
    LAS int* einfo = (LAS int*)(lds + 33280);
    const float* router = P.in[I_MROUTER]; const float* mg = P.in[I_MNORM];
    for (int i = tid; i < 8192; i += 512) { const int k = i >> 3, e = i & 7; const float v = router[i] * mg[k];
        const unsigned hb = cvtpk(v, 0.f) & 0xffffu; const float vh = __uint_as_float(hb << 16); const unsigned lb = cvtpk(v - vh, 0.f) & 0xffffu;
        RBH[e * RPITCH + k] = (bf16_t)hb; RBL[e * RPITCH + k] = (bf16_t)lb; }
    __syncthreads();
    const bf16_t* xb3 = P.bf(WS_HM);
    {
        const int rt = wid & 3, kh = wid >> 2;
        const bf16_t* ap = xb3 + ((size_t)blk * 128 + 32 * rt + r32) * DM + 512 * kh + 8 * hi;
        const LAS bf16_t* bh = RBH + (r32 & 7) * RPITCH + 512 * kh + 8 * hi; const LAS bf16_t* bl = RBL + (r32 & 7) * RPITCH + 512 * kh + 8 * hi;
        f32x16 c;
#pragma unroll
        for (int r = 0; r < 16; ++r) c[r] = 0.f;
#pragma unroll 8
        for (int ks = 0; ks < 32; ++ks) {
            const bf16x8 A = *(const bf16x8*)(ap + 16 * ks);
            c = MFMA32(A, *(const LAS bf16x8*)(bh + 16 * ks), c); c = MFMA32(A, *(const LAS bf16x8*)(bl + 16 * ks), c);
        }
        if (kh == 1 && r32 < 8) {
#pragma unroll
            for (int r = 0; r < 16; ++r) PART[(32 * rt + att::crow(r, hi)) * 8 + r32] = c[r];
        }
        __syncthreads();
        if (kh == 0 && r32 < 8) {
#pragma unroll
            for (int r = 0; r < 16; ++r) { const int tk = 32 * rt + att::crow(r, hi); LG[tk * 8 + r32] = c[r] + PART[tk * 8 + r32]; }
        }
        __syncthreads();
    }
    if (tid < 128) {
        const int tl = tid, t = blk * 128 + tl;
        const f32x4 la = *(const LAS f32x4*)(LG + tl * 8), lb = *(const LAS f32x4*)(LG + tl * 8 + 4);
        const float rs = pg8::row_rstd(P.f32(CT_SS3), t);
        const float acc[8] = {la[0], la[1], la[2], la[3], lb[0], lb[1], lb[2], lb[3]};
        int e1 = 0; float l1 = acc[0] * rs;
#pragma unroll
        for (int e = 1; e < 8; ++e) { const float l = acc[e] * rs; if (l > l1) { l1 = l; e1 = e; } }
        int e2 = -1; float l2 = -3.0e38f;
#pragma unroll
        for (int e = 0; e < 8; ++e) { const float l = acc[e] * rs; if (e != e1 && l > l2) { l2 = l; e2 = e; } }
        const float w1 = 1.0f / (1.0f + __expf(l2 - l1));
        einfo[tl * 2] = e1; einfo[tl * 2 + 1] = e2;
        P.f32(MO_TOKW)[(size_t)t * 2] = w1; P.f32(MO_TOKW)[(size_t)t * 2 + 1] = 1.0f - w1;
        P.f32(MO_TOKR)[t] = rs;
    }
    __syncthreads();
    LAS int* rk = (LAS int*)(lds + 34304);
    if (tid < 256) { const int e = einfo[tid]; int r = 0; for (int j = 0; j < tid; ++j) r += (einfo[j] == e) ? 1 : 0; rk[tid] = r; }
    if (tid >= 256 && tid < 264) { const int e = tid - 256; int c = 0; for (int j = 0; j < 256; ++j) c += (einfo[j] == e) ? 1 : 0; P.i32(MO_HIST)[blk * 8 + e] = c; }
    __syncthreads();
    if (tid < 128) { const int t = blk * 128 + tid; ((unsigned*)P.i32(MO_TOKE))[t] = (unsigned)einfo[2 * tid] | ((unsigned)einfo[2 * tid + 1] << 4) | ((unsigned)rk[2 * tid] << 8) | ((unsigned)rk[2 * tid + 1] << 20); }
    __syncthreads();
}
DI void scatter_block(const Ptrs& P, int blk, LAS char* lds) {
    int tid_l_ = threadIdx.x; asm volatile("" : "+v"(tid_l_)); const int tid = tid_l_, lane = tid & 63, wid = __builtin_amdgcn_readfirstlane(tid >> 6);
    LAS int* sh = (LAS int*)lds;
    const int* hist = P.i32(MO_HIST);
    { typedef int i32x4 __attribute__((ext_vector_type(4))); *(LAS i32x4*)(sh + 64 + tid * 4) = *(const i32x4*)(hist + tid * 4); }
    __syncthreads();
    if (tid < 8) { int c = 0, pre = 0; for (int j = 0; j < 256; ++j) { const int v = sh[64 + j * 8 + tid]; c += v; if (j < blk) pre += v; } sh[tid] = c; sh[8 + tid] = pre; }
    __syncthreads();
    if (tid == 0) { int acc = 0; for (int e = 0; e < 8; ++e) { sh[16 + e] = acc; acc += ((sh[e] + 255) >> 8) << 8; } sh[24] = acc; }
    __syncthreads();
    const bf16_t* xb3 = P.bf(WS_HM); bf16_t* xy = P.bf(WS_XY);
    for (int q0 = wid * 32; q0 < wid * 32 + 32; q0 += 4) {
        u32x4 a[4], c[4]; int rowv[4];
#pragma unroll
        for (int u = 0; u < 4; ++u) {
            const int q = q0 + u, tl = q >> 1, slot = q & 1, t = blk * 128 + tl;
            const unsigned info = ((const unsigned*)P.i32(MO_TOKE))[t];
            const int e = slot ? (info >> 4) & 15 : info & 15, lr = slot ? (info >> 20) & 4095 : (info >> 8) & 4095;
            rowv[u] = sh[16 + e] + sh[8 + e] + lr;
            const u32x4* src = (const u32x4*)(xb3 + (size_t)t * DM) + lane;
            a[u] = src[0]; c[u] = src[64];
            if (lane == 0) { P.f32(MO_RSCALE)[rowv[u]] = P.f32(MO_TOKR)[t]; P.f32(MO_RGATE)[rowv[u]] = P.f32(MO_TOKW)[(size_t)t * 2 + slot]; P.f32(MO_RKEEP)[rowv[u]] = slot ? 0.f : 1.f; P.i32(MO_POS)[(size_t)t * 2 + slot] = rowv[u];
                if (rowv[u] >= MOE_XROW0) P.i32(MO_ROWTOK)[rowv[u] - MOE_XROW0] = t; }
        }
#pragma unroll
        for (int u = 0; u < 4; ++u) { u32x4* dst = (u32x4*)(xy + (size_t)rowv[u] * DM) + lane; dst[0] = a[u]; dst[64] = c[u]; }
    }
    if (blk < 8) {
        const int e = blk, r0 = sh[16 + e] + sh[e], r1 = sh[16 + e + 1];
        for (int row = r0 + wid; row < r1; row += 8) { u32x2* o8 = (u32x2*)(xy + (size_t)row * DM) + lane;
#pragma unroll
            for (int j = 0; j < 4; ++j) o8[64 * j] = (u32x2){0u, 0u};
            if (lane == 0) { P.f32(MO_RSCALE)[row] = 0.f; P.f32(MO_RGATE)[row] = 0.f; P.f32(MO_RKEEP)[row] = 0.f; if (row >= MOE_XROW0) P.i32(MO_ROWTOK)[row - MOE_XROW0] = -1; } }
    }
    if (blk == 8) {
        int* te = P.i32(MO_TILEE); const int ntl = sh[24] >> 8;
        for (int tl = tid; tl < 271; tl += 512) { int e = 0; for (int k = 1; k < 8; ++k) if (tl * 256 >= sh[16 + k]) e = k; te[tl] = e; }
        if (tid == 0) te[271] = ntl;
    }
    __syncthreads();
}
DI f32x4 moe_row_piece(const Ptrs& P, int p, int lane, int j) {
    const u32x2 w = ((const u32x2*)(P.bf(WS_XY) + (size_t)p * DM) + lane)[64 * j];
    const f32x4 old = {bflo(w[0]), bfhi(w[0]), bflo(w[1]), bfhi(w[1])};
    if (p < MOE_XROW0) return old;
    const f32x4* pp = (const f32x4*)(P.f32(WS_PART) + (size_t)(p - MOE_XROW0) * 11 * DM) + 64 * j + lane;
    f32x4 s = pp[0];
#pragma unroll
    for (int k = 1; k < 11; ++k) s += pp[k * (DM / 4)];
    return old * P.f32(MO_RKEEP)[p] + s * P.f32(MO_RGATE)[p];
}
DI void combine_tail_row(const Ptrs& P, int xr, int lane) {
    const int t = __builtin_amdgcn_readfirstlane(P.i32(MO_ROWTOK)[xr]);
    if (t < 0) return;
    const int p1 = __builtin_amdgcn_readfirstlane(P.i32(MO_POS)[(size_t)t * 2]), p2 = __builtin_amdgcn_readfirstlane(P.i32(MO_POS)[(size_t)t * 2 + 1]);
    if (p1 >= MOE_XROW0 && p2 >= MOE_XROW0 && (p1 < p2 ? p1 : p2) != MOE_XROW0 + xr) return;
    f32x4* orow = (f32x4*)(P.out + (size_t)t * DM) + lane;
#pragma unroll 2
    for (int j = 0; j < 4; ++j) orow[64 * j] = moe_row_piece(P, p1, lane, j) + moe_row_piece(P, p2, lane, j);
}
template <int NR> DI void combine_rows(const Ptrs& P, int t0, int lane) {
    const bf16_t* y = P.bf(WS_XY);
    int p1[NR], p2[NR];
#pragma unroll
    for (int u = 0; u < NR; ++u) { p1[u] = P.i32(MO_POS)[(size_t)(t0 + u) * 2]; p2[u] = P.i32(MO_POS)[(size_t)(t0 + u) * 2 + 1]; }
    { bool tail = false;
#pragma unroll
      for (int u = 0; u < NR; ++u) tail = tail || p1[u] >= MOE_XROW0 || p2[u] >= MOE_XROW0;
      if (tail) {
#pragma unroll 1
        for (int u = 0; u < NR; ++u) { if (p1[u] >= MOE_XROW0 || p2[u] >= MOE_XROW0) continue;
            f32x4* orow = (f32x4*)(P.out + (size_t)(t0 + u) * DM) + lane;
#pragma unroll 1
            for (int j = 0; j < 4; ++j) orow[64 * j] = moe_row_piece(P, p1[u], lane, j) + moe_row_piece(P, p2[u], lane, j); }
        return; } }
    u32x2 a[NR][4], c[NR][4];
#pragma unroll
    for (int u = 0; u < NR; ++u) {
        const u32x2* y1 = (const u32x2*)(y + (size_t)p1[u] * DM) + lane; const u32x2* y2 = (const u32x2*)(y + (size_t)p2[u] * DM) + lane;
#pragma unroll
        for (int j = 0; j < 4; ++j) { a[u][j] = y1[64 * j]; c[u][j] = y2[64 * j]; }
    }
#pragma unroll
    for (int u = 0; u < NR; ++u) {
        f32x4* orow = (f32x4*)(P.out + (size_t)(t0 + u) * DM) + lane;
#pragma unroll
        for (int j = 0; j < 4; ++j) { f32x4 w; w[0] = bflo(a[u][j][0]) + bflo(c[u][j][0]); w[1] = bfhi(a[u][j][0]) + bfhi(c[u][j][0]); w[2] = bflo(a[u][j][1]) + bflo(c[u][j][1]); w[3] = bfhi(a[u][j][1]) + bfhi(c[u][j][1]); orow[64 * j] = w; }
    }
}
}
#define XB_TMO      128
#define XB_XCNT(j)  (256  + 64 * (j))
#define XB_XSUB(j)  (1280 + 64 * (j))
#define XB_XGEN(j)  (2304 + 64 * (j))
#define XB_TOP      3328
#define XB_TOPGEN   3392
#define XCD_BAR_WORDS 3456
#define XB_SPIN_CAP (1u << 18)

__device__ __forceinline__ unsigned xb_ld(unsigned* p)              { return __hip_atomic_load(p, __ATOMIC_RELAXED, __HIP_MEMORY_SCOPE_AGENT); }
__device__ __forceinline__ unsigned xb_add(unsigned* p, unsigned v) { return __hip_atomic_fetch_add(p, v, __ATOMIC_RELAXED, __HIP_MEMORY_SCOPE_AGENT); }
__device__ __forceinline__ unsigned xb_xcc_id() { return (unsigned)__builtin_amdgcn_s_getreg((3 << 11) | 20) & 0xFu; }
#define XB_SPIN(cond, bar) do { unsigned _sp = 0; while (cond) { __builtin_amdgcn_s_sleep(1); \
    if ((++_sp & 255u) == 0u) { if (xb_ld(&(bar)[XB_TMO])) break; if (_sp > XB_SPIN_CAP) { atomicAdd(&(bar)[XB_TMO], 1u); break; } } } } while (0)

struct XcdBarrier {
    unsigned* bar; unsigned x;
    volatile LAS unsigned* st;
};

__device__ __forceinline__ XcdBarrier xcd_barrier_post(unsigned* bar, volatile LAS unsigned* st) {
    XcdBarrier b; b.bar = bar; b.x = xb_xcc_id(); b.st = st;
    if (threadIdx.x == 0) (void)xb_add(&bar[XB_XCNT(b.x)], 1u);
    return b;
}
__device__ __forceinline__ void xcd_barrier_complete(unsigned* bar, unsigned x, unsigned& nloc, unsigned& nx) {
    const unsigned G = gridDim.x * gridDim.y * gridDim.z;
    unsigned sum, cnt, mine, sp = 0u;
    for (;;) {
        sum = 0u; cnt = 0u; mine = 0u;
#pragma unroll
        for (unsigned j = 0; j < 16; ++j) { const unsigned c = xb_ld(&bar[XB_XCNT(j)]); sum += c; cnt += (c > 0u) ? 1u : 0u; mine = (j == x) ? c : mine; }
        if (sum == G) break;
        __builtin_amdgcn_s_sleep(1);
        if ((++sp & 255u) == 0u) { if (xb_ld(&bar[XB_TMO])) break; if (sp > XB_SPIN_CAP) { atomicAdd(&bar[XB_TMO], 1u); break; } }
    }
    nloc = mine > 0u ? mine : 1u; nx = cnt > 0u ? cnt : 1u;
}

__device__ __forceinline__ void xcd_barrier(const XcdBarrier& b) {
    asm volatile("s_waitcnt vmcnt(0)" ::: "memory");
    __syncthreads();
    if (threadIdx.x == 0) {
        unsigned* bar = b.bar;
        __builtin_amdgcn_s_waitcnt(0);
        unsigned nloc = b.st[0], nx = b.st[1];
        if (nloc == 0u) { xcd_barrier_complete(bar, b.x, nloc, nx); b.st[0] = nloc; b.st[1] = nx; }
        const unsigned old = xb_add(&bar[XB_XSUB(b.x)], 1u);
        const unsigned gen = old / nloc;
        if (old + 1u == (gen + 1u) * nloc) {
            __builtin_amdgcn_fence(__ATOMIC_RELEASE, "agent");
            asm volatile("s_waitcnt vmcnt(0)" ::: "memory");
            const unsigned og = xb_add(&bar[XB_TOP], 1u);
            const unsigned tg = og / nx;
            if (og + 1u == (tg + 1u) * nx) xb_add(&bar[XB_TOPGEN], 1u);
            else XB_SPIN(xb_ld(&bar[XB_TOPGEN]) == tg, bar);
            __builtin_amdgcn_fence(__ATOMIC_ACQUIRE, "agent");
            xb_add(&bar[XB_XGEN(b.x)], 1u);
            asm volatile("s_waitcnt vmcnt(0)" ::: "memory");
        } else {
            XB_SPIN(xb_ld(&bar[XB_XGEN(b.x)]) == gen, bar);
            __builtin_amdgcn_fence(__ATOMIC_ACQUIRE, "agent");
            asm volatile("s_waitcnt vmcnt(0)" ::: "memory");
        }
    }
    __syncthreads();
}

#ifndef MK_N_LAUNCHES
#define MK_N_LAUNCHES 1
#endif
constexpr int N_PHASES = 18;

__global__ void __launch_bounds__(512, 2) mega_fwd(Args args) {
    extern __shared__ __attribute__((aligned(16))) unsigned char lds_raw[];
    LAS char* lds = (LAS char*)lds_raw;
    cg::grid_group grid = cg::this_grid();
    Ptrs P;
#pragma unroll
    for (int i = 0; i < 31; ++i) P.in[i] = args.in[i];
    P.out = args.out; P.ws = args.ws;
    const int lo = args.ph_lo, hi_ = args.ph_hi;
    const int tid = threadIdx.x, lane = tid & 63, wid = __builtin_amdgcn_readfirstlane(tid >> 6);
    const int G = gridDim.x, gw = blockIdx.x * 8 + wid, NGW = G * 8;
#define IN(k) (lo <= (k) && (k) < hi_)
    { volatile LAS unsigned* st0 = (volatile LAS unsigned*)(lds_raw + LDS_MISC); if (tid < 64) st0[tid] = 0u; }
    __syncthreads();
    XcdBarrier xbar; xbar.bar = (unsigned*)(args.ws + CT_BAR); xbar.x = 0; xbar.st = (volatile LAS unsigned*)(lds_raw + LDS_MISC) + 8;
    const bool one_launch = (lo == 0 && hi_ == N_PHASES);
    if (one_launch) { if (blockIdx.x == 0) { for (int i = tid; i < 1024; i += 512) ((unsigned*)(args.ws + CT_CTR))[i] = 0u; for (int i = tid; i < 4096; i += 512) ((unsigned*)(args.ws + CT_BAR))[i] = 0u; } }
    else xbar = xcd_barrier_post((unsigned*)(args.ws + CT_BAR), (volatile LAS unsigned*)(lds_raw + LDS_MISC) + 8);
#define SEAM(k) do { if (IN(k) && IN((k) + 1)) { if ((k) == 0) { grid.sync(); if (one_launch) xbar = xcd_barrier_post((unsigned*)(args.ws + CT_BAR), (volatile LAS unsigned*)(lds_raw + LDS_MISC) + 8); } else xcd_barrier(xbar); } } while (0)
    LAS unsigned char* glds = (LAS unsigned char*)lds_raw;

    if (IN(0)) { pro::prologue(P, lds); }
    SEAM(0);
    if (IN(1)) {
        pg8::Gemm g{P.bf(WS_XB), P.bf(WS_WA), T, NA_PAD, DM}; pg8::StaticOrder S; S.init(T, NA_PAD, G, (int)blockIdx.x);
        const float* cosT = P.f32(CT_ROPE);
        pg8::EpiInA E{P.bf(WS_BIG), P.f32(CT_RSTD0), cosT, cosT + SEQ * 8, P.in[I_AQN], P.in[I_AKN], P.in[I_FQN], P.in[I_FKN], P.in[I_GBIAS], P.in[I_FFB], P.f32(CT_GATE), P.f32(CT_LOGF)};
        pg8::gemm_phase<pg8::EpiInA, pg8::StaticOrder, true, true>(glds, g, S, E);
    }
    SEAM(1);
    if (IN(2)) {
        if (gw < 64) pro::fox_cum(P, gw, lane);
        for (int it = blockIdx.x; it < 256; it += G) pro::compress_item(P, it, lds);
    }
    SEAM(2);
    if (IN(3)) {
        att::Tensors AT{P.bf(WS_BIG), P.bf(CT_KCMP), P.bf(CT_VCMP), P.f32(CT_GATE), P.f32(CT_CUM), P.bf(WS_O), P.in[I_FQN], P.in[I_FKN], P.in[I_AQN], P.in[I_AKN]};
        att::attn_phase(AT, (unsigned*)(P.ws + CT_CTR), lds);
    }
    SEAM(3);
    if (IN(4)) {
        pg8::Gemm g{P.bf(WS_O), P.bf(WS_WO), T, DM, DM}; pg8::StaticOrder S; S.init(T, DM, G, (int)blockIdx.x);
        pg8::EpiResid<true> E{P.in[I_X], P.bf(WS_XB), P.f32(CT_SS1)};
        pg8::gemm_phase<pg8::EpiResid<true>, pg8::StaticOrder, true, true>(glds, g, S, E);
    }
    SEAM(4);
    if (IN(5)) {
        pg8::Gemm g{P.bf(WS_XB), P.bf(WS_WFGU), T, 2 * DFF, DM}; pg8::StaticOrder S; S.init(T, 2 * DFF, G, (int)blockIdx.x);
        for (int blk = blockIdx.x; blk < 256; blk += G) if (tid < 128) { const int row = blk * 128 + tid; P.f32(CT_RSTD0)[row] = pg8::row_rstd(P.f32(CT_SS1), row); }
        xcd_barrier(xbar);
        pg8::EpiSwiglu<true> E{P.bf(WS_BIG), P.f32(CT_RSTD0), 0};
        pg8::gemm_phase<pg8::EpiSwiglu<true>, pg8::StaticOrder, true, true>(glds, g, S, E);
    }
    SEAM(5);
    if (IN(6)) {
        pg8::Gemm g{P.bf(WS_BIG), P.bf(WS_WFD), T, DM, DFF}; pg8::StaticOrder S; S.init(T, DM, G, (int)blockIdx.x);
        pg8::EpiResid<false> E{P.bf(WS_XB), P.bf(WS_XB), P.f32(CT_SS2)};
        pg8::gemm_phase<pg8::EpiResid<false>, pg8::StaticOrder, true, true>(glds, g, S, E);
    }
    SEAM(6);
    if (IN(7)) {
        for (int blk = blockIdx.x; blk < 256; blk += G) if (tid < 128) { const int row = blk * 128 + tid; P.f32(CT_RSTD0)[row] = pg8::row_rstd(P.f32(CT_SS2), row); }
        for (int it = blockIdx.x; it < T / 128; it += G) gla::gla_a1_item(P.bf(WS_XB), P.bf(WS_WC) + (size_t)LDC * DM, P.f32(CT_SS2), P.f32(CT_A1), it, lds);
        xcd_barrier(xbar);
        pg8::Gemm g{P.bf(WS_XB), P.bf(WS_WC), T, LDC, DM}; pg8::StaticOrder S; S.init(T, LDC, G, (int)blockIdx.x);
        pg8::EpiGlaIn E{P.bf(WS_BIG), P.f32(CT_RSTD0)};
        pg8::gemm_phase<pg8::EpiGlaIn, pg8::StaticOrder, true, true>(glds, g, S, E);
    }
    SEAM(7);
    if (IN(8)) {
        gla::GlaT GT{P.bf(WS_BIG), P.f32(CT_A1), P.in[I_CWA2], P.in[I_CBA], P.bf(WS_O), P.bf(WS_ATT), P.f32(CT_GATE)};
        {
            gla::PrepRegs Ra, Rb; int it = blockIdx.x;
            if (it < 2048) gla::prep_load(Ra, GT, it, tid);
            while (it < 2048) {
                const int i1 = it + G; if (i1 < 2048) gla::prep_load(Rb, GT, i1, tid);
                gla::gla_prep(GT, it, Ra, lds);
                if (i1 >= 2048) break;
                const int i2 = i1 + G; if (i2 < 2048) gla::prep_load(Ra, GT, i2, tid);
                gla::gla_prep(GT, i1, Rb, lds);
                it = i2;
            }
        }
        xcd_barrier(xbar);
        for (int u = blockIdx.x; u < 256; u += G) { const int bh = (u & 7) * 4 + (u >> 6), es = (u >> 3) & 7; gla::gla_unit(GT, bh >> 2, bh & 3, es, lds); }
    }
    SEAM(8);
    if (IN(9)) {
        for (int m = gw * 2; m < T; m += NGW * 2) gla::gla_gate_rows2(P.bf(WS_O), P.bf(WS_BIG) + PC_R, P.in[I_CONORM], m, lane);
    }
    SEAM(9);
    if (IN(10)) {
        pg8::Gemm g{P.bf(WS_O), P.bf(WS_WCO), T, DM, DM}; pg8::StaticOrder S; S.init(T, DM, G, (int)blockIdx.x);
        pg8::EpiResid<false> E{P.bf(WS_XB), P.bf(WS_HM), P.f32(CT_SS3)};
        pg8::gemm_phase<pg8::EpiResid<false>, pg8::StaticOrder, true, true>(glds, g, S, E);
    }
    SEAM(10);
    if (IN(11)) { for (int blk = blockIdx.x; blk < 256; blk += G) moe::route_block(P, blk, lds); }
    SEAM(11);
    if (IN(12)) { for (int blk = blockIdx.x; blk < 256; blk += G) moe::scatter_block(P, blk, lds); }
    SEAM(12);
#pragma unroll 1
    for (int pass = 0; pass < 2; ++pass) {
        const int tile0 = pass * MOE_PASS_TILES;
        if (IN(13 + 2 * pass)) {
            int ntp = __builtin_amdgcn_readfirstlane(P.i32(MO_TILEE)[271]) - tile0; { const int cap = pass == 0 ? MOE_PASS_TILES : MOE_PASS1_MAX; ntp = ntp < 0 ? 0 : (ntp > cap ? cap : ntp); }
            if (ntp > 0) {
                pg8::Gemm g{P.bf(WS_XY) + (size_t)tile0 * 256 * DM, P.bf(WS_WMGU), ntp * 256, 2 * DFF, DM};
                pg8::GroupedOrder S; S.so.init(ntp * 256, 2 * DFF, G, (int)blockIdx.x); S.tile_e = P.i32(MO_TILEE); S.tile0 = tile0; S.nN = 22;
                pg8::EpiSwiglu<true> E{P.bf(WS_HM), P.f32(MO_RSCALE), tile0 * 256};
                pg8::gemm_phase<pg8::EpiSwiglu<true>, pg8::GroupedOrder, true, true>(glds, g, S, E);
            }
        }
        SEAM(13 + 2 * pass);
        if (IN(14 + 2 * pass)) {
            int ntp = __builtin_amdgcn_readfirstlane(P.i32(MO_TILEE)[271]) - tile0; { const int cap = pass == 0 ? MOE_PASS_TILES : MOE_PASS1_MAX; ntp = ntp < 0 ? 0 : (ntp > cap ? cap : ntp); }
            const int ntm = ntp < MOE_PASS_TILES ? ntp : MOE_PASS_TILES, nx = ntp - ntm;
            if (ntm > 0) {
                pg8::Gemm g{P.bf(WS_HM), P.bf(WS_WMD), ntm * 256, DM, DFF};
                pg8::GroupedOrder S; S.so.init(ntm * 256, DM, G, (int)blockIdx.x); S.tile_e = P.i32(MO_TILEE); S.tile0 = tile0; S.nN = 4;
                pg8::EpiMoeDown E{P.bf(WS_XY), P.f32(MO_RGATE), P.f32(MO_RKEEP), tile0 * 256};
                pg8::gemm_phase<pg8::EpiMoeDown, pg8::GroupedOrder, true, true>(glds, g, S, E);
            }
            if (nx > 0) {
                pg8::Gemm g{P.bf(WS_HM), P.bf(WS_WMD), ntp * 256, DM, 256, DFF};
                pg8::SliceOrder S{P.i32(MO_TILEE), tile0, ntm, nx * 44, G, (int)blockIdx.x};
                pg8::EpiMoePart E{P.f32(WS_PART), ntm};
                pg8::gemm_phase<pg8::EpiMoePart, pg8::SliceOrder, true, true>(glds, g, S, E);
            }
        }
        SEAM(14 + 2 * pass);
    }
    if (IN(17)) { int t17 = tid; asm volatile("" : "+v"(t17)); const int lane17 = t17 & 63;
        { const int nxr = (__builtin_amdgcn_readfirstlane(P.i32(MO_TILEE)[271]) - 2 * MOE_PASS_TILES) * 256;
          for (int xr = gw; xr < nxr; xr += NGW) moe::combine_tail_row(P, xr, lane17); }
        for (int m = gw * 2; m < T; m += NGW * 2) moe::combine_rows<2>(P, m, lane17); }
#undef IN
#undef SEAM
}

extern "C" void kernel_launch(void* const* d_in, const int* in_sizes, int n_in, void* d_out, int out_size, void* d_ws, size_t ws_size, hipStream_t stream) {
    static int grid = 0;
    if (grid == 0) {
        if (n_in != 31 || out_size != T * DM || ws_size < WS_END) { fprintf(stderr, "kernel_launch: unexpected problem (n_in %d, out %d, ws %zu)\n", n_in, out_size, ws_size); grid = -1; return; }
        int dev = 0, cus = 0, per_cu = 0;
        hipGetDevice(&dev); hipDeviceGetAttribute(&cus, hipDeviceAttributeMultiprocessorCount, dev);
        if (hipFuncSetAttribute((const void*)mega_fwd, hipFuncAttributeMaxDynamicSharedMemorySize, LDS_BYTES) != hipSuccess) { fprintf(stderr, "kernel_launch: hipFuncSetAttribute failed\n"); grid = -1; return; }
        if (hipOccupancyMaxActiveBlocksPerMultiprocessor(&per_cu, (const void*)mega_fwd, 512, LDS_BYTES) != hipSuccess || per_cu < 1) { fprintf(stderr, "kernel_launch: occupancy query says %d\n", per_cu); per_cu = 1; }
        (void)hipGetLastError();
        grid = cus * 1;
        if (per_cu < 1) grid = -1;
    }
    if (grid < 0) return;
#if MK_N_LAUNCHES != 1
    hipMemsetAsync((char*)d_ws, 0, CT_ZERO_BYTES, stream);
#endif
    Args a{};
    for (int i = 0; i < 31; ++i) a.in[i] = (const float*)d_in[i];
    a.out = (float*)d_out; a.ws = (unsigned char*)d_ws;
#if MK_N_LAUNCHES == 1
    a.ph_lo = 0; a.ph_hi = N_PHASES;
    void* kargs[] = {&a};
    hipError_t e = hipLaunchCooperativeKernel((const void*)mega_fwd, dim3(grid), dim3(512), kargs, LDS_BYTES, stream);
    if (e != hipSuccess) fprintf(stderr, "cooperative launch failed: %s (grid %d)\n", hipGetErrorString(e), grid);
#else
    for (int ph = 0; ph < N_PHASES; ++ph) {
        a.ph_lo = ph; a.ph_hi = ph + 1;
        hipLaunchKernelGGL(mega_fwd, dim3(grid), dim3(512), LDS_BYTES, stream, a);
    }
#endif
}
```

```cpp
#include <hip/hip_runtime.h>
#include <hip/hip_cooperative_groups.h>
#include <cstdio>
#include <cstdint>
namespace cg = cooperative_groups;

#define DI __device__ __forceinline__
#define LAS __attribute__((address_space(3)))
#define GAS __attribute__((address_space(1)))
typedef unsigned short bf16_t;
typedef short bf16x8 __attribute__((ext_vector_type(8)));
typedef short s16x4 __attribute__((ext_vector_type(4)));
typedef float f32x2 __attribute__((ext_vector_type(2)));
typedef float f32x4 __attribute__((ext_vector_type(4)));
typedef float f32x16 __attribute__((ext_vector_type(16)));
typedef unsigned u32x2 __attribute__((ext_vector_type(2)));
typedef unsigned u32x4 __attribute__((ext_vector_type(4)));

constexpr int BATCH = 8, SEQ = 4096, DM = 1024, T = BATCH * SEQ;
constexpr int HD = 64;
constexpr int NSA_H = 8, NSA_G = 2, FOX_H = 8;
constexpr int NCMP = 255, NCMP_PAD = 256;
constexpr int IN_A = 2848, LDA = 2816  , NA_PAD = 3072;
constexpr int DFF = 2816;
constexpr int IN_C = 3088, LDC = 3072  , NC_PAD = 3328;
constexpr int NEXP = 8;
constexpr int MOE_TILES_MAX = 264, MOE_PASS_TILES = 128, MOE_PASS1_MAX = 136;
constexpr float EPS = 1e-6f;
constexpr float LOG2E = 1.4426950408889634f;
constexpr float QSCALE = 0.125f * LOG2E;
constexpr int PA_QA = 0, PA_KSL = 512, PA_KWN = 640, PA_VSL = 768, PA_VWN = 896, PA_KC = 1024, PA_VC = 1152, PA_QB = 1280, PA_KB = 1792, PA_VB = 2304;
constexpr int PC_Q = 0, PC_K = 512, PC_V = 1024, PC_R = 2048;

constexpr size_t MiB = 1u << 20;
constexpr size_t CT_CTR = 0;
constexpr size_t CT_BAR = 65536;
constexpr size_t CT_SS1 = 501 * MiB, CT_SS2 = 503 * MiB, CT_SS3 = 505 * MiB;
constexpr size_t CT_ZERO_BYTES = 1 * MiB;
static_assert(CT_BAR + 16384 <= CT_ZERO_BYTES, "zero region");
constexpr size_t CT_RSTD0 = 1 * MiB;
constexpr size_t CT_ROPE = CT_RSTD0 + (size_t)T * 4;
constexpr size_t CT_LOGF = 2 * MiB;
constexpr size_t CT_CUM = 3 * MiB;
constexpr size_t CT_GATE = 4 * MiB;
constexpr size_t CT_A1 = 7 * MiB;
constexpr size_t CT_KCMP = 9 * MiB, CT_VCMP = CT_KCMP + 512 * 1024;
constexpr size_t CT_CW = 10 * MiB;
constexpr size_t CT_MOE = 11 * MiB;
constexpr size_t WS_WA = 16 * MiB;
constexpr size_t WS_WO = WS_WA + 6 * MiB;
constexpr size_t WS_WFGU = WS_WO + 2 * MiB;
constexpr size_t WS_WFD = WS_WFGU + 11 * MiB;
constexpr size_t WS_WC = WS_WFD + 5632 * 1024;
constexpr size_t WS_WCO = WS_WC + 6656 * 1024;
constexpr size_t WS_WMGU = 49 * MiB;
constexpr size_t WS_WMD = WS_WMGU + 88 * MiB;
static_assert(WS_WCO + 2 * MiB <= WS_WMGU, "weights map");
constexpr size_t WS_XB = 181 * MiB;
constexpr size_t WS_O = 245 * MiB;
constexpr size_t WS_ATT = WS_WA;
constexpr size_t WS_BIG = 309 * MiB;
constexpr size_t WS_XY = 181 * MiB;
constexpr size_t WS_HM = 313 * MiB;
constexpr size_t WS_PART = 16 * MiB;
constexpr int MOE_XROW0 = 2 * MOE_PASS_TILES * 256;
constexpr size_t WS_END = 512 * MiB;
static_assert(WS_PART + (size_t)8 * 256 * 11 * 1024 * 4 <= WS_WMD, "partials map");
static_assert(WS_WMD + 44 * MiB <= WS_XB && WS_BIG + (size_t)T * LDC * 2 <= WS_END && WS_XY + (size_t)MOE_TILES_MAX * 256 * 1024 * 2 <= WS_HM && WS_HM + (size_t)MOE_PASS1_MAX * 256 * DFF * 2 <= WS_END, "d_ws map");
constexpr size_t MO_TOKE = CT_MOE;
constexpr size_t MO_TOKW = MO_TOKE + (size_t)T * 4;
constexpr size_t MO_TOKR = MO_TOKW + (size_t)T * 8;
constexpr size_t MO_POS = MO_TOKR + (size_t)T * 4;
constexpr size_t MO_HIST = MO_POS + (size_t)T * 8;
constexpr size_t MO_RSCALE = MO_HIST + 8192;
constexpr size_t MO_RGATE = MO_RSCALE + (size_t)MOE_TILES_MAX * 256 * 4;
constexpr size_t MO_RKEEP = MO_RGATE + (size_t)MOE_TILES_MAX * 256 * 4;
constexpr size_t MO_TILEE = MO_RKEEP + (size_t)MOE_TILES_MAX * 256 * 4;
constexpr size_t MO_ROWTOK = MO_TILEE + 2048;
static_assert(MO_ROWTOK + 8192 <= WS_WA, "moe tables");

constexpr int LDS_BYTES = 163840;
constexpr int LDS_MISC = 163584;

DI unsigned cvtpk(float lo, float hi) { typedef __bf16 b2 __attribute__((ext_vector_type(2))); f32x2 v = {lo, hi}; b2 b = __builtin_convertvector(v, b2); return __builtin_bit_cast(unsigned, b); }
DI float bf2f(unsigned short h) { return __uint_as_float((unsigned)h << 16); }
DI float bflo(unsigned w) { return __uint_as_float(w << 16); }
DI float bfhi(unsigned w) { return __uint_as_float(w & 0xffff0000u); }
DI float wave_sum(float v) {
#pragma unroll
    for (int o = 1; o < 64; o <<= 1) v += __shfl_xor(v, o);
    return v;
}
DI float xsum16(float x) { const unsigned u = __float_as_uint(x); const u32x2 r = __builtin_amdgcn_permlane16_swap(u, u, false, false); return __uint_as_float(r[0]) + __uint_as_float(r[1]); }
DI float xsum32(float x) { const unsigned u = __float_as_uint(x); const u32x2 r = __builtin_amdgcn_permlane32_swap(u, u, false, false); return __uint_as_float(r[0]) + __uint_as_float(r[1]); }
DI float xchg16(float x, bool odd_row) { const unsigned u = __float_as_uint(x); const u32x2 r = __builtin_amdgcn_permlane16_swap(u, u, false, false); return __uint_as_float(odd_row ? r[0] : r[1]); }
DI float sigmoidf_(float z) { return 1.0f / (1.0f + __expf(-z)); }
DI float log_sigmoidf_(float z) { return fminf(z, 0.f) - __logf(1.0f + __expf(-fabsf(z))); }
DI float siluf_(float z) { return z * __builtin_amdgcn_rcpf(1.0f + __builtin_amdgcn_exp2f(-LOG2E * z)); }
DI float gelu_tanh(float x) { const float u = 0.7978845608028654f * (x + 0.044715f * x * x * x); const float e = __expf(2.f * u); const float t = 1.f - 2.f / (e + 1.f); return 0.5f * x * (1.f + t); }

struct Args {
    const float* in[31];
    float* out;
    unsigned char* ws;
    int ph_lo, ph_hi;
};
namespace pg8 {
#define PG8_LAS __attribute__((address_space(3)))
typedef unsigned short bf16_t;
typedef short bf16x8 __attribute__((ext_vector_type(8)));
typedef float f32x4 __attribute__((ext_vector_type(4)));
typedef unsigned u32x4 __attribute__((ext_vector_type(4)));
constexpr int BM = 256, BK = 64, HALF = 128, HTB = HALF * BK * 2  , STAGE_BYTES = 8 * HTB, NXCD = 8, WGM = 8;

__host__ __device__ __forceinline__ int lds_byte(int r, int c) { const int st = (r >> 4) * 2 + (c >> 5), rr = r & 15, cc = c & 31, ob = rr * 64 + cc * 2; return st * 1024 + (ob ^ (((ob >> 9) & 1) << 5)); }
__host__ __device__ __forceinline__ void stage_rc(int b, int& R, int& C) { const int st = b / 1024, sb = b % 1024, swz = sb ^ (((sb >> 9) & 1) << 5); R = (st >> 1) * 16 + swz / 64; C = (st & 1) * 32 + (swz % 64) / 2; }
__host__ __device__ __forceinline__ int perm32(int rho) { const int n = rho >> 4, i = rho & 15; return 8 * (i >> 2) + 4 * n + (i & 3); }

struct Unit { int pm, pn, ko; };
struct Gemm { const bf16_t* A; const bf16_t* Bt; int M, N, K; int ld = 0; };

struct StaticOrder {
    static constexpr bool SLICED = false;
    int nM, nN, nwg, G, c;
    __host__ __device__ void init(int M, int N, int G_, int c_) { nM = M / BM; nN = N / BM; nwg = nM * nN; G = G_; c = c_; }
    __host__ __device__ bool next(int i, Unit& u) const {
        const long L = (long)i * G + c; if (L >= nwg) return false;
        int wgid = (int)L; { const int q = nwg / NXCD, r = nwg % NXCD, xcd = wgid % NXCD, off = wgid / NXCD; wgid = (xcd < r ? xcd * (q + 1) : r * (q + 1) + (xcd - r) * q) + off; }
        const int nig = WGM * nN, gid = wgid / nig, fm = gid * WGM, gsz = (nM - fm) < WGM ? (nM - fm) : WGM;
        u.pm = fm + ((wgid % nig) % gsz); u.pn = (wgid % nig) / gsz; return true;
    }
    __device__ __forceinline__ void a_ready(const Unit&) const {}
    __device__ __forceinline__ void done(const Unit&) const {}
};


#define EPI_ROWS(...) _Pragma("unroll") for (int ai = 0; ai < 2; ++ai) _Pragma("unroll") for (int m = 0; m < 4; ++m) { const int rowl = u.pm * BM + ai * HALF + wr * 64 + m * 16 + fr; __VA_ARGS__ }

struct EpiInA {
    static constexpr bool PERM = true, AFTER_DRAIN = false;
    bf16_t* projA; const float* rstd0; const float* cosT; const float* sinT;
    const float *qn, *kn, *fqn, *fkn, *gbias, *fbias; float* gate; float* logf;
    __device__ __forceinline__ void operator()(const f32x4 (&acc)[2][2][4][2], const Unit& u, int wr, int wc, int fr, int fq) const {
        const int s = u.pn * 4 + wc;
        if (s > 44) return;
        int kind = 0; const float* gain = qn; float scale = 1.f;
        if (s < 8) { kind = 2; gain = qn; scale = QSCALE; }
        else if (s < 12) { kind = 2; gain = kn; }
        else if (s < 20) { kind = 0; }
        else if (s < 28) { kind = 1; gain = fqn; scale = QSCALE; }
        else if (s < 36) { kind = 1; gain = fkn; }
        else if (s < 44) { kind = 0; }
        else kind = 3;
        float rsv[8];
#pragma unroll
        for (int q = 0; q < 8; ++q) rsv[q] = rstd0[u.pm * BM + (q >> 2) * HALF + wr * 64 + (q & 3) * 16 + fr];
        if (kind == 3) {
            EPI_ROWS(
                const float rs = rsv[ai * 4 + m];
                float v[8];
                _Pragma("unroll") for (int n = 0; n < 2; ++n) _Pragma("unroll") for (int e = 0; e < 4; ++e) v[n * 4 + e] = acc[ai][0][m][n][e] * rs;
                if (fq < 3) { float o[8]; _Pragma("unroll") for (int j = 0; j < 8; ++j) o[j] = sigmoidf_(v[j] + gbias[8 * fq + j]);
                    *(f32x4*)(gate + (size_t)rowl * 24 + 8 * fq) = (f32x4){o[0], o[1], o[2], o[3]}; *(f32x4*)(gate + (size_t)rowl * 24 + 8 * fq + 4) = (f32x4){o[4], o[5], o[6], o[7]}; }
                else { float o[8]; _Pragma("unroll") for (int j = 0; j < 8; ++j) o[j] = log_sigmoidf_(v[j] + fbias[j]);
                    _Pragma("unroll") for (int j = 0; j < 8; ++j) logf[((size_t)(rowl >> 12) * 8 + j) * SEQ + (rowl & (SEQ - 1))] = o[j]; }
            )
            return;
        }
        const bool do_norm = kind >= 1, do_rope = kind == 2;
        float g[16];
        { const float* gp = gain + 8 * fq; const f32x4 g0 = *(const f32x4*)gp, g1 = *(const f32x4*)(gp + 4), g2 = *(const f32x4*)(gp + 32), g3 = *(const f32x4*)(gp + 36);
#pragma unroll
          for (int i = 0; i < 4; ++i) { g[i] = do_norm ? g0[i] * scale : scale; g[4 + i] = do_norm ? g1[i] * scale : scale; g[8 + i] = do_norm ? g2[i] * scale : scale; g[12 + i] = do_norm ? g3[i] * scale : scale; } }
        const float ir[8] = {0.15915494309189535f, 0.03086376340470123f, 0.005985185712713705f, 0.001160663641240061f, 0.00022507907903927653f, 4.364795279280289e-05f, 8.464330808241401e-06f, 1.6414262627950345e-06f};
        const bool rope_lane = do_rope && fq < 2;
        EPI_ROWS(
            const float rs = rsv[ai * 4 + m];
            float v[16];
            _Pragma("unroll") for (int bj = 0; bj < 2; ++bj) _Pragma("unroll") for (int n = 0; n < 2; ++n) _Pragma("unroll") for (int e = 0; e < 4; ++e) v[bj * 8 + n * 4 + e] = acc[ai][bj][m][n][e];
            float sc = rs;
            if (do_norm) { float s0 = 0.f, s1 = 0.f;
                _Pragma("unroll") for (int i = 0; i < 16; i += 2) { s0 += v[i] * v[i]; s1 += v[i + 1] * v[i + 1]; }
                float ss = xsum32(xsum16(s0 + s1));
                sc = rs * rsqrtf(ss * (rs * rs) * (1.0f / 64.0f) + EPS); }
            _Pragma("unroll") for (int i = 0; i < 16; ++i) v[i] = v[i] * (sc * g[i]);
            if (do_rope) {
            float oth[8];
            _Pragma("unroll") for (int j = 0; j < 8; ++j) oth[j] = xchg16(v[j], (fq & 1) != 0);
            const float pos = rope_lane ? (float)(rowl & (SEQ - 1)) : 0.f;
            const float sgn = (fq == 0) ? -1.f : 1.f;
            _Pragma("unroll") for (int j = 0; j < 8; ++j) { const float rev = pos * ir[j]; const float fr_ = rev - floorf(rev); const float cc = __builtin_amdgcn_cosf(fr_), sn = __builtin_amdgcn_sinf(fr_) * sgn;
                v[j] = v[j] * cc + oth[j] * sn; }
            }
            bf16_t* dst = projA + (size_t)rowl * LDA + s * 64 + 8 * fq;
            _Pragma("unroll") for (int bj = 0; bj < 2; ++bj) { u32x4 w; w.x = ::cvtpk(v[bj * 8 + 0], v[bj * 8 + 1]); w.y = ::cvtpk(v[bj * 8 + 2], v[bj * 8 + 3]);
                w.z = ::cvtpk(v[bj * 8 + 4], v[bj * 8 + 5]); w.w = ::cvtpk(v[bj * 8 + 6], v[bj * 8 + 7]); *(u32x4*)(dst + 32 * bj) = w; }
        )
    }
};

__device__ __forceinline__ float row_rstd(const float* ssp, int row) { const f32x4* q = (const f32x4*)(ssp + (size_t)row * 16); const f32x4 a = q[0], b = q[1], c = q[2], d = q[3];
    const float s = (((a[0] + a[1]) + (a[2] + a[3])) + ((b[0] + b[1]) + (b[2] + b[3]))) + (((c[0] + c[1]) + (c[2] + c[3])) + ((d[0] + d[1]) + (d[2] + d[3]))); return rsqrtf(s * (1.0f / 1024.0f) + EPS); }
template <bool RES_F32> struct EpiResid {
    static constexpr bool PERM = true, AFTER_DRAIN = false;
    const void* res; bf16_t* outb; float* ss;
    __device__ __forceinline__ void operator()(const f32x4 (&acc)[2][2][4][2], const Unit& u, int wr, int wc, int fr, int fq) const {
        constexpr int MB = RES_F32 ? 2 : 4;
#pragma unroll
        for (int ai = 0; ai < 2; ++ai)
#pragma unroll
            for (int m0 = 0; m0 < 4; m0 += MB) {
                f32x4 r0[MB][2], r1[MB][2];
#pragma unroll
                for (int mm = 0; mm < MB; ++mm) { const int rowl = u.pm * BM + ai * HALF + wr * 64 + (m0 + mm) * 16 + fr; const size_t off = (size_t)rowl * DM + u.pn * BM + wc * 32 + 8 * fq;
#pragma unroll
                    for (int bj = 0; bj < 2; ++bj) {
                        if (RES_F32) { r0[mm][bj] = *(const f32x4*)((const float*)res + off + bj * HALF); r1[mm][bj] = *(const f32x4*)((const float*)res + off + bj * HALF + 4); }
                        else { const u32x4 rw = *(const u32x4*)((const bf16_t*)res + off + bj * HALF); r0[mm][bj] = (f32x4){bflo(rw.x), bfhi(rw.x), bflo(rw.y), bfhi(rw.y)}; r1[mm][bj] = (f32x4){bflo(rw.z), bfhi(rw.z), bflo(rw.w), bfhi(rw.w)}; } } }
#pragma unroll
                for (int mm = 0; mm < MB; ++mm) { const int m = m0 + mm; const int rowl = u.pm * BM + ai * HALF + wr * 64 + m * 16 + fr; const size_t off = (size_t)rowl * DM + u.pn * BM + wc * 32 + 8 * fq; float part = 0.f;
#pragma unroll
                    for (int bj = 0; bj < 2; ++bj) {
                        const f32x4 x0 = r0[mm][bj] + acc[ai][bj][m][0], x1 = r1[mm][bj] + acc[ai][bj][m][1];
                        u32x4 w; w.x = ::cvtpk(x0[0], x0[1]); w.y = ::cvtpk(x0[2], x0[3]); w.z = ::cvtpk(x1[0], x1[1]); w.w = ::cvtpk(x1[2], x1[3]); *(u32x4*)(outb + off + bj * HALF) = w;
                        part += (x0[0] * x0[0] + x0[1] * x0[1]) + (x0[2] * x0[2] + x0[3] * x0[3]) + (x1[0] * x1[0] + x1[1] * x1[1]) + (x1[2] * x1[2] + x1[3] * x1[3]);
                    }
                    part = xsum32(xsum16(part));
                    if (fq == 0 && ss) ss[(size_t)rowl * 16 + u.pn * 4 + wc] = part; }
            }
    }
};

template <bool MOE> struct EpiSwiglu {
    static constexpr bool PERM = true, AFTER_DRAIN = false;
    bf16_t* h; const float* rsrc; int row_off;
    __device__ __forceinline__ void operator()(const f32x4 (&acc)[2][2][4][2], const Unit& u, int wr, int wc, int fr, int fq) const {
        const int pnl = MOE ? (u.pn % 22) : u.pn;
        float rsv[8];
#pragma unroll
        for (int q = 0; q < 8; ++q) { const int rl = u.pm * BM + (q >> 2) * HALF + wr * 64 + (q & 3) * 16 + fr; rsv[q] = MOE ? rsrc[row_off + rl] : row_rstd(rsrc, rl); }
        EPI_ROWS(
            const float rs = rsv[ai * 4 + m]; const float c1 = -LOG2E * rs, kq = __builtin_amdgcn_rcpf(rs * rs);
            f32x4 o4[2];
            _Pragma("unroll") for (int n = 0; n < 2; ++n) { const f32x4 gg = acc[ai][0][m][n], uu = acc[ai][1][m][n]; const f32x4 a = gg * c1;
                const f32x4 ex = {__builtin_amdgcn_exp2f(a[0]), __builtin_amdgcn_exp2f(a[1]), __builtin_amdgcn_exp2f(a[2]), __builtin_amdgcn_exp2f(a[3])};
                const f32x4 d = ex * kq + kq;
                const f32x4 r = {__builtin_amdgcn_rcpf(d[0]), __builtin_amdgcn_rcpf(d[1]), __builtin_amdgcn_rcpf(d[2]), __builtin_amdgcn_rcpf(d[3])};
                o4[n] = (gg * uu) * r; }
            u32x4 w; w.x = ::cvtpk(o4[0][0], o4[0][1]); w.y = ::cvtpk(o4[0][2], o4[0][3]); w.z = ::cvtpk(o4[1][0], o4[1][1]); w.w = ::cvtpk(o4[1][2], o4[1][3]);
            *(u32x4*)(h + (size_t)rowl * DFF + pnl * 128 + wc * 32 + 8 * fq) = w;
        )
    }
};

struct EpiGlaIn {
    static constexpr bool PERM = true, AFTER_DRAIN = false;
    bf16_t* projC; const float* rstd2;
    __device__ __forceinline__ void operator()(const f32x4 (&acc)[2][2][4][2], const Unit& u, int wr, int wc, int fr, int fq) const {
        float rsv[8];
#pragma unroll
        for (int q = 0; q < 8; ++q) rsv[q] = rstd2[u.pm * BM + (q >> 2) * HALF + wr * 64 + (q & 3) * 16 + fr];
        EPI_ROWS(
            float rs = rsv[ai * 4 + m]; if (u.pn < 2) rs *= 0.08838834764831845f;
            _Pragma("unroll") for (int bj = 0; bj < 2; ++bj) { const f32x4 x0 = acc[ai][bj][m][0] * rs, x1 = acc[ai][bj][m][1] * rs;
                u32x4 w; w.x = ::cvtpk(x0[0], x0[1]); w.y = ::cvtpk(x0[2], x0[3]); w.z = ::cvtpk(x1[0], x1[1]); w.w = ::cvtpk(x1[2], x1[3]);
                *(u32x4*)(projC + (size_t)rowl * LDC + u.pn * BM + bj * HALF + wc * 32 + 8 * fq) = w; }
        )
    }
};

struct EpiMoeDown {
    static constexpr bool PERM = true, AFTER_DRAIN = false;
    bf16_t* xy; const float* rgate; const float* rkeep; int row_off;
    __device__ __forceinline__ void operator()(const f32x4 (&acc)[2][2][4][2], const Unit& u, int wr, int wc, int fr, int fq) const {
        const int pnl = u.pn & 3;
        float gv[8], kv[8];
#pragma unroll
        for (int q = 0; q < 8; ++q) { const int rg_ = row_off + u.pm * BM + (q >> 2) * HALF + wr * 64 + (q & 3) * 16 + fr; gv[q] = rgate[rg_]; kv[q] = rkeep[rg_]; }
#pragma unroll
        for (int ai = 0; ai < 2; ++ai) {
            u32x4 old4[4][2];
#pragma unroll
            for (int m = 0; m < 4; ++m) { const int rowg = row_off + u.pm * BM + ai * HALF + wr * 64 + m * 16 + fr;
#pragma unroll
                for (int bj = 0; bj < 2; ++bj) old4[m][bj] = *(const u32x4*)(xy + (size_t)rowg * DM + pnl * BM + bj * HALF + wc * 32 + 8 * fq); }
#pragma unroll
            for (int m = 0; m < 4; ++m) { const int rowg = row_off + u.pm * BM + ai * HALF + wr * 64 + m * 16 + fr; const float w8 = gv[ai * 4 + m], kp = kv[ai * 4 + m];
#pragma unroll
                for (int bj = 0; bj < 2; ++bj) {
                    bf16_t* dst = xy + (size_t)rowg * DM + pnl * BM + bj * HALF + wc * 32 + 8 * fq;
                    const u32x4 rw = old4[m][bj];
                    const f32x4 r0 = (f32x4){bflo(rw.x), bfhi(rw.x), bflo(rw.y), bfhi(rw.y)}, r1 = (f32x4){bflo(rw.z), bfhi(rw.z), bflo(rw.w), bfhi(rw.w)};
                    const f32x4 x0 = r0 * kp + acc[ai][bj][m][0] * w8, x1 = r1 * kp + acc[ai][bj][m][1] * w8;
                    u32x4 w; w.x = ::cvtpk(x0[0], x0[1]); w.y = ::cvtpk(x0[2], x0[3]); w.z = ::cvtpk(x1[0], x1[1]); w.w = ::cvtpk(x1[2], x1[3]);
                    *(u32x4*)dst = w; } }
        }
    }
};

struct GroupedOrder {
    static constexpr bool SLICED = false;
    StaticOrder so; const int* tile_e; int tile0, nN;
    __device__ __forceinline__ bool next(int i, Unit& u) const { if (!so.next(i, u)) return false; u.pn = __builtin_amdgcn_readfirstlane(tile_e[tile0 + u.pm]) * nN + u.pn; return true; }
    __device__ __forceinline__ void a_ready(const Unit&) const {}
    __device__ __forceinline__ void done(const Unit&) const {}
};

struct SliceOrder {
    static constexpr bool SLICED = true;
    const int* tile_e; int tile0  , xt0  , nunits, G, c;
    __device__ __forceinline__ bool next(int i, Unit& u) const { const int j = i * G + c; if (j >= nunits) return false;
        const int xt = j / 44, rem = j - xt * 44; u.pm = xt0 + xt; u.pn = __builtin_amdgcn_readfirstlane(tile_e[tile0 + u.pm]) * 4 + (rem & 3); u.ko = (rem >> 2) * 256; return true; }
    __device__ __forceinline__ void a_ready(const Unit&) const {}
    __device__ __forceinline__ void done(const Unit&) const {}
};
struct EpiMoePart {
    static constexpr bool PERM = true, AFTER_DRAIN = false;
    float* part; int xt0;
    __device__ __forceinline__ void operator()(const f32x4 (&acc)[2][2][4][2], const Unit& u, int wr, int wc, int fr, int fq) const {
        const int pnl = u.pn & 3, sl = u.ko >> 8;
#pragma unroll
        for (int ai = 0; ai < 2; ++ai)
#pragma unroll
            for (int m = 0; m < 4; ++m) { const int xr = (u.pm - xt0) * BM + ai * HALF + wr * 64 + m * 16 + fr;
                float* dst = part + ((size_t)xr * 11 + sl) * DM + pnl * BM + wc * 32 + 8 * fq;
#pragma unroll
                for (int bj = 0; bj < 2; ++bj) { *(f32x4*)(dst + bj * HALF) = acc[ai][bj][m][0]; *(f32x4*)(dst + bj * HALF + 4) = acc[ai][bj][m][1]; } }
    }
};
template <class Epi, class Sched, bool ALIGN_EPI = false, bool SP2 = false>
__device__ __forceinline__ void gemm_phase(PG8_LAS unsigned char* lds, const Gemm g, const Sched& S, const Epi& E) {
    int tid_l_ = threadIdx.x; asm volatile("" : "+v"(tid_l_)); const int tid = tid_l_, wid = __builtin_amdgcn_readfirstlane(tid >> 6), lane = tid & 63, wr = wid >> 2, wc = wid & 3, fr = lane & 15, fq = lane >> 4;
    const int K = g.ld ? g.ld : g.K  , nt = g.K / BK;
    unsigned voffA[2], voffB[2];
#pragma unroll
    for (int i = 0; i < 2; ++i) { int R, C; stage_rc(tid * 16 + i * 8192, R, C); const int Rb = Epi::PERM ? ((R & ~31) + perm32(R & 31)) : R;
        voffA[i] = (unsigned)(R * K + C) * 2u; voffB[i] = (unsigned)(Rb * K + C) * 2u; }
    const size_t kstep = (size_t)(BK * 2);
    const size_t hstep = (size_t)HALF * K * 2;
    const size_t tstep = 2 * hstep;
    const unsigned ldsw = (unsigned)wid * 1024u;
    const int aoff = lds_byte(wr * 64 + fr, fq * 8), boff = lds_byte(wc * 32 + fr, fq * 8);
#define PG8_SA(b, h) (((b) * 2 + (h)) * HTB)
#define PG8_SB(b, h) ((4 + (b) * 2 + (h)) * HTB)
#define PG8_STAGE(bufoff, gbase, voff) do { _Pragma("unroll") for (int _i = 0; _i < 2; ++_i) \
        __builtin_amdgcn_global_load_lds((const unsigned*)((const char*)(gbase) + (voff)[_i]), (PG8_LAS unsigned*)(lds + (bufoff) + ldsw + _i * 8192), 16, 0, 0); } while (0)
#define PG8_LDA(dst, b, h) do { _Pragma("unroll") for (int m = 0; m < 4; ++m) _Pragma("unroll") for (int k = 0; k < 2; ++k) dst[m][k] = *(const PG8_LAS bf16x8*)(lds + PG8_SA(b, h) + aoff + m * 2048 + k * 1024); } while (0)
#define PG8_LDB(dst, b, h) do { _Pragma("unroll") for (int n = 0; n < 2; ++n) _Pragma("unroll") for (int k = 0; k < 2; ++k) dst[n][k] = *(const PG8_LAS bf16x8*)(lds + PG8_SB(b, h) + boff + n * 2048 + k * 1024); } while (0)
#define PG8_MMA(ai, bj, At, Bt) do { __builtin_amdgcn_s_setprio(1); _Pragma("unroll") for (int m = 0; m < 4; ++m) _Pragma("unroll") for (int n = 0; n < 2; ++n) _Pragma("unroll") for (int k = 0; k < 2; ++k) \
        acc[ai][bj][m][n] = __builtin_amdgcn_mfma_f32_16x16x32_bf16(Bt[n][k], At[m][k], acc[ai][bj][m][n], 0, 0, 0); __builtin_amdgcn_s_setprio(0); } while (0)
#define PG8_WAIT_V(n) asm volatile("s_waitcnt vmcnt(" #n ")" ::: "memory")
#define PG8_WAIT_L(n) asm volatile("s_waitcnt lgkmcnt(" #n ")" ::: "memory")
#define PG8_BAR __builtin_amdgcn_s_barrier()
#define PG8_SCHED __builtin_amdgcn_sched_barrier(0)
    Unit cur, nxt; int ui = 0;
    if (!S.next(0, cur)) return;
    f32x4 acc[2][2][4][2];
#pragma unroll
    for (int a = 0; a < 2; ++a)
#pragma unroll
        for (int b = 0; b < 2; ++b)
#pragma unroll
            for (int m = 0; m < 4; ++m)
#pragma unroll
                for (int n = 0; n < 2; ++n) acc[a][b][m][n] = (f32x4){0.f, 0.f, 0.f, 0.f};
    bf16x8 At[4][2], B0[2][2], B1[2][2];
    const char* cA = (const char*)g.A + (size_t)cur.pm * tstep; const char* cB = (const char*)g.Bt + (size_t)cur.pn * tstep;
    if constexpr (Sched::SLICED) { cA += (size_t)cur.ko * 2; cB += (size_t)cur.ko * 2; }
    S.a_ready(cur);
    if constexpr (SP2) {
        PG8_STAGE(PG8_SB(0, 0), cB, voffB); PG8_STAGE(PG8_SB(0, 1), cB + hstep, voffB); PG8_STAGE(PG8_SA(0, 0), cA, voffA); PG8_STAGE(PG8_SA(0, 1), cA + hstep, voffA);
        if (wr == 1) PG8_BAR;
        PG8_WAIT_V(2); PG8_BAR;
        PG8_STAGE(PG8_SB(1, 0), cB + kstep, voffB); PG8_STAGE(PG8_SA(1, 0), cA + kstep, voffA); PG8_STAGE(PG8_SB(1, 1), cB + hstep + kstep, voffB);
        PG8_WAIT_V(6); PG8_BAR;
    } else {
        PG8_STAGE(PG8_SB(0, 0), cB, voffB); PG8_STAGE(PG8_SA(0, 0), cA, voffA); PG8_STAGE(PG8_SB(0, 1), cB + hstep, voffB); PG8_STAGE(PG8_SA(0, 1), cA + hstep, voffA);
        if (wr == 1) PG8_BAR;
        PG8_WAIT_V(4); PG8_BAR;
        PG8_STAGE(PG8_SB(1, 0), cB + kstep, voffB); PG8_STAGE(PG8_SA(1, 0), cA + kstep, voffA); PG8_STAGE(PG8_SB(1, 1), cB + hstep + kstep, voffB);
        PG8_WAIT_V(6); PG8_BAR;
    }
    for (;;) {
        const bool has_next = S.next(ui + 1, nxt);
        const char* nA = has_next ? (const char*)g.A + (size_t)nxt.pm * tstep + (Sched::SLICED ? (size_t)nxt.ko * 2 : (size_t)0) : cA; const char* nB = has_next ? (const char*)g.Bt + (size_t)nxt.pn * tstep + (Sched::SLICED ? (size_t)nxt.ko * 2 : (size_t)0) : cB;
        for (int t = 0; t < nt; t += 2) {
            const bool last = (t == nt - 2);
            const char* a1 = cA + (size_t)(t + 1) * kstep;
            const char* a2 = last ? nA : cA + (size_t)(t + 2) * kstep; const char* b2 = last ? nB : cB + (size_t)(t + 2) * kstep;
            const char* a3 = a2 + kstep; const char* b3 = b2 + kstep;
            if (last && has_next) S.a_ready(nxt);
            if constexpr (SP2) {
            PG8_LDB(B0, 0, 0); PG8_LDB(B1, 0, 1); PG8_SCHED; PG8_LDA(At, 0, 0); PG8_STAGE(PG8_SA(1, 1), a1 + hstep, voffA);
            PG8_WAIT_V(8); PG8_WAIT_L(0); PG8_BAR; PG8_MMA(0, 0, At, B0); PG8_MMA(0, 1, At, B1); PG8_BAR; PG8_SCHED;
            PG8_LDA(At, 0, 1); PG8_STAGE(PG8_SB(0, 0), b2, voffB); PG8_STAGE(PG8_SB(0, 1), b2 + hstep, voffB); PG8_STAGE(PG8_SA(0, 0), a2, voffA);
            PG8_WAIT_V(8); PG8_WAIT_L(0); PG8_BAR; PG8_MMA(1, 0, At, B0); PG8_MMA(1, 1, At, B1); PG8_BAR; PG8_SCHED;
            PG8_LDB(B0, 1, 0); PG8_LDB(B1, 1, 1); PG8_SCHED; PG8_LDA(At, 1, 0); PG8_STAGE(PG8_SA(0, 1), a2 + hstep, voffA);
            PG8_WAIT_V(8); PG8_WAIT_L(0); PG8_BAR; PG8_MMA(0, 0, At, B0); PG8_MMA(0, 1, At, B1); PG8_BAR; PG8_SCHED;
            PG8_LDA(At, 1, 1); PG8_STAGE(PG8_SB(1, 0), b3, voffB); PG8_STAGE(PG8_SB(1, 1), b3 + hstep, voffB); PG8_STAGE(PG8_SA(1, 0), a3, voffA);
            PG8_WAIT_V(8); PG8_WAIT_L(0); PG8_BAR; PG8_MMA(1, 0, At, B0); PG8_MMA(1, 1, At, B1); PG8_BAR; PG8_SCHED;
            } else {
            PG8_LDB(B0, 0, 0); PG8_SCHED; PG8_LDA(At, 0, 0); PG8_STAGE(PG8_SA(1, 1), a1 + hstep, voffA);
            PG8_WAIT_L(8); PG8_BAR; PG8_WAIT_L(0); PG8_MMA(0, 0, At, B0); PG8_BAR; PG8_SCHED;
            PG8_LDB(B1, 0, 1); PG8_STAGE(PG8_SB(0, 0), b2, voffB);
            PG8_BAR; PG8_WAIT_L(0); PG8_MMA(0, 1, At, B1); PG8_BAR;
            PG8_LDA(At, 0, 1); PG8_STAGE(PG8_SA(0, 0), a2, voffA);
            PG8_BAR; PG8_WAIT_L(0); PG8_MMA(1, 0, At, B0); PG8_BAR; PG8_SCHED;
            PG8_STAGE(PG8_SB(0, 1), b2 + hstep, voffB);
            PG8_WAIT_V(6); PG8_BAR; PG8_MMA(1, 1, At, B1); PG8_BAR;
            PG8_LDB(B0, 1, 0); PG8_SCHED; PG8_LDA(At, 1, 0); PG8_STAGE(PG8_SA(0, 1), a2 + hstep, voffA);
            PG8_WAIT_L(8); PG8_BAR; PG8_WAIT_L(0); PG8_MMA(0, 0, At, B0); PG8_BAR; PG8_SCHED;
            PG8_LDB(B1, 1, 1); PG8_STAGE(PG8_SB(1, 0), b3, voffB);
            PG8_BAR; PG8_WAIT_L(0); PG8_MMA(0, 1, At, B1); PG8_BAR;
            PG8_LDA(At, 1, 1); PG8_STAGE(PG8_SA(1, 0), a3, voffA);
            PG8_BAR; PG8_WAIT_L(0); PG8_MMA(1, 0, At, B0); PG8_BAR; PG8_SCHED;
            PG8_STAGE(PG8_SB(1, 1), b3 + hstep, voffB);
            PG8_WAIT_V(6); PG8_BAR; PG8_MMA(1, 1, At, B1); PG8_BAR;
            }
        }
        if constexpr (ALIGN_EPI) { if (wr == 0) PG8_BAR; }
        if constexpr (!Epi::AFTER_DRAIN) { E(acc, cur, wr, wc, fr, fq);
            S.done(cur); }
        if (!has_next) break;
#pragma unroll
        for (int a = 0; a < 2; ++a)
#pragma unroll
            for (int b = 0; b < 2; ++b)
#pragma unroll
                for (int m = 0; m < 4; ++m)
#pragma unroll
                    for (int n = 0; n < 2; ++n) acc[a][b][m][n] = (f32x4){0.f, 0.f, 0.f, 0.f};
        cur = nxt; cA = nA; cB = nB; ++ui;
        if constexpr (ALIGN_EPI) { if (wr == 1) PG8_BAR; }
    }
    PG8_WAIT_V(0);
    if constexpr (!ALIGN_EPI) { if (wr == 0) PG8_BAR; }
    PG8_BAR;
    if constexpr (Epi::AFTER_DRAIN) { E.fused(acc, cur, wr, wc, fr, fq, lds, wid, lane); S.done(cur); }
#undef PG8_SA
#undef PG8_SB
#undef PG8_STAGE
#undef PG8_LDA
#undef PG8_LDB
#undef PG8_MMA
#undef PG8_WAIT_V
#undef PG8_WAIT_L
#undef PG8_BAR
#undef PG8_SCHED
}
}

namespace att {
constexpr int A_KV = 0, A_KB = 49152, A_WS = 49920, A_MASK = 51968, A_SHQ = 52480, A_IMP = 53248, A_OC = 119808, A_IVC = 152576;
DI constexpr int crc(int r) { return (r & 3) + 8 * (r >> 2); }
constexpr int IMP_LD = 65;
DI int crow(int r, int hi) { return (r & 3) + 8 * (r >> 2) + 4 * hi; }
#define MFMA32(a, b, c) __builtin_amdgcn_mfma_f32_32x32x16_bf16((a), (b), (c), 0, 0, 0)

struct KVRegs { u32x4 k, v; float kb; };
struct Sweep {
    const bf16_t* K; const bf16_t* V; int ld;
    const float* kbias;
};
DI void kv_issue(KVRegs& r, const Sweep& s, int tile, int tid) {
    const int key = tid & 63, ch = tid >> 6;
    const size_t row0 = (size_t)tile * 64;
    r.k = *(const u32x4*)(s.K + (row0 + key) * s.ld + ch * 8);
    const int p = tid >> 6, l = tid & 63; const int row = 16 * (p & 3) + (l >> 2), col = (p >> 2) * 32 + (l & 3) * 8;
    r.v = *(const u32x4*)(s.V + (row0 + row) * s.ld + col);
    r.kb = (s.kbias && tid < 64) ? s.kbias[row0 + tid] : 0.f;
}
DI void kv_commit(const KVRegs& r, LAS char* lds, int slot, int tid, bool has_kb) {
    LAS char* sl = lds + A_KV + slot * 16384;
    *(LAS u32x4*)(sl + (tid >> 6) * 1024 + (tid & 63) * 16) = r.k;
    *(LAS u32x4*)(sl + 8192 + tid * 16) = r.v;
    if (has_kb && tid < 64) *(LAS float*)(lds + A_KB + slot * 256 + tid * 4) = r.kb;
}
DI void glds16(const void* gsrc, unsigned lds_dst) { unsigned keep;
    asm volatile("s_mov_b32 %0, m0\n\ts_mov_b32 m0, %2\n\ts_nop 0\n\tglobal_load_lds_dwordx4 %1, off\n\ts_mov_b32 m0, %0" : "=&s"(keep) : "v"(gsrc), "s"(lds_dst) : "memory"); }
DI void glds4(const void* gsrc, unsigned lds_dst) { unsigned keep;
    asm volatile("s_mov_b32 %0, m0\n\ts_mov_b32 m0, %2\n\ts_nop 0\n\tglobal_load_lds_dword %1, off\n\ts_mov_b32 m0, %0" : "=&s"(keep) : "v"(gsrc), "s"(lds_dst) : "memory"); }
DI void kv_dma(const Sweep& s, int tile, LAS char* lds, int slot, int tid, int wid, bool has_kb) {
    const int l = tid & 63;
    const size_t row0 = (size_t)tile * 64;
    const bf16_t* ksrc = s.K + (row0 + l) * s.ld + wid * 8;
    const bf16_t* vsrc = s.V + (row0 + 16 * (wid & 3) + (l >> 2)) * s.ld + (wid >> 2) * 32 + (l & 3) * 8;
    const unsigned sl = (unsigned)__builtin_amdgcn_readfirstlane((int)(unsigned)(uintptr_t)(lds + A_KV + slot * 16384 + wid * 1024));
    glds16(ksrc, sl);
    glds16(vsrc, sl + 8192);
    if (has_kb) glds4(s.kbias + row0 + l, (unsigned)__builtin_amdgcn_readfirstlane((int)(unsigned)(uintptr_t)(lds + A_KB + slot * 256)));
}
struct FState { float m, l; f32x16 o0, o1, la, negm; };
DI float max3f(float a, float b, float c) { float r; asm("v_max3_f32 %0, %1, %2, %3" : "=v"(r) : "v"(a), "v"(b), "v"(c)); return r; }
DI void fs_init(FState& s) { s.m = 0.f; s.l = 0.f;

#pragma unroll
    for (int r = 0; r < 16; ++r) { s.o0[r] = 0.f; s.o1[r] = 0.f; s.la[r] = 0.f; s.negm[r] = 0.f; } }

DI void qk_tile(f32x16& p0, f32x16& p1, const f32x16& c0, const f32x16& c1, const LAS char* Ks, const bf16x8 (&qr)[4], int r32, int hi) {
    const LAS char* kb = Ks + hi * 1024 + r32 * 16;
    bf16x8 kf[8];
#pragma unroll
    for (int d0 = 0; d0 < 4; ++d0) { kf[2 * d0] = *(const LAS bf16x8*)(kb + d0 * 2048); kf[2 * d0 + 1] = *(const LAS bf16x8*)(kb + d0 * 2048 + 512); }
    __builtin_amdgcn_s_setprio(1);
#pragma unroll
    for (int d0 = 0; d0 < 4; ++d0) {
        if (d0 == 0) { p0 = MFMA32(kf[0], qr[0], c0); p1 = MFMA32(kf[1], qr[0], c1); }
        else { p0 = MFMA32(kf[2 * d0], qr[d0], p0); p1 = MFMA32(kf[2 * d0 + 1], qr[d0], p1); }
    }
    __builtin_amdgcn_s_setprio(0);
}
DI s16x4 vtr(const LAS char* p) { typedef short v4i16_t __attribute__((ext_vector_type(4))); return __builtin_bit_cast(s16x4, __builtin_amdgcn_ds_read_tr16_b64_v4i16((LAS v4i16_t*)p)); }

template <bool NOMAX, bool SUML> DI void softmax_pv(FState& s, f32x16& p0, f32x16& p1, const LAS char* Vs, LAS float* wsf, int lane, int r32, int hi) {
    if (!NOMAX) {
        asm volatile("s_nop 15\n\ts_nop 7" : "+v"(p0), "+v"(p1));
        float rm = max3f(p0[0], p0[1], p1[0]), rm2 = max3f(p0[2], p0[3], p1[1]);
        rm = max3f(rm, p1[2], p1[3]);
#pragma unroll
        for (int r = 4; r < 16; r += 4) { rm = max3f(rm, p0[r], p0[r + 1]); rm2 = max3f(rm2, p0[r + 2], p0[r + 3]); rm = max3f(rm, p1[r], p1[r + 1]); rm2 = max3f(rm2, p1[r + 2], p1[r + 3]); }
        rm = fmaxf(rm, rm2);
        rm = fmaxf(rm, __shfl_xor(rm, 32));
        if (__any(rm > 8.0f)) {
            const float dl = fmaxf(rm, 0.f);
            s.m += dl; const float alpha = __builtin_amdgcn_exp2f(-dl);
#pragma unroll
            for (int r = 0; r < 16; ++r) s.negm[r] = -s.m;
#pragma unroll
            for (int r = 0; r < 16; ++r) { p0[r] -= dl; p1[r] -= dl; }
            if (hi == 0) wsf[r32] = alpha;
#pragma unroll
            for (int r = 0; r < 16; ++r) { const float a = wsf[crow(r, hi)]; s.o0[r] *= a; s.o1[r] *= a; s.la[r] *= a; }
            if (SUML) s.l *= alpha;
        }
    }
#pragma unroll
    for (int r = 0; r < 16; ++r) { p0[r] = __builtin_amdgcn_exp2f(p0[r]); p1[r] = __builtin_amdgcn_exp2f(p1[r]); }
    if (SUML) { float sum = 0.f;
#pragma unroll
        for (int r = 0; r < 16; ++r) sum += p0[r] + p1[r];
        s.l += sum; }
    u32x4 pw[4];
    pw[0] = (u32x4){cvtpk(p0[0], p0[1]), cvtpk(p0[2], p0[3]), cvtpk(p0[4], p0[5]), cvtpk(p0[6], p0[7])};
    pw[1] = (u32x4){cvtpk(p0[8], p0[9]), cvtpk(p0[10], p0[11]), cvtpk(p0[12], p0[13]), cvtpk(p0[14], p0[15])};
    pw[2] = (u32x4){cvtpk(p1[0], p1[1]), cvtpk(p1[2], p1[3]), cvtpk(p1[4], p1[5]), cvtpk(p1[6], p1[7])};
    pw[3] = (u32x4){cvtpk(p1[8], p1[9]), cvtpk(p1[10], p1[11]), cvtpk(p1[12], p1[13]), cvtpk(p1[14], p1[15])};
    const bf16x8 ones = (bf16x8){0x3F80, 0x3F80, 0x3F80, 0x3F80, 0x3F80, 0x3F80, 0x3F80, 0x3F80};
    const LAS char* vp = Vs + ((lane >> 4) & 1) * 32 + (lane & 3) * 8 + (4 * hi + ((lane & 15) >> 2)) * 64;
#pragma unroll
    for (int ks = 0; ks < 4; ++ks) {
        const bf16x8 pa = __builtin_bit_cast(bf16x8, pw[ks]);
        { const s16x4 lo = vtr(vp + ks * 1024), hh = vtr(vp + ks * 1024 + 512); const bf16x8 vf = (bf16x8){lo[0], lo[1], lo[2], lo[3], hh[0], hh[1], hh[2], hh[3]}; s.o0 = MFMA32(pa, vf, s.o0); }
        { const s16x4 lo = vtr(vp + 4096 + ks * 1024), hh = vtr(vp + 4096 + ks * 1024 + 512); const bf16x8 vf = (bf16x8){lo[0], lo[1], lo[2], lo[3], hh[0], hh[1], hh[2], hh[3]}; s.o1 = MFMA32(pa, vf, s.o1); }
        s.la = MFMA32(pa, ones, s.la);
    }
}
template <int MODE> DI float fs_finish(const FState& s, const float (&gr)[16], LAS float* wsf, LAS char* stg_bf, LAS char* stg_f32, int r32, int hi) {
    LAS bf16_t* sb = (LAS bf16_t*)stg_bf; LAS float* sf = (LAS float*)stg_f32;
#pragma unroll
    for (int r = 0; r < 16; ++r) {
        const int orow = crow(r, hi); const float lt = s.la[r]; const float inv = lt > 0.f ? __builtin_amdgcn_rcpf(lt) : 0.f; const float f = inv * gr[r];
        float c0 = s.o0[r] * f, c1 = s.o1[r] * f;
        if (MODE == 1) { c0 += bf2f(sb[orow * 64 + r32]); c1 += bf2f(sb[orow * 64 + 32 + r32]); sf[orow * 64 + r32] = c0; sf[orow * 64 + 32 + r32] = c1; }
        else { if (MODE == 2) { c0 += sf[orow * 64 + r32]; c1 += sf[orow * 64 + 32 + r32]; }
            sb[orow * 64 + r32] = (bf16_t)(cvtpk(c0, 0.f) & 0xffffu); sb[orow * 64 + 32 + r32] = (bf16_t)(cvtpk(c1, 0.f) & 0xffffu); }
    }
    if (MODE == 0) { const float lt = s.l + __shfl_xor(s.l, 32); return lt > 0.f ? 1.0f / lt : 0.f; }
    return 0.f;
}
DI void store_o(bf16_t* Orow0  , int ldo, const LAS char* stg, int lane) {
#pragma unroll
    for (int i = 0; i < 4; ++i) { const int row = i * 8 + (lane >> 3), ch = lane & 7; const u32x4 v = *(const LAS u32x4*)(stg + row * 128 + ch * 16); *(u32x4*)(Orow0 + (size_t)row * ldo + ch * 8) = v; }
}

struct BrP { int cur; int tq; int tt; unsigned long long msk, anym; int jlo, jhi; int fox_lim, fox_lo; float m_c, inv_c; int head_l, tok_l; };
template <int BR> DI int next_tile(const BrP& b, int j) {
    ++j;
    if (BR == 1) { while (j <= b.jhi && !((b.anym >> j) & 1ull)) ++j; }
    return j <= b.jhi ? j : -1;
}
template <int BR, bool NOMAX> DI void sweep(FState& st, const Sweep& sw, const BrP& b, const bf16x8 (&qr)[4], LAS char* lds, LAS float* wsf, int tid, int lane, int r32, int hi, float& carry) {
    const int wid_ = __builtin_amdgcn_readfirstlane(tid >> 6);
#define ATT_WAIT_BAR(n) asm volatile("s_waitcnt vmcnt(" #n ") lgkmcnt(0)\n\ts_barrier" ::: "memory")
#define ATT_END_TILE(more) do { if (more) { if (BR == 3) ATT_WAIT_BAR(3); else ATT_WAIT_BAR(2); } else ATT_WAIT_BAR(0); } while (0)
    int j = next_tile<BR>(b, b.jlo - 1);
    if (j < 0) return;
    int jn = next_tile<BR>(b, j);
    kv_dma(sw, j, lds, 0, tid, wid_, BR == 3);
    if (jn >= 0) kv_dma(sw, jn, lds, 1, tid, wid_, BR == 3);
    ATT_END_TILE(jn >= 0);
    int slot = 0;
    while (j >= 0) {
        const int jn2 = jn >= 0 ? next_tile<BR>(b, jn) : -1;
        if (jn2 >= 0) kv_dma(sw, jn2, lds, slot >= 1 ? slot - 1 : 2, tid, wid_, BR == 3);
        const LAS char* Ks = lds + A_KV + slot * 16384; const LAS char* Vs = Ks + 8192;
        bool active = true;
        if (BR == 3) active = (j <= b.fox_lim) && (j >= b.fox_lo);
        if (active) {
            f32x16 p0, p1;
            const float NEG = -__builtin_inff();
            if (BR == 3) {
                f32x16 c0, c1;
                const LAS float* kb = (const LAS float*)(lds + A_KB + slot * 256);
#pragma unroll
                for (int i = 0; i < 4; ++i) { const f32x4 k0 = *(const LAS f32x4*)(kb + 8 * i + 4 * hi), k1 = *(const LAS f32x4*)(kb + 32 + 8 * i + 4 * hi);
#pragma unroll
                    for (int e = 0; e < 4; ++e) { c0[4 * i + e] = k0[e] + st.negm[4 * i + e]; c1[4 * i + e] = k1[e] + st.negm[4 * i + e]; } }
                qk_tile(p0, p1, c0, c1, Ks, qr, r32, hi);
            } else if (BR == 1) {
                f32x16 cs; const bool sel = (b.msk >> j) & 1ull;
#pragma unroll
                for (int r = 0; r < 16; ++r) cs[r] = sel ? (NOMAX ? 0.f : st.negm[r]) : NEG;
                qk_tile(p0, p1, cs, cs, Ks, qr, r32, hi);
            } else if (NOMAX) {
                f32x16 z;
#pragma unroll
                for (int r = 0; r < 16; ++r) z[r] = 0.f;
                qk_tile(p0, p1, z, z, Ks, qr, r32, hi);
            } else qk_tile(p0, p1, st.negm, st.negm, Ks, qr, r32, hi);
            int tth = b.tt - 4 * hi; asm volatile("" : "+v"(tth));
            if (BR == 0 || BR == 4) {
                int lim = ((b.tq - 31) >> 4) - 64 * j - 4 * hi; asm volatile("" : "+v"(lim));
#pragma unroll
                for (int r = 0; r < 16; ++r) { if (crc(r) > lim) p0[r] = NEG; if (crc(r) + 32 > lim) p1[r] = NEG; }
            } else if (BR == 1) {
                if (j == b.cur) {
#pragma unroll
                    for (int r = 0; r < 16; ++r) { if (crc(r) > tth) p0[r] = NEG; if (crc(r) + 32 > tth) p1[r] = NEG; }
                }
            } else if (BR == 2) {
                if (j == b.cur) {
#pragma unroll
                    for (int r = 0; r < 16; ++r) { if (crc(r) > tth) p0[r] = NEG; if (crc(r) + 32 > tth) p1[r] = NEG; }
                } else if (j == b.cur - 8) {
#pragma unroll
                    for (int r = 0; r < 16; ++r) { if (crc(r) <= tth) p0[r] = NEG; if (crc(r) + 32 <= tth) p1[r] = NEG; }
                }
            } else if (BR == 3) {
                if (j == b.fox_lim) {
#pragma unroll
                    for (int r = 0; r < 16; ++r) { if (crc(r) > tth) p0[r] = NEG; if (crc(r) + 32 > tth) p1[r] = NEG; }
                }
            }
            if (BR != 4) softmax_pv<NOMAX, BR == 0>(st, p0, p1, Vs, wsf, lane, r32, hi);
            if (BR == 4 || (BR == 0 && NOMAX)) {
                const float scl = (BR == 4) ? b.inv_c : 1.0f;
                float G[8], H[8];
#pragma unroll
                for (int i = 0; i < 4; ++i) {
                    float a[4], c[4];
#pragma unroll
                    for (int e = 0; e < 4; ++e) { a[e] = (BR == 4 ? __builtin_amdgcn_exp2f(p0[4 * i + e]) : p0[4 * i + e]) * scl; c[e] = (BR == 4 ? __builtin_amdgcn_exp2f(p1[4 * i + e]) : p1[4 * i + e]) * scl; }
                    H[i] = 0.5f * a[3]; G[i] = a[0] + a[1] + a[2] + H[i]; H[4 + i] = 0.5f * c[3]; G[4 + i] = c[0] + c[1] + c[2] + H[4 + i];
                }
                float Hp[8];
#pragma unroll
                for (int k = 0; k < 8; ++k) Hp[k] = __shfl_xor(H[k], 32);
                LAS float* imp = (LAS float*)(lds + A_IMP) + (b.head_l * 64 + b.tok_l) * IMP_LD + 16 * j;
#pragma unroll
                for (int k = 0; k < 8; ++k) {
                    const float prev = (hi == 1) ? Hp[k] : (k == 0 ? carry : Hp[k - 1]);
                    const int sidx = (k < 4) ? (2 * k + hi) : (8 + 2 * (k - 4) + hi);
                    imp[sidx] = G[k] + prev;
                }
                carry = Hp[7];
            }
        }
        ATT_END_TILE(jn2 >= 0);
        slot = slot == 2 ? 0 : slot + 1; j = jn; jn = jn2;
    }
#undef ATT_WAIT_BAR
#undef ATT_END_TILE
}

struct Tensors {
    const bf16_t* projA; const bf16_t* kcmp; const bf16_t* vcmp; const float* gate; const float* cumneg; bf16_t* O; const float* fqn; const float* fkn; const float* aqn; const float* akn;
};

template <bool NOMAX> DI void nsa_unit(const Tensors& T_, int b, int g, int qt, LAS char* lds) {
    int tid_ = threadIdx.x; asm volatile("" : "+v"(tid_));
    const int tid = tid_, lane = tid & 63, r32 = lane & 31, hi = lane >> 5, wid = __builtin_amdgcn_readfirstlane(tid >> 6);
    LAS float* wsf = (LAS float*)(lds + A_WS) + wid * 64;
    const int head_l = wid >> 1, head = 4 * g + head_l, tok_l = 32 * (wid & 1) + r32;
    const int tq = 64 * qt + tok_l;
    const size_t rowq = (size_t)b * SEQ + tq;
    bf16x8 qr[4];
#pragma unroll
    for (int d0 = 0; d0 < 4; ++d0) qr[d0] = *(const bf16x8*)(T_.projA + rowq * LDA + PA_QA + head * 64 + d0 * 16 + hi * 8);
    LAS char* stg_bf = lds + A_OC + wid * 4096; LAS char* stg_f32 = lds + A_IMP + wid * 8192;
    const size_t rowbase = (size_t)b * SEQ + 64 * qt + 32 * (wid & 1);
    float gr[16];
    BrP bp; bp.cur = qt; bp.tq = tq; bp.tt = tok_l; bp.msk = 0; bp.anym = 0; bp.fox_lim = 0; bp.fox_lo = 0; bp.head_l = head_l; bp.tok_l = tok_l; bp.m_c = 0.f; bp.inv_c = 0.f;
    float carry = 0.f;
    {
        Sweep sw; sw.K = T_.kcmp + ((size_t)b * NCMP_PAD * 2 + g) * 64; sw.V = T_.vcmp + ((size_t)b * NCMP_PAD * 2 + g) * 64; sw.ld = 128; sw.kbias = nullptr;
        const int ntc = (4 * qt + 2) / 64 + 1;
        bp.jlo = 0; bp.jhi = ntc - 1;
        FState st; fs_init(st);
        LAS float* imp = (LAS float*)(lds + A_IMP) + (head_l * 64 + tok_l) * IMP_LD;
        for (int s2 = 16 * ntc + hi; s2 < 64; s2 += 2) imp[s2] = 0.f;
        carry = 0.f;
#pragma unroll
        for (int r = 0; r < 16; ++r) gr[r] = T_.gate[(rowbase + crow(r, hi)) * 24 + 3 * head + 0];
        sweep<0, NOMAX>(st, sw, bp, qr, lds, wsf, tid, lane, r32, hi, carry);
        bp.inv_c = fs_finish<0>(st, gr, wsf, stg_bf, stg_f32, r32, hi); bp.m_c = st.m;
        if (hi == 0) ((LAS float*)(lds + A_IVC))[head_l * 64 + tok_l] = NOMAX ? bp.inv_c : 1.0f;
        if (!NOMAX) { carry = 0.f; sweep<4, NOMAX>(st, sw, bp, qr, lds, wsf, tid, lane, r32, hi, carry); }
    }
    __syncthreads();
    {
        LAS float* imp = (LAS float*)(lds + A_IMP); const LAS float* ivc = (const LAS float*)(lds + A_IVC);
        const int tok = tid >> 3, part = tid & 7;
        float v[8];
#pragma unroll
        for (int k = 0; k < 8; ++k) { const int s2 = 8 * part + k;
            float x = ((imp[(0 * 64 + tok) * IMP_LD + s2] * ivc[tok] + imp[(1 * 64 + tok) * IMP_LD + s2] * ivc[64 + tok]) + imp[(2 * 64 + tok) * IMP_LD + s2] * ivc[128 + tok]) + imp[(3 * 64 + tok) * IMP_LD + s2] * ivc[192 + tok];
            if (s2 == 0 || s2 == qt || s2 == qt - 1) x = 1e6f; else if (s2 > qt) x = -1e6f;
            v[k] = x; }
        __syncthreads();
#pragma unroll
        for (int k = 0; k < 8; ++k) imp[tok * IMP_LD + 8 * part + k] = v[k];
        __syncthreads();
        int rank[8];
#pragma unroll
        for (int k = 0; k < 8; ++k) rank[k] = 0;
        for (int s2 = 0; s2 <= qt; ++s2) { const float x = imp[tok * IMP_LD + s2];
#pragma unroll
            for (int k = 0; k < 8; ++k) rank[k] += (x > v[k] || (x == v[k] && s2 < 8 * part + k)) ? 1 : 0; }
        unsigned byte = 0;
#pragma unroll
        for (int k = 0; k < 8; ++k) byte |= (rank[k] < 16 ? 1u : 0u) << k;
        ((LAS unsigned char*)(lds + A_MASK))[tok * 8 + part] = (unsigned char)byte;
        __syncthreads();
        const LAS unsigned long long* mk = (const LAS unsigned long long*)(lds + A_MASK);
        bp.msk = mk[tok_l];
        unsigned long long am = mk[lane];
        unsigned lo = (unsigned)am, hh = (unsigned)(am >> 32);
#pragma unroll
        for (int o = 1; o < 64; o <<= 1) { lo |= (unsigned)__shfl_xor((int)lo, o); hh |= (unsigned)__shfl_xor((int)hh, o); }
        bp.anym = ((unsigned long long)(unsigned)__builtin_amdgcn_readfirstlane((int)hh) << 32) | (unsigned)__builtin_amdgcn_readfirstlane((int)lo);
    }
    {
        Sweep sw; sw.K = T_.projA + (size_t)b * SEQ * LDA + PA_KSL + g * 64; sw.V = T_.projA + (size_t)b * SEQ * LDA + PA_VSL + g * 64; sw.ld = LDA; sw.kbias = nullptr;
        bp.jlo = 0; bp.jhi = qt;
        FState st; fs_init(st);
#pragma unroll
        for (int r = 0; r < 16; ++r) gr[r] = T_.gate[(rowbase + crow(r, hi)) * 24 + 3 * head + 1];
        sweep<1, NOMAX>(st, sw, bp, qr, lds, wsf, tid, lane, r32, hi, carry);
        fs_finish<1>(st, gr, wsf, stg_bf, stg_f32, r32, hi);
    }
    {
        Sweep sw; sw.K = T_.projA + (size_t)b * SEQ * LDA + PA_KWN + g * 64; sw.V = T_.projA + (size_t)b * SEQ * LDA + PA_VWN + g * 64; sw.ld = LDA; sw.kbias = nullptr;
        bp.jlo = qt - 8 < 0 ? 0 : qt - 8; bp.jhi = qt;
        FState st; fs_init(st);
#pragma unroll
        for (int r = 0; r < 16; ++r) gr[r] = T_.gate[(rowbase + crow(r, hi)) * 24 + 3 * head + 2];
        sweep<2, NOMAX>(st, sw, bp, qr, lds, wsf, tid, lane, r32, hi, carry);
        fs_finish<2>(st, gr, wsf, stg_bf, stg_f32, r32, hi);
    }
    store_o(T_.O + rowbase * DM + head * 64, DM, stg_bf, lane);
    __syncthreads();
}

DI void fox_unit(const Tensors& T_, int b, int h, int qb, LAS char* lds) {
    int tid_ = threadIdx.x; asm volatile("" : "+v"(tid_));
    const int tid = tid_, lane = tid & 63, r32 = lane & 31, hi = lane >> 5, wid = __builtin_amdgcn_readfirstlane(tid >> 6);
    LAS float* wsf = (LAS float*)(lds + A_WS) + wid * 64;
    const int tq = 256 * qb + 32 * wid + r32;
    const size_t rowq = (size_t)b * SEQ + tq;
    bf16x8 qr[4];
#pragma unroll
    for (int d0 = 0; d0 < 4; ++d0) qr[d0] = *(const bf16x8*)(T_.projA + rowq * LDA + PA_QB + h * 64 + d0 * 16 + hi * 8);
    LAS char* stg_bf = lds + A_OC + wid * 4096;
    BrP bp; bp.cur = 0; bp.tq = tq; bp.tt = 32 * (wid & 1) + r32; bp.msk = 0; bp.anym = 0; bp.head_l = 0; bp.tok_l = 0; bp.m_c = 0.f; bp.inv_c = 0.f;
    bp.jlo = 0; bp.jhi = 4 * qb + 3; bp.fox_lim = 4 * qb + (wid >> 1);
    {
        float gq = fabsf(T_.fqn[lane]), gk = fabsf(T_.fkn[lane]);
#pragma unroll
        for (int o = 1; o < 64; o <<= 1) { gq = fmaxf(gq, __shfl_xor(gq, o)); gk = fmaxf(gk, __shfl_xor(gk, o)); }
        const float need = 2.0f * 11.66f * gq * gk + 40.0f;
        const float* kbp = T_.cumneg + ((size_t)b * FOX_H + h) * SEQ;
        const float kb0 = kbp[256 * qb];
        const bool needed = (lane <= bp.jhi) && (kb0 - kbp[64 * lane + 63] <= need);
        const unsigned long long bal = __ballot(needed);
        bp.jlo = bal ? (int)__builtin_ctzll(bal) : 0;
        const bool needed_w = (lane <= bp.jhi) && (kbp[256 * qb + 32 * wid] - kbp[64 * lane + 63] <= need);
        const unsigned long long balw = __ballot(needed_w);
        bp.fox_lo = balw ? (int)__builtin_ctzll(balw) : 0;
    }
    Sweep sw; sw.K = T_.projA + (size_t)b * SEQ * LDA + PA_KB + h * 64; sw.V = T_.projA + (size_t)b * SEQ * LDA + PA_VB + h * 64; sw.ld = LDA;
    sw.kbias = T_.cumneg + ((size_t)b * FOX_H + h) * SEQ;
    FState st; fs_init(st);
    float carry = 0.f;
    sweep<3, false>(st, sw, bp, qr, lds, wsf, tid, lane, r32, hi, carry);
    float gr[16];
#pragma unroll
    for (int r = 0; r < 16; ++r) gr[r] = 1.f;
    fs_finish<3>(st, gr, wsf, stg_bf, stg_bf, r32, hi);
    const size_t rowbase = (size_t)b * SEQ + 256 * qb + 32 * wid;
    store_o(T_.O + rowbase * DM + 512 + h * 64, DM, stg_bf, lane);
    __syncthreads();
}

DI void attn_phase(const Tensors& T_, unsigned* ctr, LAS char* lds) {
    LAS int* shq = (LAS int*)(lds + A_SHQ);
    bool nomax;
    { const int lane = threadIdx.x & 63; float gq = fabsf(T_.aqn[lane]), gk = fabsf(T_.akn[lane]);
#pragma unroll
      for (int o = 1; o < 64; o <<= 1) { gq = fmaxf(gq, __shfl_xor(gq, o)); gk = fmaxf(gk, __shfl_xor(gk, o)); }
      nomax = __builtin_amdgcn_readfirstlane((int)(11.66f * gq * gk < 50.0f)) != 0; }
    for (;;) {
        if (threadIdx.x == 0) shq[0] = (int)__hip_atomic_fetch_add(ctr, 1u, __ATOMIC_RELAXED, __HIP_MEMORY_SCOPE_AGENT);
        __syncthreads();
        const int i = __builtin_amdgcn_readfirstlane(shq[0]);
        __syncthreads();
        if (i >= 2048) break;
        if (i < 1024) { if (nomax) nsa_unit<true>(T_, (i & 15) >> 1, i & 1, 63 - (i >> 4), lds); else nsa_unit<false>(T_, (i & 15) >> 1, i & 1, 63 - (i >> 4), lds); }
        else { const int r = i - 1024; fox_unit(T_, (r & 63) >> 3, r & 7, 15 - (r >> 6), lds); }
    }
}
}

namespace gla {
constexpr int G_A1 = 0, G_QI = 4096, G_QR = 20480, G_KR = 36864, G_KH = 53248, G_V = 69632, G_BQ = 73728, G_ST = 77824, G_DEC = 94208;
DI int swo(int row, int colbyte) { return row * 256 + (colbyte ^ ((row & 15) << 4)); }
using att::crow; using att::vtr;

struct GlaT { bf16_t* projC; const float* a1; const float* w_a2; const float* b_a; bf16_t* O; bf16_t* att; float* dec; };

DI void gla_a1_item(const bf16_t* xb, const bf16_t* wa1t  , const float* ss2, float* a1, int item, LAS char* lds) {
    int tid_l_ = threadIdx.x; asm volatile("" : "+v"(tid_l_)); const int tid = tid_l_, lane = tid & 63, r32 = lane & 31, hi = lane >> 5, wid = __builtin_amdgcn_readfirstlane(tid >> 6);
    const int rg = wid & 3, kh = wid >> 2;
    const size_t row0 = (size_t)item * 128 + 32 * rg;
    const bf16_t* ap = xb + (row0 + r32) * DM + 512 * kh + 8 * hi;
    const bf16_t* bp = wa1t + (size_t)(r32 & 15) * DM + 512 * kh + 8 * hi;
    f32x16 c;
#pragma unroll
    for (int r = 0; r < 16; ++r) c[r] = 0.f;
#pragma unroll 8
    for (int ks = 0; ks < 32; ++ks) {
        const bf16x8 A = *(const bf16x8*)(ap + 16 * ks);
        bf16x8 B = *(const bf16x8*)(bp + 16 * ks);
        if (r32 >= 16) B = (bf16x8){0, 0, 0, 0, 0, 0, 0, 0};
        c = MFMA32(A, B, c);
    }
    LAS float* red = (LAS float*)lds + rg * 1024;
    if (kh == 1) {
#pragma unroll
        for (int r = 0; r < 16; ++r) red[crow(r, hi) * 32 + r32] = c[r];
    }
    __syncthreads();
    if (kh == 0 && r32 < 16) {
#pragma unroll
        for (int r = 0; r < 16; ++r) { const int rw = crow(r, hi); const size_t grow = row0 + rw;
            a1[grow * 16 + r32] = (c[r] + red[rw * 32 + r32]) * pg8::row_rstd(ss2, (int)grow); }
    }
    __syncthreads();
}

constexpr int P_A1 = 0, P_QR = 4096, P_KR = 20480, P_BQ = 36864;
struct PrepRegs { unsigned q[8], k[8]; f32x4 a1; };
DI void prep_load(PrepRegs& R, const GlaT& G, int item, int tid) {
    const int ch = item & 63, h = (item >> 6) & 3, b = item >> 8, d0 = 2 * (tid & 63), tg = tid >> 6;
    const size_t rb = (size_t)b * SEQ + 64 * ch;
#pragma unroll
    for (int c8 = 0; c8 < 8; ++c8) { const size_t rw = rb + 8 * tg + c8; R.q[c8] = *(const unsigned*)(G.projC + rw * LDC + PC_Q + h * 128 + d0); R.k[c8] = *(const unsigned*)(G.projC + rw * LDC + PC_K + h * 128 + d0); }
    R.a1 = (tid < 256) ? *(const f32x4*)(G.a1 + (rb + (tid >> 2)) * 16 + (tid & 3) * 4) : (f32x4){0.f, 0.f, 0.f, 0.f};
}
DI void gla_prep(const GlaT& G, int item, const PrepRegs& R, LAS char* lds) {
    int tid_l_ = threadIdx.x; asm volatile("" : "+v"(tid_l_)); const int tid = tid_l_, lane = tid & 63, r32 = lane & 31, hi = lane >> 5, wid = __builtin_amdgcn_readfirstlane(tid >> 6);
    const int ch = item & 63, h = (item >> 6) & 3, b = item >> 8;
    const int dp = tid & 63, tg = wid, d0 = 2 * dp;
    const size_t rb = (size_t)b * SEQ + 64 * ch;
    unsigned qraw[8], kraw[8];
#pragma unroll
    for (int c8 = 0; c8 < 8; ++c8) { qraw[c8] = R.q[c8]; kraw[c8] = R.k[c8]; }
    if (tid < 256) *(LAS f32x4*)(lds + P_A1 + tid * 16) = R.a1;
    float w2a[16], w2b[16];
#pragma unroll
    for (int r = 0; r < 16; ++r) { const f32x2 w = *(const f32x2*)(G.w_a2 + r * 512 + h * 128 + d0); w2a[r] = w[0]; w2b[r] = w[1]; }
    const f32x2 bav = *(const f32x2*)(G.b_a + h * 128 + d0);
    __syncthreads();
    float lp0[8], lp1[8]; float run0 = 0.f, run1 = 0.f;
#pragma unroll
    for (int c8 = 0; c8 < 8; ++c8) {
        const LAS f32x4* ar = (const LAS f32x4*)(lds + P_A1 + (8 * tg + c8) * 64);
        float z0 = bav[0], z1 = bav[1];
#pragma unroll
        for (int q4 = 0; q4 < 4; ++q4) { const f32x4 a = ar[q4];
#pragma unroll
            for (int e = 0; e < 4; ++e) { z0 += a[e] * w2a[4 * q4 + e]; z1 += a[e] * w2b[4 * q4 + e]; } }
        const float l0 = fminf(z0, 0.f) - __logf(1.0f + __expf(-fabsf(z0))), l1 = fminf(z1, 0.f) - __logf(1.0f + __expf(-fabsf(z1)));
        run0 += l0 * (1.0f / 16.0f); run1 += l1 * (1.0f / 16.0f);
        lp0[c8] = run0; lp1[c8] = run1;
    }
    *(LAS f32x2*)(lds + P_BQ + tg * 512 + d0 * 4) = (f32x2){run0, run1};
    __syncthreads();
    {
        float off0 = 0.f, off1 = 0.f, ref0 = 0.f, ref1 = 0.f, last0 = 0.f, last1 = 0.f;
#pragma unroll
        for (int t8 = 0; t8 < 8; ++t8) { const f32x2 q = *(const LAS f32x2*)(lds + P_BQ + t8 * 512 + d0 * 4);
            if (t8 < tg) { off0 += q[0]; off1 += q[1]; } if (t8 < 4) { ref0 += q[0]; ref1 += q[1]; } last0 += q[0]; last1 += q[1]; }
        const float emr0 = __expf(-ref0), emr1 = __expf(-ref1), epr0 = __expf(ref0), epr1 = __expf(ref1), epl0 = __expf(last0), epl1 = __expf(last1);
#pragma unroll
        for (int c8 = 0; c8 < 8; ++c8) {
            const int c = 8 * tg + c8;
            const float eb0 = __expf(off0 + lp0[c8]), eb1 = __expf(off1 + lp1[c8]);
            const float ib0 = __builtin_amdgcn_rcpf(eb0), ib1 = __builtin_amdgcn_rcpf(eb1);
            const float q0 = bflo(qraw[c8]), q1 = bfhi(qraw[c8]), k0 = bflo(kraw[c8]), k1 = bfhi(kraw[c8]);
            const float qi0 = q0 * eb0, qi1 = q1 * eb1, kb0 = k0 * ib0, kb1 = k1 * ib1;
            const int o = swo(c, 4 * dp);
            *(LAS unsigned*)(lds + P_QR + o) = cvtpk(qi0 * emr0, qi1 * emr1);
            *(LAS unsigned*)(lds + P_KR + o) = cvtpk(kb0 * epr0, kb1 * epr1);
            const size_t rw = rb + c;
            *(unsigned*)(G.projC + rw * LDC + PC_Q + h * 128 + d0) = cvtpk(qi0, qi1);
            *(unsigned*)(G.projC + rw * LDC + PC_K + h * 128 + d0) = cvtpk(kb0 * epl0, kb1 * epl1);
        }
        if (tg == 0) *(f32x2*)(G.dec + (size_t)item * 128 + d0) = (f32x2){epl0, epl1};
    }
    __syncthreads();
    if (wid < 3) {
        const int jt = wid == 2 ? 1 : 0, it = wid == 0 ? 0 : 1;
        f32x16 X;
#pragma unroll
        for (int r = 0; r < 16; ++r) X[r] = 0.f;
#pragma unroll
        for (int ks = 0; ks < 8; ++ks) {
            const bf16x8 A = *(const LAS bf16x8*)(lds + P_KR + swo(32 * jt + r32, (16 * ks + 8 * hi) * 2));
            const bf16x8 B = *(const LAS bf16x8*)(lds + P_QR + swo(32 * it + r32, (16 * ks + 8 * hi) * 2));
            X = MFMA32(A, B, X);
        }
        if (jt == it) {
#pragma unroll
            for (int r = 0; r < 16; ++r) if (att::crc(r) > r32 - 4 * hi) X[r] = 0.f;
        }
        bf16_t* ap = G.att + (size_t)item * 4096 + (32 * it + r32) * 64 + 32 * jt + 4 * hi;
#pragma unroll
        for (int g4 = 0; g4 < 4; ++g4) *(u32x2*)(ap + 8 * g4) = (u32x2){cvtpk(X[4 * g4], X[4 * g4 + 1]), cvtpk(X[4 * g4 + 2], X[4 * g4 + 3])};
    }
    __syncthreads();
}

constexpr int R_QI = 0, R_KH = 16384, R_ATT = 32768, R_V = 40960, R_DEC = 45056, R_BUF = 45568, R_ST = 2 * R_BUF;
DI void gla_unit(const GlaT& G, int b, int h, int es, LAS char* lds) {
    int tid_l_ = threadIdx.x; asm volatile("" : "+v"(tid_l_)); const int tid = tid_l_, lane = tid & 63, r32 = lane & 31, hi = lane >> 5, wid = __builtin_amdgcn_readfirstlane(tid >> 6);
    f32x16 S;
#pragma unroll
    for (int r = 0; r < 16; ++r) S[r] = 0.f;
    *(LAS u32x4*)(lds + R_ST + tid * 16) = (u32x4){0u, 0u, 0u, 0u};
    const size_t row00 = (size_t)b * SEQ;
    const int lrow = tid >> 3, lc = tid & 7;
    struct GlaRegs { u32x4 q0, q1, k0, k1, a, v; };
    GlaRegs RA, RB;
#define GLA_LOAD(R_, ch) do { const size_t rw_ = row00 + 64 * (ch) + lrow; const bf16_t* pq_ = G.projC + rw_ * LDC + h * 128 + lc * 8; \
        R_.q0 = *(const u32x4*)(pq_ + PC_Q); R_.q1 = *(const u32x4*)(pq_ + PC_Q + 64); R_.k0 = *(const u32x4*)(pq_ + PC_K); R_.k1 = *(const u32x4*)(pq_ + PC_K + 64); \
        R_.a = *(const u32x4*)(G.att + ((size_t)((b * 4 + h) * 64 + (ch))) * 4096 + tid * 8); \
        if (tid < 256) R_.v = *(const u32x4*)(G.projC + (row00 + 64 * (ch) + (tid >> 2)) * LDC + PC_V + h * 256 + 32 * es + (tid & 3) * 8); \
        else if (tid < 288) R_.v = *(const u32x4*)(G.dec + ((size_t)((b * 4 + h) * 64 + (ch))) * 128 + (tid - 256) * 4); } while (0)
#define GLA_COMMIT(R_, buf) do { LAS char* bb_ = lds + (buf) * R_BUF; \
        *(LAS u32x4*)(bb_ + R_QI + swo(lrow, lc * 16)) = R_.q0; *(LAS u32x4*)(bb_ + R_QI + swo(lrow, (lc + 8) * 16)) = R_.q1; \
        *(LAS u32x4*)(bb_ + R_KH + swo(lrow, lc * 16)) = R_.k0; *(LAS u32x4*)(bb_ + R_KH + swo(lrow, (lc + 8) * 16)) = R_.k1; \
        *(LAS u32x4*)(bb_ + R_ATT + lrow * 128 + ((lc ^ (lrow & 7)) * 16)) = R_.a; \
        if (tid < 256) *(LAS u32x4*)(bb_ + R_V + tid * 16) = R_.v; else if (tid < 288) *(LAS u32x4*)(bb_ + R_DEC + (tid - 256) * 16) = R_.v; } while (0)
    auto step = [&](const int ch, const int par) __attribute__((always_inline)) {
        const LAS char* bb = lds + par * R_BUF;
        const size_t rowc = row00 + 64 * ch;
        if (wid < 2) {
            const int it = wid;
            f32x16 oacc;
#pragma unroll
            for (int r = 0; r < 16; ++r) oacc[r] = 0.f;
#pragma unroll
            for (int s = 0; s < 4; ++s) {
                if (s < 2 || it == 1) {
                    const int i = 32 * it + r32;
                    const bf16x8 A = *(const LAS bf16x8*)(bb + R_ATT + i * 128 + (((2 * s + hi) ^ (i & 7)) * 16));
                    const LAS char* vb = bb + R_V + (16 * s + 8 * hi + ((lane & 15) >> 2)) * 64 + ((lane >> 4) & 1) * 32 + (lane & 3) * 8;
                    const s16x4 lo = vtr(vb), hh = vtr(vb + 256);
                    const bf16x8 vf = (bf16x8){lo[0], lo[1], lo[2], lo[3], hh[0], hh[1], hh[2], hh[3]};
                    oacc = MFMA32(A, vf, oacc);
                }
            }
#pragma unroll
            for (int ks = 0; ks < 8; ++ks) {
                const bf16x8 A = *(const LAS bf16x8*)(bb + R_QI + swo(32 * it + r32, (16 * ks + 8 * hi) * 2));
                const bf16x8 B = *(const LAS bf16x8*)(lds + R_ST + par * 8192 + swo(r32, (16 * ks + 8 * hi) * 2));
                oacc = MFMA32(A, B, oacc);
            }
            LAS bf16_t* stg = (LAS bf16_t*)(lds + R_ST + 16384) + it * 1024;
#pragma unroll
            for (int r = 0; r < 16; ++r) stg[crow(r, hi) * 32 + r32] = (bf16_t)(cvtpk(oacc[r], 0.f) & 0xffffu);
#pragma unroll
            for (int i = 0; i < 2; ++i) { const int pc = lane + 64 * i, row = pc >> 2, q4 = pc & 3; const u32x4 v = *(const LAS u32x4*)(stg + row * 32 + q4 * 8);
                *(u32x4*)(G.O + (rowc + 32 * it + row) * DM + h * 256 + 32 * es + q4 * 8) = v; }
        } else if (wid >= 4) {
            const int dt = wid - 4;
            const LAS float* dec = (const LAS float*)(bb + R_DEC) + 32 * dt;
#pragma unroll
            for (int i = 0; i < 4; ++i) { const f32x4 dv = *(const LAS f32x4*)(dec + 8 * i + 4 * hi);
#pragma unroll
                for (int e = 0; e < 4; ++e) S[4 * i + e] *= dv[e]; }
#pragma unroll
            for (int s = 0; s < 4; ++s) {
                const int cq = 16 * s + 4 * hi + ((lane & 15) >> 2), colb = (32 * dt + 16 * ((lane >> 4) & 1) + 4 * (lane & 3)) * 2;
                const s16x4 alo = vtr(bb + R_KH + swo(cq, colb)), ahh = vtr(bb + R_KH + swo(cq + 8, colb));
                const LAS char* vb = bb + R_V + cq * 64 + ((lane >> 4) & 1) * 32 + (lane & 3) * 8;
                const s16x4 lo = vtr(vb), hh = vtr(vb + 512);
                const bf16x8 af = (bf16x8){alo[0], alo[1], alo[2], alo[3], ahh[0], ahh[1], ahh[2], ahh[3]};
                const bf16x8 vf = (bf16x8){lo[0], lo[1], lo[2], lo[3], hh[0], hh[1], hh[2], hh[3]};
                S = MFMA32(af, vf, S);
            }
#pragma unroll
            for (int i = 0; i < 4; ++i)
                *(LAS u32x2*)(lds + R_ST + (par ^ 1) * 8192 + swo(r32, (32 * dt + 8 * i + 4 * hi) * 2)) = (u32x2){cvtpk(S[4 * i], S[4 * i + 1]), cvtpk(S[4 * i + 2], S[4 * i + 3])};
        }
    };
    GLA_LOAD(RA, 0); GLA_COMMIT(RA, 0); GLA_LOAD(RA, 1); GLA_LOAD(RB, 2);
    __syncthreads();
#pragma unroll 1
    for (int ch = 0; ch < 64; ch += 2) {
        step(ch, 0);
        GLA_COMMIT(RA, 1);
        { const int c3 = ch + 3 < 64 ? ch + 3 : 63; GLA_LOAD(RA, c3); }
        asm volatile("s_waitcnt lgkmcnt(0)" ::: "memory"); __builtin_amdgcn_s_barrier();
        step(ch + 1, 1);
        GLA_COMMIT(RB, 0);
        { const int c4 = ch + 4 < 64 ? ch + 4 : 63; GLA_LOAD(RB, c4); }
        asm volatile("s_waitcnt lgkmcnt(0)" ::: "memory"); __builtin_amdgcn_s_barrier();
    }
#undef GLA_LOAD
#undef GLA_COMMIT
}

DI void gla_gate_rows2(bf16_t* O, const bf16_t* R, const float* gain, int m0, int lane) {
    u32x4 o0[2], o1[2], r0[2], r1[2];
#pragma unroll
    for (int u = 0; u < 2; ++u) { const bf16_t* Orow = O + (size_t)(m0 + u) * DM; const bf16_t* Rrow = R + (size_t)(m0 + u) * LDC;
        o0[u] = *(const u32x4*)(Orow + lane * 16); o1[u] = *(const u32x4*)(Orow + lane * 16 + 8); r0[u] = *(const u32x4*)(Rrow + lane * 16); r1[u] = *(const u32x4*)(Rrow + lane * 16 + 8); }
    const int c0 = (lane & 15) * 16;
    float gn[16];
#pragma unroll
    for (int i = 0; i < 4; ++i) { const f32x4 g4 = *(const f32x4*)(gain + c0 + 4 * i); gn[4 * i] = g4[0]; gn[4 * i + 1] = g4[1]; gn[4 * i + 2] = g4[2]; gn[4 * i + 3] = g4[3]; }
#pragma unroll
    for (int u = 0; u < 2; ++u) {
        float o[16], rr[16];
#pragma unroll
        for (int i = 0; i < 4; ++i) { o[2 * i] = bflo(o0[u][i]); o[2 * i + 1] = bfhi(o0[u][i]); o[8 + 2 * i] = bflo(o1[u][i]); o[8 + 2 * i + 1] = bfhi(o1[u][i]);
            rr[2 * i] = bflo(r0[u][i]); rr[2 * i + 1] = bfhi(r0[u][i]); rr[8 + 2 * i] = bflo(r1[u][i]); rr[8 + 2 * i + 1] = bfhi(r1[u][i]); }
        float ss = 0.f;
#pragma unroll
        for (int i = 0; i < 16; ++i) ss += o[i] * o[i];
        ss += __shfl_xor(ss, 1); ss += __shfl_xor(ss, 2); ss += __shfl_xor(ss, 4); ss += __shfl_xor(ss, 8);
        const float rs = rsqrtf(ss * (1.0f / 256.0f) + EPS);
        unsigned w[8];
#pragma unroll
        for (int i = 0; i < 8; ++i) { const float x0 = o[2 * i] * rs * gn[2 * i] * siluf_(rr[2 * i]), x1 = o[2 * i + 1] * rs * gn[2 * i + 1] * siluf_(rr[2 * i + 1]); w[i] = cvtpk(x0, x1); }
        bf16_t* Orow = O + (size_t)(m0 + u) * DM;
        *(u32x4*)(Orow + lane * 16) = (u32x4){w[0], w[1], w[2], w[3]}; *(u32x4*)(Orow + lane * 16 + 8) = (u32x4){w[4], w[5], w[6], w[7]};
    }
}
}

struct Ptrs {
    const float* in[31]; float* out; unsigned char* ws;
    DI bf16_t* bf(size_t off) const { return (bf16_t*)(ws + off); }
    DI float* f32(size_t off) const { return (float*)(ws + off); }
    DI int* i32(size_t off) const { return (int*)(ws + off); }
};
enum { I_X = 0, I_ANORM, I_AWIN, I_AQN, I_AKN, I_APEK, I_APEV, I_CK1, I_CK2, I_CV1, I_CV2, I_GBIAS, I_FQN, I_FKN, I_FFB, I_AWOUT, I_FNORM, I_FWG, I_FWU, I_FWD,
       I_CNORM, I_CWIN, I_CWA2, I_CBA, I_CONORM, I_CWOUT, I_MNORM, I_MROUTER, I_MWG, I_MWU, I_MWD };

namespace pro {
struct ConvM { const float* src; const float* src2; const float* gain; bf16_t* dst; int K, Ns, Nd, mode; };
DI int srccolA(int n) {
    const int pn = n >> 8, bj = (n >> 7) & 1, wc = (n >> 5) & 3, j = n & 31, s = 4 * pn + wc, d = 32 * bj + j;
    if (s < 8) return 64 * s + d;
    if (s < 10) return 768 + 64 * (s - 8) + d;
    if (s < 12) return 1024 + 64 * (s - 10) + d;
    if (s < 14) return 896 + 64 * (s - 12) + d;
    if (s < 16) return 1152 + 64 * (s - 14) + d;
    if (s < 18) return 512 + 64 * (s - 16) + d;
    if (s < 20) return 640 + 64 * (s - 18) + d;
    if (s < 28) return 1304 + 64 * (s - 20) + d;
    if (s < 36) return 1816 + 64 * (s - 28) + d;
    if (s < 44) return 2328 + 64 * (s - 36) + d;
    if (s == 44) { if (d < 24) return 1280 + d; if (d < 32) return 2840 + d - 24; }
    return -1;
}
DI void conv_item(const ConvM& M, int item, LAS float* scr, int lane) {
    const int nblk = M.Nd / 32, kb = item / nblk, nb = item % nblk, k0 = 64 * kb, n0 = 32 * nb;
    const int n = n0 + (lane & 31);
    const float* sp = M.src; int col = n;
    if (M.mode == 0) { if (n >= M.Ns) col = -1; }
    else if (M.mode == 1) col = srccolA(n);
    else { const int pn = n >> 8, half = (n >> 7) & 1, j = n & 127; sp = half ? M.src2 : M.src; col = 128 * pn + j; }
#pragma unroll 8
    for (int i = 0; i < 32; ++i) { const int kk = 2 * i + (lane >> 5); float w = 0.f; if (col >= 0) w = sp[(size_t)(k0 + kk) * M.Ns + col]; if (M.gain) w *= M.gain[k0 + kk]; scr[kk * 33 + (lane & 31)] = w; }
    const int c = lane & 7;
#pragma unroll
    for (int j = 0; j < 4; ++j) { const int nn = (lane >> 3) + 8 * j; const LAS float* s = scr + (8 * c) * 33 + nn;
        u32x4 o; o.x = cvtpk(s[0 * 33], s[1 * 33]); o.y = cvtpk(s[2 * 33], s[3 * 33]); o.z = cvtpk(s[4 * 33], s[5 * 33]); o.w = cvtpk(s[6 * 33], s[7 * 33]);
        *(u32x4*)(M.dst + (size_t)(n0 + nn) * M.K + k0 + 8 * c) = o; }
}
struct ConvRegs { f32x4 v[8]; };
DI void conv_big_load(ConvRegs& R, const ConvM& M, int item, int wid, int lane) {
    const int nblk = M.Nd / 256, kb = item / nblk, nb = item % nblk;
    const int k0 = 64 * kb + 8 * wid, n = 256 * nb + 4 * lane;
    const float* sp = M.src; int col = n;
    if (M.mode == 0) { if (n >= M.Ns) col = -1; }
    else if (M.mode == 1) col = srccolA(n);
    else { const int pn = n >> 8, half = (n >> 7) & 1, j = n & 127; sp = half ? M.src2 : M.src; col = 128 * pn + j; }
#pragma unroll
    for (int j = 0; j < 8; ++j) R.v[j] = (col >= 0) ? *(const f32x4*)(sp + (size_t)(k0 + j) * M.Ns + col) : (f32x4){0.f, 0.f, 0.f, 0.f};
}
DI void conv_big_store(ConvRegs& R, const ConvM& M, int item, LAS char* tile, int tid, int wid, int lane) {
    const int nblk = M.Nd / 256, kb = item / nblk, nb = item % nblk;
    if (M.gain) { const int k0 = 64 * kb + 8 * wid;
#pragma unroll
        for (int j = 0; j < 8; ++j) R.v[j] = R.v[j] * M.gain[k0 + j]; }
#pragma unroll
    for (int c = 0; c < 4; ++c) { u32x4 o; o.x = cvtpk(R.v[0][c], R.v[1][c]); o.y = cvtpk(R.v[2][c], R.v[3][c]); o.z = cvtpk(R.v[4][c], R.v[5][c]); o.w = cvtpk(R.v[6][c], R.v[7][c]);
        const int nl = 4 * lane + c; *(LAS u32x4*)(tile + nl * 128 + ((wid ^ (lane & 7)) * 16)) = o; }
    __syncthreads();
#pragma unroll
    for (int i = 0; i < 4; ++i) { const int r = (tid >> 3) + 64 * i, ch = tid & 7; const u32x4 o = *(const LAS u32x4*)(tile + r * 128 + ((ch ^ ((r >> 2) & 7)) * 16));
        *(u32x4*)(M.dst + (size_t)(256 * nb + r) * M.K + 64 * kb + 8 * ch) = o; }
    __syncthreads();
}
DI ConvM conv_desc(const Ptrs& P, int mat) {
    ConvM M; M.src2 = nullptr; M.gain = nullptr; M.mode = 0;
    switch (mat) {
    case 0: M.src = P.in[I_AWIN]; M.gain = P.in[I_ANORM]; M.dst = P.bf(WS_WA); M.K = 1024; M.Ns = IN_A; M.Nd = NA_PAD; M.mode = 1; break;
    case 1: M.src = P.in[I_AWOUT]; M.dst = P.bf(WS_WO); M.K = 1024; M.Ns = 1024; M.Nd = 1024; break;
    case 2: M.src = P.in[I_FWG]; M.src2 = P.in[I_FWU]; M.gain = P.in[I_FNORM]; M.dst = P.bf(WS_WFGU); M.K = 1024; M.Ns = DFF; M.Nd = 2 * DFF; M.mode = 2; break;
    case 3: M.src = P.in[I_FWD]; M.dst = P.bf(WS_WFD); M.K = DFF; M.Ns = 1024; M.Nd = 1024; break;
    case 4: M.src = P.in[I_CWIN]; M.gain = P.in[I_CNORM]; M.dst = P.bf(WS_WC); M.K = 1024; M.Ns = IN_C; M.Nd = NC_PAD; break;
    case 5: M.src = P.in[I_CWOUT]; M.dst = P.bf(WS_WCO); M.K = 1024; M.Ns = 1024; M.Nd = 1024; break;
    case 6: M.src = P.in[I_CK1]; M.dst = P.bf(CT_CW); M.K = 2048; M.Ns = 64; M.Nd = 64; break;
    case 7: M.src = P.in[I_CV1]; M.dst = P.bf(CT_CW + 262144); M.K = 2048; M.Ns = 64; M.Nd = 64; break;
    case 8: M.src = P.in[I_CK2]; M.dst = P.bf(CT_CW + 524288); M.K = 64; M.Ns = 64; M.Nd = 64; break;
    case 9: M.src = P.in[I_CV2]; M.dst = P.bf(CT_CW + 524288 + 8192); M.K = 64; M.Ns = 64; M.Nd = 64; break;
    default:
        if (mat < 18) { const int e = mat - 10; M.src = P.in[I_MWG] + (size_t)e * 1024 * DFF; M.src2 = P.in[I_MWU] + (size_t)e * 1024 * DFF; M.gain = P.in[I_MNORM];
            M.dst = P.bf(WS_WMGU) + (size_t)e * 2 * DFF * 1024; M.K = 1024; M.Ns = DFF; M.Nd = 2 * DFF; M.mode = 2; }
        else { const int e = mat - 18; M.src = P.in[I_MWD] + (size_t)e * DFF * 1024; M.dst = P.bf(WS_WMD) + (size_t)e * 1024 * DFF; M.K = DFF; M.Ns = 1024; M.Nd = 1024; }
    }
    return M;
}
DI int conv_items(int mat) {
    switch (mat) { case 0: return 16 * 12; case 1: return 16 * 4; case 2: return 16 * 22; case 3: return 44 * 4; case 4: return 16 * 13; case 5: return 16 * 4;
                   case 6: case 7: return 32 * 2; case 8: case 9: return 2; default: return mat < 18 ? 16 * 22 : 44 * 4; }
}
DI void prologue(const Ptrs& P, LAS char* lds) {
    int tid_l_ = threadIdx.x; asm volatile("" : "+v"(tid_l_)); const int tid = tid_l_, lane = tid & 63, wid = __builtin_amdgcn_readfirstlane(tid >> 6);
    const int gw = blockIdx.x * 8 + wid, NGW = gridDim.x * 8;
    LAS float* scr = (LAS float*)(lds + wid * 16384);
    {
        ConvRegs Ra, Rb; ConvM Ma, Mb; int ia = -1, ib = -1;
        int g = blockIdx.x, mat = 25, base = 0;
        auto advance = [&](ConvM& M, int& it) {
            it = -1;
            while (mat >= 0) {
                if (mat >= 6 && mat <= 9) { --mat; continue; }
                const int ni = conv_items(mat);
                if (g - base < ni) { M = conv_desc(P, mat); it = g - base; g += gridDim.x; return; }
                base += ni; --mat;
            }
        };
        advance(Ma, ia); if (ia >= 0) conv_big_load(Ra, Ma, ia, wid, lane);
        while (ia >= 0) {
            advance(Mb, ib); if (ib >= 0) conv_big_load(Rb, Mb, ib, wid, lane);
            conv_big_store(Ra, Ma, ia, lds + 65536 + 2048, tid, wid, lane);
            if (ib < 0) break;
            advance(Ma, ia); if (ia >= 0) conv_big_load(Ra, Ma, ia, wid, lane);
            conv_big_store(Rb, Mb, ib, lds + 65536 + 2048, tid, wid, lane);
        }
        for (int m2 = 6; m2 <= 9; ++m2) { const ConvM M = conv_desc(P, m2); const int ni = conv_items(m2); for (int it = gw; it < ni; it += NGW) conv_item(M, it, scr, lane); }
    }
    const float* x = P.in[I_X]; bf16_t* xb = P.bf(WS_XB); float* rstd0 = P.f32(CT_RSTD0);
    for (int m0 = gw * 2; m0 < T; m0 += NGW * 2) {
        f32x4 v[2][4];
#pragma unroll
        for (int u = 0; u < 2; ++u) { const f32x4* xr = (const f32x4*)(x + (size_t)(m0 + u) * DM) + lane;
#pragma unroll
            for (int j = 0; j < 4; ++j) v[u][j] = xr[64 * j]; }
#pragma unroll
        for (int u = 0; u < 2; ++u) {
            float s = 0.f;
#pragma unroll
            for (int j = 0; j < 4; ++j) s += (v[u][j][0] * v[u][j][0] + v[u][j][1] * v[u][j][1]) + (v[u][j][2] * v[u][j][2] + v[u][j][3] * v[u][j][3]);
            s = wave_sum(s);
            if (lane == 0) rstd0[m0 + u] = rsqrtf(s * (1.0f / 1024.0f) + EPS);
            u32x2* o8 = (u32x2*)(xb + (size_t)(m0 + u) * DM) + lane;
#pragma unroll
            for (int j = 0; j < 4; ++j) o8[64 * j] = (u32x2){cvtpk(v[u][j][0], v[u][j][1]), cvtpk(v[u][j][2], v[u][j][3])};
        }
    }
    float* cosT = P.f32(CT_ROPE); float* sinT = cosT + SEQ * 8;
    for (int idx = blockIdx.x * 512 + tid; idx < SEQ * 8; idx += gridDim.x * 512) {
        const int pos = idx >> 3, i = idx & 7;
        const float inv = powf(500000.0f, -(float)(2 * i) / 16.0f);
        const float ang = (float)pos * inv;
        const double rev = (double)ang * 0.15915494309189535; const float fr = (float)(rev - floor(rev));
        cosT[idx] = __builtin_amdgcn_cosf(fr); sinT[idx] = __builtin_amdgcn_sinf(fr);
    }
}

DI void fox_cum(const Ptrs& P, int bh, int lane) {
    const f32x4* lf = (const f32x4*)(P.f32(CT_LOGF) + (size_t)bh * SEQ + 64 * lane); f32x4* dst = (f32x4*)(P.f32(CT_CUM) + (size_t)bh * SEQ + 64 * lane);
    f32x4 v[16]; float tot = 0.f;
#pragma unroll
    for (int i = 0; i < 16; ++i) { v[i] = lf[i]; }
#pragma unroll
    for (int i = 0; i < 16; ++i) { v[i][1] += v[i][0]; v[i][2] += v[i][1]; v[i][3] += v[i][2]; const float t = v[i][3]; v[i] = v[i] + tot; tot += t; }
    float inc = tot;
#pragma unroll
    for (int o = 1; o < 64; o <<= 1) { const float t = __shfl_up(inc, o); if (lane >= o) inc += t; }
    const float base = inc - tot;
#pragma unroll
    for (int i = 0; i < 16; ++i) dst[i] = (v[i] + base) * (-LOG2E);
}

DI void compress_item(const Ptrs& P, int item, LAS char* lds) {
    int tid_l_ = threadIdx.x; asm volatile("" : "+v"(tid_l_)); const int tid = tid_l_, lane = tid & 63, r32 = lane & 31, hi = lane >> 5, wid = __builtin_amdgcn_readfirstlane(tid >> 6);
    const int kv = item >> 7, b = (item >> 4) & 7, g = (item >> 3) & 1, nt = item & 7;
    const bf16_t* projA = P.bf(WS_BIG);
    const float* pe = (kv ? P.in[I_APEV] : P.in[I_APEK]);
    const bf16_t* w1t = P.bf(CT_CW + (kv ? 262144 : 0)); const bf16_t* w2t = P.bf(CT_CW + 524288 + (kv ? 8192 : 0));
    int n = 32 * nt + r32; if (n > 254) n = 254;
    f32x16 c0, c1;
#pragma unroll
    for (int r = 0; r < 16; ++r) { c0[r] = 0.f; c1[r] = 0.f; }
#pragma unroll 8
    for (int kk = 0; kk < 16; ++kk) { const int ks = 16 * wid + kk;
        const int l = ks >> 2, d = 16 * (ks & 3) + 8 * hi;
        const u32x4 raw = *(const u32x4*)(projA + ((size_t)b * SEQ + 16 * n + l) * LDA + (kv ? PA_VC : PA_KC) + g * 64 + d);
        const f32x4 p0 = *(const f32x4*)(pe + l * 64 + d), p1 = *(const f32x4*)(pe + l * 64 + d + 4);
        u32x4 aw; aw.x = cvtpk(bflo(raw.x) + p0[0], bfhi(raw.x) + p0[1]); aw.y = cvtpk(bflo(raw.y) + p0[2], bfhi(raw.y) + p0[3]);
        aw.z = cvtpk(bflo(raw.z) + p1[0], bfhi(raw.z) + p1[1]); aw.w = cvtpk(bflo(raw.w) + p1[2], bfhi(raw.w) + p1[3]);
        const bf16x8 A = __builtin_bit_cast(bf16x8, aw);
        const bf16x8 B0 = *(const bf16x8*)(w1t + (size_t)r32 * 2048 + 16 * ks + 8 * hi), B1 = *(const bf16x8*)(w1t + (size_t)(32 + r32) * 2048 + 16 * ks + 8 * hi);
        c0 = MFMA32(A, B0, c0); c1 = MFMA32(A, B1, c1);
    }
    LAS float* red = (LAS float*)lds + wid * 2048;
#pragma unroll
    for (int r = 0; r < 16; ++r) { const int nn = att::crow(r, hi); red[nn * 64 + r32] = c0[r]; red[nn * 64 + 32 + r32] = c1[r]; }
    __syncthreads();
    {
        LAS bf16_t* H1 = (LAS bf16_t*)(lds + 65536);
        const LAS float* rd = (const LAS float*)lds;
        float s4[4];
#pragma unroll
        for (int e = 0; e < 4; ++e) { float s = 0.f;
#pragma unroll
            for (int w = 0; w < 8; ++w) s += rd[w * 2048 + tid * 4 + e];
            s4[e] = gelu_tanh(s); }
        *(LAS u32x2*)(H1 + tid * 4) = (u32x2){cvtpk(s4[0], s4[1]), cvtpk(s4[2], s4[3])};
    }
    __syncthreads();
    if (wid == 0) {
        f32x16 o0, o1;
#pragma unroll
        for (int r = 0; r < 16; ++r) { o0[r] = 0.f; o1[r] = 0.f; }
#pragma unroll
        for (int ks = 0; ks < 4; ++ks) {
            const bf16x8 A = *(const LAS bf16x8*)(lds + 65536 + r32 * 128 + (16 * ks + 8 * hi) * 2);
            const bf16x8 B0 = *(const bf16x8*)(w2t + r32 * 64 + 16 * ks + 8 * hi), B1 = *(const bf16x8*)(w2t + (32 + r32) * 64 + 16 * ks + 8 * hi);
            o0 = MFMA32(A, B0, o0); o1 = MFMA32(A, B1, o1);
        }
        bf16_t* dst = P.bf(kv ? CT_VCMP : CT_KCMP);
        if (kv == 0) {
            const float* kn = P.in[I_AKN]; const float g0 = kn[r32], g1 = kn[32 + r32];
            const float* cosT = P.f32(CT_ROPE); const float* sinT = cosT + SEQ * 8;
#pragma unroll
            for (int r = 0; r < 16; ++r) {
                float ss = o0[r] * o0[r] + o1[r] * o1[r];
                ss += __shfl_xor(ss, 1); ss += __shfl_xor(ss, 2); ss += __shfl_xor(ss, 4); ss += __shfl_xor(ss, 8); ss += __shfl_xor(ss, 16);
                const float rs = rsqrtf(ss * (1.0f / 64.0f) + EPS);
                float y0 = o0[r] * rs * g0; const float y1 = o1[r] * rs * g1;
                const float oth = __shfl_xor(y0, 8);
                const int nn = 32 * nt + att::crow(r, hi); const int pos = (16 * nn + 31) & (SEQ - 1);
                const float cc = cosT[pos * 8 + (r32 & 7)], sn = sinT[pos * 8 + (r32 & 7)];
                if (r32 < 8) y0 = y0 * cc - oth * sn; else if (r32 < 16) y0 = oth * sn + y0 * cc;
                o0[r] = y0; o1[r] = y1;
            }
        }
#pragma unroll
        for (int r = 0; r < 16; ++r) {
            const int nn = 32 * nt + att::crow(r, hi);
            const bool pad = nn > 254;
            bf16_t* dp = dst + (((size_t)b * NCMP_PAD + nn) * 2 + g) * 64;
            dp[r32] = pad ? (bf16_t)0 : (bf16_t)(cvtpk(o0[r], 0.f) & 0xffffu); dp[32 + r32] = pad ? (bf16_t)0 : (bf16_t)(cvtpk(o1[r], 0.f) & 0xffffu);
        }
    }
    __syncthreads();
}
}

namespace moe {
DI void route_block(const Ptrs& P, int blk, LAS char* lds) {
    int tid_l_ = threadIdx.x; asm volatile("" : "+v"(tid_l_)); const int tid = tid_l_, lane = tid & 63, r32 = lane & 31, hi = lane >> 5, wid = __builtin_amdgcn_readfirstlane(tid >> 6);
    constexpr int RPITCH = 1032;
    LAS bf16_t* RBH = (LAS bf16_t*)lds; LAS bf16_t* RBL = RBH + 8 * RPITCH;
    LAS float* PART = (LAS float*)(lds + 36864); LAS float* LG = (LAS float*)(lds + 40960);
    LAS int* einfo = (LAS int*)(lds + 33280);
    const float* router = P.in[I_MROUTER]; const float* mg = P.in[I_MNORM];
    for (int i = tid; i < 8192; i += 512) { const int k = i >> 3, e = i & 7; const float v = router[i] * mg[k];
        const unsigned hb = cvtpk(v, 0.f) & 0xffffu; const float vh = __uint_as_float(hb << 16); const unsigned lb = cvtpk(v - vh, 0.f) & 0xffffu;
        RBH[e * RPITCH + k] = (bf16_t)hb; RBL[e * RPITCH + k] = (bf16_t)lb; }
    __syncthreads();
    const bf16_t* xb3 = P.bf(WS_HM);
    {
        const int rt = wid & 3, kh = wid >> 2;
        const bf16_t* ap = xb3 + ((size_t)blk * 128 + 32 * rt + r32) * DM + 512 * kh + 8 * hi;
        const LAS bf16_t* bh = RBH + (r32 & 7) * RPITCH + 512 * kh + 8 * hi; const LAS bf16_t* bl = RBL + (r32 & 7) * RPITCH + 512 * kh + 8 * hi;
        f32x16 c;
#pragma unroll
        for (int r = 0; r < 16; ++r) c[r] = 0.f;
#pragma unroll 8
        for (int ks = 0; ks < 32; ++ks) {
            const bf16x8 A = *(const bf16x8*)(ap + 16 * ks);
            c = MFMA32(A, *(const LAS bf16x8*)(bh + 16 * ks), c); c = MFMA32(A, *(const LAS bf16x8*)(bl + 16 * ks), c);
        }
        if (kh == 1 && r32 < 8) {
#pragma unroll
            for (int r = 0; r < 16; ++r) PART[(32 * rt + att::crow(r, hi)) * 8 + r32] = c[r];
        }
        __syncthreads();
        if (kh == 0 && r32 < 8) {
#pragma unroll
            for (int r = 0; r < 16; ++r) { const int tk = 32 * rt + att::crow(r, hi); LG[tk * 8 + r32] = c[r] + PART[tk * 8 + r32]; }
        }
        __syncthreads();
    }
    if (tid < 128) {
        const int tl = tid, t = blk * 128 + tl;
        const f32x4 la = *(const LAS f32x4*)(LG + tl * 8), lb = *(const LAS f32x4*)(LG + tl * 8 + 4);
        const float rs = pg8::row_rstd(P.f32(CT_SS3), t);
        const float acc[8] = {la[0], la[1], la[2], la[3], lb[0], lb[1], lb[2], lb[3]};
        int e1 = 0; float l1 = acc[0] * rs;
#pragma unroll
        for (int e = 1; e < 8; ++e) { const float l = acc[e] * rs; if (l > l1) { l1 = l; e1 = e; } }
        int e2 = -1; float l2 = -3.0e38f;
#pragma unroll
        for (int e = 0; e < 8; ++e) { const float l = acc[e] * rs; if (e != e1 && l > l2) { l2 = l; e2 = e; } }
        const float w1 = 1.0f / (1.0f + __expf(l2 - l1));
        einfo[tl * 2] = e1; einfo[tl * 2 + 1] = e2;
        P.f32(MO_TOKW)[(size_t)t * 2] = w1; P.f32(MO_TOKW)[(size_t)t * 2 + 1] = 1.0f - w1;
        P.f32(MO_TOKR)[t] = rs;
    }
    __syncthreads();
    LAS int* rk = (LAS int*)(lds + 34304);
    if (tid < 256) { const int e = einfo[tid]; int r = 0; for (int j = 0; j < tid; ++j) r += (einfo[j] == e) ? 1 : 0; rk[tid] = r; }
    if (tid >= 256 && tid < 264) { const int e = tid - 256; int c = 0; for (int j = 0; j < 256; ++j) c += (einfo[j] == e) ? 1 : 0; P.i32(MO_HIST)[blk * 8 + e] = c; }
    __syncthreads();
    if (tid < 128) { const int t = blk * 128 + tid; ((unsigned*)P.i32(MO_TOKE))[t] = (unsigned)einfo[2 * tid] | ((unsigned)einfo[2 * tid + 1] << 4) | ((unsigned)rk[2 * tid] << 8) | ((unsigned)rk[2 * tid + 1] << 20); }
    __syncthreads();
}
DI void scatter_block(const Ptrs& P, int blk, LAS char* lds) {
    int tid_l_ = threadIdx.x; asm volatile("" : "+v"(tid_l_)); const int tid = tid_l_, lane = tid & 63, wid = __builtin_amdgcn_readfirstlane(tid >> 6);
    LAS int* sh = (LAS int*)lds;
    const int* hist = P.i32(MO_HIST);
    { typedef int i32x4 __attribute__((ext_vector_type(4))); *(LAS i32x4*)(sh + 64 + tid * 4) = *(const i32x4*)(hist + tid * 4); }
    __syncthreads();
    if (tid < 8) { int c = 0, pre = 0; for (int j = 0; j < 256; ++j) { const int v = sh[64 + j * 8 + tid]; c += v; if (j < blk) pre += v; } sh[tid] = c; sh[8 + tid] = pre; }
    __syncthreads();
    if (tid == 0) { int acc = 0; for (int e = 0; e < 8; ++e) { sh[16 + e] = acc; acc += ((sh[e] + 255) >> 8) << 8; } sh[24] = acc; }
    __syncthreads();
    const bf16_t* xb3 = P.bf(WS_HM); bf16_t* xy = P.bf(WS_XY);
    for (int q0 = wid * 32; q0 < wid * 32 + 32; q0 += 4) {
        u32x4 a[4], c[4]; int rowv[4];
#pragma unroll
        for (int u = 0; u < 4; ++u) {
            const int q = q0 + u, tl = q >> 1, slot = q & 1, t = blk * 128 + tl;
            const unsigned info = ((const unsigned*)P.i32(MO_TOKE))[t];
            const int e = slot ? (info >> 4) & 15 : info & 15, lr = slot ? (info >> 20) & 4095 : (info >> 8) & 4095;
            rowv[u] = sh[16 + e] + sh[8 + e] + lr;
            const u32x4* src = (const u32x4*)(xb3 + (size_t)t * DM) + lane;
            a[u] = src[0]; c[u] = src[64];
            if (lane == 0) { P.f32(MO_RSCALE)[rowv[u]] = P.f32(MO_TOKR)[t]; P.f32(MO_RGATE)[rowv[u]] = P.f32(MO_TOKW)[(size_t)t * 2 + slot]; P.f32(MO_RKEEP)[rowv[u]] = slot ? 0.f : 1.f; P.i32(MO_POS)[(size_t)t * 2 + slot] = rowv[u];
                if (rowv[u] >= MOE_XROW0) P.i32(MO_ROWTOK)[rowv[u] - MOE_XROW0] = t; }
        }
#pragma unroll
        for (int u = 0; u < 4; ++u) { u32x4* dst = (u32x4*)(xy + (size_t)rowv[u] * DM) + lane; dst[0] = a[u]; dst[64] = c[u]; }
    }
    if (blk < 8) {
        const int e = blk, r0 = sh[16 + e] + sh[e], r1 = sh[16 + e + 1];
        for (int row = r0 + wid; row < r1; row += 8) { u32x2* o8 = (u32x2*)(xy + (size_t)row * DM) + lane;
#pragma unroll
            for (int j = 0; j < 4; ++j) o8[64 * j] = (u32x2){0u, 0u};
            if (lane == 0) { P.f32(MO_RSCALE)[row] = 0.f; P.f32(MO_RGATE)[row] = 0.f; P.f32(MO_RKEEP)[row] = 0.f; if (row >= MOE_XROW0) P.i32(MO_ROWTOK)[row - MOE_XROW0] = -1; } }
    }
    if (blk == 8) {
        int* te = P.i32(MO_TILEE); const int ntl = sh[24] >> 8;
        for (int tl = tid; tl < 271; tl += 512) { int e = 0; for (int k = 1; k < 8; ++k) if (tl * 256 >= sh[16 + k]) e = k; te[tl] = e; }
        if (tid == 0) te[271] = ntl;
    }
    __syncthreads();
}
DI f32x4 moe_row_piece(const Ptrs& P, int p, int lane, int j) {
    const u32x2 w = ((const u32x2*)(P.bf(WS_XY) + (size_t)p * DM) + lane)[64 * j];
    const f32x4 old = {bflo(w[0]), bfhi(w[0]), bflo(w[1]), bfhi(w[1])};
    if (p < MOE_XROW0) return old;
    const f32x4* pp = (const f32x4*)(P.f32(WS_PART) + (size_t)(p - MOE_XROW0) * 11 * DM) + 64 * j + lane;
    f32x4 s = pp[0];
#pragma unroll
    for (int k = 1; k < 11; ++k) s += pp[k * (DM / 4)];
    return old * P.f32(MO_RKEEP)[p] + s * P.f32(MO_RGATE)[p];
}
DI void combine_tail_row(const Ptrs& P, int xr, int lane) {
    const int t = __builtin_amdgcn_readfirstlane(P.i32(MO_ROWTOK)[xr]);
    if (t < 0) return;
    const int p1 = __builtin_amdgcn_readfirstlane(P.i32(MO_POS)[(size_t)t * 2]), p2 = __builtin_amdgcn_readfirstlane(P.i32(MO_POS)[(size_t)t * 2 + 1]);
    if (p1 >= MOE_XROW0 && p2 >= MOE_XROW0 && (p1 < p2 ? p1 : p2) != MOE_XROW0 + xr) return;
    f32x4* orow = (f32x4*)(P.out + (size_t)t * DM) + lane;
#pragma unroll 2
    for (int j = 0; j < 4; ++j) orow[64 * j] = moe_row_piece(P, p1, lane, j) + moe_row_piece(P, p2, lane, j);
}
template <int NR> DI void combine_rows(const Ptrs& P, int t0, int lane) {
    const bf16_t* y = P.bf(WS_XY);
    int p1[NR], p2[NR];
#pragma unroll
    for (int u = 0; u < NR; ++u) { p1[u] = P.i32(MO_POS)[(size_t)(t0 + u) * 2]; p2[u] = P.i32(MO_POS)[(size_t)(t0 + u) * 2 + 1]; }
    { bool tail = false;
#pragma unroll
      for (int u = 0; u < NR; ++u) tail = tail || p1[u] >= MOE_XROW0 || p2[u] >= MOE_XROW0;
      if (tail) {
#pragma unroll 1
        for (int u = 0; u < NR; ++u) { if (p1[u] >= MOE_XROW0 || p2[u] >= MOE_XROW0) continue;
            f32x4* orow = (f32x4*)(P.out + (size_t)(t0 + u) * DM) + lane;
#pragma unroll 1
            for (int j = 0; j < 4; ++j) orow[64 * j] = moe_row_piece(P, p1[u], lane, j) + moe_row_piece(P, p2[u], lane, j); }
        return; } }
    u32x2 a[NR][4], c[NR][4];
#pragma unroll
    for (int u = 0; u < NR; ++u) {
        const u32x2* y1 = (const u32x2*)(y + (size_t)p1[u] * DM) + lane; const u32x2* y2 = (const u32x2*)(y + (size_t)p2[u] * DM) + lane;
#pragma unroll
        for (int j = 0; j < 4; ++j) { a[u][j] = y1[64 * j]; c[u][j] = y2[64 * j]; }
    }
#pragma unroll
    for (int u = 0; u < NR; ++u) {
        f32x4* orow = (f32x4*)(P.out + (size_t)(t0 + u) * DM) + lane;
#pragma unroll
        for (int j = 0; j < 4; ++j) { f32x4 w; w[0] = bflo(a[u][j][0]) + bflo(c[u][j][0]); w[1] = bfhi(a[u][j][0]) + bfhi(c[u][j][0]); w[2] = bflo(a[u][j][1]) + bflo(c[u][j][1]); w[3] = bfhi(a[u][j][1]) + bfhi(c[u][j][1]); orow[64 * j] = w; }
    }
}
}
#define XB_TMO      128
#define XB_XCNT(j)  (256  + 64 * (j))
#define XB_XSUB(j)  (1280 + 64 * (j))
#define XB_XGEN(j)  (2304 + 64 * (j))
#define XB_TOP      3328
#define XB_TOPGEN   3392
#define XCD_BAR_WORDS 3456
#define XB_SPIN_CAP (1u << 18)

__device__ __forceinline__ unsigned xb_ld(unsigned* p)              { return __hip_atomic_load(p, __ATOMIC_RELAXED, __HIP_MEMORY_SCOPE_AGENT); }
__device__ __forceinline__ unsigned xb_add(unsigned* p, unsigned v) { return __hip_atomic_fetch_add(p, v, __ATOMIC_RELAXED, __HIP_MEMORY_SCOPE_AGENT); }
__device__ __forceinline__ unsigned xb_xcc_id() { return (unsigned)__builtin_amdgcn_s_getreg((3 << 11) | 20) & 0xFu; }
#define XB_SPIN(cond, bar) do { unsigned _sp = 0; while (cond) { __builtin_amdgcn_s_sleep(1); \
    if ((++_sp & 255u) == 0u) { if (xb_ld(&(bar)[XB_TMO])) break; if (_sp > XB_SPIN_CAP) { atomicAdd(&(bar)[XB_TMO], 1u); break; } } } } while (0)

struct XcdBarrier {
    unsigned* bar; unsigned x;
    volatile LAS unsigned* st;
};

__device__ __forceinline__ XcdBarrier xcd_barrier_post(unsigned* bar, volatile LAS unsigned* st) {
    XcdBarrier b; b.bar = bar; b.x = xb_xcc_id(); b.st = st;
    if (threadIdx.x == 0) (void)xb_add(&bar[XB_XCNT(b.x)], 1u);
    return b;
}
__device__ __forceinline__ void xcd_barrier_complete(unsigned* bar, unsigned x, unsigned& nloc, unsigned& nx) {
    const unsigned G = gridDim.x * gridDim.y * gridDim.z;
    unsigned sum, cnt, mine, sp = 0u;
    for (;;) {
        sum = 0u; cnt = 0u; mine = 0u;
#pragma unroll
        for (unsigned j = 0; j < 16; ++j) { const unsigned c = xb_ld(&bar[XB_XCNT(j)]); sum += c; cnt += (c > 0u) ? 1u : 0u; mine = (j == x) ? c : mine; }
        if (sum == G) break;
        __builtin_amdgcn_s_sleep(1);
        if ((++sp & 255u) == 0u) { if (xb_ld(&bar[XB_TMO])) break; if (sp > XB_SPIN_CAP) { atomicAdd(&bar[XB_TMO], 1u); break; } }
    }
    nloc = mine > 0u ? mine : 1u; nx = cnt > 0u ? cnt : 1u;
}

__device__ __forceinline__ void xcd_barrier(const XcdBarrier& b) {
    asm volatile("s_waitcnt vmcnt(0)" ::: "memory");
    __syncthreads();
    if (threadIdx.x == 0) {
        unsigned* bar = b.bar;
        __builtin_amdgcn_s_waitcnt(0);
        unsigned nloc = b.st[0], nx = b.st[1];
        if (nloc == 0u) { xcd_barrier_complete(bar, b.x, nloc, nx); b.st[0] = nloc; b.st[1] = nx; }
        const unsigned old = xb_add(&bar[XB_XSUB(b.x)], 1u);
        const unsigned gen = old / nloc;
        if (old + 1u == (gen + 1u) * nloc) {
            __builtin_amdgcn_fence(__ATOMIC_RELEASE, "agent");
            asm volatile("s_waitcnt vmcnt(0)" ::: "memory");
            const unsigned og = xb_add(&bar[XB_TOP], 1u);
            const unsigned tg = og / nx;
            if (og + 1u == (tg + 1u) * nx) xb_add(&bar[XB_TOPGEN], 1u);
            else XB_SPIN(xb_ld(&bar[XB_TOPGEN]) == tg, bar);
            __builtin_amdgcn_fence(__ATOMIC_ACQUIRE, "agent");
            xb_add(&bar[XB_XGEN(b.x)], 1u);
            asm volatile("s_waitcnt vmcnt(0)" ::: "memory");
        } else {
            XB_SPIN(xb_ld(&bar[XB_XGEN(b.x)]) == gen, bar);
            __builtin_amdgcn_fence(__ATOMIC_ACQUIRE, "agent");
            asm volatile("s_waitcnt vmcnt(0)" ::: "memory");
        }
    }
    __syncthreads();
}

#ifndef MK_N_LAUNCHES
#define MK_N_LAUNCHES 1
#endif
constexpr int N_PHASES = 18;

__global__ void __launch_bounds__(512, 2) mega_fwd(Args args) {
    extern __shared__ __attribute__((aligned(16))) unsigned char lds_raw[];
    LAS char* lds = (LAS char*)lds_raw;
    cg::grid_group grid = cg::this_grid();
    Ptrs P;
#pragma unroll
    for (int i = 0; i < 31; ++i) P.in[i] = args.in[i];
    P.out = args.out; P.ws = args.ws;
    const int lo = args.ph_lo, hi_ = args.ph_hi;
    const int tid = threadIdx.x, lane = tid & 63, wid = __builtin_amdgcn_readfirstlane(tid >> 6);
    const int G = gridDim.x, gw = blockIdx.x * 8 + wid, NGW = G * 8;
#define IN(k) (lo <= (k) && (k) < hi_)
    { volatile LAS unsigned* st0 = (volatile LAS unsigned*)(lds_raw + LDS_MISC); if (tid < 64) st0[tid] = 0u; }
    __syncthreads();
    XcdBarrier xbar; xbar.bar = (unsigned*)(args.ws + CT_BAR); xbar.x = 0; xbar.st = (volatile LAS unsigned*)(lds_raw + LDS_MISC) + 8;
    const bool one_launch = (lo == 0 && hi_ == N_PHASES);
    if (one_launch) { if (blockIdx.x == 0) { for (int i = tid; i < 1024; i += 512) ((unsigned*)(args.ws + CT_CTR))[i] = 0u; for (int i = tid; i < 4096; i += 512) ((unsigned*)(args.ws + CT_BAR))[i] = 0u; } }
    else xbar = xcd_barrier_post((unsigned*)(args.ws + CT_BAR), (volatile LAS unsigned*)(lds_raw + LDS_MISC) + 8);
#define SEAM(k) do { if (IN(k) && IN((k) + 1)) { if ((k) == 0) { grid.sync(); if (one_launch) xbar = xcd_barrier_post((unsigned*)(args.ws + CT_BAR), (volatile LAS unsigned*)(lds_raw + LDS_MISC) + 8); } else xcd_barrier(xbar); } } while (0)
    LAS unsigned char* glds = (LAS unsigned char*)lds_raw;

    if (IN(0)) { pro::prologue(P, lds); }
    SEAM(0);
    if (IN(1)) {
        pg8::Gemm g{P.bf(WS_XB), P.bf(WS_WA), T, NA_PAD, DM}; pg8::StaticOrder S; S.init(T, NA_PAD, G, (int)blockIdx.x);
        const float* cosT = P.f32(CT_ROPE);
        pg8::EpiInA E{P.bf(WS_BIG), P.f32(CT_RSTD0), cosT, cosT + SEQ * 8, P.in[I_AQN], P.in[I_AKN], P.in[I_FQN], P.in[I_FKN], P.in[I_GBIAS], P.in[I_FFB], P.f32(CT_GATE), P.f32(CT_LOGF)};
        pg8::gemm_phase<pg8::EpiInA, pg8::StaticOrder, true, true>(glds, g, S, E);
    }
    SEAM(1);
    if (IN(2)) {
        if (gw < 64) pro::fox_cum(P, gw, lane);
        for (int it = blockIdx.x; it < 256; it += G) pro::compress_item(P, it, lds);
    }
    SEAM(2);
    if (IN(3)) {
        att::Tensors AT{P.bf(WS_BIG), P.bf(CT_KCMP), P.bf(CT_VCMP), P.f32(CT_GATE), P.f32(CT_CUM), P.bf(WS_O), P.in[I_FQN], P.in[I_FKN], P.in[I_AQN], P.in[I_AKN]};
        att::attn_phase(AT, (unsigned*)(P.ws + CT_CTR), lds);
    }
    SEAM(3);
    if (IN(4)) {
        pg8::Gemm g{P.bf(WS_O), P.bf(WS_WO), T, DM, DM}; pg8::StaticOrder S; S.init(T, DM, G, (int)blockIdx.x);
        pg8::EpiResid<true> E{P.in[I_X], P.bf(WS_XB), P.f32(CT_SS1)};
        pg8::gemm_phase<pg8::EpiResid<true>, pg8::StaticOrder, true, true>(glds, g, S, E);
    }
    SEAM(4);
    if (IN(5)) {
        pg8::Gemm g{P.bf(WS_XB), P.bf(WS_WFGU), T, 2 * DFF, DM}; pg8::StaticOrder S; S.init(T, 2 * DFF, G, (int)blockIdx.x);
        for (int blk = blockIdx.x; blk < 256; blk += G) if (tid < 128) { const int row = blk * 128 + tid; P.f32(CT_RSTD0)[row] = pg8::row_rstd(P.f32(CT_SS1), row); }
        xcd_barrier(xbar);
        pg8::EpiSwiglu<true> E{P.bf(WS_BIG), P.f32(CT_RSTD0), 0};
        pg8::gemm_phase<pg8::EpiSwiglu<true>, pg8::StaticOrder, true, true>(glds, g, S, E);
    }
    SEAM(5);
    if (IN(6)) {
        pg8::Gemm g{P.bf(WS_BIG), P.bf(WS_WFD), T, DM, DFF}; pg8::StaticOrder S; S.init(T, DM, G, (int)blockIdx.x);
        pg8::EpiResid<false> E{P.bf(WS_XB), P.bf(WS_XB), P.f32(CT_SS2)};
        pg8::gemm_phase<pg8::EpiResid<false>, pg8::StaticOrder, true, true>(glds, g, S, E);
    }
    SEAM(6);
    if (IN(7)) {
        for (int blk = blockIdx.x; blk < 256; blk += G) if (tid < 128) { const int row = blk * 128 + tid; P.f32(CT_RSTD0)[row] = pg8::row_rstd(P.f32(CT_SS2), row); }
        for (int it = blockIdx.x; it < T / 128; it += G) gla::gla_a1_item(P.bf(WS_XB), P.bf(WS_WC) + (size_t)LDC * DM, P.f32(CT_SS2), P.f32(CT_A1), it, lds);
        xcd_barrier(xbar);
        pg8::Gemm g{P.bf(WS_XB), P.bf(WS_WC), T, LDC, DM}; pg8::StaticOrder S; S.init(T, LDC, G, (int)blockIdx.x);
        pg8::EpiGlaIn E{P.bf(WS_BIG), P.f32(CT_RSTD0)};
        pg8::gemm_phase<pg8::EpiGlaIn, pg8::StaticOrder, true, true>(glds, g, S, E);
    }
    SEAM(7);
    if (IN(8)) {
        gla::GlaT GT{P.bf(WS_BIG), P.f32(CT_A1), P.in[I_CWA2], P.in[I_CBA], P.bf(WS_O), P.bf(WS_ATT), P.f32(CT_GATE)};
        {
            gla::PrepRegs Ra, Rb; int it = blockIdx.x;
            if (it < 2048) gla::prep_load(Ra, GT, it, tid);
            while (it < 2048) {
                const int i1 = it + G; if (i1 < 2048) gla::prep_load(Rb, GT, i1, tid);
                gla::gla_prep(GT, it, Ra, lds);
                if (i1 >= 2048) break;
                const int i2 = i1 + G; if (i2 < 2048) gla::prep_load(Ra, GT, i2, tid);
                gla::gla_prep(GT, i1, Rb, lds);
                it = i2;
            }
        }
        xcd_barrier(xbar);
        for (int u = blockIdx.x; u < 256; u += G) { const int bh = (u & 7) * 4 + (u >> 6), es = (u >> 3) & 7; gla::gla_unit(GT, bh >> 2, bh & 3, es, lds); }
    }
    SEAM(8);
    if (IN(9)) {
        for (int m = gw * 2; m < T; m += NGW * 2) gla::gla_gate_rows2(P.bf(WS_O), P.bf(WS_BIG) + PC_R, P.in[I_CONORM], m, lane);
    }
    SEAM(9);
    if (IN(10)) {
        pg8::Gemm g{P.bf(WS_O), P.bf(WS_WCO), T, DM, DM}; pg8::StaticOrder S; S.init(T, DM, G, (int)blockIdx.x);
        pg8::EpiResid<false> E{P.bf(WS_XB), P.bf(WS_HM), P.f32(CT_SS3)};
        pg8::gemm_phase<pg8::EpiResid<false>, pg8::StaticOrder, true, true>(glds, g, S, E);
    }
    SEAM(10);
    if (IN(11)) { for (int blk = blockIdx.x; blk < 256; blk += G) moe::route_block(P, blk, lds); }
    SEAM(11);
    if (IN(12)) { for (int blk = blockIdx.x; blk < 256; blk += G) moe::scatter_block(P, blk, lds); }
    SEAM(12);
#pragma unroll 1
    for (int pass = 0; pass < 2; ++pass) {
        const int tile0 = pass * MOE_PASS_TILES;
        if (IN(13 + 2 * pass)) {
            int ntp = __builtin_amdgcn_readfirstlane(P.i32(MO_TILEE)[271]) - tile0; { const int cap = pass == 0 ? MOE_PASS_TILES : MOE_PASS1_MAX; ntp = ntp < 0 ? 0 : (ntp > cap ? cap : ntp); }
            if (ntp > 0) {
                pg8::Gemm g{P.bf(WS_XY) + (size_t)tile0 * 256 * DM, P.bf(WS_WMGU), ntp * 256, 2 * DFF, DM};
                pg8::GroupedOrder S; S.so.init(ntp * 256, 2 * DFF, G, (int)blockIdx.x); S.tile_e = P.i32(MO_TILEE); S.tile0 = tile0; S.nN = 22;
                pg8::EpiSwiglu<true> E{P.bf(WS_HM), P.f32(MO_RSCALE), tile0 * 256};
                pg8::gemm_phase<pg8::EpiSwiglu<true>, pg8::GroupedOrder, true, true>(glds, g, S, E);
            }
        }
        SEAM(13 + 2 * pass);
        if (IN(14 + 2 * pass)) {
            int ntp = __builtin_amdgcn_readfirstlane(P.i32(MO_TILEE)[271]) - tile0; { const int cap = pass == 0 ? MOE_PASS_TILES : MOE_PASS1_MAX; ntp = ntp < 0 ? 0 : (ntp > cap ? cap : ntp); }
            const int ntm = ntp < MOE_PASS_TILES ? ntp : MOE_PASS_TILES, nx = ntp - ntm;
            if (ntm > 0) {
                pg8::Gemm g{P.bf(WS_HM), P.bf(WS_WMD), ntm * 256, DM, DFF};
                pg8::GroupedOrder S; S.so.init(ntm * 256, DM, G, (int)blockIdx.x); S.tile_e = P.i32(MO_TILEE); S.tile0 = tile0; S.nN = 4;
                pg8::EpiMoeDown E{P.bf(WS_XY), P.f32(MO_RGATE), P.f32(MO_RKEEP), tile0 * 256};
                pg8::gemm_phase<pg8::EpiMoeDown, pg8::GroupedOrder, true, true>(glds, g, S, E);
            }
            if (nx > 0) {
                pg8::Gemm g{P.bf(WS_HM), P.bf(WS_WMD), ntp * 256, DM, 256, DFF};
                pg8::SliceOrder S{P.i32(MO_TILEE), tile0, ntm, nx * 44, G, (int)blockIdx.x};
                pg8::EpiMoePart E{P.f32(WS_PART), ntm};
                pg8::gemm_phase<pg8::EpiMoePart, pg8::SliceOrder, true, true>(glds, g, S, E);
            }
        }
        SEAM(14 + 2 * pass);
    }
    if (IN(17)) { int t17 = tid; asm volatile("" : "+v"(t17)); const int lane17 = t17 & 63;
        { const int nxr = (__builtin_amdgcn_readfirstlane(P.i32(MO_TILEE)[271]) - 2 * MOE_PASS_TILES) * 256;
          for (int xr = gw; xr < nxr; xr += NGW) moe::combine_tail_row(P, xr, lane17); }
        for (int m = gw * 2; m < T; m += NGW * 2) moe::combine_rows<2>(P, m, lane17); }
#undef IN
#undef SEAM
}

extern "C" void kernel_launch(void* const* d_in, const int* in_sizes, int n_in, void* d_out, int out_size, void* d_ws, size_t ws_size, hipStream_t stream) {
    static int grid = 0;
    if (grid == 0) {
        if (n_in != 31 || out_size != T * DM || ws_size < WS_END) { fprintf(stderr, "kernel_launch: unexpected problem (n_in %d, out %d, ws %zu)\n", n_in, out_size, ws_size); grid = -1; return; }
        int dev = 0, cus = 0, per_cu = 0;
        hipGetDevice(&dev); hipDeviceGetAttribute(&cus, hipDeviceAttributeMultiprocessorCount, dev);
        if (hipFuncSetAttribute((const void*)mega_fwd, hipFuncAttributeMaxDynamicSharedMemorySize, LDS_BYTES) != hipSuccess) { fprintf(stderr, "kernel_launch: hipFuncSetAttribute failed\n"); grid = -1; return; }
        if (hipOccupancyMaxActiveBlocksPerMultiprocessor(&per_cu, (const void*)mega_fwd, 512, LDS_BYTES) != hipSuccess || per_cu < 1) { fprintf(stderr, "kernel_launch: occupancy query says %d\n", per_cu); per_cu = 1; }
        (void)hipGetLastError();
        grid = cus * 1;
        if (per_cu < 1) grid = -1;
    }
    if (grid < 0) return;
#if MK_N_LAUNCHES != 1
    hipMemsetAsync((char*)d_ws, 0, CT_ZERO_BYTES, stream);
#endif
    Args a{};
    for (int i = 0; i < 31; ++i) a.in[i] = (const float*)d_in[i];
    a.out = (float*)d_out; a.ws = (unsigned char*)d_ws;
#if MK_N_LAUNCHES == 1
    a.ph_lo = 0; a.ph_hi = N_PHASES;
    void* kargs[] = {&a};
    hipError_t e = hipLaunchCooperativeKernel((const void*)mega_fwd, dim3(grid), dim3(512), kargs, LDS_BYTES, stream);
    if (e != hipSuccess) fprintf(stderr, "cooperative launch failed: %s (grid %d)\n", hipGetErrorString(e), grid);
#else
    for (int ph = 0; ph < N_PHASES; ++ph) {
        a.ph_lo = ph; a.ph_hi = ph + 1;
        hipLaunchKernelGGL(mega_fwd, dim3(grid), dim3(512), LDS_BYTES, stream, a);
    }
#endif
}
```

```cpp
#include <hip/hip_runtime.h>
#include <hip/hip_cooperative_groups.h>
#include <cstdio>
#include <cstdint>
namespace cg = cooperative_groups;

#define DI __device__ __forceinline__
#define LAS __attribute__((address_space(3)))
#define GAS __attribute__((address_space(1)))
typedef unsigned short bf16_t;
typedef short bf16x8 __attribute__((ext_vector_type(8)));
typedef short s16x4 __attribute__((ext_vector_type(4)));
typedef float f32x2 __attribute__((ext_vector_type(2)));
typedef float f32x4 __attribute__((ext_vector_type(4)));
typedef float f32x16 __attribute__((ext_vector_type(16)));
typedef unsigned u32x2 __attribute__((ext_vector_type(2)));
typedef unsigned u32x4 __attribute__((ext_vector_type(4)));

constexpr int BATCH = 8, SEQ = 4096, DM = 1024, T = BATCH * SEQ;
constexpr int HD = 64;
constexpr int NSA_H = 8, NSA_G = 2, FOX_H = 8;
constexpr int NCMP = 255, NCMP_PAD = 256;
constexpr int IN_A = 2848, LDA = 2816  , NA_PAD = 3072;
constexpr int DFF = 2816;
constexpr int IN_C = 3088, LDC = 3072  , NC_PAD = 3328;
constexpr int NEXP = 8;
constexpr int MOE_TILES_MAX = 264, MOE_PASS_TILES = 128, MOE_PASS1_MAX = 136;
constexpr float EPS = 1e-6f;
constexpr float LOG2E = 1.4426950408889634f;
constexpr float QSCALE = 0.125f * LOG2E;
constexpr int PA_QA = 0, PA_KSL = 512, PA_KWN = 640, PA_VSL = 768, PA_VWN = 896, PA_KC = 1024, PA_VC = 1152, PA_QB = 1280, PA_KB = 1792, PA_VB = 2304;
constexpr int PC_Q = 0, PC_K = 512, PC_V = 1024, PC_R = 2048;

constexpr size_t MiB = 1u << 20;
constexpr size_t CT_CTR = 0;
constexpr size_t CT_BAR = 65536;
constexpr size_t CT_SS1 = 501 * MiB, CT_SS2 = 503 * MiB, CT_SS3 = 505 * MiB;
constexpr size_t CT_ZERO_BYTES = 1 * MiB;
static_assert(CT_BAR + 16384 <= CT_ZERO_BYTES, "zero region");
constexpr size_t CT_RSTD0 = 1 * MiB;
constexpr size_t CT_ROPE = CT_RSTD0 + (size_t)T * 4;
constexpr size_t CT_LOGF = 2 * MiB;
constexpr size_t CT_CUM = 3 * MiB;
constexpr size_t CT_GATE = 4 * MiB;
constexpr size_t CT_A1 = 7 * MiB;
constexpr size_t CT_KCMP = 9 * MiB, CT_VCMP = CT_KCMP + 512 * 1024;
constexpr size_t CT_CW = 10 * MiB;
constexpr size_t CT_MOE = 11 * MiB;
constexpr size_t WS_WA = 16 * MiB;
constexpr size_t WS_WO = WS_WA + 6 * MiB;
constexpr size_t WS_WFGU = WS_WO + 2 * MiB;
constexpr size_t WS_WFD = WS_WFGU + 11 * MiB;
constexpr size_t WS_WC = WS_WFD + 5632 * 1024;
constexpr size_t WS_WCO = WS_WC + 6656 * 1024;
constexpr size_t WS_WMGU = 49 * MiB;
constexpr size_t WS_WMD = WS_WMGU + 88 * MiB;
static_assert(WS_WCO + 2 * MiB <= WS_WMGU, "weights map");
constexpr size_t WS_XB = 181 * MiB;
constexpr size_t WS_O = 245 * MiB;
constexpr size_t WS_ATT = WS_WA;
constexpr size_t WS_BIG = 309 * MiB;
constexpr size_t WS_XY = 181 * MiB;
constexpr size_t WS_HM = 313 * MiB;
constexpr size_t WS_PART = 16 * MiB;
constexpr int MOE_XROW0 = 2 * MOE_PASS_TILES * 256;
constexpr size_t WS_END = 512 * MiB;
static_assert(WS_PART + (size_t)8 * 256 * 11 * 1024 * 4 <= WS_WMD, "partials map");
static_assert(WS_WMD + 44 * MiB <= WS_XB && WS_BIG + (size_t)T * LDC * 2 <= WS_END && WS_XY + (size_t)MOE_TILES_MAX * 256 * 1024 * 2 <= WS_HM && WS_HM + (size_t)MOE_PASS1_MAX * 256 * DFF * 2 <= WS_END, "d_ws map");
constexpr size_t MO_TOKE = CT_MOE;
constexpr size_t MO_TOKW = MO_TOKE + (size_t)T * 4;
constexpr size_t MO_TOKR = MO_TOKW + (size_t)T * 8;
constexpr size_t MO_POS = MO_TOKR + (size_t)T * 4;
constexpr size_t MO_HIST = MO_POS + (size_t)T * 8;
constexpr size_t MO_RSCALE = MO_HIST + 8192;
constexpr size_t MO_RGATE = MO_RSCALE + (size_t)MOE_TILES_MAX * 256 * 4;
constexpr size_t MO_RKEEP = MO_RGATE + (size_t)MOE_TILES_MAX * 256 * 4;
constexpr size_t MO_TILEE = MO_RKEEP + (size_t)MOE_TILES_MAX * 256 * 4;
constexpr size_t MO_ROWTOK = MO_TILEE + 2048;
static_assert(MO_ROWTOK + 8192 <= WS_WA, "moe tables");

constexpr int LDS_BYTES = 163840;
constexpr int LDS_MISC = 163584;

DI unsigned cvtpk(float lo, float hi) { typedef __bf16 b2 __attribute__((ext_vector_type(2))); f32x2 v = {lo, hi}; b2 b = __builtin_convertvector(v, b2); return __builtin_bit_cast(unsigned, b); }
DI float bf2f(unsigned short h) { return __uint_as_float((unsigned)h << 16); }
DI float bflo(unsigned w) { return __uint_as_float(w << 16); }
DI float bfhi(unsigned w) { return __uint_as_float(w & 0xffff0000u); }
DI float wave_sum(float v) {
#pragma unroll
    for (int o = 1; o < 64; o <<= 1) v += __shfl_xor(v, o);
    return v;
}
DI float xsum16(float x) { const unsigned u = __float_as_uint(x); const u32x2 r = __builtin_amdgcn_permlane16_swap(u, u, false, false); return __uint_as_float(r[0]) + __uint_as_float(r[1]); }
DI float xsum32(float x) { const unsigned u = __float_as_uint(x); const u32x2 r = __builtin_amdgcn_permlane32_swap(u, u, false, false); return __uint_as_float(r[0]) + __uint_as_float(r[1]); }
DI float xchg16(float x, bool odd_row) { const unsigned u = __float_as_uint(x); const u32x2 r = __builtin_amdgcn_permlane16_swap(u, u, false, false); return __uint_as_float(odd_row ? r[0] : r[1]); }
DI float sigmoidf_(float z) { return 1.0f / (1.0f + __expf(-z)); }
DI float log_sigmoidf_(float z) { return fminf(z, 0.f) - __logf(1.0f + __expf(-fabsf(z))); }
DI float siluf_(float z) { return z * __builtin_amdgcn_rcpf(1.0f + __builtin_amdgcn_exp2f(-LOG2E * z)); }
DI float gelu_tanh(float x) { const float u = 0.7978845608028654f * (x + 0.044715f * x * x * x); const float e = __expf(2.f * u); const float t = 1.f - 2.f / (e + 1.f); return 0.5f * x * (1.f + t); }

struct Args {
    const float* in[31];
    float* out;
    unsigned char* ws;
    int ph_lo, ph_hi;
};
namespace pg8 {
#define PG8_LAS __attribute__((address_space(3)))
typedef unsigned short bf16_t;
typedef short bf16x8 __attribute__((ext_vector_type(8)));
typedef float f32x4 __attribute__((ext_vector_type(4)));
typedef unsigned u32x4 __attribute__((ext_vector_type(4)));
constexpr int BM = 256, BK = 64, HALF = 128, HTB = HALF * BK * 2  , STAGE_BYTES = 8 * HTB, NXCD = 8, WGM = 8;

__host__ __device__ __forceinline__ int lds_byte(int r, int c) { const int st = (r >> 4) * 2 + (c >> 5), rr = r & 15, cc = c & 31, ob = rr * 64 + cc * 2; return st * 1024 + (ob ^ (((ob >> 9) & 1) << 5)); }
__host__ __device__ __forceinline__ void stage_rc(int b, int& R, int& C) { const int st = b / 1024, sb = b % 1024, swz = sb ^ (((sb >> 9) & 1) << 5); R = (st >> 1) * 16 + swz / 64; C = (st & 1) * 32 + (swz % 64) / 2; }
__host__ __device__ __forceinline__ int perm32(int rho) { const int n = rho >> 4, i = rho & 15; return 8 * (i >> 2) + 4 * n + (i & 3); }

struct Unit { int pm, pn, ko; };
struct Gemm { const bf16_t* A; const bf16_t* Bt; int M, N, K; int ld = 0; };

struct StaticOrder {
    static constexpr bool SLICED = false;
    int nM, nN, nwg, G, c;
    __host__ __device__ void init(int M, int N, int G_, int c_) { nM = M / BM; nN = N / BM; nwg = nM * nN; G = G_; c = c_; }
    __host__ __device__ bool next(int i, Unit& u) const {
        const long L = (long)i * G + c; if (L >= nwg) return false;
        int wgid = (int)L; { const int q = nwg / NXCD, r = nwg % NXCD, xcd = wgid % NXCD, off = wgid / NXCD; wgid = (xcd < r ? xcd * (q + 1) : r * (q + 1) + (xcd - r) * q) + off; }
        const int nig = WGM * nN, gid = wgid / nig, fm = gid * WGM, gsz = (nM - fm) < WGM ? (nM - fm) : WGM;
        u.pm = fm + ((wgid % nig) % gsz); u.pn = (wgid % nig) / gsz; return true;
    }
    __device__ __forceinline__ void a_ready(const Unit&) const {}
    __device__ __forceinline__ void done(const Unit&) const {}
};


#define EPI_ROWS(...) _Pragma("unroll") for (int ai = 0; ai < 2; ++ai) _Pragma("unroll") for (int m = 0; m < 4; ++m) { const int rowl = u.pm * BM + ai * HALF + wr * 64 + m * 16 + fr; __VA_ARGS__ }

struct EpiInA {
    static constexpr bool PERM = true, AFTER_DRAIN = false;
    bf16_t* projA; const float* rstd0; const float* cosT; const float* sinT;
    const float *qn, *kn, *fqn, *fkn, *gbias, *fbias; float* gate; float* logf;
    __device__ __forceinline__ void operator()(const f32x4 (&acc)[2][2][4][2], const Unit& u, int wr, int wc, int fr, int fq) const {
        const int s = u.pn * 4 + wc;
        if (s > 44) return;
        int kind = 0; const float* gain = qn; float scale = 1.f;
        if (s < 8) { kind = 2; gain = qn; scale = QSCALE; }
        else if (s < 12) { kind = 2; gain = kn; }
        else if (s < 20) { kind = 0; }
        else if (s < 28) { kind = 1; gain = fqn; scale = QSCALE; }
        else if (s < 36) { kind = 1; gain = fkn; }
        else if (s < 44) { kind = 0; }
        else kind = 3;
        float rsv[8];
#pragma unroll
        for (int q = 0; q < 8; ++q) rsv[q] = rstd0[u.pm * BM + (q >> 2) * HALF + wr * 64 + (q & 3) * 16 + fr];
        if (kind == 3) {
            EPI_ROWS(
                const float rs = rsv[ai * 4 + m];
                float v[8];
                _Pragma("unroll") for (int n = 0; n < 2; ++n) _Pragma("unroll") for (int e = 0; e < 4; ++e) v[n * 4 + e] = acc[ai][0][m][n][e] * rs;
                if (fq < 3) { float o[8]; _Pragma("unroll") for (int j = 0; j < 8; ++j) o[j] = sigmoidf_(v[j] + gbias[8 * fq + j]);
                    *(f32x4*)(gate + (size_t)rowl * 24 + 8 * fq) = (f32x4){o[0], o[1], o[2], o[3]}; *(f32x4*)(gate + (size_t)rowl * 24 + 8 * fq + 4) = (f32x4){o[4], o[5], o[6], o[7]}; }
                else { float o[8]; _Pragma("unroll") for (int j = 0; j < 8; ++j) o[j] = log_sigmoidf_(v[j] + fbias[j]);
                    _Pragma("unroll") for (int j = 0; j < 8; ++j) logf[((size_t)(rowl >> 12) * 8 + j) * SEQ + (rowl & (SEQ - 1))] = o[j]; }
            )
            return;
        }
        const bool do_norm = kind >= 1, do_rope = kind == 2;
        float g[16];
        { const float* gp = gain + 8 * fq; const f32x4 g0 = *(const f32x4*)gp, g1 = *(const f32x4*)(gp + 4), g2 = *(const f32x4*)(gp + 32), g3 = *(const f32x4*)(gp + 36);
#pragma unroll
          for (int i = 0; i < 4; ++i) { g[i] = do_norm ? g0[i] * scale : scale; g[4 + i] = do_norm ? g1[i] * scale : scale; g[8 + i] = do_norm ? g2[i] * scale : scale; g[12 + i] = do_norm ? g3[i] * scale : scale; } }
        const float ir[8] = {0.15915494309189535f, 0.03086376340470123f, 0.005985185712713705f, 0.001160663641240061f, 0.00022507907903927653f, 4.364795279280289e-05f, 8.464330808241401e-06f, 1.6414262627950345e-06f};
        const bool rope_lane = do_rope && fq < 2;
        EPI_ROWS(
            const float rs = rsv[ai * 4 + m];
            float v[16];
            _Pragma("unroll") for (int bj = 0; bj < 2; ++bj) _Pragma("unroll") for (int n = 0; n < 2; ++n) _Pragma("unroll") for (int e = 0; e < 4; ++e) v[bj * 8 + n * 4 + e] = acc[ai][bj][m][n][e];
            float sc = rs;
            if (do_norm) { float s0 = 0.f, s1 = 0.f;
                _Pragma("unroll") for (int i = 0; i < 16; i += 2) { s0 += v[i] * v[i]; s1 += v[i + 1] * v[i + 1]; }
                float ss = xsum32(xsum16(s0 + s1));
                sc = rs * rsqrtf(ss * (rs * rs) * (1.0f / 64.0f) + EPS); }
            _Pragma("unroll") for (int i = 0; i < 16; ++i) v[i] = v[i] * (sc * g[i]);
            if (do_rope) {
            float oth[8];
            _Pragma("unroll") for (int j = 0; j < 8; ++j) oth[j] = xchg16(v[j], (fq & 1) != 0);
            const float pos = rope_lane ? (float)(rowl & (SEQ - 1)) : 0.f;
            const float sgn = (fq == 0) ? -1.f : 1.f;
            _Pragma("unroll") for (int j = 0; j < 8; ++j) { const float rev = pos * ir[j]; const float fr_ = rev - floorf(rev); const float cc = __builtin_amdgcn_cosf(fr_), sn = __builtin_amdgcn_sinf(fr_) * sgn;
                v[j] = v[j] * cc + oth[j] * sn; }
            }
            bf16_t* dst = projA + (size_t)rowl * LDA + s * 64 + 8 * fq;
            _Pragma("unroll") for (int bj = 0; bj < 2; ++bj) { u32x4 w; w.x = ::cvtpk(v[bj * 8 + 0], v[bj * 8 + 1]); w.y = ::cvtpk(v[bj * 8 + 2], v[bj * 8 + 3]);
                w.z = ::cvtpk(v[bj * 8 + 4], v[bj * 8 + 5]); w.w = ::cvtpk(v[bj * 8 + 6], v[bj * 8 + 7]); *(u32x4*)(dst + 32 * bj) = w; }
        )
    }
};

__device__ __forceinline__ float row_rstd(const float* ssp, int row) { const f32x4* q = (const f32x4*)(ssp + (size_t)row * 16); const f32x4 a = q[0], b = q[1], c = q[2], d = q[3];
    const float s = (((a[0] + a[1]) + (a[2] + a[3])) + ((b[0] + b[1]) + (b[2] + b[3]))) + (((c[0] + c[1]) + (c[2] + c[3])) + ((d[0] + d[1]) + (d[2] + d[3]))); return rsqrtf(s * (1.0f / 1024.0f) + EPS); }
template <bool RES_F32> struct EpiResid {
    static constexpr bool PERM = true, AFTER_DRAIN = false;
    const void* res; bf16_t* outb; float* ss;
    __device__ __forceinline__ void operator()(const f32x4 (&acc)[2][2][4][2], const Unit& u, int wr, int wc, int fr, int fq) const {
        constexpr int MB = RES_F32 ? 2 : 4;
#pragma unroll
        for (int ai = 0; ai < 2; ++ai)
#pragma unroll
            for (int m0 = 0; m0 < 4; m0 += MB) {
                f32x4 r0[MB][2], r1[MB][2];
#pragma unroll
                for (int mm = 0; mm < MB; ++mm) { const int rowl = u.pm * BM + ai * HALF + wr * 64 + (m0 + mm) * 16 + fr; const size_t off = (size_t)rowl * DM + u.pn * BM + wc * 32 + 8 * fq;
#pragma unroll
                    for (int bj = 0; bj < 2; ++bj) {
                        if (RES_F32) { r0[mm][bj] = *(const f32x4*)((const float*)res + off + bj * HALF); r1[mm][bj] = *(const f32x4*)((const float*)res + off + bj * HALF + 4); }
                        else { const u32x4 rw = *(const u32x4*)((const bf16_t*)res + off + bj * HALF); r0[mm][bj] = (f32x4){bflo(rw.x), bfhi(rw.x), bflo(rw.y), bfhi(rw.y)}; r1[mm][bj] = (f32x4){bflo(rw.z), bfhi(rw.z), bflo(rw.w), bfhi(rw.w)}; } } }
#pragma unroll
                for (int mm = 0; mm < MB; ++mm) { const int m = m0 + mm; const int rowl = u.pm * BM + ai * HALF + wr * 64 + m * 16 + fr; const size_t off = (size_t)rowl * DM + u.pn * BM + wc * 32 + 8 * fq; float part = 0.f;
#pragma unroll
                    for (int bj = 0; bj < 2; ++bj) {
                        const f32x4 x0 = r0[mm][bj] + acc[ai][bj][m][0], x1 = r1[mm][bj] + acc[ai][bj][m][1];
                        u32x4 w; w.x = ::cvtpk(x0[0], x0[1]); w.y = ::cvtpk(x0[2], x0[3]); w.z = ::cvtpk(x1[0], x1[1]); w.w = ::cvtpk(x1[2], x1[3]); *(u32x4*)(outb + off + bj * HALF) = w;
                        part += (x0[0] * x0[0] + x0[1] * x0[1]) + (x0[2] * x0[2] + x0[3] * x0[3]) + (x1[0] * x1[0] + x1[1] * x1[1]) + (x1[2] * x1[2] + x1[3] * x1[3]);
                    }
                    part = xsum32(xsum16(part));
                    if (fq == 0 && ss) ss[(size_t)rowl * 16 + u.pn * 4 + wc] = part; }
            }
    }
};

template <bool MOE> struct EpiSwiglu {
    static constexpr bool PERM = true, AFTER_DRAIN = false;
    bf16_t* h; const float* rsrc; int row_off;
    __device__ __forceinline__ void operator()(const f32x4 (&acc)[2][2][4][2], const Unit& u, int wr, int wc, int fr, int fq) const {
        const int pnl = MOE ? (u.pn % 22) : u.pn;
        float rsv[8];
#pragma unroll
        for (int q = 0; q < 8; ++q) { const int rl = u.pm * BM + (q >> 2) * HALF + wr * 64 + (q & 3) * 16 + fr; rsv[q] = MOE ? rsrc[row_off + rl] : row_rstd(rsrc, rl); }
        EPI_ROWS(
            const float rs = rsv[ai * 4 + m]; const float c1 = -LOG2E * rs, kq = __builtin_amdgcn_rcpf(rs * rs);
            f32x4 o4[2];
            _Pragma("unroll") for (int n = 0; n < 2; ++n) { const f32x4 gg = acc[ai][0][m][n], uu = acc[ai][1][m][n]; const f32x4 a = gg * c1;
                const f32x4 ex = {__builtin_amdgcn_exp2f(a[0]), __builtin_amdgcn_exp2f(a[1]), __builtin_amdgcn_exp2f(a[2]), __builtin_amdgcn_exp2f(a[3])};
                const f32x4 d = ex * kq + kq;
                const f32x4 r = {__builtin_amdgcn_rcpf(d[0]), __builtin_amdgcn_rcpf(d[1]), __builtin_amdgcn_rcpf(d[2]), __builtin_amdgcn_rcpf(d[3])};
                o4[n] = (gg * uu) * r; }
            u32x4 w; w.x = ::cvtpk(o4[0][0], o4[0][1]); w.y = ::cvtpk(o4[0][2], o4[0][3]); w.z = ::cvtpk(o4[1][0], o4[1][1]); w.w = ::cvtpk(o4[1][2], o4[1][3]);
            *(u32x4*)(h + (size_t)rowl * DFF + pnl * 128 + wc * 32 + 8 * fq) = w;
        )
    }
};

struct EpiGlaIn {
    static constexpr bool PERM = true, AFTER_DRAIN = false;
    bf16_t* projC; const float* rstd2;
    __device__ __forceinline__ void operator()(const f32x4 (&acc)[2][2][4][2], const Unit& u, int wr, int wc, int fr, int fq) const {
        float rsv[8];
#pragma unroll
        for (int q = 0; q < 8; ++q) rsv[q] = rstd2[u.pm * BM + (q >> 2) * HALF + wr * 64 + (q & 3) * 16 + fr];
        EPI_ROWS(
            float rs = rsv[ai * 4 + m]; if (u.pn < 2) rs *= 0.08838834764831845f;
            _Pragma("unroll") for (int bj = 0; bj < 2; ++bj) { const f32x4 x0 = acc[ai][bj][m][0] * rs, x1 = acc[ai][bj][m][1] * rs;
                u32x4 w; w.x = ::cvtpk(x0[0], x0[1]); w.y = ::cvtpk(x0[2], x0[3]); w.z = ::cvtpk(x1[0], x1[1]); w.w = ::cvtpk(x1[2], x1[3]);
                *(u32x4*)(projC + (size_t)rowl * LDC + u.pn * BM + bj * HALF + wc * 32 + 8 * fq) = w; }
        )
    }
};

struct EpiMoeDown {
    static constexpr bool PERM = true, AFTER_DRAIN = false;
    bf16_t* xy; const float* rgate; const float* rkeep; int row_off;
    __device__ __forceinline__ void operator()(const f32x4 (&acc)[2][2][4][2], const Unit& u, int wr, int wc, int fr, int fq) const {
        const int pnl = u.pn & 3;
        float gv[8], kv[8];
#pragma unroll
        for (int q = 0; q < 8; ++q) { const int rg_ = row_off + u.pm * BM + (q >> 2) * HALF + wr * 64 + (q & 3) * 16 + fr; gv[q] = rgate[rg_]; kv[q] = rkeep[rg_]; }
#pragma unroll
        for (int ai = 0; ai < 2; ++ai) {
            u32x4 old4[4][2];
#pragma unroll
            for (int m = 0; m < 4; ++m) { const int rowg = row_off + u.pm * BM + ai * HALF + wr * 64 + m * 16 + fr;
#pragma unroll
                for (int bj = 0; bj < 2; ++bj) old4[m][bj] = *(const u32x4*)(xy + (size_t)rowg * DM + pnl * BM + bj * HALF + wc * 32 + 8 * fq); }
#pragma unroll
            for (int m = 0; m < 4; ++m) { const int rowg = row_off + u.pm * BM + ai * HALF + wr * 64 + m * 16 + fr; const float w8 = gv[ai * 4 + m], kp = kv[ai * 4 + m];
#pragma unroll
                for (int bj = 0; bj < 2; ++bj) {
                    bf16_t* dst = xy + (size_t)rowg * DM + pnl * BM + bj * HALF + wc * 32 + 8 * fq;
                    const u32x4 rw = old4[m][bj];
                    const f32x4 r0 = (f32x4){bflo(rw.x), bfhi(rw.x), bflo(rw.y), bfhi(rw.y)}, r1 = (f32x4){bflo(rw.z), bfhi(rw.z), bflo(rw.w), bfhi(rw.w)};
                    const f32x4 x0 = r0 * kp + acc[ai][bj][m][0] * w8, x1 = r1 * kp + acc[ai][bj][m][1] * w8;
                    u32x4 w; w.x = ::cvtpk(x0[0], x0[1]); w.y = ::cvtpk(x0[2], x0[3]); w.z = ::cvtpk(x1[0], x1[1]); w.w = ::cvtpk(x1[2], x1[3]);
                    *(u32x4*)dst = w; } }
        }
    }
};

struct GroupedOrder {
    static constexpr bool SLICED = false;
    StaticOrder so; const int* tile_e; int tile0, nN;
    __device__ __forceinline__ bool next(int i, Unit& u) const { if (!so.next(i, u)) return false; u.pn = __builtin_amdgcn_readfirstlane(tile_e[tile0 + u.pm]) * nN + u.pn; return true; }
    __device__ __forceinline__ void a_ready(const Unit&) const {}
    __device__ __forceinline__ void done(const Unit&) const {}
};

struct SliceOrder {
    static constexpr bool SLICED = true;
    const int* tile_e; int tile0  , xt0  , nunits, G, c;
    __device__ __forceinline__ bool next(int i, Unit& u) const { const int j = i * G + c; if (j >= nunits) return false;
        const int xt = j / 44, rem = j - xt * 44; u.pm = xt0 + xt; u.pn = __builtin_amdgcn_readfirstlane(tile_e[tile0 + u.pm]) * 4 + (rem & 3); u.ko = (rem >> 2) * 256; return true; }
    __device__ __forceinline__ void a_ready(const Unit&) const {}
    __device__ __forceinline__ void done(const Unit&) const {}
};
struct EpiMoePart {
    static constexpr bool PERM = true, AFTER_DRAIN = false;
    float* part; int xt0;
    __device__ __forceinline__ void operator()(const f32x4 (&acc)[2][2][4][2], const Unit& u, int wr, int wc, int fr, int fq) const {
        const int pnl = u.pn & 3, sl = u.ko >> 8;
#pragma unroll
        for (int ai = 0; ai < 2; ++ai)
#pragma unroll
            for (int m = 0; m < 4; ++m) { const int xr = (u.pm - xt0) * BM + ai * HALF + wr * 64 + m * 16 + fr;
                float* dst = part + ((size_t)xr * 11 + sl) * DM + pnl * BM + wc * 32 + 8 * fq;
#pragma unroll
                for (int bj = 0; bj < 2; ++bj) { *(f32x4*)(dst + bj * HALF) = acc[ai][bj][m][0]; *(f32x4*)(dst + bj * HALF + 4) = acc[ai][bj][m][1]; } }
    }
};
template <class Epi, class Sched, bool ALIGN_EPI = false, bool SP2 = false>
__device__ __forceinline__ void gemm_phase(PG8_LAS unsigned char* lds, const Gemm g, const Sched& S, const Epi& E) {
    int tid_l_ = threadIdx.x; asm volatile("" : "+v"(tid_l_)); const int tid = tid_l_, wid = __builtin_amdgcn_readfirstlane(tid >> 6), lane = tid & 63, wr = wid >> 2, wc = wid & 3, fr = lane & 15, fq = lane >> 4;
    const int K = g.ld ? g.ld : g.K  , nt = g.K / BK;
    unsigned voffA[2], voffB[2];
#pragma unroll
    for (int i = 0; i < 2; ++i) { int R, C; stage_rc(tid * 16 + i * 8192, R, C); const int Rb = Epi::PERM ? ((R & ~31) + perm32(R & 31)) : R;
        voffA[i] = (unsigned)(R * K + C) * 2u; voffB[i] = (unsigned)(Rb * K + C) * 2u; }
    const size_t kstep = (size_t)(BK * 2);
    const size_t hstep = (size_t)HALF * K * 2;
    const size_t tstep = 2 * hstep;
    const unsigned ldsw = (unsigned)wid * 1024u;
    const int aoff = lds_byte(wr * 64 + fr, fq * 8), boff = lds_byte(wc * 32 + fr, fq * 8);
#define PG8_SA(b, h) (((b) * 2 + (h)) * HTB)
#define PG8_SB(b, h) ((4 + (b) * 2 + (h)) * HTB)
#define PG8_STAGE(bufoff, gbase, voff) do { _Pragma("unroll") for (int _i = 0; _i < 2; ++_i) \
        __builtin_amdgcn_global_load_lds((const unsigned*)((const char*)(gbase) + (voff)[_i]), (PG8_LAS unsigned*)(lds + (bufoff) + ldsw + _i * 8192), 16, 0, 0); } while (0)
#define PG8_LDA(dst, b, h) do { _Pragma("unroll") for (int m = 0; m < 4; ++m) _Pragma("unroll") for (int k = 0; k < 2; ++k) dst[m][k] = *(const PG8_LAS bf16x8*)(lds + PG8_SA(b, h) + aoff + m * 2048 + k * 1024); } while (0)
#define PG8_LDB(dst, b, h) do { _Pragma("unroll") for (int n = 0; n < 2; ++n) _Pragma("unroll") for (int k = 0; k < 2; ++k) dst[n][k] = *(const PG8_LAS bf16x8*)(lds + PG8_SB(b, h) + boff + n * 2048 + k * 1024); } while (0)
#define PG8_MMA(ai, bj, At, Bt) do { __builtin_amdgcn_s_setprio(1); _Pragma("unroll") for (int m = 0; m < 4; ++m) _Pragma("unroll") for (int n = 0; n < 2; ++n) _Pragma("unroll") for (int k = 0; k < 2; ++k) \
        acc[ai][bj][m][n] = __builtin_amdgcn_mfma_f32_16x16x32_bf16(Bt[n][k], At[m][k], acc[ai][bj][m][n], 0, 0, 0); __builtin_amdgcn_s_setprio(0); } while (0)
#define PG8_WAIT_V(n) asm volatile("s_waitcnt vmcnt(" #n ")" ::: "memory")
#define PG8_WAIT_L(n) asm volatile("s_waitcnt lgkmcnt(" #n ")" ::: "memory")
#define PG8_BAR __builtin_amdgcn_s_barrier()
#define PG8_SCHED __builtin_amdgcn_sched_barrier(0)
    Unit cur, nxt; int ui = 0;
    if (!S.next(0, cur)) return;
    f32x4 acc[2][2][4][2];
#pragma unroll
    for (int a = 0; a < 2; ++a)
#pragma unroll
        for (int b = 0; b < 2; ++b)
#pragma unroll
            for (int m = 0; m < 4; ++m)
#pragma unroll
                for (int n = 0; n < 2; ++n) acc[a][b][m][n] = (f32x4){0.f, 0.f, 0.f, 0.f};
    bf16x8 At[4][2], B0[2][2], B1[2][2];
    const char* cA = (const char*)g.A + (size_t)cur.pm * tstep; const char* cB = (const char*)g.Bt + (size_t)cur.pn * tstep;
    if constexpr (Sched::SLICED) { cA += (size_t)cur.ko * 2; cB += (size_t)cur.ko * 2; }
    S.a_ready(cur);
    if constexpr (SP2) {
        PG8_STAGE(PG8_SB(0, 0), cB, voffB); PG8_STAGE(PG8_SB(0, 1), cB + hstep, voffB); PG8_STAGE(PG8_SA(0, 0), cA, voffA); PG8_STAGE(PG8_SA(0, 1), cA + hstep, voffA);
        if (wr == 1) PG8_BAR;
        PG8_WAIT_V(2); PG8_BAR;
        PG8_STAGE(PG8_SB(1, 0), cB + kstep, voffB); PG8_STAGE(PG8_SA(1, 0), cA + kstep, voffA); PG8_STAGE(PG8_SB(1, 1), cB + hstep + kstep, voffB);
        PG8_WAIT_V(6); PG8_BAR;
    } else {
        PG8_STAGE(PG8_SB(0, 0), cB, voffB); PG8_STAGE(PG8_SA(0, 0), cA, voffA); PG8_STAGE(PG8_SB(0, 1), cB + hstep, voffB); PG8_STAGE(PG8_SA(0, 1), cA + hstep, voffA);
        if (wr == 1) PG8_BAR;
        PG8_WAIT_V(4); PG8_BAR;
        PG8_STAGE(PG8_SB(1, 0), cB + kstep, voffB); PG8_STAGE(PG8_SA(1, 0), cA + kstep, voffA); PG8_STAGE(PG8_SB(1, 1), cB + hstep + kstep, voffB);
        PG8_WAIT_V(6); PG8_BAR;
    }
    for (;;) {
        const bool has_next = S.next(ui + 1, nxt);
        const char* nA = has_next ? (const char*)g.A + (size_t)nxt.pm * tstep + (Sched::SLICED ? (size_t)nxt.ko * 2 : (size_t)0) : cA; const char* nB = has_next ? (const char*)g.Bt + (size_t)nxt.pn * tstep + (Sched::SLICED ? (size_t)nxt.ko * 2 : (size_t)0) : cB;
        for (int t = 0; t < nt; t += 2) {
            const bool last = (t == nt - 2);
            const char* a1 = cA + (size_t)(t + 1) * kstep;
            const char* a2 = last ? nA : cA + (size_t)(t + 2) * kstep; const char* b2 = last ? nB : cB + (size_t)(t + 2) * kstep;
            const char* a3 = a2 + kstep; const char* b3 = b2 + kstep;
            if (last && has_next) S.a_ready(nxt);
            if constexpr (SP2) {
            PG8_LDB(B0, 0, 0); PG8_LDB(B1, 0, 1); PG8_SCHED; PG8_LDA(At, 0, 0); PG8_STAGE(PG8_SA(1, 1), a1 + hstep, voffA);
            PG8_WAIT_V(8); PG8_WAIT_L(0); PG8_BAR; PG8_MMA(0, 0, At, B0); PG8_MMA(0, 1, At, B1); PG8_BAR; PG8_SCHED;
            PG8_LDA(At, 0, 1); PG8_STAGE(PG8_SB(0, 0), b2, voffB); PG8_STAGE(PG8_SB(0, 1), b2 + hstep, voffB); PG8_STAGE(PG8_SA(0, 0), a2, voffA);
            PG8_WAIT_V(8); PG8_WAIT_L(0); PG8_BAR; PG8_MMA(1, 0, At, B0); PG8_MMA(1, 1, At, B1); PG8_BAR; PG8_SCHED;
            PG8_LDB(B0, 1, 0); PG8_LDB(B1, 1, 1); PG8_SCHED; PG8_LDA(At, 1, 0); PG8_STAGE(PG8_SA(0, 1), a2 + hstep, voffA);
            PG8_WAIT_V(8); PG8_WAIT_L(0); PG8_BAR; PG8_MMA(0, 0, At, B0); PG8_MMA(0, 1, At, B1); PG8_BAR; PG8_SCHED;
            PG8_LDA(At, 1, 1); PG8_STAGE(PG8_SB(1, 0), b3, voffB); PG8_STAGE(PG8_SB(1, 1), b3 + hstep, voffB); PG8_STAGE(PG8_SA(1, 0), a3, voffA);
            PG8_WAIT_V(8); PG8_WAIT_L(0); PG8_BAR; PG8_MMA(1, 0, At, B0); PG8_MMA(1, 1, At, B1); PG8_BAR; PG8_SCHED;
            } else {
            PG8_LDB(B0, 0, 0); PG8_SCHED; PG8_LDA(At, 0, 0); PG8_STAGE(PG8_SA(1, 1), a1 + hstep, voffA);
            PG8_WAIT_L(8); PG8_BAR; PG8_WAIT_L(0); PG8_MMA(0, 0, At, B0); PG8_BAR; PG8_SCHED;
            PG8_LDB(B1, 0, 1); PG8_STAGE(PG8_SB(0, 0), b2, voffB);
            PG8_BAR; PG8_WAIT_L(0); PG8_MMA(0, 1, At, B1); PG8_BAR;
            PG8_LDA(At, 0, 1); PG8_STAGE(PG8_SA(0, 0), a2, voffA);
            PG8_BAR; PG8_WAIT_L(0); PG8_MMA(1, 0, At, B0); PG8_BAR; PG8_SCHED;
            PG8_STAGE(PG8_SB(0, 1), b2 + hstep, voffB);
            PG8_WAIT_V(6); PG8_BAR; PG8_MMA(1, 1, At, B1); PG8_BAR;
            PG8_LDB(B0, 1, 0); PG8_SCHED; PG8_LDA(At, 1, 0); PG8_STAGE(PG8_SA(0, 1), a2 + hstep, voffA);
            PG8_WAIT_L(8); PG8_BAR; PG8_WAIT_L(0); PG8_MMA(0, 0, At, B0); PG8_BAR; PG8_SCHED;
            PG8_LDB(B1, 1, 1); PG8_STAGE(PG8_SB(1, 0), b3, voffB);
            PG8_BAR; PG8_WAIT_L(0); PG8_MMA(0, 1, At, B1); PG8_BAR;
            PG8_LDA(At, 1, 1); PG8_STAGE(PG8_SA(1, 0), a3, voffA);
            PG8_BAR; PG8_WAIT_L(0); PG8_MMA(1, 0, At, B0); PG8_BAR; PG8_SCHED;
            PG8_STAGE(PG8_SB(1, 1), b3 + hstep, voffB);
            PG8_WAIT_V(6); PG8_BAR; PG8_MMA(1, 1, At, B1); PG8_BAR;
            }
        }
        if constexpr (ALIGN_EPI) { if (wr == 0) PG8_BAR; }
        if constexpr (!Epi::AFTER_DRAIN) { E(acc, cur, wr, wc, fr, fq);
            S.done(cur); }
        if (!has_next) break;
#pragma unroll
        for (int a = 0; a < 2; ++a)
#pragma unroll
            for (int b = 0; b < 2; ++b)
#pragma unroll
                for (int m = 0; m < 4; ++m)
#pragma unroll
                    for (int n = 0; n < 2; ++n) acc[a][b][m][n] = (f32x4){0.f, 0.f, 0.f, 0.f};
        cur = nxt; cA = nA; cB = nB; ++ui;
        if constexpr (ALIGN_EPI) { if (wr == 1) PG8_BAR; }
    }
    PG8_WAIT_V(0);
    if constexpr (!ALIGN_EPI) { if (wr == 0) PG8_BAR; }
    PG8_BAR;
    if constexpr (Epi::AFTER_DRAIN) { E.fused(acc, cur, wr, wc, fr, fq, lds, wid, lane); S.done(cur); }
#undef PG8_SA
#undef PG8_SB
#undef PG8_STAGE
#undef PG8_LDA
#undef PG8_LDB
#undef PG8_MMA
#undef PG8_WAIT_V
#undef PG8_WAIT_L
#undef PG8_BAR
#undef PG8_SCHED
}
}

namespace att {
constexpr int A_KV = 0, A_KB = 49152, A_WS = 49920, A_MASK = 51968, A_SHQ = 52480, A_IMP = 53248, A_OC = 119808, A_IVC = 152576;
DI constexpr int crc(int r) { return (r & 3) + 8 * (r >> 2); }
constexpr int IMP_LD = 65;
DI int crow(int r, int hi) { return (r & 3) + 8 * (r >> 2) + 4 * hi; }
#define MFMA32(a, b, c) __builtin_amdgcn_mfma_f32_32x32x16_bf16((a), (b), (c), 0, 0, 0)

struct KVRegs { u32x4 k, v; float kb; };
struct Sweep {
    const bf16_t* K; const bf16_t* V; int ld;
    const float* kbias;
};
DI void kv_issue(KVRegs& r, const Sweep& s, int tile, int tid) {
    const int key = tid & 63, ch = tid >> 6;
    const size_t row0 = (size_t)tile * 64;
    r.k = *(const u32x4*)(s.K + (row0 + key) * s.ld + ch * 8);
    const int p = tid >> 6, l = tid & 63; const int row = 16 * (p & 3) + (l >> 2), col = (p >> 2) * 32 + (l & 3) * 8;
    r.v = *(const u32x4*)(s.V + (row0 + row) * s.ld + col);
    r.kb = (s.kbias && tid < 64) ? s.kbias[row0 + tid] : 0.f;
}
DI void kv_commit(const KVRegs& r, LAS char* lds, int slot, int tid, bool has_kb) {
    LAS char* sl = lds + A_KV + slot * 16384;
    *(LAS u32x4*)(sl + (tid >> 6) * 1024 + (tid & 63) * 16) = r.k;
    *(LAS u32x4*)(sl + 8192 + tid * 16) = r.v;
    if (has_kb && tid < 64) *(LAS float*)(lds + A_KB + slot * 256 + tid * 4) = r.kb;
}
DI void glds16(const void* gsrc, unsigned lds_dst) { unsigned keep;
    asm volatile("s_mov_b32 %0, m0\n\ts_mov_b32 m0, %2\n\ts_nop 0\n\tglobal_load_lds_dwordx4 %1, off\n\ts_mov_b32 m0, %0" : "=&s"(keep) : "v"(gsrc), "s"(lds_dst) : "memory"); }
DI void glds4(const void* gsrc, unsigned lds_dst) { unsigned keep;
    asm volatile("s_mov_b32 %0, m0\n\ts_mov_b32 m0, %2\n\ts_nop 0\n\tglobal_load_lds_dword %1, off\n\ts_mov_b32 m0, %0" : "=&s"(keep) : "v"(gsrc), "s"(lds_dst) : "memory"); }
DI void kv_dma(const Sweep& s, int tile, LAS char* lds, int slot, int tid, int wid, bool has_kb) {
    const int l = tid & 63;
    const size_t row0 = (size_t)tile * 64;
    const bf16_t* ksrc = s.K + (row0 + l) * s.ld + wid * 8;
    const bf16_t* vsrc = s.V + (row0 + 16 * (wid & 3) + (l >> 2)) * s.ld + (wid >> 2) * 32 + (l & 3) * 8;
    const unsigned sl = (unsigned)__builtin_amdgcn_readfirstlane((int)(unsigned)(uintptr_t)(lds + A_KV + slot * 16384 + wid * 1024));
    glds16(ksrc, sl);
    glds16(vsrc, sl + 8192);
    if (has_kb) glds4(s.kbias + row0 + l, (unsigned)__builtin_amdgcn_readfirstlane((int)(unsigned)(uintptr_t)(lds + A_KB + slot * 256)));
}
struct FState { float m, l; f32x16 o0, o1, la, negm; };
DI float max3f(float a, float b, float c) { float r; asm("v_max3_f32 %0, %1, %2, %3" : "=v"(r) : "v"(a), "v"(b), "v"(c)); return r; }
DI void fs_init(FState& s) { s.m = 0.f; s.l = 0.f;

#pragma unroll
    for (int r = 0; r < 16; ++r) { s.o0[r] = 0.f; s.o1[r] = 0.f; s.la[r] = 0.f; s.negm[r] = 0.f; } }

DI void qk_tile(f32x16& p0, f32x16& p1, const f32x16& c0, const f32x16& c1, const LAS char* Ks, const bf16x8 (&qr)[4], int r32, int hi) {
    const LAS char* kb = Ks + hi * 1024 + r32 * 16;
    bf16x8 kf[8];
#pragma unroll
    for (int d0 = 0; d0 < 4; ++d0) { kf[2 * d0] = *(const LAS bf16x8*)(kb + d0 * 2048); kf[2 * d0 + 1] = *(const LAS bf16x8*)(kb + d0 * 2048 + 512); }
    __builtin_amdgcn_s_setprio(1);
#pragma unroll
    for (int d0 = 0; d0 < 4; ++d0) {
        if (d0 == 0) { p0 = MFMA32(kf[0], qr[0], c0); p1 = MFMA32(kf[1], qr[0], c1); }
        else { p0 = MFMA32(kf[2 * d0], qr[d0], p0); p1 = MFMA32(kf[2 * d0 + 1], qr[d0], p1); }
    }
    __builtin_amdgcn_s_setprio(0);
}
DI s16x4 vtr(const LAS char* p) { typedef short v4i16_t __attribute__((ext_vector_type(4))); return __builtin_bit_cast(s16x4, __builtin_amdgcn_ds_read_tr16_b64_v4i16((LAS v4i16_t*)p)); }

template <bool NOMAX, bool SUML> DI void softmax_pv(FState& s, f32x16& p0, f32x16& p1, const LAS char* Vs, LAS float* wsf, int lane, int r32, int hi) {
    if (!NOMAX) {
        asm volatile("s_nop 15\n\ts_nop 7" : "+v"(p0), "+v"(p1));
        float rm = max3f(p0[0], p0[1], p1[0]), rm2 = max3f(p0[2], p0[3], p1[1]);
        rm = max3f(rm, p1[2], p1[3]);
#pragma unroll
        for (int r = 4; r < 16; r += 4) { rm = max3f(rm, p0[r], p0[r + 1]); rm2 = max3f(rm2, p0[r + 2], p0[r + 3]); rm = max3f(rm, p1[r], p1[r + 1]); rm2 = max3f(rm2, p1[r + 2], p1[r + 3]); }
        rm = fmaxf(rm, rm2);
        rm = fmaxf(rm, __shfl_xor(rm, 32));
        if (__any(rm > 8.0f)) {
            const float dl = fmaxf(rm, 0.f);
            s.m += dl; const float alpha = __builtin_amdgcn_exp2f(-dl);
#pragma unroll
            for (int r = 0; r < 16; ++r) s.negm[r] = -s.m;
#pragma unroll
            for (int r = 0; r < 16; ++r) { p0[r] -= dl; p1[r] -= dl; }
            if (hi == 0) wsf[r32] = alpha;
#pragma unroll
            for (int r = 0; r < 16; ++r) { const float a = wsf[crow(r, hi)]; s.o0[r] *= a; s.o1[r] *= a; s.la[r] *= a; }
            if (SUML) s.l *= alpha;
        }
    }
#pragma unroll
    for (int r = 0; r < 16; ++r) { p0[r] = __builtin_amdgcn_exp2f(p0[r]); p1[r] = __builtin_amdgcn_exp2f(p1[r]); }
    if (SUML) { float sum = 0.f;
#pragma unroll
        for (int r = 0; r < 16; ++r) sum += p0[r] + p1[r];
        s.l += sum; }
    u32x4 pw[4];
    pw[0] = (u32x4){cvtpk(p0[0], p0[1]), cvtpk(p0[2], p0[3]), cvtpk(p0[4], p0[5]), cvtpk(p0[6], p0[7])};
    pw[1] = (u32x4){cvtpk(p0[8], p0[9]), cvtpk(p0[10], p0[11]), cvtpk(p0[12], p0[13]), cvtpk(p0[14], p0[15])};
    pw[2] = (u32x4){cvtpk(p1[0], p1[1]), cvtpk(p1[2], p1[3]), cvtpk(p1[4], p1[5]), cvtpk(p1[6], p1[7])};
    pw[3] = (u32x4){cvtpk(p1[8], p1[9]), cvtpk(p1[10], p1[11]), cvtpk(p1[12], p1[13]), cvtpk(p1[14], p1[15])};
    const bf16x8 ones = (bf16x8){0x3F80, 0x3F80, 0x3F80, 0x3F80, 0x3F80, 0x3F80, 0x3F80, 0x3F80};
    const LAS char* vp = Vs + ((lane >> 4) & 1) * 32 + (lane & 3) * 8 + (4 * hi + ((lane & 15) >> 2)) * 64;
#pragma unroll
    for (int ks = 0; ks < 4; ++ks) {
        const bf16x8 pa = __builtin_bit_cast(bf16x8, pw[ks]);
        { const s16x4 lo = vtr(vp + ks * 1024), hh = vtr(vp + ks * 1024 + 512); const bf16x8 vf = (bf16x8){lo[0], lo[1], lo[2], lo[3], hh[0], hh[1], hh[2], hh[3]}; s.o0 = MFMA32(pa, vf, s.o0); }
        { const s16x4 lo = vtr(vp + 4096 + ks * 1024), hh = vtr(vp + 4096 + ks * 1024 + 512); const bf16x8 vf = (bf16x8){lo[0], lo[1], lo[2], lo[3], hh[0], hh[1], hh[2], hh[3]}; s.o1 = MFMA32(pa, vf, s.o1); }
        s.la = MFMA32(pa, ones, s.la);
    }
}
template <int MODE> DI float fs_finish(const FState& s, const float (&gr)[16], LAS float* wsf, LAS char* stg_bf, LAS char* stg_f32, int r32, int hi) {
    LAS bf16_t* sb = (LAS bf16_t*)stg_bf; LAS float* sf = (LAS float*)stg_f32;
#pragma unroll
    for (int r = 0; r < 16; ++r) {
        const int orow = crow(r, hi); const float lt = s.la[r]; const float inv = lt > 0.f ? __builtin_amdgcn_rcpf(lt) : 0.f; const float f = inv * gr[r];
        float c0 = s.o0[r] * f, c1 = s.o1[r] * f;
        if (MODE == 1) { c0 += bf2f(sb[orow * 64 + r32]); c1 += bf2f(sb[orow * 64 + 32 + r32]); sf[orow * 64 + r32] = c0; sf[orow * 64 + 32 + r32] = c1; }
        else { if (MODE == 2) { c0 += sf[orow * 64 + r32]; c1 += sf[orow * 64 + 32 + r32]; }
            sb[orow * 64 + r32] = (bf16_t)(cvtpk(c0, 0.f) & 0xffffu); sb[orow * 64 + 32 + r32] = (bf16_t)(cvtpk(c1, 0.f) & 0xffffu); }
    }
    if (MODE == 0) { const float lt = s.l + __shfl_xor(s.l, 32); return lt > 0.f ? 1.0f / lt : 0.f; }
    return 0.f;
}
DI void store_o(bf16_t* Orow0  , int ldo, const LAS char* stg, int lane) {
#pragma unroll
    for (int i = 0; i < 4; ++i) { const int row = i * 8 + (lane >> 3), ch = lane & 7; const u32x4 v = *(const LAS u32x4*)(stg + row * 128 + ch * 16); *(u32x4*)(Orow0 + (size_t)row * ldo + ch * 8) = v; }
}

struct BrP { int cur; int tq; int tt; unsigned long long msk, anym; int jlo, jhi; int fox_lim, fox_lo; float m_c, inv_c; int head_l, tok_l; };
template <int BR> DI int next_tile(const BrP& b, int j) {
    ++j;
    if (BR == 1) { while (j <= b.jhi && !((b.anym >> j) & 1ull)) ++j; }
    return j <= b.jhi ? j : -1;
}
template <int BR, bool NOMAX> DI void sweep(FState& st, const Sweep& sw, const BrP& b, const bf16x8 (&qr)[4], LAS char* lds, LAS float* wsf, int tid, int lane, int r32, int hi, float& carry) {
    const int wid_ = __builtin_amdgcn_readfirstlane(tid >> 6);
#define ATT_WAIT_BAR(n) asm volatile("s_waitcnt vmcnt(" #n ") lgkmcnt(0)\n\ts_barrier" ::: "memory")
#define ATT_END_TILE(more) do { if (more) { if (BR == 3) ATT_WAIT_BAR(3); else ATT_WAIT_BAR(2); } else ATT_WAIT_BAR(0); } while (0)
    int j = next_tile<BR>(b, b.jlo - 1);
    if (j < 0) return;
    int jn = next_tile<BR>(b, j);
    kv_dma(sw, j, lds, 0, tid, wid_, BR == 3);
    if (jn >= 0) kv_dma(sw, jn, lds, 1, tid, wid_, BR == 3);
    ATT_END_TILE(jn >= 0);
    int slot = 0;
    while (j >= 0) {
        const int jn2 = jn >= 0 ? next_tile<BR>(b, jn) : -1;
        if (jn2 >= 0) kv_dma(sw, jn2, lds, slot >= 1 ? slot - 1 : 2, tid, wid_, BR == 3);
        const LAS char* Ks = lds + A_KV + slot * 16384; const LAS char* Vs = Ks + 8192;
        bool active = true;
        if (BR == 3) active = (j <= b.fox_lim) && (j >= b.fox_lo);
        if (active) {
            f32x16 p0, p1;
            const float NEG = -__builtin_inff();
            if (BR == 3) {
                f32x16 c0, c1;
                const LAS float* kb = (const LAS float*)(lds + A_KB + slot * 256);
#pragma unroll
                for (int i = 0; i < 4; ++i) { const f32x4 k0 = *(const LAS f32x4*)(kb + 8 * i + 4 * hi), k1 = *(const LAS f32x4*)(kb + 32 + 8 * i + 4 * hi);
#pragma unroll
                    for (int e = 0; e < 4; ++e) { c0[4 * i + e] = k0[e] + st.negm[4 * i + e]; c1[4 * i + e] = k1[e] + st.negm[4 * i + e]; } }
                qk_tile(p0, p1, c0, c1, Ks, qr, r32, hi);
            } else if (BR == 1) {
                f32x16 cs; const bool sel = (b.msk >> j) & 1ull;
#pragma unroll
                for (int r = 0; r < 16; ++r) cs[r] = sel ? (NOMAX ? 0.f : st.negm[r]) : NEG;
                qk_tile(p0, p1, cs, cs, Ks, qr, r32, hi);
            } else if (NOMAX) {
                f32x16 z;
#pragma unroll
                for (int r = 0; r < 16; ++r) z[r] = 0.f;
                qk_tile(p0, p1, z, z, Ks, qr, r32, hi);
            } else qk_tile(p0, p1, st.negm, st.negm, Ks, qr, r32, hi);
            int tth = b.tt - 4 * hi; asm volatile("" : "+v"(tth));
            if (BR == 0 || BR == 4) {
                int lim = ((b.tq - 31) >> 4) - 64 * j - 4 * hi; asm volatile("" : "+v"(lim));
#pragma unroll
                for (int r = 0; r < 16; ++r) { if (crc(r) > lim) p0[r] = NEG; if (crc(r) + 32 > lim) p1[r] = NEG; }
            } else if (BR == 1) {
                if (j == b.cur) {
#pragma unroll
                    for (int r = 0; r < 16; ++r) { if (crc(r) > tth) p0[r] = NEG; if (crc(r) + 32 > tth) p1[r] = NEG; }
                }
            } else if (BR == 2) {
                if (j == b.cur) {
#pragma unroll
                    for (int r = 0; r < 16; ++r) { if (crc(r) > tth) p0[r] = NEG; if (crc(r) + 32 > tth) p1[r] = NEG; }
                } else if (j == b.cur - 8) {
#pragma unroll
                    for (int r = 0; r < 16; ++r) { if (crc(r) <= tth) p0[r] = NEG; if (crc(r) + 32 <= tth) p1[r] = NEG; }
                }
            } else if (BR == 3) {
                if (j == b.fox_lim) {
#pragma unroll
                    for (int r = 0; r < 16; ++r) { if (crc(r) > tth) p0[r] = NEG; if (crc(r) + 32 > tth) p1[r] = NEG; }
                }
            }
            if (BR != 4) softmax_pv<NOMAX, BR == 0>(st, p0, p1, Vs, wsf, lane, r32, hi);
            if (BR == 4 || (BR == 0 && NOMAX)) {
                const float scl = (BR == 4) ? b.inv_c : 1.0f;
                float G[8], H[8];
#pragma unroll
                for (int i = 0; i < 4; ++i) {
                    float a[4], c[4];
#pragma unroll
                    for (int e = 0; e < 4; ++e) { a[e] = (BR == 4 ? __builtin_amdgcn_exp2f(p0[4 * i + e]) : p0[4 * i + e]) * scl; c[e] = (BR == 4 ? __builtin_amdgcn_exp2f(p1[4 * i + e]) : p1[4 * i + e]) * scl; }
                    H[i] = 0.5f * a[3]; G[i] = a[0] + a[1] + a[2] + H[i]; H[4 + i] = 0.5f * c[3]; G[4 + i] = c[0] + c[1] + c[2] + H[4 + i];
                }
                float Hp[8];
#pragma unroll
                for (int k = 0; k < 8; ++k) Hp[k] = __shfl_xor(H[k], 32);
                LAS float* imp = (LAS float*)(lds + A_IMP) + (b.head_l * 64 + b.tok_l) * IMP_LD + 16 * j;
#pragma unroll
                for (int k = 0; k < 8; ++k) {
                    const float prev = (hi == 1) ? Hp[k] : (k == 0 ? carry : Hp[k - 1]);
                    const int sidx = (k < 4) ? (2 * k + hi) : (8 + 2 * (k - 4) + hi);
                    imp[sidx] = G[k] + prev;
                }
                carry = Hp[7];
            }
        }
        ATT_END_TILE(jn2 >= 0);
        slot = slot == 2 ? 0 : slot + 1; j = jn; jn = jn2;
    }
#undef ATT_WAIT_BAR
#undef ATT_END_TILE
}

struct Tensors {
    const bf16_t* projA; const bf16_t* kcmp; const bf16_t* vcmp; const float* gate; const float* cumneg; bf16_t* O; const float* fqn; const float* fkn; const float* aqn; const float* akn;
};

template <bool NOMAX> DI void nsa_unit(const Tensors& T_, int b, int g, int qt, LAS char* lds) {
    int tid_ = threadIdx.x; asm volatile("" : "+v"(tid_));
    const int tid = tid_, lane = tid & 63, r32 = lane & 31, hi = lane >> 5, wid = __builtin_amdgcn_readfirstlane(tid >> 6);
    LAS float* wsf = (LAS float*)(lds + A_WS) + wid * 64;
    const int head_l = wid >> 1, head = 4 * g + head_l, tok_l = 32 * (wid & 1) + r32;
    const int tq = 64 * qt + tok_l;
    const size_t rowq = (size_t)b * SEQ + tq;
    bf16x8 qr[4];
#pragma unroll
    for (int d0 = 0; d0 < 4; ++d0) qr[d0] = *(const bf16x8*)(T_.projA + rowq * LDA + PA_QA + head * 64 + d0 * 16 + hi * 8);
    LAS char* stg_bf = lds + A_OC + wid * 4096; LAS char* stg_f32 = lds + A_IMP + wid * 8192;
    const size_t rowbase = (size_t)b * SEQ + 64 * qt + 32 * (wid & 1);
    float gr[16];
    BrP bp; bp.cur = qt; bp.tq = tq; bp.tt = tok_l; bp.msk = 0; bp.anym = 0; bp.fox_lim = 0; bp.fox_lo = 0; bp.head_l = head_l; bp.tok_l = tok_l; bp.m_c = 0.f; bp.inv_c = 0.f;
    float carry = 0.f;
    {
        Sweep sw; sw.K = T_.kcmp + ((size_t)b * NCMP_PAD * 2 + g) * 64; sw.V = T_.vcmp + ((size_t)b * NCMP_PAD * 2 + g) * 64; sw.ld = 128; sw.kbias = nullptr;
        const int ntc = (4 * qt + 2) / 64 + 1;
        bp.jlo = 0; bp.jhi = ntc - 1;
        FState st; fs_init(st);
        LAS float* imp = (LAS float*)(lds + A_IMP) + (head_l * 64 + tok_l) * IMP_LD;
        for (int s2 = 16 * ntc + hi; s2 < 64; s2 += 2) imp[s2] = 0.f;
        carry = 0.f;
#pragma unroll
        for (int r = 0; r < 16; ++r) gr[r] = T_.gate[(rowbase + crow(r, hi)) * 24 + 3 * head + 0];
        sweep<0, NOMAX>(st, sw, bp, qr, lds, wsf, tid, lane, r32, hi, carry);
        bp.inv_c = fs_finish<0>(st, gr, wsf, stg_bf, stg_f32, r32, hi); bp.m_c = st.m;
        if (hi == 0) ((LAS float*)(lds + A_IVC))[head_l * 64 + tok_l] = NOMAX ? bp.inv_c : 1.0f;
        if (!NOMAX) { carry = 0.f; sweep<4, NOMAX>(st, sw, bp, qr, lds, wsf, tid, lane, r32, hi, carry); }
    }
    __syncthreads();
    {
        LAS float* imp = (LAS float*)(lds + A_IMP); const LAS float* ivc = (const LAS float*)(lds + A_IVC);
        const int tok = tid & 63, part = __builtin_amdgcn_readfirstlane(tid >> 6);
        float v[8];
#pragma unroll
        for (int k = 0; k < 8; ++k) { const int s2 = 8 * part + k;
            float x = ((imp[(0 * 64 + tok) * IMP_LD + s2] * ivc[tok] + imp[(1 * 64 + tok) * IMP_LD + s2] * ivc[64 + tok]) + imp[(2 * 64 + tok) * IMP_LD + s2] * ivc[128 + tok]) + imp[(3 * 64 + tok) * IMP_LD + s2] * ivc[192 + tok];
            if (s2 == 0 || s2 == qt || s2 == qt - 1) x = 1e6f; else if (s2 > qt) x = -1e6f;
            v[k] = x; }
        __syncthreads();
#pragma unroll
        for (int k = 0; k < 8; ++k) imp[tok * IMP_LD + 8 * part + k] = v[k];
        __syncthreads();
        int rank[8];
#pragma unroll
        for (int k = 0; k < 8; ++k) rank[k] = 0;
        const int lim = qt + 1, a1 = 8 * part < lim ? 8 * part : lim, b1 = 8 * part + 8 < lim ? 8 * part + 8 : lim;
        for (int s2 = 0; s2 < a1; ++s2) { const float x = imp[tok * IMP_LD + s2];
#pragma unroll
            for (int k = 0; k < 8; ++k) rank[k] += (x >= v[k]) ? 1 : 0; }
        for (int s2 = a1; s2 < b1; ++s2) { const float x = imp[tok * IMP_LD + s2];
#pragma unroll
            for (int k = 0; k < 8; ++k) rank[k] += (x > v[k] || (x == v[k] && s2 < 8 * part + k)) ? 1 : 0; }
        for (int s2 = b1; s2 < lim; ++s2) { const float x = imp[tok * IMP_LD + s2];
#pragma unroll
            for (int k = 0; k < 8; ++k) rank[k] += (x > v[k]) ? 1 : 0; }
        unsigned byte = 0;
#pragma unroll
        for (int k = 0; k < 8; ++k) byte |= (rank[k] < 16 ? 1u : 0u) << k;
        ((LAS unsigned char*)(lds + A_MASK))[tok * 8 + part] = (unsigned char)byte;
        __syncthreads();
        const LAS unsigned long long* mk = (const LAS unsigned long long*)(lds + A_MASK);
        bp.msk = mk[tok_l];
        unsigned long long am = mk[lane];
        unsigned lo = (unsigned)am, hh = (unsigned)(am >> 32);
#pragma unroll
        for (int o = 1; o < 64; o <<= 1) { lo |= (unsigned)__shfl_xor((int)lo, o); hh |= (unsigned)__shfl_xor((int)hh, o); }
        bp.anym = ((unsigned long long)(unsigned)__builtin_amdgcn_readfirstlane((int)hh) << 32) | (unsigned)__builtin_amdgcn_readfirstlane((int)lo);
    }
    {
        Sweep sw; sw.K = T_.projA + (size_t)b * SEQ * LDA + PA_KSL + g * 64; sw.V = T_.projA + (size_t)b * SEQ * LDA + PA_VSL + g * 64; sw.ld = LDA; sw.kbias = nullptr;
        bp.jlo = 0; bp.jhi = qt;
        FState st; fs_init(st);
#pragma unroll
        for (int r = 0; r < 16; ++r) gr[r] = T_.gate[(rowbase + crow(r, hi)) * 24 + 3 * head + 1];
        sweep<1, NOMAX>(st, sw, bp, qr, lds, wsf, tid, lane, r32, hi, carry);
        fs_finish<1>(st, gr, wsf, stg_bf, stg_f32, r32, hi);
    }
    {
        Sweep sw; sw.K = T_.projA + (size_t)b * SEQ * LDA + PA_KWN + g * 64; sw.V = T_.projA + (size_t)b * SEQ * LDA + PA_VWN + g * 64; sw.ld = LDA; sw.kbias = nullptr;
        bp.jlo = qt - 8 < 0 ? 0 : qt - 8; bp.jhi = qt;
        FState st; fs_init(st);
#pragma unroll
        for (int r = 0; r < 16; ++r) gr[r] = T_.gate[(rowbase + crow(r, hi)) * 24 + 3 * head + 2];
        sweep<2, NOMAX>(st, sw, bp, qr, lds, wsf, tid, lane, r32, hi, carry);
        fs_finish<2>(st, gr, wsf, stg_bf, stg_f32, r32, hi);
    }
    store_o(T_.O + rowbase * DM + head * 64, DM, stg_bf, lane);
    __syncthreads();
}

DI void fox_unit(const Tensors& T_, int b, int h, int qb, LAS char* lds) {
    int tid_ = threadIdx.x; asm volatile("" : "+v"(tid_));
    const int tid = tid_, lane = tid & 63, r32 = lane & 31, hi = lane >> 5, wid = __builtin_amdgcn_readfirstlane(tid >> 6);
    LAS float* wsf = (LAS float*)(lds + A_WS) + wid * 64;
    const int tq = 256 * qb + 32 * wid + r32;
    const size_t rowq = (size_t)b * SEQ + tq;
    bf16x8 qr[4];
#pragma unroll
    for (int d0 = 0; d0 < 4; ++d0) qr[d0] = *(const bf16x8*)(T_.projA + rowq * LDA + PA_QB + h * 64 + d0 * 16 + hi * 8);
    LAS char* stg_bf = lds + A_OC + wid * 4096;
    BrP bp; bp.cur = 0; bp.tq = tq; bp.tt = 32 * (wid & 1) + r32; bp.msk = 0; bp.anym = 0; bp.head_l = 0; bp.tok_l = 0; bp.m_c = 0.f; bp.inv_c = 0.f;
    bp.jlo = 0; bp.jhi = 4 * qb + 3; bp.fox_lim = 4 * qb + (wid >> 1);
    {
        float gq = fabsf(T_.fqn[lane]), gk = fabsf(T_.fkn[lane]);
#pragma unroll
        for (int o = 1; o < 64; o <<= 1) { gq = fmaxf(gq, __shfl_xor(gq, o)); gk = fmaxf(gk, __shfl_xor(gk, o)); }
        const float need = 2.0f * 11.66f * gq * gk + 40.0f;
        const float* kbp = T_.cumneg + ((size_t)b * FOX_H + h) * SEQ;
        const float kb0 = kbp[256 * qb];
        const bool needed = (lane <= bp.jhi) && (kb0 - kbp[64 * lane + 63] <= need);
        const unsigned long long bal = __ballot(needed);
        bp.jlo = bal ? (int)__builtin_ctzll(bal) : 0;
        const bool needed_w = (lane <= bp.jhi) && (kbp[256 * qb + 32 * wid] - kbp[64 * lane + 63] <= need);
        const unsigned long long balw = __ballot(needed_w);
        bp.fox_lo = balw ? (int)__builtin_ctzll(balw) : 0;
    }
    Sweep sw; sw.K = T_.projA + (size_t)b * SEQ * LDA + PA_KB + h * 64; sw.V = T_.projA + (size_t)b * SEQ * LDA + PA_VB + h * 64; sw.ld = LDA;
    sw.kbias = T_.cumneg + ((size_t)b * FOX_H + h) * SEQ;
    FState st; fs_init(st);
    float carry = 0.f;
    sweep<3, false>(st, sw, bp, qr, lds, wsf, tid, lane, r32, hi, carry);
    float gr[16];
#pragma unroll
    for (int r = 0; r < 16; ++r) gr[r] = 1.f;
    fs_finish<3>(st, gr, wsf, stg_bf, stg_bf, r32, hi);
    const size_t rowbase = (size_t)b * SEQ + 256 * qb + 32 * wid;
    store_o(T_.O + rowbase * DM + 512 + h * 64, DM, stg_bf, lane);
    __syncthreads();
}

DI void attn_phase(const Tensors& T_, unsigned* ctr, LAS char* lds) {
    LAS int* shq = (LAS int*)(lds + A_SHQ);
    bool nomax;
    { const int lane = threadIdx.x & 63; float gq = fabsf(T_.aqn[lane]), gk = fabsf(T_.akn[lane]);
#pragma unroll
      for (int o = 1; o < 64; o <<= 1) { gq = fmaxf(gq, __shfl_xor(gq, o)); gk = fmaxf(gk, __shfl_xor(gk, o)); }
      nomax = __builtin_amdgcn_readfirstlane((int)(11.66f * gq * gk < 50.0f)) != 0; }
    for (;;) {
        if (threadIdx.x == 0) shq[0] = (int)__hip_atomic_fetch_add(ctr, 1u, __ATOMIC_RELAXED, __HIP_MEMORY_SCOPE_AGENT);
        __syncthreads();
        const int i = __builtin_amdgcn_readfirstlane(shq[0]);
        __syncthreads();
        if (i >= 2048) break;
        if (i < 1024) { if (nomax) nsa_unit<true>(T_, (i & 15) >> 1, i & 1, 63 - (i >> 4), lds); else nsa_unit<false>(T_, (i & 15) >> 1, i & 1, 63 - (i >> 4), lds); }
        else { const int r = i - 1024; fox_unit(T_, (r & 63) >> 3, r & 7, 15 - (r >> 6), lds); }
    }
}
}

namespace gla {
constexpr int G_A1 = 0, G_QI = 4096, G_QR = 20480, G_KR = 36864, G_KH = 53248, G_V = 69632, G_BQ = 73728, G_ST = 77824, G_DEC = 94208;
DI int swo(int row, int colbyte) { return row * 256 + (colbyte ^ ((row & 15) << 4)); }
using att::crow; using att::vtr;

struct GlaT { bf16_t* projC; const float* a1; const float* w_a2; const float* b_a; bf16_t* O; bf16_t* att; float* dec; };

DI void gla_a1_item(const bf16_t* xb, const bf16_t* wa1t  , const float* ss2, float* a1, int item, LAS char* lds) {
    int tid_l_ = threadIdx.x; asm volatile("" : "+v"(tid_l_)); const int tid = tid_l_, lane = tid & 63, r32 = lane & 31, hi = lane >> 5, wid = __builtin_amdgcn_readfirstlane(tid >> 6);
    const int rg = wid & 3, kh = wid >> 2;
    const size_t row0 = (size_t)item * 128 + 32 * rg;
    const bf16_t* ap = xb + (row0 + r32) * DM + 512 * kh + 8 * hi;
    const bf16_t* bp = wa1t + (size_t)(r32 & 15) * DM + 512 * kh + 8 * hi;
    f32x16 c;
#pragma unroll
    for (int r = 0; r < 16; ++r) c[r] = 0.f;
#pragma unroll 8
    for (int ks = 0; ks < 32; ++ks) {
        const bf16x8 A = *(const bf16x8*)(ap + 16 * ks);
        bf16x8 B = *(const bf16x8*)(bp + 16 * ks);
        if (r32 >= 16) B = (bf16x8){0, 0, 0, 0, 0, 0, 0, 0};
        c = MFMA32(A, B, c);
    }
    LAS float* red = (LAS float*)lds + rg * 1024;
    if (kh == 1) {
#pragma unroll
        for (int r = 0; r < 16; ++r) red[crow(r, hi) * 32 + r32] = c[r];
    }
    __syncthreads();
    if (kh == 0 && r32 < 16) {
#pragma unroll
        for (int r = 0; r < 16; ++r) { const int rw = crow(r, hi); const size_t grow = row0 + rw;
            a1[grow * 16 + r32] = (c[r] + red[rw * 32 + r32]) * pg8::row_rstd(ss2, (int)grow); }
    }
    __syncthreads();
}

constexpr int P_A1 = 0, P_QR = 4096, P_KR = 20480, P_BQ = 36864;
struct PrepRegs { unsigned q[8], k[8]; f32x4 a1; };
DI void prep_load(PrepRegs& R, const GlaT& G, int item, int tid) {
    const int ch = item & 63, h = (item >> 6) & 3, b = item >> 8, d0 = 2 * (tid & 63), tg = tid >> 6;
    const size_t rb = (size_t)b * SEQ + 64 * ch;
#pragma unroll
    for (int c8 = 0; c8 < 8; ++c8) { const size_t rw = rb + 8 * tg + c8; R.q[c8] = *(const unsigned*)(G.projC + rw * LDC + PC_Q + h * 128 + d0); R.k[c8] = *(const unsigned*)(G.projC + rw * LDC + PC_K + h * 128 + d0); }
    R.a1 = (tid < 256) ? *(const f32x4*)(G.a1 + (rb + (tid >> 2)) * 16 + (tid & 3) * 4) : (f32x4){0.f, 0.f, 0.f, 0.f};
}
DI void gla_prep(const GlaT& G, int item, const PrepRegs& R, LAS char* lds) {
    int tid_l_ = threadIdx.x; asm volatile("" : "+v"(tid_l_)); const int tid = tid_l_, lane = tid & 63, r32 = lane & 31, hi = lane >> 5, wid = __builtin_amdgcn_readfirstlane(tid >> 6);
    const int ch = item & 63, h = (item >> 6) & 3, b = item >> 8;
    const int dp = tid & 63, tg = wid, d0 = 2 * dp;
    const size_t rb = (size_t)b * SEQ + 64 * ch;
    unsigned qraw[8], kraw[8];
#pragma unroll
    for (int c8 = 0; c8 < 8; ++c8) { qraw[c8] = R.q[c8]; kraw[c8] = R.k[c8]; }
    if (tid < 256) *(LAS f32x4*)(lds + P_A1 + tid * 16) = R.a1;
    float w2a[16], w2b[16];
#pragma unroll
    for (int r = 0; r < 16; ++r) { const f32x2 w = *(const f32x2*)(G.w_a2 + r * 512 + h * 128 + d0); w2a[r] = w[0]; w2b[r] = w[1]; }
    const f32x2 bav = *(const f32x2*)(G.b_a + h * 128 + d0);
    __syncthreads();
    float lp0[8], lp1[8]; float run0 = 0.f, run1 = 0.f;
#pragma unroll
    for (int c8 = 0; c8 < 8; ++c8) {
        const LAS f32x4* ar = (const LAS f32x4*)(lds + P_A1 + (8 * tg + c8) * 64);
        float z0 = bav[0], z1 = bav[1];
#pragma unroll
        for (int q4 = 0; q4 < 4; ++q4) { const f32x4 a = ar[q4];
#pragma unroll
            for (int e = 0; e < 4; ++e) { z0 += a[e] * w2a[4 * q4 + e]; z1 += a[e] * w2b[4 * q4 + e]; } }
        const float l0 = fminf(z0, 0.f) - __logf(1.0f + __expf(-fabsf(z0))), l1 = fminf(z1, 0.f) - __logf(1.0f + __expf(-fabsf(z1)));
        run0 += l0 * (1.0f / 16.0f); run1 += l1 * (1.0f / 16.0f);
        lp0[c8] = run0; lp1[c8] = run1;
    }
    *(LAS f32x2*)(lds + P_BQ + tg * 512 + d0 * 4) = (f32x2){run0, run1};
    __syncthreads();
    {
        float off0 = 0.f, off1 = 0.f, ref0 = 0.f, ref1 = 0.f, last0 = 0.f, last1 = 0.f;
#pragma unroll
        for (int t8 = 0; t8 < 8; ++t8) { const f32x2 q = *(const LAS f32x2*)(lds + P_BQ + t8 * 512 + d0 * 4);
            if (t8 < tg) { off0 += q[0]; off1 += q[1]; } if (t8 < 4) { ref0 += q[0]; ref1 += q[1]; } last0 += q[0]; last1 += q[1]; }
        const float emr0 = __expf(-ref0), emr1 = __expf(-ref1), epr0 = __expf(ref0), epr1 = __expf(ref1), epl0 = __expf(last0), epl1 = __expf(last1);
#pragma unroll
        for (int c8 = 0; c8 < 8; ++c8) {
            const int c = 8 * tg + c8;
            const float eb0 = __expf(off0 + lp0[c8]), eb1 = __expf(off1 + lp1[c8]);
            const float ib0 = __builtin_amdgcn_rcpf(eb0), ib1 = __builtin_amdgcn_rcpf(eb1);
            const float q0 = bflo(qraw[c8]), q1 = bfhi(qraw[c8]), k0 = bflo(kraw[c8]), k1 = bfhi(kraw[c8]);
            const float qi0 = q0 * eb0, qi1 = q1 * eb1, kb0 = k0 * ib0, kb1 = k1 * ib1;
            const int o = swo(c, 4 * dp);
            *(LAS unsigned*)(lds + P_QR + o) = cvtpk(qi0 * emr0, qi1 * emr1);
            *(LAS unsigned*)(lds + P_KR + o) = cvtpk(kb0 * epr0, kb1 * epr1);
            const size_t rw = rb + c;
            *(unsigned*)(G.projC + rw * LDC + PC_Q + h * 128 + d0) = cvtpk(qi0, qi1);
            *(unsigned*)(G.projC + rw * LDC + PC_K + h * 128 + d0) = cvtpk(kb0 * epl0, kb1 * epl1);
        }
        if (tg == 0) *(f32x2*)(G.dec + (size_t)item * 128 + d0) = (f32x2){epl0, epl1};
    }
    __syncthreads();
    if (wid < 3) {
        const int jt = wid == 2 ? 1 : 0, it = wid == 0 ? 0 : 1;
        f32x16 X;
#pragma unroll
        for (int r = 0; r < 16; ++r) X[r] = 0.f;
#pragma unroll
        for (int ks = 0; ks < 8; ++ks) {
            const bf16x8 A = *(const LAS bf16x8*)(lds + P_KR + swo(32 * jt + r32, (16 * ks + 8 * hi) * 2));
            const bf16x8 B = *(const LAS bf16x8*)(lds + P_QR + swo(32 * it + r32, (16 * ks + 8 * hi) * 2));
            X = MFMA32(A, B, X);
        }
        if (jt == it) {
#pragma unroll
            for (int r = 0; r < 16; ++r) if (att::crc(r) > r32 - 4 * hi) X[r] = 0.f;
        }
        bf16_t* ap = G.att + (size_t)item * 4096 + (32 * it + r32) * 64 + 32 * jt + 4 * hi;
#pragma unroll
        for (int g4 = 0; g4 < 4; ++g4) *(u32x2*)(ap + 8 * g4) = (u32x2){cvtpk(X[4 * g4], X[4 * g4 + 1]), cvtpk(X[4 * g4 + 2], X[4 * g4 + 3])};
    }
    __syncthreads();
}

constexpr int R_QI = 0, R_KH = 16384, R_ATT = 32768, R_V = 40960, R_DEC = 45056, R_BUF = 45568, R_ST = 2 * R_BUF;
DI void gla_unit(const GlaT& G, int b, int h, int es, LAS char* lds) {
    int tid_l_ = threadIdx.x; asm volatile("" : "+v"(tid_l_)); const int tid = tid_l_, lane = tid & 63, r32 = lane & 31, hi = lane >> 5, wid = __builtin_amdgcn_readfirstlane(tid >> 6);
    f32x16 S;
#pragma unroll
    for (int r = 0; r < 16; ++r) S[r] = 0.f;
    *(LAS u32x4*)(lds + R_ST + tid * 16) = (u32x4){0u, 0u, 0u, 0u};
    const size_t row00 = (size_t)b * SEQ;
    const int lrow = tid >> 3, lc = tid & 7;
    struct GlaRegs { u32x4 q0, q1, k0, k1, a, v; };
    GlaRegs RA, RB;
#define GLA_LOAD(R_, ch) do { const size_t rw_ = row00 + 64 * (ch) + lrow; const bf16_t* pq_ = G.projC + rw_ * LDC + h * 128 + lc * 8; \
        R_.q0 = *(const u32x4*)(pq_ + PC_Q); R_.q1 = *(const u32x4*)(pq_ + PC_Q + 64); R_.k0 = *(const u32x4*)(pq_ + PC_K); R_.k1 = *(const u32x4*)(pq_ + PC_K + 64); \
        R_.a = *(const u32x4*)(G.att + ((size_t)((b * 4 + h) * 64 + (ch))) * 4096 + tid * 8); \
        if (tid < 256) R_.v = *(const u32x4*)(G.projC + (row00 + 64 * (ch) + (tid >> 2)) * LDC + PC_V + h * 256 + 32 * es + (tid & 3) * 8); \
        else if (tid < 288) R_.v = *(const u32x4*)(G.dec + ((size_t)((b * 4 + h) * 64 + (ch))) * 128 + (tid - 256) * 4); } while (0)
#define GLA_COMMIT(R_, buf) do { LAS char* bb_ = lds + (buf) * R_BUF; \
        *(LAS u32x4*)(bb_ + R_QI + swo(lrow, lc * 16)) = R_.q0; *(LAS u32x4*)(bb_ + R_QI + swo(lrow, (lc + 8) * 16)) = R_.q1; \
        *(LAS u32x4*)(bb_ + R_KH + swo(lrow, lc * 16)) = R_.k0; *(LAS u32x4*)(bb_ + R_KH + swo(lrow, (lc + 8) * 16)) = R_.k1; \
        *(LAS u32x4*)(bb_ + R_ATT + lrow * 128 + ((lc ^ (lrow & 7)) * 16)) = R_.a; \
        if (tid < 256) *(LAS u32x4*)(bb_ + R_V + tid * 16) = R_.v; else if (tid < 288) *(LAS u32x4*)(bb_ + R_DEC + (tid - 256) * 16) = R_.v; } while (0)
    auto step = [&](const int ch, const int par) __attribute__((always_inline)) {
        const LAS char* bb = lds + par * R_BUF;
        const size_t rowc = row00 + 64 * ch;
        if (wid < 2) {
            const int it = wid;
            f32x16 oacc;
#pragma unroll
            for (int r = 0; r < 16; ++r) oacc[r] = 0.f;
#pragma unroll
            for (int s = 0; s < 4; ++s) {
                if (s < 2 || it == 1) {
                    const int i = 32 * it + r32;
                    const bf16x8 A = *(const LAS bf16x8*)(bb + R_ATT + i * 128 + (((2 * s + hi) ^ (i & 7)) * 16));
                    const LAS char* vb = bb + R_V + (16 * s + 8 * hi + ((lane & 15) >> 2)) * 64 + ((lane >> 4) & 1) * 32 + (lane & 3) * 8;
                    const s16x4 lo = vtr(vb), hh = vtr(vb + 256);
                    const bf16x8 vf = (bf16x8){lo[0], lo[1], lo[2], lo[3], hh[0], hh[1], hh[2], hh[3]};
                    oacc = MFMA32(A, vf, oacc);
                }
            }
#pragma unroll
            for (int ks = 0; ks < 8; ++ks) {
                const bf16x8 A = *(const LAS bf16x8*)(bb + R_QI + swo(32 * it + r32, (16 * ks + 8 * hi) * 2));
                const bf16x8 B = *(const LAS bf16x8*)(lds + R_ST + par * 8192 + swo(r32, (16 * ks + 8 * hi) * 2));
                oacc = MFMA32(A, B, oacc);
            }
            LAS bf16_t* stg = (LAS bf16_t*)(lds + R_ST + 16384) + it * 1024;
#pragma unroll
            for (int r = 0; r < 16; ++r) stg[crow(r, hi) * 32 + r32] = (bf16_t)(cvtpk(oacc[r], 0.f) & 0xffffu);
#pragma unroll
            for (int i = 0; i < 2; ++i) { const int pc = lane + 64 * i, row = pc >> 2, q4 = pc & 3; const u32x4 v = *(const LAS u32x4*)(stg + row * 32 + q4 * 8);
                *(u32x4*)(G.O + (rowc + 32 * it + row) * DM + h * 256 + 32 * es + q4 * 8) = v; }
        } else if (wid >= 4) {
            const int dt = wid - 4;
            const LAS float* dec = (const LAS float*)(bb + R_DEC) + 32 * dt;
#pragma unroll
            for (int i = 0; i < 4; ++i) { const f32x4 dv = *(const LAS f32x4*)(dec + 8 * i + 4 * hi);
#pragma unroll
                for (int e = 0; e < 4; ++e) S[4 * i + e] *= dv[e]; }
#pragma unroll
            for (int s = 0; s < 4; ++s) {
                const int cq = 16 * s + 4 * hi + ((lane & 15) >> 2), colb = (32 * dt + 16 * ((lane >> 4) & 1) + 4 * (lane & 3)) * 2;
                const s16x4 alo = vtr(bb + R_KH + swo(cq, colb)), ahh = vtr(bb + R_KH + swo(cq + 8, colb));
                const LAS char* vb = bb + R_V + cq * 64 + ((lane >> 4) & 1) * 32 + (lane & 3) * 8;
                const s16x4 lo = vtr(vb), hh = vtr(vb + 512);
                const bf16x8 af = (bf16x8){alo[0], alo[1], alo[2], alo[3], ahh[0], ahh[1], ahh[2], ahh[3]};
                const bf16x8 vf = (bf16x8){lo[0], lo[1], lo[2], lo[3], hh[0], hh[1], hh[2], hh[3]};
                S = MFMA32(af, vf, S);
            }
#pragma unroll
            for (int i = 0; i < 4; ++i)
                *(LAS u32x2*)(lds + R_ST + (par ^ 1) * 8192 + swo(r32, (32 * dt + 8 * i + 4 * hi) * 2)) = (u32x2){cvtpk(S[4 * i], S[4 * i + 1]), cvtpk(S[4 * i + 2], S[4 * i + 3])};
        }
    };
    GLA_LOAD(RA, 0); GLA_COMMIT(RA, 0); GLA_LOAD(RA, 1); GLA_LOAD(RB, 2);
    __syncthreads();
#pragma unroll 1
    for (int ch = 0; ch < 64; ch += 2) {
        step(ch, 0);
        GLA_COMMIT(RA, 1);
        { const int c3 = ch + 3 < 64 ? ch + 3 : 63; GLA_LOAD(RA, c3); }
        asm volatile("s_waitcnt lgkmcnt(0)" ::: "memory"); __builtin_amdgcn_s_barrier();
        step(ch + 1, 1);
        GLA_COMMIT(RB, 0);
        { const int c4 = ch + 4 < 64 ? ch + 4 : 63; GLA_LOAD(RB, c4); }
        asm volatile("s_waitcnt lgkmcnt(0)" ::: "memory"); __builtin_amdgcn_s_barrier();
    }
#undef GLA_LOAD
#undef GLA_COMMIT
}

DI void gla_gate_rows2(bf16_t* O, const bf16_t* R, const float* gain, int m0, int lane) {
    u32x4 o0[2], o1[2], r0[2], r1[2];
#pragma unroll
    for (int u = 0; u < 2; ++u) { const bf16_t* Orow = O + (size_t)(m0 + u) * DM; const bf16_t* Rrow = R + (size_t)(m0 + u) * LDC;
        o0[u] = *(const u32x4*)(Orow + lane * 16); o1[u] = *(const u32x4*)(Orow + lane * 16 + 8); r0[u] = *(const u32x4*)(Rrow + lane * 16); r1[u] = *(const u32x4*)(Rrow + lane * 16 + 8); }
    const int c0 = (lane & 15) * 16;
    float gn[16];
#pragma unroll
    for (int i = 0; i < 4; ++i) { const f32x4 g4 = *(const f32x4*)(gain + c0 + 4 * i); gn[4 * i] = g4[0]; gn[4 * i + 1] = g4[1]; gn[4 * i + 2] = g4[2]; gn[4 * i + 3] = g4[3]; }
#pragma unroll
    for (int u = 0; u < 2; ++u) {
        float o[16], rr[16];
#pragma unroll
        for (int i = 0; i < 4; ++i) { o[2 * i] = bflo(o0[u][i]); o[2 * i + 1] = bfhi(o0[u][i]); o[8 + 2 * i] = bflo(o1[u][i]); o[8 + 2 * i + 1] = bfhi(o1[u][i]);
            rr[2 * i] = bflo(r0[u][i]); rr[2 * i + 1] = bfhi(r0[u][i]); rr[8 + 2 * i] = bflo(r1[u][i]); rr[8 + 2 * i + 1] = bfhi(r1[u][i]); }
        float ss = 0.f;
#pragma unroll
        for (int i = 0; i < 16; ++i) ss += o[i] * o[i];
        ss += __shfl_xor(ss, 1); ss += __shfl_xor(ss, 2); ss += __shfl_xor(ss, 4); ss += __shfl_xor(ss, 8);
        const float rs = rsqrtf(ss * (1.0f / 256.0f) + EPS);
        unsigned w[8];
#pragma unroll
        for (int i = 0; i < 8; ++i) { const float x0 = o[2 * i] * rs * gn[2 * i] * siluf_(rr[2 * i]), x1 = o[2 * i + 1] * rs * gn[2 * i + 1] * siluf_(rr[2 * i + 1]); w[i] = cvtpk(x0, x1); }
        bf16_t* Orow = O + (size_t)(m0 + u) * DM;
        *(u32x4*)(Orow + lane * 16) = (u32x4){w[0], w[1], w[2], w[3]}; *(u32x4*)(Orow + lane * 16 + 8) = (u32x4){w[4], w[5], w[6], w[7]};
    }
}
}

struct Ptrs {
    const float* in[31]; float* out; unsigned char* ws;
    DI bf16_t* bf(size_t off) const { return (bf16_t*)(ws + off); }
    DI float* f32(size_t off) const { return (float*)(ws + off); }
    DI int* i32(size_t off) const { return (int*)(ws + off); }
};
enum { I_X = 0, I_ANORM, I_AWIN, I_AQN, I_AKN, I_APEK, I_APEV, I_CK1, I_CK2, I_CV1, I_CV2, I_GBIAS, I_FQN, I_FKN, I_FFB, I_AWOUT, I_FNORM, I_FWG, I_FWU, I_FWD,
       I_CNORM, I_CWIN, I_CWA2, I_CBA, I_CONORM, I_CWOUT, I_MNORM, I_MROUTER, I_MWG, I_MWU, I_MWD };

namespace pro {
struct ConvM { const float* src; const float* src2; const float* gain; bf16_t* dst; int K, Ns, Nd, mode; };
DI int srccolA(int n) {
    const int pn = n >> 8, bj = (n >> 7) & 1, wc = (n >> 5) & 3, j = n & 31, s = 4 * pn + wc, d = 32 * bj + j;
    if (s < 8) return 64 * s + d;
    if (s < 10) return 768 + 64 * (s - 8) + d;
    if (s < 12) return 1024 + 64 * (s - 10) + d;
    if (s < 14) return 896 + 64 * (s - 12) + d;
    if (s < 16) return 1152 + 64 * (s - 14) + d;
    if (s < 18) return 512 + 64 * (s - 16) + d;
    if (s < 20) return 640 + 64 * (s - 18) + d;
    if (s < 28) return 1304 + 64 * (s - 20) + d;
    if (s < 36) return 1816 + 64 * (s - 28) + d;
    if (s < 44) return 2328 + 64 * (s - 36) + d;
    if (s == 44) { if (d < 24) return 1280 + d; if (d < 32) return 2840 + d - 24; }
    return -1;
}
DI void conv_item(const ConvM& M, int item, LAS float* scr, int lane) {
    const int nblk = M.Nd / 32, kb = item / nblk, nb = item % nblk, k0 = 64 * kb, n0 = 32 * nb;
    const int n = n0 + (lane & 31);
    const float* sp = M.src; int col = n;
    if (M.mode == 0) { if (n >= M.Ns) col = -1; }
    else if (M.mode == 1) col = srccolA(n);
    else { const int pn = n >> 8, half = (n >> 7) & 1, j = n & 127; sp = half ? M.src2 : M.src; col = 128 * pn + j; }
#pragma unroll 8
    for (int i = 0; i < 32; ++i) { const int kk = 2 * i + (lane >> 5); float w = 0.f; if (col >= 0) w = sp[(size_t)(k0 + kk) * M.Ns + col]; if (M.gain) w *= M.gain[k0 + kk]; scr[kk * 33 + (lane & 31)] = w; }
    const int c = lane & 7;
#pragma unroll
    for (int j = 0; j < 4; ++j) { const int nn = (lane >> 3) + 8 * j; const LAS float* s = scr + (8 * c) * 33 + nn;
        u32x4 o; o.x = cvtpk(s[0 * 33], s[1 * 33]); o.y = cvtpk(s[2 * 33], s[3 * 33]); o.z = cvtpk(s[4 * 33], s[5 * 33]); o.w = cvtpk(s[6 * 33], s[7 * 33]);
        *(u32x4*)(M.dst + (size_t)(n0 + nn) * M.K + k0 + 8 * c) = o; }
}
struct ConvRegs { f32x4 v[8]; };
DI void conv_big_load(ConvRegs& R, const ConvM& M, int item, int wid, int lane) {
    const int nblk = M.Nd / 256, kb = item / nblk, nb = item % nblk;
    const int k0 = 64 * kb + 8 * wid, n = 256 * nb + 4 * lane;
    const float* sp = M.src; int col = n;
    if (M.mode == 0) { if (n >= M.Ns) col = -1; }
    else if (M.mode == 1) col = srccolA(n);
    else { const int pn = n >> 8, half = (n >> 7) & 1, j = n & 127; sp = half ? M.src2 : M.src; col = 128 * pn + j; }
#pragma unroll
    for (int j = 0; j < 8; ++j) R.v[j] = (col >= 0) ? *(const f32x4*)(sp + (size_t)(k0 + j) * M.Ns + col) : (f32x4){0.f, 0.f, 0.f, 0.f};
}
DI void conv_big_store(ConvRegs& R, const ConvM& M, int item, LAS char* tile, int tid, int wid, int lane) {
    const int nblk = M.Nd / 256, kb = item / nblk, nb = item % nblk;
    if (M.gain) { const int k0 = 64 * kb + 8 * wid;
#pragma unroll
        for (int j = 0; j < 8; ++j) R.v[j] = R.v[j] * M.gain[k0 + j]; }
#pragma unroll
    for (int c = 0; c < 4; ++c) { u32x4 o; o.x = cvtpk(R.v[0][c], R.v[1][c]); o.y = cvtpk(R.v[2][c], R.v[3][c]); o.z = cvtpk(R.v[4][c], R.v[5][c]); o.w = cvtpk(R.v[6][c], R.v[7][c]);
        const int nl = 4 * lane + c; *(LAS u32x4*)(tile + nl * 128 + ((wid ^ (lane & 7)) * 16)) = o; }
    __syncthreads();
#pragma unroll
    for (int i = 0; i < 4; ++i) { const int r = (tid >> 3) + 64 * i, ch = tid & 7; const u32x4 o = *(const LAS u32x4*)(tile + r * 128 + ((ch ^ ((r >> 2) & 7)) * 16));
        *(u32x4*)(M.dst + (size_t)(256 * nb + r) * M.K + 64 * kb + 8 * ch) = o; }
    __syncthreads();
}
DI ConvM conv_desc(const Ptrs& P, int mat) {
    ConvM M; M.src2 = nullptr; M.gain = nullptr; M.mode = 0;
    switch (mat) {
    case 0: M.src = P.in[I_AWIN]; M.gain = P.in[I_ANORM]; M.dst = P.bf(WS_WA); M.K = 1024; M.Ns = IN_A; M.Nd = NA_PAD; M.mode = 1; break;
    case 1: M.src = P.in[I_AWOUT]; M.dst = P.bf(WS_WO); M.K = 1024; M.Ns = 1024; M.Nd = 1024; break;
    case 2: M.src = P.in[I_FWG]; M.src2 = P.in[I_FWU]; M.gain = P.in[I_FNORM]; M.dst = P.bf(WS_WFGU); M.K = 1024; M.Ns = DFF; M.Nd = 2 * DFF; M.mode = 2; break;
    case 3: M.src = P.in[I_FWD]; M.dst = P.bf(WS_WFD); M.K = DFF; M.Ns = 1024; M.Nd = 1024; break;
    case 4: M.src = P.in[I_CWIN]; M.gain = P.in[I_CNORM]; M.dst = P.bf(WS_WC); M.K = 1024; M.Ns = IN_C; M.Nd = NC_PAD; break;
    case 5: M.src = P.in[I_CWOUT]; M.dst = P.bf(WS_WCO); M.K = 1024; M.Ns = 1024; M.Nd = 1024; break;
    case 6: M.src = P.in[I_CK1]; M.dst = P.bf(CT_CW); M.K = 2048; M.Ns = 64; M.Nd = 64; break;
    case 7: M.src = P.in[I_CV1]; M.dst = P.bf(CT_CW + 262144); M.K = 2048; M.Ns = 64; M.Nd = 64; break;
    case 8: M.src = P.in[I_CK2]; M.dst = P.bf(CT_CW + 524288); M.K = 64; M.Ns = 64; M.Nd = 64; break;
    case 9: M.src = P.in[I_CV2]; M.dst = P.bf(CT_CW + 524288 + 8192); M.K = 64; M.Ns = 64; M.Nd = 64; break;
    default:
        if (mat < 18) { const int e = mat - 10; M.src = P.in[I_MWG] + (size_t)e * 1024 * DFF; M.src2 = P.in[I_MWU] + (size_t)e * 1024 * DFF; M.gain = P.in[I_MNORM];
            M.dst = P.bf(WS_WMGU) + (size_t)e * 2 * DFF * 1024; M.K = 1024; M.Ns = DFF; M.Nd = 2 * DFF; M.mode = 2; }
        else { const int e = mat - 18; M.src = P.in[I_MWD] + (size_t)e * DFF * 1024; M.dst = P.bf(WS_WMD) + (size_t)e * 1024 * DFF; M.K = DFF; M.Ns = 1024; M.Nd = 1024; }
    }
    return M;
}
DI int conv_items(int mat) {
    switch (mat) { case 0: return 16 * 12; case 1: return 16 * 4; case 2: return 16 * 22; case 3: return 44 * 4; case 4: return 16 * 13; case 5: return 16 * 4;
                   case 6: case 7: return 32 * 2; case 8: case 9: return 2; default: return mat < 18 ? 16 * 22 : 44 * 4; }
}
DI void prologue(const Ptrs& P, LAS char* lds) {
    int tid_l_ = threadIdx.x; asm volatile("" : "+v"(tid_l_)); const int tid = tid_l_, lane = tid & 63, wid = __builtin_amdgcn_readfirstlane(tid >> 6);
    const int gw = blockIdx.x * 8 + wid, NGW = gridDim.x * 8;
    LAS float* scr = (LAS float*)(lds + wid * 16384);
    {
        ConvRegs Ra, Rb; ConvM Ma, Mb; int ia = -1, ib = -1;
        int g = blockIdx.x, mat = 25, base = 0;
        auto advance = [&](ConvM& M, int& it) {
            it = -1;
            while (mat >= 0) {
                if (mat >= 6 && mat <= 9) { --mat; continue; }
                const int ni = conv_items(mat);
                if (g - base < ni) { M = conv_desc(P, mat); it = g - base; g += gridDim.x; return; }
                base += ni; --mat;
            }
        };
        advance(Ma, ia); if (ia >= 0) conv_big_load(Ra, Ma, ia, wid, lane);
        while (ia >= 0) {
            advance(Mb, ib); if (ib >= 0) conv_big_load(Rb, Mb, ib, wid, lane);
            conv_big_store(Ra, Ma, ia, lds + 65536 + 2048, tid, wid, lane);
            if (ib < 0) break;
            advance(Ma, ia); if (ia >= 0) conv_big_load(Ra, Ma, ia, wid, lane);
            conv_big_store(Rb, Mb, ib, lds + 65536 + 2048, tid, wid, lane);
        }
        for (int m2 = 6; m2 <= 9; ++m2) { const ConvM M = conv_desc(P, m2); const int ni = conv_items(m2); for (int it = gw; it < ni; it += NGW) conv_item(M, it, scr, lane); }
    }
    const float* x = P.in[I_X]; bf16_t* xb = P.bf(WS_XB); float* rstd0 = P.f32(CT_RSTD0);
    for (int m0 = gw * 2; m0 < T; m0 += NGW * 2) {
        f32x4 v[2][4];
#pragma unroll
        for (int u = 0; u < 2; ++u) { const f32x4* xr = (const f32x4*)(x + (size_t)(m0 + u) * DM) + lane;
#pragma unroll
            for (int j = 0; j < 4; ++j) v[u][j] = xr[64 * j]; }
#pragma unroll
        for (int u = 0; u < 2; ++u) {
            float s = 0.f;
#pragma unroll
            for (int j = 0; j < 4; ++j) s += (v[u][j][0] * v[u][j][0] + v[u][j][1] * v[u][j][1]) + (v[u][j][2] * v[u][j][2] + v[u][j][3] * v[u][j][3]);
            s = wave_sum(s);
            if (lane == 0) rstd0[m0 + u] = rsqrtf(s * (1.0f / 1024.0f) + EPS);
            u32x2* o8 = (u32x2*)(xb + (size_t)(m0 + u) * DM) + lane;
#pragma unroll
            for (int j = 0; j < 4; ++j) o8[64 * j] = (u32x2){cvtpk(v[u][j][0], v[u][j][1]), cvtpk(v[u][j][2], v[u][j][3])};
        }
    }
    float* cosT = P.f32(CT_ROPE); float* sinT = cosT + SEQ * 8;
    for (int idx = blockIdx.x * 512 + tid; idx < SEQ * 8; idx += gridDim.x * 512) {
        const int pos = idx >> 3, i = idx & 7;
        const float inv = powf(500000.0f, -(float)(2 * i) / 16.0f);
        const float ang = (float)pos * inv;
        const double rev = (double)ang * 0.15915494309189535; const float fr = (float)(rev - floor(rev));
        cosT[idx] = __builtin_amdgcn_cosf(fr); sinT[idx] = __builtin_amdgcn_sinf(fr);
    }
}

DI void fox_cum(const Ptrs& P, int bh, int lane) {
    const f32x4* lf = (const f32x4*)(P.f32(CT_LOGF) + (size_t)bh * SEQ + 64 * lane); f32x4* dst = (f32x4*)(P.f32(CT_CUM) + (size_t)bh * SEQ + 64 * lane);
    f32x4 v[16]; float tot = 0.f;
#pragma unroll
    for (int i = 0; i < 16; ++i) { v[i] = lf[i]; }
#pragma unroll
    for (int i = 0; i < 16; ++i) { v[i][1] += v[i][0]; v[i][2] += v[i][1]; v[i][3] += v[i][2]; const float t = v[i][3]; v[i] = v[i] + tot; tot += t; }
    float inc = tot;
#pragma unroll
    for (int o = 1; o < 64; o <<= 1) { const float t = __shfl_up(inc, o); if (lane >= o) inc += t; }
    const float base = inc - tot;
#pragma unroll
    for (int i = 0; i < 16; ++i) dst[i] = (v[i] + base) * (-LOG2E);
}

DI void compress_item(const Ptrs& P, int item, LAS char* lds) {
    int tid_l_ = threadIdx.x; asm volatile("" : "+v"(tid_l_)); const int tid = tid_l_, lane = tid & 63, r32 = lane & 31, hi = lane >> 5, wid = __builtin_amdgcn_readfirstlane(tid >> 6);
    const int kv = item >> 7, b = (item >> 4) & 7, g = (item >> 3) & 1, nt = item & 7;
    const bf16_t* projA = P.bf(WS_BIG);
    const float* pe = (kv ? P.in[I_APEV] : P.in[I_APEK]);
    const bf16_t* w1t = P.bf(CT_CW + (kv ? 262144 : 0)); const bf16_t* w2t = P.bf(CT_CW + 524288 + (kv ? 8192 : 0));
    int n = 32 * nt + r32; if (n > 254) n = 254;
    f32x16 c0, c1;
#pragma unroll
    for (int r = 0; r < 16; ++r) { c0[r] = 0.f; c1[r] = 0.f; }
#pragma unroll 8
    for (int kk = 0; kk < 16; ++kk) { const int ks = 16 * wid + kk;
        const int l = ks >> 2, d = 16 * (ks & 3) + 8 * hi;
        const u32x4 raw = *(const u32x4*)(projA + ((size_t)b * SEQ + 16 * n + l) * LDA + (kv ? PA_VC : PA_KC) + g * 64 + d);
        const f32x4 p0 = *(const f32x4*)(pe + l * 64 + d), p1 = *(const f32x4*)(pe + l * 64 + d + 4);
        u32x4 aw; aw.x = cvtpk(bflo(raw.x) + p0[0], bfhi(raw.x) + p0[1]); aw.y = cvtpk(bflo(raw.y) + p0[2], bfhi(raw.y) + p0[3]);
        aw.z = cvtpk(bflo(raw.z) + p1[0], bfhi(raw.z) + p1[1]); aw.w = cvtpk(bflo(raw.w) + p1[2], bfhi(raw.w) + p1[3]);
        const bf16x8 A = __builtin_bit_cast(bf16x8, aw);
        const bf16x8 B0 = *(const bf16x8*)(w1t + (size_t)r32 * 2048 + 16 * ks + 8 * hi), B1 = *(const bf16x8*)(w1t + (size_t)(32 + r32) * 2048 + 16 * ks + 8 * hi);
        c0 = MFMA32(A, B0, c0); c1 = MFMA32(A, B1, c1);
    }
    LAS float* red = (LAS float*)lds + wid * 2048;
#pragma unroll
    for (int r = 0; r < 16; ++r) { const int nn = att::crow(r, hi); red[nn * 64 + r32] = c0[r]; red[nn * 64 + 32 + r32] = c1[r]; }
    __syncthreads();
    {
        LAS bf16_t* H1 = (LAS bf16_t*)(lds + 65536);
        const LAS float* rd = (const LAS float*)lds;
        float s4[4];
#pragma unroll
        for (int e = 0; e < 4; ++e) { float s = 0.f;
#pragma unroll
            for (int w = 0; w < 8; ++w) s += rd[w * 2048 + tid * 4 + e];
            s4[e] = gelu_tanh(s); }
        *(LAS u32x2*)(H1 + tid * 4) = (u32x2){cvtpk(s4[0], s4[1]), cvtpk(s4[2], s4[3])};
    }
    __syncthreads();
    if (wid == 0) {
        f32x16 o0, o1;
#pragma unroll
        for (int r = 0; r < 16; ++r) { o0[r] = 0.f; o1[r] = 0.f; }
#pragma unroll
        for (int ks = 0; ks < 4; ++ks) {
            const bf16x8 A = *(const LAS bf16x8*)(lds + 65536 + r32 * 128 + (16 * ks + 8 * hi) * 2);
            const bf16x8 B0 = *(const bf16x8*)(w2t + r32 * 64 + 16 * ks + 8 * hi), B1 = *(const bf16x8*)(w2t + (32 + r32) * 64 + 16 * ks + 8 * hi);
            o0 = MFMA32(A, B0, o0); o1 = MFMA32(A, B1, o1);
        }
        bf16_t* dst = P.bf(kv ? CT_VCMP : CT_KCMP);
        if (kv == 0) {
            const float* kn = P.in[I_AKN]; const float g0 = kn[r32], g1 = kn[32 + r32];
            const float* cosT = P.f32(CT_ROPE); const float* sinT = cosT + SEQ * 8;
#pragma unroll
            for (int r = 0; r < 16; ++r) {
                float ss = o0[r] * o0[r] + o1[r] * o1[r];
                ss += __shfl_xor(ss, 1); ss += __shfl_xor(ss, 2); ss += __shfl_xor(ss, 4); ss += __shfl_xor(ss, 8); ss += __shfl_xor(ss, 16);
                const float rs = rsqrtf(ss * (1.0f / 64.0f) + EPS);
                float y0 = o0[r] * rs * g0; const float y1 = o1[r] * rs * g1;
                const float oth = __shfl_xor(y0, 8);
                const int nn = 32 * nt + att::crow(r, hi); const int pos = (16 * nn + 31) & (SEQ - 1);
                const float cc = cosT[pos * 8 + (r32 & 7)], sn = sinT[pos * 8 + (r32 & 7)];
                if (r32 < 8) y0 = y0 * cc - oth * sn; else if (r32 < 16) y0 = oth * sn + y0 * cc;
                o0[r] = y0; o1[r] = y1;
            }
        }
#pragma unroll
        for (int r = 0; r < 16; ++r) {
            const int nn = 32 * nt + att::crow(r, hi);
            const bool pad = nn > 254;
            bf16_t* dp = dst + (((size_t)b * NCMP_PAD + nn) * 2 + g) * 64;
            dp[r32] = pad ? (bf16_t)0 : (bf16_t)(cvtpk(o0[r], 0.f) & 0xffffu); dp[32 + r32] = pad ? (bf16_t)0 : (bf16_t)(cvtpk(o1[r], 0.f) & 0xffffu);
        }
    }
    __syncthreads();
}
}

namespace moe {
DI void route_block(const Ptrs& P, int blk, LAS char* lds) {
    int tid_l_ = threadIdx.x; asm volatile("" : "+v"(tid_l_)); const int tid = tid_l_, lane = tid & 63, r32 = lane & 31, hi = lane >> 5, wid = __builtin_amdgcn_readfirstlane(tid >> 6);
    constexpr int RPITCH = 1032;
    LAS bf16_t* RBH = (LAS bf16_t*)lds; LAS bf16_t* RBL = RBH + 8 * RPITCH;
    LAS float* PART = (LAS float*)(lds + 36864); LAS float* LG = (LAS float*)(lds + 40960);
    LAS int* einfo = (LAS int*)(lds + 33280);
    const float* router = P.in[I_MROUTER]; const float* mg = P.in[I_MNORM];
    for (int i = tid; i < 8192; i += 512) { const int k = i >> 3, e = i & 7; const float v = router[i] * mg[k];
        const unsigned hb = cvtpk(v, 0.f) & 0xffffu; const float vh = __uint_as_float(hb << 16); const unsigned lb = cvtpk(v - vh, 0.f) & 0xffffu;
        RBH[e * RPITCH + k] = (bf16_t)hb; RBL[e * RPITCH + k] = (bf16_t)lb; }
    __syncthreads();
    const bf16_t* xb3 = P.bf(WS_HM);
    {
        const int rt = wid & 3, kh = wid >> 2;
        const bf16_t* ap = xb3 + ((size_t)blk * 128 + 32 * rt + r32) * DM + 512 * kh + 8 * hi;
        const LAS bf16_t* bh = RBH + (r32 & 7) * RPITCH + 512 * kh + 8 * hi; const LAS bf16_t* bl = RBL + (r32 & 7) * RPITCH + 512 * kh + 8 * hi;
        f32x16 c;
#pragma unroll
        for (int r = 0; r < 16; ++r) c[r] = 0.f;
#pragma unroll 8
        for (int ks = 0; ks < 32; ++ks) {
            const bf16x8 A = *(const bf16x8*)(ap + 16 * ks);
            c = MFMA32(A, *(const LAS bf16x8*)(bh + 16 * ks), c); c = MFMA32(A, *(const LAS bf16x8*)(bl + 16 * ks), c);
        }
        if (kh == 1 && r32 < 8) {
#pragma unroll
            for (int r = 0; r < 16; ++r) PART[(32 * rt + att::crow(r, hi)) * 8 + r32] = c[r];
        }
        __syncthreads();
        if (kh == 0 && r32 < 8) {
#pragma unroll
            for (int r = 0; r < 16; ++r) { const int tk = 32 * rt + att::crow(r, hi); LG[tk * 8 + r32] = c[r] + PART[tk * 8 + r32]; }
        }
        __syncthreads();
    }
    if (tid < 128) {
        const int tl = tid, t = blk * 128 + tl;
        const f32x4 la = *(const LAS f32x4*)(LG + tl * 8), lb = *(const LAS f32x4*)(LG + tl * 8 + 4);
        const float rs = pg8::row_rstd(P.f32(CT_SS3), t);
        const float acc[8] = {la[0], la[1], la[2], la[3], lb[0], lb[1], lb[2], lb[3]};
        int e1 = 0; float l1 = acc[0] * rs;
#pragma unroll
        for (int e = 1; e < 8; ++e) { const float l = acc[e] * rs; if (l > l1) { l1 = l; e1 = e; } }
        int e2 = -1; float l2 = -3.0e38f;
#pragma unroll
        for (int e = 0; e < 8; ++e) { const float l = acc[e] * rs; if (e != e1 && l > l2) { l2 = l; e2 = e; } }
        const float w1 = 1.0f / (1.0f + __expf(l2 - l1));
        einfo[tl * 2] = e1; einfo[tl * 2 + 1] = e2;
        P.f32(MO_TOKW)[(size_t)t * 2] = w1; P.f32(MO_TOKW)[(size_t)t * 2 + 1] = 1.0f - w1;
        P.f32(MO_TOKR)[t] = rs;
    }
    __syncthreads();
    LAS int* rk = (LAS int*)(lds + 34304);
    if (tid < 256) { const int e = einfo[tid]; int r = 0; for (int j = 0; j < tid; ++j) r += (einfo[j] == e) ? 1 : 0; rk[tid] = r; }
    if (tid >= 256 && tid < 264) { const int e = tid - 256; int c = 0; for (int j = 0; j < 256; ++j) c += (einfo[j] == e) ? 1 : 0; P.i32(MO_HIST)[blk * 8 + e] = c; }
    __syncthreads();
    if (tid < 128) { const int t = blk * 128 + tid; ((unsigned*)P.i32(MO_TOKE))[t] = (unsigned)einfo[2 * tid] | ((unsigned)einfo[2 * tid + 1] << 4) | ((unsigned)rk[2 * tid] << 8) | ((unsigned)rk[2 * tid + 1] << 20); }
    __syncthreads();
}
DI void scatter_block(const Ptrs& P, int blk, LAS char* lds) {
    int tid_l_ = threadIdx.x; asm volatile("" : "+v"(tid_l_)); const int tid = tid_l_, lane = tid & 63, wid = __builtin_amdgcn_readfirstlane(tid >> 6);
    LAS int* sh = (LAS int*)lds;
    const int* hist = P.i32(MO_HIST);
    { typedef int i32x4 __attribute__((ext_vector_type(4))); *(LAS i32x4*)(sh + 64 + tid * 4) = *(const i32x4*)(hist + tid * 4); }
    __syncthreads();
    if (tid < 8) { int c = 0, pre = 0; for (int j = 0; j < 256; ++j) { const int v = sh[64 + j * 8 + tid]; c += v; if (j < blk) pre += v; } sh[tid] = c; sh[8 + tid] = pre; }
    __syncthreads();
    if (tid == 0) { int acc = 0; for (int e = 0; e < 8; ++e) { sh[16 + e] = acc; acc += ((sh[e] + 255) >> 8) << 8; } sh[24] = acc; }
    __syncthreads();
    const bf16_t* xb3 = P.bf(WS_HM); bf16_t* xy = P.bf(WS_XY);
    for (int q0 = wid * 32; q0 < wid * 32 + 32; q0 += 4) {
        u32x4 a[4], c[4]; int rowv[4];
#pragma unroll
        for (int u = 0; u < 4; ++u) {
            const int q = q0 + u, tl = q >> 1, slot = q & 1, t = blk * 128 + tl;
            const unsigned info = ((const unsigned*)P.i32(MO_TOKE))[t];
            const int e = slot ? (info >> 4) & 15 : info & 15, lr = slot ? (info >> 20) & 4095 : (info >> 8) & 4095;
            rowv[u] = sh[16 + e] + sh[8 + e] + lr;
            const u32x4* src = (const u32x4*)(xb3 + (size_t)t * DM) + lane;
            a[u] = src[0]; c[u] = src[64];
            if (lane == 0) { P.f32(MO_RSCALE)[rowv[u]] = P.f32(MO_TOKR)[t]; P.f32(MO_RGATE)[rowv[u]] = P.f32(MO_TOKW)[(size_t)t * 2 + slot]; P.f32(MO_RKEEP)[rowv[u]] = slot ? 0.f : 1.f; P.i32(MO_POS)[(size_t)t * 2 + slot] = rowv[u];
                if (rowv[u] >= MOE_XROW0) P.i32(MO_ROWTOK)[rowv[u] - MOE_XROW0] = t; }
        }
#pragma unroll
        for (int u = 0; u < 4; ++u) { u32x4* dst = (u32x4*)(xy + (size_t)rowv[u] * DM) + lane; dst[0] = a[u]; dst[64] = c[u]; }
    }
    if (blk < 8) {
        const int e = blk, r0 = sh[16 + e] + sh[e], r1 = sh[16 + e + 1];
        for (int row = r0 + wid; row < r1; row += 8) { u32x2* o8 = (u32x2*)(xy + (size_t)row * DM) + lane;
#pragma unroll
            for (int j = 0; j < 4; ++j) o8[64 * j] = (u32x2){0u, 0u};
            if (lane == 0) { P.f32(MO_RSCALE)[row] = 0.f; P.f32(MO_RGATE)[row] = 0.f; P.f32(MO_RKEEP)[row] = 0.f; if (row >= MOE_XROW0) P.i32(MO_ROWTOK)[row - MOE_XROW0] = -1; } }
    }
    if (blk == 8) {
        int* te = P.i32(MO_TILEE); const int ntl = sh[24] >> 8;
        for (int tl = tid; tl < 271; tl += 512) { int e = 0; for (int k = 1; k < 8; ++k) if (tl * 256 >= sh[16 + k]) e = k; te[tl] = e; }
        if (tid == 0) te[271] = ntl;
    }
    __syncthreads();
}
DI f32x4 moe_row_piece(const Ptrs& P, int p, int lane, int j) {
    const u32x2 w = ((const u32x2*)(P.bf(WS_XY) + (size_t)p * DM) + lane)[64 * j];
    const f32x4 old = {bflo(w[0]), bfhi(w[0]), bflo(w[1]), bfhi(w[1])};
    if (p < MOE_XROW0) return old;
    const f32x4* pp = (const f32x4*)(P.f32(WS_PART) + (size_t)(p - MOE_XROW0) * 11 * DM) + 64 * j + lane;
    f32x4 s = pp[0];
#pragma unroll
    for (int k = 1; k < 11; ++k) s += pp[k * (DM / 4)];
    return old * P.f32(MO_RKEEP)[p] + s * P.f32(MO_RGATE)[p];
}
DI void combine_tail_row(const Ptrs& P, int xr, int lane) {
    const int t = __builtin_amdgcn_readfirstlane(P.i32(MO_ROWTOK)[xr]);
    if (t < 0) return;
    const int p1 = __builtin_amdgcn_readfirstlane(P.i32(MO_POS)[(size_t)t * 2]), p2 = __builtin_amdgcn_readfirstlane(P.i32(MO_POS)[(size_t)t * 2 + 1]);
    if (p1 >= MOE_XROW0 && p2 >= MOE_XROW0 && (p1 < p2 ? p1 : p2) != MOE_XROW0 + xr) return;
    f32x4* orow = (f32x4*)(P.out + (size_t)t * DM) + lane;
#pragma unroll 2
    for (int j = 0; j < 4; ++j) orow[64 * j] = moe_row_piece(P, p1, lane, j) + moe_row_piece(P, p2, lane, j);
}
template <int NR> DI void combine_rows(const Ptrs& P, int t0, int lane) {
    const bf16_t* y = P.bf(WS_XY);
    int p1[NR], p2[NR];
#pragma unroll
    for (int u = 0; u < NR; ++u) { p1[u] = P.i32(MO_POS)[(size_t)(t0 + u) * 2]; p2[u] = P.i32(MO_POS)[(size_t)(t0 + u) * 2 + 1]; }
    { bool tail = false;
#pragma unroll
      for (int u = 0; u < NR; ++u) tail = tail || p1[u] >= MOE_XROW0 || p2[u] >= MOE_XROW0;
      if (tail) {
#pragma unroll 1
        for (int u = 0; u < NR; ++u) { if (p1[u] >= MOE_XROW0 || p2[u] >= MOE_XROW0) continue;
            f32x4* orow = (f32x4*)(P.out + (size_t)(t0 + u) * DM) + lane;
#pragma unroll 1
            for (int j = 0; j < 4; ++j) orow[64 * j] = moe_row_piece(P, p1[u], lane, j) + moe_row_piece(P, p2[u], lane, j); }
        return; } }
    u32x2 a[NR][4], c[NR][4];
#pragma unroll
    for (int u = 0; u < NR; ++u) {
        const u32x2* y1 = (const u32x2*)(y + (size_t)p1[u] * DM) + lane; const u32x2* y2 = (const u32x2*)(y + (size_t)p2[u] * DM) + lane;
#pragma unroll
        for (int j = 0; j < 4; ++j) { a[u][j] = y1[64 * j]; c[u][j] = y2[64 * j]; }
    }
#pragma unroll
    for (int u = 0; u < NR; ++u) {
        f32x4* orow = (f32x4*)(P.out + (size_t)(t0 + u) * DM) + lane;
#pragma unroll
        for (int j = 0; j < 4; ++j) { f32x4 w; w[0] = bflo(a[u][j][0]) + bflo(c[u][j][0]); w[1] = bfhi(a[u][j][0]) + bfhi(c[u][j][0]); w[2] = bflo(a[u][j][1]) + bflo(c[u][j][1]); w[3] = bfhi(a[u][j][1]) + bfhi(c[u][j][1]); orow[64 * j] = w; }
    }
}
}
#define XB_TMO      128
#define XB_XCNT(j)  (256  + 64 * (j))
#define XB_XSUB(j)  (1280 + 64 * (j))
#define XB_XGEN(j)  (2304 + 64 * (j))
#define XB_TOP      3328
#define XB_TOPGEN   3392
#define XCD_BAR_WORDS 3456
#define XB_SPIN_CAP (1u << 18)

__device__ __forceinline__ unsigned xb_ld(unsigned* p)              { return __hip_atomic_load(p, __ATOMIC_RELAXED, __HIP_MEMORY_SCOPE_AGENT); }
__device__ __forceinline__ unsigned xb_add(unsigned* p, unsigned v) { return __hip_atomic_fetch_add(p, v, __ATOMIC_RELAXED, __HIP_MEMORY_SCOPE_AGENT); }
__device__ __forceinline__ unsigned xb_xcc_id() { return (unsigned)__builtin_amdgcn_s_getreg((3 << 11) | 20) & 0xFu; }
#define XB_SPIN(cond, bar) do { unsigned _sp = 0; while (cond) { __builtin_amdgcn_s_sleep(1); \
    if ((++_sp & 255u) == 0u) { if (xb_ld(&(bar)[XB_TMO])) break; if (_sp > XB_SPIN_CAP) { atomicAdd(&(bar)[XB_TMO], 1u); break; } } } } while (0)

struct XcdBarrier {
    unsigned* bar; unsigned x;
    volatile LAS unsigned* st;
};

__device__ __forceinline__ XcdBarrier xcd_barrier_post(unsigned* bar, volatile LAS unsigned* st) {
    XcdBarrier b; b.bar = bar; b.x = xb_xcc_id(); b.st = st;
    if (threadIdx.x == 0) (void)xb_add(&bar[XB_XCNT(b.x)], 1u);
    return b;
}
__device__ __forceinline__ void xcd_barrier_complete(unsigned* bar, unsigned x, unsigned& nloc, unsigned& nx) {
    const unsigned G = gridDim.x * gridDim.y * gridDim.z;
    unsigned sum, cnt, mine, sp = 0u;
    for (;;) {
        sum = 0u; cnt = 0u; mine = 0u;
#pragma unroll
        for (unsigned j = 0; j < 16; ++j) { const unsigned c = xb_ld(&bar[XB_XCNT(j)]); sum += c; cnt += (c > 0u) ? 1u : 0u; mine = (j == x) ? c : mine; }
        if (sum == G) break;
        __builtin_amdgcn_s_sleep(1);
        if ((++sp & 255u) == 0u) { if (xb_ld(&bar[XB_TMO])) break; if (sp > XB_SPIN_CAP) { atomicAdd(&bar[XB_TMO], 1u); break; } }
    }
    nloc = mine > 0u ? mine : 1u; nx = cnt > 0u ? cnt : 1u;
}

__device__ __forceinline__ void xcd_barrier(const XcdBarrier& b) {
    asm volatile("s_waitcnt vmcnt(0)" ::: "memory");
    __syncthreads();
    if (threadIdx.x == 0) {
        unsigned* bar = b.bar;
        __builtin_amdgcn_s_waitcnt(0);
        unsigned nloc = b.st[0], nx = b.st[1];
        if (nloc == 0u) { xcd_barrier_complete(bar, b.x, nloc, nx); b.st[0] = nloc; b.st[1] = nx; }
        const unsigned old = xb_add(&bar[XB_XSUB(b.x)], 1u);
        const unsigned gen = old / nloc;
        if (old + 1u == (gen + 1u) * nloc) {
            __builtin_amdgcn_fence(__ATOMIC_RELEASE, "agent");
            asm volatile("s_waitcnt vmcnt(0)" ::: "memory");
            const unsigned og = xb_add(&bar[XB_TOP], 1u);
            const unsigned tg = og / nx;
            if (og + 1u == (tg + 1u) * nx) xb_add(&bar[XB_TOPGEN], 1u);
            else XB_SPIN(xb_ld(&bar[XB_TOPGEN]) == tg, bar);
            __builtin_amdgcn_fence(__ATOMIC_ACQUIRE, "agent");
            xb_add(&bar[XB_XGEN(b.x)], 1u);
            asm volatile("s_waitcnt vmcnt(0)" ::: "memory");
        } else {
            XB_SPIN(xb_ld(&bar[XB_XGEN(b.x)]) == gen, bar);
            __builtin_amdgcn_fence(__ATOMIC_ACQUIRE, "agent");
            asm volatile("s_waitcnt vmcnt(0)" ::: "memory");
        }
    }
    __syncthreads();
}

#ifndef MK_N_LAUNCHES
#define MK_N_LAUNCHES 1
#endif
constexpr int N_PHASES = 18;

__global__ void __launch_bounds__(512, 2) mega_fwd(Args args) {
    extern __shared__ __attribute__((aligned(16))) unsigned char lds_raw[];
    LAS char* lds = (LAS char*)lds_raw;
    cg::grid_group grid = cg::this_grid();
    Ptrs P;
#pragma unroll
    for (int i = 0; i < 31; ++i) P.in[i] = args.in[i];
    P.out = args.out; P.ws = args.ws;
    const int lo = args.ph_lo, hi_ = args.ph_hi;
    const int tid = threadIdx.x, lane = tid & 63, wid = __builtin_amdgcn_readfirstlane(tid >> 6);
    const int G = gridDim.x, gw = blockIdx.x * 8 + wid, NGW = G * 8;
#define IN(k) (lo <= (k) && (k) < hi_)
    { volatile LAS unsigned* st0 = (volatile LAS unsigned*)(lds_raw + LDS_MISC); if (tid < 64) st0[tid] = 0u; }
    __syncthreads();
    XcdBarrier xbar; xbar.bar = (unsigned*)(args.ws + CT_BAR); xbar.x = 0; xbar.st = (volatile LAS unsigned*)(lds_raw + LDS_MISC) + 8;
    const bool one_launch = (lo == 0 && hi_ == N_PHASES);
    if (one_launch) { if (blockIdx.x == 0) { for (int i = tid; i < 1024; i += 512) ((unsigned*)(args.ws + CT_CTR))[i] = 0u; for (int i = tid; i < 4096; i += 512) ((unsigned*)(args.ws + CT_BAR))[i] = 0u; } }
    else xbar = xcd_barrier_post((unsigned*)(args.ws + CT_BAR), (volatile LAS unsigned*)(lds_raw + LDS_MISC) + 8);
#define SEAM(k) do { if (IN(k) && IN((k) + 1)) { if ((k) == 0) { grid.sync(); if (one_launch) xbar = xcd_barrier_post((unsigned*)(args.ws + CT_BAR), (volatile LAS unsigned*)(lds_raw + LDS_MISC) + 8); } else xcd_barrier(xbar); } } while (0)
    LAS unsigned char* glds = (LAS unsigned char*)lds_raw;

    if (IN(0)) { pro::prologue(P, lds); }
    SEAM(0);
    if (IN(1)) {
        pg8::Gemm g{P.bf(WS_XB), P.bf(WS_WA), T, NA_PAD, DM}; pg8::StaticOrder S; S.init(T, NA_PAD, G, (int)blockIdx.x);
        const float* cosT = P.f32(CT_ROPE);
        pg8::EpiInA E{P.bf(WS_BIG), P.f32(CT_RSTD0), cosT, cosT + SEQ * 8, P.in[I_AQN], P.in[I_AKN], P.in[I_FQN], P.in[I_FKN], P.in[I_GBIAS], P.in[I_FFB], P.f32(CT_GATE), P.f32(CT_LOGF)};
        pg8::gemm_phase<pg8::EpiInA, pg8::StaticOrder, true, true>(glds, g, S, E);
    }
    SEAM(1);
    if (IN(2)) {
        if (gw < 64) pro::fox_cum(P, gw, lane);
        for (int it = blockIdx.x; it < 256; it += G) pro::compress_item(P, it, lds);
    }
    SEAM(2);
    if (IN(3)) {
        att::Tensors AT{P.bf(WS_BIG), P.bf(CT_KCMP), P.bf(CT_VCMP), P.f32(CT_GATE), P.f32(CT_CUM), P.bf(WS_O), P.in[I_FQN], P.in[I_FKN], P.in[I_AQN], P.in[I_AKN]};
        att::attn_phase(AT, (unsigned*)(P.ws + CT_CTR), lds);
    }
    SEAM(3);
    if (IN(4)) {
        pg8::Gemm g{P.bf(WS_O), P.bf(WS_WO), T, DM, DM}; pg8::StaticOrder S; S.init(T, DM, G, (int)blockIdx.x);
        pg8::EpiResid<true> E{P.in[I_X], P.bf(WS_XB), P.f32(CT_SS1)};
        pg8::gemm_phase<pg8::EpiResid<true>, pg8::StaticOrder, true, true>(glds, g, S, E);
    }
    SEAM(4);
    if (IN(5)) {
        pg8::Gemm g{P.bf(WS_XB), P.bf(WS_WFGU), T, 2 * DFF, DM}; pg8::StaticOrder S; S.init(T, 2 * DFF, G, (int)blockIdx.x);
        for (int blk = blockIdx.x; blk < 256; blk += G) if (tid < 128) { const int row = blk * 128 + tid; P.f32(CT_RSTD0)[row] = pg8::row_rstd(P.f32(CT_SS1), row); }
        xcd_barrier(xbar);
        pg8::EpiSwiglu<true> E{P.bf(WS_BIG), P.f32(CT_RSTD0), 0};
        pg8::gemm_phase<pg8::EpiSwiglu<true>, pg8::StaticOrder, true, true>(glds, g, S, E);
    }
    SEAM(5);
    if (IN(6)) {
        pg8::Gemm g{P.bf(WS_BIG), P.bf(WS_WFD), T, DM, DFF}; pg8::StaticOrder S; S.init(T, DM, G, (int)blockIdx.x);
        pg8::EpiResid<false> E{P.bf(WS_XB), P.bf(WS_XB), P.f32(CT_SS2)};
        pg8::gemm_phase<pg8::EpiResid<false>, pg8::StaticOrder, true, true>(glds, g, S, E);
    }
    SEAM(6);
    if (IN(7)) {
        for (int blk = blockIdx.x; blk < 256; blk += G) if (tid < 128) { const int row = blk * 128 + tid; P.f32(CT_RSTD0)[row] = pg8::row_rstd(P.f32(CT_SS2), row); }
        for (int it = blockIdx.x; it < T / 128; it += G) gla::gla_a1_item(P.bf(WS_XB), P.bf(WS_WC) + (size_t)LDC * DM, P.f32(CT_SS2), P.f32(CT_A1), it, lds);
        xcd_barrier(xbar);
        pg8::Gemm g{P.bf(WS_XB), P.bf(WS_WC), T, LDC, DM}; pg8::StaticOrder S; S.init(T, LDC, G, (int)blockIdx.x);
        pg8::EpiGlaIn E{P.bf(WS_BIG), P.f32(CT_RSTD0)};
        pg8::gemm_phase<pg8::EpiGlaIn, pg8::StaticOrder, true, true>(glds, g, S, E);
    }
    SEAM(7);
    if (IN(8)) {
        gla::GlaT GT{P.bf(WS_BIG), P.f32(CT_A1), P.in[I_CWA2], P.in[I_CBA], P.bf(WS_O), P.bf(WS_ATT), P.f32(CT_GATE)};
        {
            gla::PrepRegs Ra, Rb; int it = blockIdx.x;
            if (it < 2048) gla::prep_load(Ra, GT, it, tid);
            while (it < 2048) {
                const int i1 = it + G; if (i1 < 2048) gla::prep_load(Rb, GT, i1, tid);
                gla::gla_prep(GT, it, Ra, lds);
                if (i1 >= 2048) break;
                const int i2 = i1 + G; if (i2 < 2048) gla::prep_load(Ra, GT, i2, tid);
                gla::gla_prep(GT, i1, Rb, lds);
                it = i2;
            }
        }
        xcd_barrier(xbar);
        for (int u = blockIdx.x; u < 256; u += G) { const int bh = (u & 7) * 4 + (u >> 6), es = (u >> 3) & 7; gla::gla_unit(GT, bh >> 2, bh & 3, es, lds); }
    }
    SEAM(8);
    if (IN(9)) {
        for (int m = gw * 2; m < T; m += NGW * 2) gla::gla_gate_rows2(P.bf(WS_O), P.bf(WS_BIG) + PC_R, P.in[I_CONORM], m, lane);
    }
    SEAM(9);
    if (IN(10)) {
        pg8::Gemm g{P.bf(WS_O), P.bf(WS_WCO), T, DM, DM}; pg8::StaticOrder S; S.init(T, DM, G, (int)blockIdx.x);
        pg8::EpiResid<false> E{P.bf(WS_XB), P.bf(WS_HM), P.f32(CT_SS3)};
        pg8::gemm_phase<pg8::EpiResid<false>, pg8::StaticOrder, true, true>(glds, g, S, E);
    }
    SEAM(10);
    if (IN(11)) { for (int blk = blockIdx.x; blk < 256; blk += G) moe::route_block(P, blk, lds); }
    SEAM(11);
    if (IN(12)) { for (int blk = blockIdx.x; blk < 256; blk += G) moe::scatter_block(P, blk, lds); }
    SEAM(12);
#pragma unroll 1
    for (int pass = 0; pass < 2; ++pass) {
        const int tile0 = pass * MOE_PASS_TILES;
        if (IN(13 + 2 * pass)) {
            int ntp = __builtin_amdgcn_readfirstlane(P.i32(MO_TILEE)[271]) - tile0; { const int cap = pass == 0 ? MOE_PASS_TILES : MOE_PASS1_MAX; ntp = ntp < 0 ? 0 : (ntp > cap ? cap : ntp); }
            if (ntp > 0) {
                pg8::Gemm g{P.bf(WS_XY) + (size_t)tile0 * 256 * DM, P.bf(WS_WMGU), ntp * 256, 2 * DFF, DM};
                pg8::GroupedOrder S; S.so.init(ntp * 256, 2 * DFF, G, (int)blockIdx.x); S.tile_e = P.i32(MO_TILEE); S.tile0 = tile0; S.nN = 22;
                pg8::EpiSwiglu<true> E{P.bf(WS_HM), P.f32(MO_RSCALE), tile0 * 256};
                pg8::gemm_phase<pg8::EpiSwiglu<true>, pg8::GroupedOrder, true, true>(glds, g, S, E);
            }
        }
        SEAM(13 + 2 * pass);
        if (IN(14 + 2 * pass)) {
            int ntp = __builtin_amdgcn_readfirstlane(P.i32(MO_TILEE)[271]) - tile0; { const int cap = pass == 0 ? MOE_PASS_TILES : MOE_PASS1_MAX; ntp = ntp < 0 ? 0 : (ntp > cap ? cap : ntp); }
            const int ntm = ntp < MOE_PASS_TILES ? ntp : MOE_PASS_TILES, nx = ntp - ntm;
            if (ntm > 0) {
                pg8::Gemm g{P.bf(WS_HM), P.bf(WS_WMD), ntm * 256, DM, DFF};
                pg8::GroupedOrder S; S.so.init(ntm * 256, DM, G, (int)blockIdx.x); S.tile_e = P.i32(MO_TILEE); S.tile0 = tile0; S.nN = 4;
                pg8::EpiMoeDown E{P.bf(WS_XY), P.f32(MO_RGATE), P.f32(MO_RKEEP), tile0 * 256};
                pg8::gemm_phase<pg8::EpiMoeDown, pg8::GroupedOrder, true, true>(glds, g, S, E);
            }
            if (nx > 0) {
                pg8::Gemm g{P.bf(WS_HM), P.bf(WS_WMD), ntp * 256, DM, 256, DFF};
                pg8::SliceOrder S{P.i32(MO_TILEE), tile0, ntm, nx * 44, G, (int)blockIdx.x};
                pg8::EpiMoePart E{P.f32(WS_PART), ntm};
                pg8::gemm_phase<pg8::EpiMoePart, pg8::SliceOrder, true, true>(glds, g, S, E);
            }
        }
        SEAM(14 + 2 * pass);
    }
    if (IN(17)) { int t17 = tid; asm volatile("" : "+v"(t17)); const int lane17 = t17 & 63;
        { const int nxr = (__builtin_amdgcn_readfirstlane(P.i32(MO_TILEE)[271]) - 2 * MOE_PASS_TILES) * 256;
          for (int xr = gw; xr < nxr; xr += NGW) moe::combine_tail_row(P, xr, lane17); }
        for (int m = gw * 2; m < T; m += NGW * 2) moe::combine_rows<2>(P, m, lane17); }
#undef IN
#undef SEAM
}

extern "C" void kernel_launch(void* const* d_in, const int* in_sizes, int n_in, void* d_out, int out_size, void* d_ws, size_t ws_size, hipStream_t stream) {
    static int grid = 0;
    if (grid == 0) {
        if (n_in != 31 || out_size != T * DM || ws_size < WS_END) { fprintf(stderr, "kernel_launch: unexpected problem (n_in %d, out %d, ws %zu)\n", n_in, out_size, ws_size); grid = -1; return; }
        int dev = 0, cus = 0, per_cu = 0;
        hipGetDevice(&dev); hipDeviceGetAttribute(&cus, hipDeviceAttributeMultiprocessorCount, dev);
        if (hipFuncSetAttribute((const void*)mega_fwd, hipFuncAttributeMaxDynamicSharedMemorySize, LDS_BYTES) != hipSuccess) { fprintf(stderr, "kernel_launch: hipFuncSetAttribute failed\n"); grid = -1; return; }
        if (hipOccupancyMaxActiveBlocksPerMultiprocessor(&per_cu, (const void*)mega_fwd, 512, LDS_BYTES) != hipSuccess || per_cu < 1) { fprintf(stderr, "kernel_launch: occupancy query says %d\n", per_cu); per_cu = 1; }
        (void)hipGetLastError();
        grid = cus * 1;
        if (per_cu < 1) grid = -1;
    }
    if (grid < 0) return;
#if MK_N_LAUNCHES != 1
    hipMemsetAsync((char*)d_ws, 0, CT_ZERO_BYTES, stream);
#endif
    Args a{};
    for (int i = 0; i < 31; ++i) a.in[i] = (const float*)d_in[i];
    a.out = (float*)d_out; a.ws = (unsigned char*)d_ws;
#if MK_N_LAUNCHES == 1
    a.ph_lo = 0; a.ph_hi = N_PHASES;
    void* kargs[] = {&a};
    hipError_t e = hipLaunchCooperativeKernel((const void*)mega_fwd, dim3(grid), dim3(512), kargs, LDS_BYTES, stream);
    if (e != hipSuccess) fprintf(stderr, "cooperative launch failed: %s (grid %d)\n", hipGetErrorString(e), grid);
#else
    for (int ph = 0; ph < N_PHASES; ++ph) {
        a.ph_lo = ph; a.ph_hi = ph + 1;
        hipLaunchKernelGGL(mega_fwd, dim3(grid), dim3(512), LDS_BYTES, stream, a);
    }
#endif
}
```

```cpp
#include <hip/hip_runtime.h>
#include <hip/hip_cooperative_groups.h>
#include <cstdio>
#include <cstdint>
namespace cg = cooperative_groups;

#define DI __device__ __forceinline__
#define LAS __attribute__((address_space(3)))
#define GAS __attribute__((address_space(1)))
typedef unsigned short bf16_t;
typedef short bf16x8 __attribute__((ext_vector_type(8)));
typedef short s16x4 __attribute__((ext_vector_type(4)));
typedef float f32x2 __attribute__((ext_vector_type(2)));
typedef float f32x4 __attribute__((ext_vector_type(4)));
typedef float f32x16 __attribute__((ext_vector_type(16)));
typedef unsigned u32x2 __attribute__((ext_vector_type(2)));
typedef unsigned u32x4 __attribute__((ext_vector_type(4)));

constexpr int BATCH = 8, SEQ = 4096, DM = 1024, T = BATCH * SEQ;
constexpr int HD = 64;
constexpr int NSA_H = 8, NSA_G = 2, FOX_H = 8;
constexpr int NCMP = 255, NCMP_PAD = 256;
constexpr int IN_A = 2848, LDA = 2816  , NA_PAD = 3072;
constexpr int DFF = 2816;
constexpr int IN_C = 3088, LDC = 3072  , NC_PAD = 3328;
constexpr int NEXP = 8;
constexpr int MOE_TILES_MAX = 264, MOE_PASS_TILES = 256;
constexpr float EPS = 1e-6f;
constexpr float LOG2E = 1.4426950408889634f;
constexpr float QSCALE = 0.125f * LOG2E;
constexpr int PA_QA = 0, PA_KSL = 512, PA_KWN = 640, PA_VSL = 768, PA_VWN = 896, PA_KC = 1024, PA_VC = 1152, PA_QB = 1280, PA_KB = 1792, PA_VB = 2304;
constexpr int PC_Q = 0, PC_K = 512, PC_V = 1024, PC_R = 2048;

constexpr size_t MiB = 1u << 20;
constexpr size_t CT_CTR = 0;
constexpr size_t CT_BAR = 65536;
constexpr size_t CT_SS1 = 501 * MiB, CT_SS2 = 503 * MiB, CT_SS3 = 505 * MiB;
constexpr size_t CT_ZERO_BYTES = 1 * MiB;
static_assert(CT_BAR + 16384 <= CT_ZERO_BYTES, "zero region");
constexpr size_t CT_RSTD0 = 1 * MiB;
constexpr size_t CT_ROPE = CT_RSTD0 + (size_t)T * 4;
constexpr size_t CT_LOGF = 2 * MiB;
constexpr size_t CT_CUM = 3 * MiB;
constexpr size_t CT_GATE = 4 * MiB;
constexpr size_t CT_A1 = 7 * MiB;
constexpr size_t CT_KCMP = 9 * MiB, CT_VCMP = CT_KCMP + 512 * 1024;
constexpr size_t CT_CW = 10 * MiB;
constexpr size_t CT_MOE = 11 * MiB;
constexpr size_t WS_WA = 16 * MiB;
constexpr size_t WS_WO = WS_WA + 6 * MiB;
constexpr size_t WS_WFGU = WS_WO + 2 * MiB;
constexpr size_t WS_WFD = WS_WFGU + 11 * MiB;
constexpr size_t WS_WC = WS_WFD + 5632 * 1024;
constexpr size_t WS_WCO = WS_WC + 6656 * 1024;
constexpr size_t WS_WMGU = 49 * MiB;
constexpr int MOE_WS_GU = 5, MOE_WS_D = 6, MOE_HS = 3;
constexpr size_t WS_WMD = WS_WMGU + 88 * MiB;
static_assert(WS_WCO + 2 * MiB <= WS_WMGU, "weights map");
constexpr size_t WS_XB = 181 * MiB;
constexpr size_t WS_O = 245 * MiB;
constexpr size_t WS_ATT = WS_WA;
constexpr size_t WS_BIG = 309 * MiB;
constexpr size_t WS_XY = 181 * MiB;
constexpr size_t WS_HM = 313 * MiB;
constexpr size_t WS_PART = 16 * MiB;
constexpr int MOE_NSL = 5;
constexpr int MOE_XROW0 = MOE_PASS_TILES * 256;
constexpr size_t WS_END = 512 * MiB;
static_assert(WS_PART + (size_t)8 * 256 * 11 * 1024 * 4 <= WS_WMD, "partials map");
static_assert(WS_WMD + 44 * MiB <= WS_XB && WS_BIG + (size_t)T * LDC * 2 <= WS_END && WS_XY + (size_t)MOE_TILES_MAX * 256 * 1024 * 2 <= WS_HM && WS_HM + (size_t)MOE_TILES_MAX * 256 * DFF <= WS_END, "d_ws map");
constexpr size_t MO_TOKE = CT_MOE;
constexpr size_t MO_TOKW = MO_TOKE + (size_t)T * 4;
constexpr size_t MO_TOKR = MO_TOKW + (size_t)T * 8;
constexpr size_t MO_POS = MO_TOKR + (size_t)T * 4;
constexpr size_t MO_HIST = MO_POS + (size_t)T * 8;
constexpr size_t MO_RSCALE = MO_HIST + 8192;
constexpr size_t MO_RGATE = MO_RSCALE + (size_t)MOE_TILES_MAX * 256 * 4;
constexpr size_t MO_RKEEP = MO_RGATE + (size_t)MOE_TILES_MAX * 256 * 4;
constexpr size_t MO_TILEE = MO_RKEEP + (size_t)MOE_TILES_MAX * 256 * 4;
constexpr size_t MO_ROWTOK = MO_TILEE + 2048;
static_assert(MO_ROWTOK + 8192 <= WS_WA, "moe tables");

constexpr int LDS_BYTES = 163840;
constexpr int LDS_MISC = 163584;

DI unsigned cvtpk(float lo, float hi) { typedef __bf16 b2 __attribute__((ext_vector_type(2))); f32x2 v = {lo, hi}; b2 b = __builtin_convertvector(v, b2); return __builtin_bit_cast(unsigned, b); }
DI float bf2f(unsigned short h) { return __uint_as_float((unsigned)h << 16); }
DI float bflo(unsigned w) { return __uint_as_float(w << 16); }
DI float bfhi(unsigned w) { return __uint_as_float(w & 0xffff0000u); }
DI float wave_sum(float v) {
#pragma unroll
    for (int o = 1; o < 64; o <<= 1) v += __shfl_xor(v, o);
    return v;
}
DI float xsum16(float x) { const unsigned u = __float_as_uint(x); const u32x2 r = __builtin_amdgcn_permlane16_swap(u, u, false, false); return __uint_as_float(r[0]) + __uint_as_float(r[1]); }
DI float xsum32(float x) { const unsigned u = __float_as_uint(x); const u32x2 r = __builtin_amdgcn_permlane32_swap(u, u, false, false); return __uint_as_float(r[0]) + __uint_as_float(r[1]); }
DI float xchg16(float x, bool odd_row) { const unsigned u = __float_as_uint(x); const u32x2 r = __builtin_amdgcn_permlane16_swap(u, u, false, false); return __uint_as_float(odd_row ? r[0] : r[1]); }
DI float f8sat(float v) { return __builtin_amdgcn_fmed3f(v, -448.0f, 448.0f); }
DI float sigmoidf_(float z) { return 1.0f / (1.0f + __expf(-z)); }
DI float log_sigmoidf_(float z) { return fminf(z, 0.f) - __logf(1.0f + __expf(-fabsf(z))); }
DI float siluf_(float z) { return z * __builtin_amdgcn_rcpf(1.0f + __builtin_amdgcn_exp2f(-LOG2E * z)); }
DI float gelu_tanh(float x) { const float u = 0.7978845608028654f * (x + 0.044715f * x * x * x); const float e = __expf(2.f * u); const float t = 1.f - 2.f / (e + 1.f); return 0.5f * x * (1.f + t); }

struct Args {
    const float* in[31];
    float* out;
    unsigned char* ws;
    int ph_lo, ph_hi;
};
namespace pg8 {
#define PG8_LAS __attribute__((address_space(3)))
typedef unsigned short bf16_t;
typedef short bf16x8 __attribute__((ext_vector_type(8)));
typedef float f32x4 __attribute__((ext_vector_type(4)));
typedef unsigned u32x4 __attribute__((ext_vector_type(4)));
constexpr int BM = 256, BK = 64, HALF = 128, HTB = HALF * BK * 2  , STAGE_BYTES = 8 * HTB, NXCD = 8, WGM = 8;

__host__ __device__ __forceinline__ int lds_byte(int r, int c) { const int st = (r >> 4) * 2 + (c >> 5), rr = r & 15, cc = c & 31, ob = rr * 64 + cc * 2; return st * 1024 + (ob ^ (((ob >> 9) & 1) << 5)); }
__host__ __device__ __forceinline__ void stage_rc(int b, int& R, int& C) { const int st = b / 1024, sb = b % 1024, swz = sb ^ (((sb >> 9) & 1) << 5); R = (st >> 1) * 16 + swz / 64; C = (st & 1) * 32 + (swz % 64) / 2; }
__host__ __device__ __forceinline__ int perm32(int rho) { const int n = rho >> 4, i = rho & 15; return 8 * (i >> 2) + 4 * n + (i & 3); }

struct Unit { int pm, pn, ko, kt; };
struct Gemm { const bf16_t* A; const bf16_t* Bt; int M, N, K; int ld = 0; };

struct StaticOrder {
    static constexpr bool SLICED = false;
    int nM, nN, nwg, G, c;
    __host__ __device__ void init(int M, int N, int G_, int c_) { nM = M / BM; nN = N / BM; nwg = nM * nN; G = G_; c = c_; }
    __host__ __device__ bool next(int i, Unit& u) const {
        const long L = (long)i * G + c; if (L >= nwg) return false;
        int wgid = (int)L; { const int q = nwg / NXCD, r = nwg % NXCD, xcd = wgid % NXCD, off = wgid / NXCD; wgid = (xcd < r ? xcd * (q + 1) : r * (q + 1) + (xcd - r) * q) + off; }
        const int nig = WGM * nN, gid = wgid / nig, fm = gid * WGM, gsz = (nM - fm) < WGM ? (nM - fm) : WGM;
        u.pm = fm + ((wgid % nig) % gsz); u.pn = (wgid % nig) / gsz; return true;
    }
    __device__ __forceinline__ void a_ready(const Unit&) const {}
    __device__ __forceinline__ void done(const Unit&) const {}
};


#ifndef EPI_TWICE_MASK
#define EPI_TWICE_MASK 0
#endif
#define EPI_ROWS(...) _Pragma("unroll") for (int ai = 0; ai < 2; ++ai) _Pragma("unroll") for (int m = 0; m < 4; ++m) { const int rowl = u.pm * BM + ai * HALF + wr * 64 + m * 16 + fr; __VA_ARGS__ }

struct EpiInA {
    static constexpr bool PERM = true, AFTER_DRAIN = false, TWICE_OK = (EPI_TWICE_MASK & 1) != 0;
    bf16_t* projA; const float* rstd0; const float* cosT; const float* sinT;
    const float *qn, *kn, *fqn, *fkn, *gbias, *fbias; float* gate; float* logf;
    __device__ __forceinline__ void operator()(const f32x4 (&acc)[2][2][4][2], const Unit& u, int wr, int wc, int fr, int fq) const {
        const int s = u.pn * 4 + wc;
        if (s > 44) return;
        int kind = 0; const float* gain = qn; float scale = 1.f;
        if (s < 8) { kind = 2; gain = qn; scale = QSCALE; }
        else if (s < 12) { kind = 2; gain = kn; }
        else if (s < 20) { kind = 0; }
        else if (s < 28) { kind = 1; gain = fqn; scale = QSCALE; }
        else if (s < 36) { kind = 1; gain = fkn; }
        else if (s < 44) { kind = 0; }
        else kind = 3;
        float rsv[8];
#pragma unroll
        for (int q = 0; q < 8; ++q) rsv[q] = rstd0[u.pm * BM + (q >> 2) * HALF + wr * 64 + (q & 3) * 16 + fr];
        if (kind == 3) {
            EPI_ROWS(
                const float rs = rsv[ai * 4 + m];
                float v[8];
                _Pragma("unroll") for (int n = 0; n < 2; ++n) _Pragma("unroll") for (int e = 0; e < 4; ++e) v[n * 4 + e] = acc[ai][0][m][n][e] * rs;
                if (fq < 3) { float o[8]; _Pragma("unroll") for (int j = 0; j < 8; ++j) o[j] = sigmoidf_(v[j] + gbias[8 * fq + j]);
                    *(f32x4*)(gate + (size_t)rowl * 24 + 8 * fq) = (f32x4){o[0], o[1], o[2], o[3]}; *(f32x4*)(gate + (size_t)rowl * 24 + 8 * fq + 4) = (f32x4){o[4], o[5], o[6], o[7]}; }
                else { float o[8]; _Pragma("unroll") for (int j = 0; j < 8; ++j) o[j] = log_sigmoidf_(v[j] + fbias[j]);
                    _Pragma("unroll") for (int j = 0; j < 8; ++j) logf[((size_t)(rowl >> 12) * 8 + j) * SEQ + (rowl & (SEQ - 1))] = o[j]; }
            )
            return;
        }
        const bool do_norm = kind >= 1, do_rope = kind == 2;
        float g[16];
        { const float* gp = gain + 8 * fq; const f32x4 g0 = *(const f32x4*)gp, g1 = *(const f32x4*)(gp + 4), g2 = *(const f32x4*)(gp + 32), g3 = *(const f32x4*)(gp + 36);
#pragma unroll
          for (int i = 0; i < 4; ++i) { g[i] = do_norm ? g0[i] * scale : scale; g[4 + i] = do_norm ? g1[i] * scale : scale; g[8 + i] = do_norm ? g2[i] * scale : scale; g[12 + i] = do_norm ? g3[i] * scale : scale; } }
        const float ir[8] = {0.15915494309189535f, 0.03086376340470123f, 0.005985185712713705f, 0.001160663641240061f, 0.00022507907903927653f, 4.364795279280289e-05f, 8.464330808241401e-06f, 1.6414262627950345e-06f};
        const bool rope_lane = do_rope && fq < 2;
        EPI_ROWS(
            const float rs = rsv[ai * 4 + m];
            float v[16];
            _Pragma("unroll") for (int bj = 0; bj < 2; ++bj) _Pragma("unroll") for (int n = 0; n < 2; ++n) _Pragma("unroll") for (int e = 0; e < 4; ++e) v[bj * 8 + n * 4 + e] = acc[ai][bj][m][n][e];
            float sc = rs;
            if (do_norm) { float s0 = 0.f, s1 = 0.f;
                _Pragma("unroll") for (int i = 0; i < 16; i += 2) { s0 += v[i] * v[i]; s1 += v[i + 1] * v[i + 1]; }
                float ss = xsum32(xsum16(s0 + s1));
                sc = rs * rsqrtf(ss * (rs * rs) * (1.0f / 64.0f) + EPS); }
            _Pragma("unroll") for (int i = 0; i < 16; ++i) v[i] = v[i] * (sc * g[i]);
            if (do_rope) {
            float oth[8];
            _Pragma("unroll") for (int j = 0; j < 8; ++j) oth[j] = xchg16(v[j], (fq & 1) != 0);
            const float pos = rope_lane ? (float)(rowl & (SEQ - 1)) : 0.f;
            const float sgn = (fq == 0) ? -1.f : 1.f;
            _Pragma("unroll") for (int j = 0; j < 8; ++j) { const float rev = pos * ir[j]; const float fr_ = rev - floorf(rev); const float cc = __builtin_amdgcn_cosf(fr_), sn = __builtin_amdgcn_sinf(fr_) * sgn;
                v[j] = v[j] * cc + oth[j] * sn; }
            }
            bf16_t* dst = projA + (size_t)rowl * LDA + s * 64 + 8 * fq;
            _Pragma("unroll") for (int bj = 0; bj < 2; ++bj) { u32x4 w; w.x = ::cvtpk(v[bj * 8 + 0], v[bj * 8 + 1]); w.y = ::cvtpk(v[bj * 8 + 2], v[bj * 8 + 3]);
                w.z = ::cvtpk(v[bj * 8 + 4], v[bj * 8 + 5]); w.w = ::cvtpk(v[bj * 8 + 6], v[bj * 8 + 7]); *(u32x4*)(dst + 32 * bj) = w; }
        )
    }
};

__device__ __forceinline__ float row_rstd(const float* ssp, int row) { const f32x4* q = (const f32x4*)(ssp + (size_t)row * 16); const f32x4 a = q[0], b = q[1], c = q[2], d = q[3];
    const float s = (((a[0] + a[1]) + (a[2] + a[3])) + ((b[0] + b[1]) + (b[2] + b[3]))) + (((c[0] + c[1]) + (c[2] + c[3])) + ((d[0] + d[1]) + (d[2] + d[3]))); return rsqrtf(s * (1.0f / 1024.0f) + EPS); }
template <bool RES_F32> struct EpiResid {
    static constexpr bool PERM = true, AFTER_DRAIN = false, TWICE_OK = false;
    const void* res; bf16_t* outb; float* ss;
    __device__ __forceinline__ void operator()(const f32x4 (&acc)[2][2][4][2], const Unit& u, int wr, int wc, int fr, int fq) const {
        constexpr int MB = RES_F32 ? 2 : 4;
#pragma unroll
        for (int ai = 0; ai < 2; ++ai)
#pragma unroll
            for (int m0 = 0; m0 < 4; m0 += MB) {
                f32x4 r0[MB][2], r1[MB][2];
#pragma unroll
                for (int mm = 0; mm < MB; ++mm) { const int rowl = u.pm * BM + ai * HALF + wr * 64 + (m0 + mm) * 16 + fr; const size_t off = (size_t)rowl * DM + u.pn * BM + wc * 32 + 8 * fq;
#pragma unroll
                    for (int bj = 0; bj < 2; ++bj) {
                        if (RES_F32) { r0[mm][bj] = *(const f32x4*)((const float*)res + off + bj * HALF); r1[mm][bj] = *(const f32x4*)((const float*)res + off + bj * HALF + 4); }
                        else { const u32x4 rw = *(const u32x4*)((const bf16_t*)res + off + bj * HALF); r0[mm][bj] = (f32x4){bflo(rw.x), bfhi(rw.x), bflo(rw.y), bfhi(rw.y)}; r1[mm][bj] = (f32x4){bflo(rw.z), bfhi(rw.z), bflo(rw.w), bfhi(rw.w)}; } } }
#pragma unroll
                for (int mm = 0; mm < MB; ++mm) { const int m = m0 + mm; const int rowl = u.pm * BM + ai * HALF + wr * 64 + m * 16 + fr; const size_t off = (size_t)rowl * DM + u.pn * BM + wc * 32 + 8 * fq; float part = 0.f;
#pragma unroll
                    for (int bj = 0; bj < 2; ++bj) {
                        const f32x4 x0 = r0[mm][bj] + acc[ai][bj][m][0], x1 = r1[mm][bj] + acc[ai][bj][m][1];
                        u32x4 w; w.x = ::cvtpk(x0[0], x0[1]); w.y = ::cvtpk(x0[2], x0[3]); w.z = ::cvtpk(x1[0], x1[1]); w.w = ::cvtpk(x1[2], x1[3]); *(u32x4*)(outb + off + bj * HALF) = w;
                        part += (x0[0] * x0[0] + x0[1] * x0[1]) + (x0[2] * x0[2] + x0[3] * x0[3]) + (x1[0] * x1[0] + x1[1] * x1[1]) + (x1[2] * x1[2] + x1[3] * x1[3]);
                    }
                    part = xsum32(xsum16(part));
                    if (fq == 0 && ss) ss[(size_t)rowl * 16 + u.pn * 4 + wc] = part; }
            }
    }
};

template <bool MOE, bool F8 = false> struct EpiSwiglu {
    static constexpr bool PERM = true, AFTER_DRAIN = false, TWICE_OK = (EPI_TWICE_MASK & 2) != 0;
    bf16_t* h; const float* rsrc; int row_off;
    __device__ __forceinline__ void operator()(const f32x4 (&acc)[2][2][4][2], const Unit& u, int wr, int wc, int fr, int fq) const {
        asm volatile("" : "+v"(fr), "+v"(fq));
        const int pnl = MOE ? (u.pn % 22) : u.pn;
        float rsv[8];
#pragma unroll
        for (int q = 0; q < 8; ++q) { const int rl = u.pm * BM + (q >> 2) * HALF + wr * 64 + (q & 3) * 16 + fr; rsv[q] = MOE ? rsrc[row_off + rl] : row_rstd(rsrc, rl); }
        EPI_ROWS(
            const float rs = rsv[ai * 4 + m]; const float c1 = -LOG2E * rs, kq = __builtin_amdgcn_rcpf(rs * rs);
            f32x4 o4[2];
            _Pragma("unroll") for (int n = 0; n < 2; ++n) { const f32x4 gg = acc[ai][0][m][n], uu = acc[ai][1][m][n]; const f32x4 a = gg * c1;
                const f32x4 ex = {__builtin_amdgcn_exp2f(a[0]), __builtin_amdgcn_exp2f(a[1]), __builtin_amdgcn_exp2f(a[2]), __builtin_amdgcn_exp2f(a[3])};
                const f32x4 d = ex * kq + kq;
                const f32x4 r = {__builtin_amdgcn_rcpf(d[0]), __builtin_amdgcn_rcpf(d[1]), __builtin_amdgcn_rcpf(d[2]), __builtin_amdgcn_rcpf(d[3])};
                o4[n] = (gg * uu) * r; }
            u32x4 w; w.x = ::cvtpk(o4[0][0], o4[0][1]); w.y = ::cvtpk(o4[0][2], o4[0][3]); w.z = ::cvtpk(o4[1][0], o4[1][1]); w.w = ::cvtpk(o4[1][2], o4[1][3]);
            if constexpr (F8) { unsigned ob = (unsigned)rowl * (unsigned)DFF + (unsigned)(pnl * 128 + wc * 32 + 8 * fq); asm volatile("" : "+v"(ob));
              const float hs = (float)(1 << MOE_HS); unsigned w0 = 0, w1 = 0;
              w0 = __builtin_amdgcn_cvt_pk_fp8_f32(o4[0][0] * hs, o4[0][1] * hs, w0, false); w0 = __builtin_amdgcn_cvt_pk_fp8_f32(o4[0][2] * hs, o4[0][3] * hs, w0, true);
              w1 = __builtin_amdgcn_cvt_pk_fp8_f32(o4[1][0] * hs, o4[1][1] * hs, w1, false); w1 = __builtin_amdgcn_cvt_pk_fp8_f32(o4[1][2] * hs, o4[1][3] * hs, w1, true);
              *(u32x2*)((unsigned char*)h + ob) = (u32x2){w0, w1}; }
            else { unsigned ob = (unsigned)rowl * (unsigned)(DFF * 2) + (unsigned)(pnl * 128 + wc * 32 + 8 * fq) * 2u; asm volatile("" : "+v"(ob));
              *(u32x4*)((unsigned char*)h + ob) = w; }
        )
    }
};

struct EpiGlaIn {
    static constexpr bool PERM = true, AFTER_DRAIN = false, TWICE_OK = (EPI_TWICE_MASK & 4) != 0;
    bf16_t* projC; const float* rstd2;
    __device__ __forceinline__ void operator()(const f32x4 (&acc)[2][2][4][2], const Unit& u, int wr, int wc, int fr, int fq) const {
        float rsv[8];
#pragma unroll
        for (int q = 0; q < 8; ++q) rsv[q] = rstd2[u.pm * BM + (q >> 2) * HALF + wr * 64 + (q & 3) * 16 + fr];
        EPI_ROWS(
            float rs = rsv[ai * 4 + m]; if (u.pn < 2) rs *= 0.08838834764831845f;
            _Pragma("unroll") for (int bj = 0; bj < 2; ++bj) { const f32x4 x0 = acc[ai][bj][m][0] * rs, x1 = acc[ai][bj][m][1] * rs;
                u32x4 w; w.x = ::cvtpk(x0[0], x0[1]); w.y = ::cvtpk(x0[2], x0[3]); w.z = ::cvtpk(x1[0], x1[1]); w.w = ::cvtpk(x1[2], x1[3]);
                *(u32x4*)(projC + (size_t)rowl * LDC + u.pn * BM + bj * HALF + wc * 32 + 8 * fq) = w; }
        )
    }
};

struct EpiMoeDown {
    static constexpr bool PERM = true, AFTER_DRAIN = false, TWICE_OK = false;
    bf16_t* xy; const float* rgate; const float* rkeep; int row_off;
    __device__ __forceinline__ void operator()(const f32x4 (&acc)[2][2][4][2], const Unit& u, int wr, int wc, int fr, int fq) const {
        asm volatile("" : "+v"(fr), "+v"(fq));
        const int pnl = u.pn & 3;
        float gv[8], kv[8];
#pragma unroll
        for (int q = 0; q < 8; ++q) { const int rg_ = row_off + u.pm * BM + (q >> 2) * HALF + wr * 64 + (q & 3) * 16 + fr; gv[q] = rgate[rg_]; kv[q] = rkeep[rg_]; }
#pragma unroll
        for (int ai = 0; ai < 2; ++ai)
#pragma unroll
          for (int mh = 0; mh < 4; mh += 2) {
            u32x4 old4[2][2];
#pragma unroll
            for (int mm = 0; mm < 2; ++mm) { const int m = mh + mm; const int rowg = row_off + u.pm * BM + ai * HALF + wr * 64 + m * 16 + fr;
#pragma unroll
                for (int bj = 0; bj < 2; ++bj) { unsigned ob = ((unsigned)rowg * DM + (unsigned)(pnl * BM + bj * HALF + wc * 32 + 8 * fq)) * 2u; asm volatile("" : "+v"(ob));
                    old4[mm][bj] = *(const u32x4*)((const unsigned char*)xy + ob); } }
#pragma unroll
            for (int mm = 0; mm < 2; ++mm) { const int m = mh + mm; const int rowg = row_off + u.pm * BM + ai * HALF + wr * 64 + m * 16 + fr; const float w8 = gv[ai * 4 + m], kp = kv[ai * 4 + m];
#pragma unroll
                for (int bj = 0; bj < 2; ++bj) {
                    unsigned ob = ((unsigned)rowg * DM + (unsigned)(pnl * BM + bj * HALF + wc * 32 + 8 * fq)) * 2u; asm volatile("" : "+v"(ob));
                    unsigned char* dst = (unsigned char*)xy + ob;
                    const u32x4 rw = old4[mm][bj];
                    const f32x4 r0 = (f32x4){bflo(rw.x), bfhi(rw.x), bflo(rw.y), bfhi(rw.y)}, r1 = (f32x4){bflo(rw.z), bfhi(rw.z), bflo(rw.w), bfhi(rw.w)};
                    const f32x4 x0 = r0 * kp + acc[ai][bj][m][0] * w8, x1 = r1 * kp + acc[ai][bj][m][1] * w8;
                    u32x4 w; w.x = ::cvtpk(x0[0], x0[1]); w.y = ::cvtpk(x0[2], x0[3]); w.z = ::cvtpk(x1[0], x1[1]); w.w = ::cvtpk(x1[2], x1[3]);
                    *(u32x4*)dst = w; } }
          }
    }
};

struct GroupedOrder {
    static constexpr bool SLICED = false;
    StaticOrder so; const int* tile_e; int tile0, nN;
    __device__ __forceinline__ bool next(int i, Unit& u) const { if (!so.next(i, u)) return false; u.pn = __builtin_amdgcn_readfirstlane(tile_e[tile0 + u.pm]) * nN + u.pn; return true; }
    __device__ __forceinline__ void a_ready(const Unit&) const {}
    __device__ __forceinline__ void done(const Unit&) const {}
};

struct SliceOrder {
    static constexpr bool SLICED = true;
    const int* tile_e; int tile0  , xt0  , nunits, G, c;
    __device__ __forceinline__ bool next(int i, Unit& u) const { const int j = i * G + c; if (j >= nunits) return false;
        const int xt = j / (4 * MOE_NSL), rem = j - xt * (4 * MOE_NSL); u.pm = xt0 + xt; u.pn = __builtin_amdgcn_readfirstlane(tile_e[tile0 + u.pm]) * 4 + (rem & 3);
        u.ko = (rem >> 2) * 256; u.kt = (rem >> 2) == MOE_NSL - 1 ? 6 : 4; return true; }
    __device__ __forceinline__ void a_ready(const Unit&) const {}
    __device__ __forceinline__ void done(const Unit&) const {}
};
struct EpiMoePart {
    static constexpr bool PERM = true, AFTER_DRAIN = false, TWICE_OK = false;
    float* part; int xt0;
    __device__ __forceinline__ void operator()(const f32x4 (&acc)[2][2][4][2], const Unit& u, int wr, int wc, int fr, int fq) const {
        const int pnl = u.pn & 3, sl = u.ko >> 8;
#pragma unroll
        for (int ai = 0; ai < 2; ++ai)
#pragma unroll
            for (int m = 0; m < 4; ++m) { const int xr = (u.pm - xt0) * BM + ai * HALF + wr * 64 + m * 16 + fr;
                unsigned ob = (((unsigned)xr * MOE_NSL + (unsigned)sl) * DM + (unsigned)(pnl * BM + wc * 32 + 8 * fq)) * 4u; asm volatile("" : "+v"(ob));
                unsigned char* dst = (unsigned char*)part + ob;
#pragma unroll
                for (int bj = 0; bj < 2; ++bj) { *(f32x4*)(dst + bj * HALF * 4) = acc[ai][bj][m][0]; *(f32x4*)(dst + bj * HALF * 4 + 16) = acc[ai][bj][m][1]; } }
    }
};
typedef int i32x4_t __attribute__((ext_vector_type(4)));
typedef int i32x8_t __attribute__((ext_vector_type(8)));
__device__ __forceinline__ i32x8_t cat32(const bf16x8& lo, const bf16x8& hi) { const i32x4_t a = __builtin_bit_cast(i32x4_t, lo), b = __builtin_bit_cast(i32x4_t, hi); return __builtin_shufflevector(a, b, 0, 1, 2, 3, 4, 5, 6, 7); }
template <class Epi, class Sched, bool ALIGN_EPI = false, bool SP2 = false, bool FP8 = false>
__device__ __forceinline__ void gemm_phase(PG8_LAS unsigned char* lds, const Gemm g, const Sched& S, const Epi& E) {
    int tid_l_ = threadIdx.x; asm volatile("" : "+v"(tid_l_)); const int tid = tid_l_, wid = __builtin_amdgcn_readfirstlane(tid >> 6), lane = tid & 63, wr = wid >> 2, wc = wid & 3, fr = lane & 15, fq = lane >> 4;
    const int K = g.ld ? g.ld : g.K  , nt = g.K / BK;
    unsigned voffA[2], voffB[2];
#pragma unroll
    for (int i = 0; i < 2; ++i) { int R, C; stage_rc(tid * 16 + i * 8192, R, C); const int Rb = Epi::PERM ? ((R & ~31) + perm32(R & 31)) : R;
        voffA[i] = (unsigned)(R * K + C) * 2u; voffB[i] = (unsigned)(Rb * K + C) * 2u; }
    const size_t kstep = (size_t)(BK * 2);
    const size_t hstep = (size_t)HALF * K * 2;
    const size_t tstep = 2 * hstep;
    const unsigned ldsw = (unsigned)wid * 1024u;
    const int aoff = lds_byte(wr * 64 + fr, fq * 8), boff = lds_byte(wc * 32 + fr, fq * 8);
#define PG8_SA(b, h) (((b) * 2 + (h)) * HTB)
#define PG8_SB(b, h) ((4 + (b) * 2 + (h)) * HTB)
#define PG8_STAGE(bufoff, gbase, voff) do { _Pragma("unroll") for (int _i = 0; _i < 2; ++_i) { unsigned vo_ = FP8 ? (voff)[0] + (unsigned)_i * (unsigned)(64 * K * 2) : (voff)[_i];        \
        if constexpr (FP8) asm volatile("" : "+v"(vo_));        \
        __builtin_amdgcn_global_load_lds((const unsigned*)((const char*)(gbase) + vo_), (PG8_LAS unsigned*)(lds + (bufoff) + ldsw + _i * 8192), 16, 0, 0); } } while (0)
#define PG8_LDA(dst, b, h) do { _Pragma("unroll") for (int m = 0; m < 4; ++m) _Pragma("unroll") for (int k = 0; k < 2; ++k) dst[m][k] = *(const PG8_LAS bf16x8*)(lds + PG8_SA(b, h) + aoff + m * 2048 + k * 1024); } while (0)
#define PG8_LDB(dst, b, h) do { _Pragma("unroll") for (int n = 0; n < 2; ++n) _Pragma("unroll") for (int k = 0; k < 2; ++k) dst[n][k] = *(const PG8_LAS bf16x8*)(lds + PG8_SB(b, h) + boff + n * 2048 + k * 1024); } while (0)
#define PG8_MMA(ai, bj, At, Bt) do { __builtin_amdgcn_s_setprio(1); \
        if constexpr (FP8) { _Pragma("unroll") for (int m = 0; m < 4; ++m) _Pragma("unroll") for (int n = 0; n < 2; ++n) \
            acc[ai][bj][m][n] = __builtin_amdgcn_mfma_scale_f32_16x16x128_f8f6f4(cat32(Bt[n][0], Bt[n][1]), cat32(At[m][0], At[m][1]), acc[ai][bj][m][n], 0, 0, 0, 0, 0, 0); } \
        else { _Pragma("unroll") for (int m = 0; m < 4; ++m) _Pragma("unroll") for (int n = 0; n < 2; ++n) _Pragma("unroll") for (int k = 0; k < 2; ++k) \
            acc[ai][bj][m][n] = __builtin_amdgcn_mfma_f32_16x16x32_bf16(Bt[n][k], At[m][k], acc[ai][bj][m][n], 0, 0, 0); } \
        __builtin_amdgcn_s_setprio(0); } while (0)
#define PG8_WAIT_V(n) asm volatile("s_waitcnt vmcnt(" #n ")" ::: "memory")
#define PG8_WAIT_L(n) asm volatile("s_waitcnt lgkmcnt(" #n ")" ::: "memory")
#define PG8_BAR __builtin_amdgcn_s_barrier()
#define PG8_SCHED __builtin_amdgcn_sched_barrier(0)
    Unit cur, nxt; int ui = 0;
    if (!S.next(0, cur)) return;
    f32x4 acc[2][2][4][2];
#pragma unroll
    for (int a = 0; a < 2; ++a)
#pragma unroll
        for (int b = 0; b < 2; ++b)
#pragma unroll
            for (int m = 0; m < 4; ++m)
#pragma unroll
                for (int n = 0; n < 2; ++n) acc[a][b][m][n] = (f32x4){0.f, 0.f, 0.f, 0.f};
    bf16x8 At[4][2], B0[2][2], B1[2][2];
    const char* cA = (const char*)g.A + (size_t)cur.pm * tstep; const char* cB = (const char*)g.Bt + (size_t)cur.pn * tstep;
    if constexpr (Sched::SLICED) { cA += (size_t)cur.ko * 2; cB += (size_t)cur.ko * 2; }
    S.a_ready(cur);
    if constexpr (SP2) {
        PG8_STAGE(PG8_SB(0, 0), cB, voffB); PG8_STAGE(PG8_SB(0, 1), cB + hstep, voffB); PG8_STAGE(PG8_SA(0, 0), cA, voffA); PG8_STAGE(PG8_SA(0, 1), cA + hstep, voffA);
        if (wr == 1) PG8_BAR;
        PG8_WAIT_V(2); PG8_BAR;
        PG8_STAGE(PG8_SB(1, 0), cB + kstep, voffB); PG8_STAGE(PG8_SA(1, 0), cA + kstep, voffA); PG8_STAGE(PG8_SB(1, 1), cB + hstep + kstep, voffB);
        PG8_WAIT_V(6); PG8_BAR;
    } else {
        PG8_STAGE(PG8_SB(0, 0), cB, voffB); PG8_STAGE(PG8_SA(0, 0), cA, voffA); PG8_STAGE(PG8_SB(0, 1), cB + hstep, voffB); PG8_STAGE(PG8_SA(0, 1), cA + hstep, voffA);
        if (wr == 1) PG8_BAR;
        PG8_WAIT_V(4); PG8_BAR;
        PG8_STAGE(PG8_SB(1, 0), cB + kstep, voffB); PG8_STAGE(PG8_SA(1, 0), cA + kstep, voffA); PG8_STAGE(PG8_SB(1, 1), cB + hstep + kstep, voffB);
        PG8_WAIT_V(6); PG8_BAR;
    }
    for (;;) {
        const bool has_next = S.next(ui + 1, nxt);
        const char* nA = has_next ? (const char*)g.A + (size_t)nxt.pm * tstep + (Sched::SLICED ? (size_t)nxt.ko * 2 : (size_t)0) : cA; const char* nB = has_next ? (const char*)g.Bt + (size_t)nxt.pn * tstep + (Sched::SLICED ? (size_t)nxt.ko * 2 : (size_t)0) : cB;
        const int ntu = Sched::SLICED ? cur.kt : nt;
#pragma unroll 1
        for (int t = 0; t < ntu; t += 2) {
            const bool last = (t == ntu - 2);
            const char* a1 = cA + (size_t)(t + 1) * kstep;
            const char* a2 = last ? nA : cA + (size_t)(t + 2) * kstep; const char* b2 = last ? nB : cB + (size_t)(t + 2) * kstep;
            const char* a3 = a2 + kstep; const char* b3 = b2 + kstep;
            if (last && has_next) S.a_ready(nxt);
            if constexpr (SP2) {
            PG8_LDB(B0, 0, 0); PG8_LDB(B1, 0, 1); PG8_SCHED; PG8_LDA(At, 0, 0); PG8_STAGE(PG8_SA(1, 1), a1 + hstep, voffA);
            PG8_WAIT_V(8); PG8_WAIT_L(0); PG8_BAR; PG8_MMA(0, 0, At, B0); PG8_MMA(0, 1, At, B1); PG8_BAR; PG8_SCHED;
            PG8_LDA(At, 0, 1); PG8_STAGE(PG8_SB(0, 0), b2, voffB); PG8_STAGE(PG8_SB(0, 1), b2 + hstep, voffB); PG8_STAGE(PG8_SA(0, 0), a2, voffA);
            PG8_WAIT_V(8); PG8_WAIT_L(0); PG8_BAR; PG8_MMA(1, 0, At, B0); PG8_MMA(1, 1, At, B1); PG8_BAR; PG8_SCHED;
            PG8_LDB(B0, 1, 0); PG8_LDB(B1, 1, 1); PG8_SCHED; PG8_LDA(At, 1, 0); PG8_STAGE(PG8_SA(0, 1), a2 + hstep, voffA);
            PG8_WAIT_V(8); PG8_WAIT_L(0); PG8_BAR; PG8_MMA(0, 0, At, B0); PG8_MMA(0, 1, At, B1); PG8_BAR; PG8_SCHED;
            PG8_LDA(At, 1, 1); PG8_STAGE(PG8_SB(1, 0), b3, voffB); PG8_STAGE(PG8_SB(1, 1), b3 + hstep, voffB); PG8_STAGE(PG8_SA(1, 0), a3, voffA);
            PG8_WAIT_V(8); PG8_WAIT_L(0); PG8_BAR; PG8_MMA(1, 0, At, B0); PG8_MMA(1, 1, At, B1); PG8_BAR; PG8_SCHED;
            } else {
            PG8_LDB(B0, 0, 0); PG8_SCHED; PG8_LDA(At, 0, 0); PG8_STAGE(PG8_SA(1, 1), a1 + hstep, voffA);
            PG8_WAIT_L(8); PG8_BAR; PG8_WAIT_L(0); PG8_MMA(0, 0, At, B0); PG8_BAR; PG8_SCHED;
            PG8_LDB(B1, 0, 1); PG8_STAGE(PG8_SB(0, 0), b2, voffB);
            PG8_BAR; PG8_WAIT_L(0); PG8_MMA(0, 1, At, B1); PG8_BAR;
            PG8_LDA(At, 0, 1); PG8_STAGE(PG8_SA(0, 0), a2, voffA);
            PG8_BAR; PG8_WAIT_L(0); PG8_MMA(1, 0, At, B0); PG8_BAR; PG8_SCHED;
            PG8_STAGE(PG8_SB(0, 1), b2 + hstep, voffB);
            PG8_WAIT_V(6); PG8_BAR; PG8_MMA(1, 1, At, B1); PG8_BAR;
            PG8_LDB(B0, 1, 0); PG8_SCHED; PG8_LDA(At, 1, 0); PG8_STAGE(PG8_SA(0, 1), a2 + hstep, voffA);
            PG8_WAIT_L(8); PG8_BAR; PG8_WAIT_L(0); PG8_MMA(0, 0, At, B0); PG8_BAR; PG8_SCHED;
            PG8_LDB(B1, 1, 1); PG8_STAGE(PG8_SB(1, 0), b3, voffB);
            PG8_BAR; PG8_WAIT_L(0); PG8_MMA(0, 1, At, B1); PG8_BAR;
            PG8_LDA(At, 1, 1); PG8_STAGE(PG8_SA(1, 0), a3, voffA);
            PG8_BAR; PG8_WAIT_L(0); PG8_MMA(1, 0, At, B0); PG8_BAR; PG8_SCHED;
            PG8_STAGE(PG8_SB(1, 1), b3 + hstep, voffB);
            PG8_WAIT_V(6); PG8_BAR; PG8_MMA(1, 1, At, B1); PG8_BAR;
            }
        }
        if constexpr (ALIGN_EPI) { if (wr == 0) PG8_BAR; }
        if constexpr (!Epi::AFTER_DRAIN) { int te_ = threadIdx.x; asm volatile("" : "+v"(te_));
            E(acc, cur, wr, wc, te_ & 15, (te_ >> 4) & 3);
#ifdef EPI_TWICE
            if (Epi::TWICE_OK) { asm volatile("" ::: "memory"); E(acc, cur, wr, wc, fr, fq); }
#endif
            S.done(cur); }
        if (!has_next) break;
#pragma unroll
        for (int a = 0; a < 2; ++a)
#pragma unroll
            for (int b = 0; b < 2; ++b)
#pragma unroll
                for (int m = 0; m < 4; ++m)
#pragma unroll
                    for (int n = 0; n < 2; ++n) acc[a][b][m][n] = (f32x4){0.f, 0.f, 0.f, 0.f};
        cur = nxt; cA = nA; cB = nB; ++ui;
        if constexpr (ALIGN_EPI) { if (wr == 1) PG8_BAR; }
    }
    PG8_WAIT_V(0);
    if constexpr (!ALIGN_EPI) { if (wr == 0) PG8_BAR; }
    PG8_BAR;
    if constexpr (Epi::AFTER_DRAIN) { E.fused(acc, cur, wr, wc, fr, fq, lds, wid, lane); S.done(cur); }
#undef PG8_SA
#undef PG8_SB
#undef PG8_STAGE
#undef PG8_LDA
#undef PG8_LDB
#undef PG8_MMA
#undef PG8_WAIT_V
#undef PG8_WAIT_L
#undef PG8_BAR
#undef PG8_SCHED
}
}

#ifndef NSA_BR
#define NSA_BR 15
#endif
#ifndef ATT_ONLY
#define ATT_ONLY 3
#endif
namespace att {
constexpr int A_KV = 0, A_KB = 49152, A_WS = 49920, A_MASK = 51968, A_SHQ = 52480, A_IMP = 53248, A_OC = 119808, A_IVC = 152576;
DI constexpr int crc(int r) { return (r & 3) + 8 * (r >> 2); }
constexpr int IMP_LD = 65;
DI int crow(int r, int hi) { return (r & 3) + 8 * (r >> 2) + 4 * hi; }
#define MFMA32(a, b, c) __builtin_amdgcn_mfma_f32_32x32x16_bf16((a), (b), (c), 0, 0, 0)

struct KVRegs { u32x4 k, v; float kb; };
struct Sweep {
    const bf16_t* K; const bf16_t* V; int ld;
    const float* kbias;
};
DI void kv_issue(KVRegs& r, const Sweep& s, int tile, int tid) {
    const int key = tid & 63, ch = tid >> 6;
    const size_t row0 = (size_t)tile * 64;
    r.k = *(const u32x4*)(s.K + (row0 + key) * s.ld + ch * 8);
    const int p = tid >> 6, l = tid & 63; const int row = 16 * (p & 3) + (l >> 2), col = (p >> 2) * 32 + (l & 3) * 8;
    r.v = *(const u32x4*)(s.V + (row0 + row) * s.ld + col);
    r.kb = (s.kbias && tid < 64) ? s.kbias[row0 + tid] : 0.f;
}
DI void kv_commit(const KVRegs& r, LAS char* lds, int slot, int tid, bool has_kb) {
    LAS char* sl = lds + A_KV + slot * 16384;
    *(LAS u32x4*)(sl + (tid >> 6) * 1024 + (tid & 63) * 16) = r.k;
    *(LAS u32x4*)(sl + 8192 + tid * 16) = r.v;
    if (has_kb && tid < 64) *(LAS float*)(lds + A_KB + slot * 256 + tid * 4) = r.kb;
}
DI void glds16(const void* gsrc, unsigned lds_dst) { unsigned keep;
    asm volatile("s_mov_b32 %0, m0\n\ts_mov_b32 m0, %2\n\ts_nop 0\n\tglobal_load_lds_dwordx4 %1, off\n\ts_mov_b32 m0, %0" : "=&s"(keep) : "v"(gsrc), "s"(lds_dst) : "memory"); }
DI void glds4(const void* gsrc, unsigned lds_dst) { unsigned keep;
    asm volatile("s_mov_b32 %0, m0\n\ts_mov_b32 m0, %2\n\ts_nop 0\n\tglobal_load_lds_dword %1, off\n\ts_mov_b32 m0, %0" : "=&s"(keep) : "v"(gsrc), "s"(lds_dst) : "memory"); }
DI void kv_dma(const Sweep& s, int tile, LAS char* lds, int slot, int tid, int wid, bool has_kb) {
    const int l = tid & 63;
    const size_t row0 = (size_t)tile * 64;
    const bf16_t* ksrc = s.K + (row0 + l) * s.ld + wid * 8;
    const bf16_t* vsrc = s.V + (row0 + 16 * (wid & 3) + (l >> 2)) * s.ld + (wid >> 2) * 32 + (l & 3) * 8;
    const unsigned sl = (unsigned)__builtin_amdgcn_readfirstlane((int)(unsigned)(uintptr_t)(lds + A_KV + slot * 16384 + wid * 1024));
    glds16(ksrc, sl);
    glds16(vsrc, sl + 8192);
    if (has_kb) glds4(s.kbias + row0 + l, (unsigned)__builtin_amdgcn_readfirstlane((int)(unsigned)(uintptr_t)(lds + A_KB + slot * 256)));
}
struct FState { float m, l; f32x16 o0, o1, la, negm; };
DI float max3f(float a, float b, float c) { float r; asm("v_max3_f32 %0, %1, %2, %3" : "=v"(r) : "v"(a), "v"(b), "v"(c)); return r; }
DI void fs_init(FState& s) { s.m = 0.f; s.l = 0.f;

#pragma unroll
    for (int r = 0; r < 16; ++r) { s.o0[r] = 0.f; s.o1[r] = 0.f; s.la[r] = 0.f; s.negm[r] = 0.f; } }

DI void qk_tile(f32x16& p0, f32x16& p1, const f32x16& c0, const f32x16& c1, const LAS char* Ks, const bf16x8 (&qr)[4], int r32, int hi) {
    const LAS char* kb = Ks + hi * 1024 + r32 * 16;
    bf16x8 kf[8];
#pragma unroll
    for (int d0 = 0; d0 < 4; ++d0) { kf[2 * d0] = *(const LAS bf16x8*)(kb + d0 * 2048); kf[2 * d0 + 1] = *(const LAS bf16x8*)(kb + d0 * 2048 + 512); }
    __builtin_amdgcn_s_setprio(1);
#pragma unroll
    for (int d0 = 0; d0 < 4; ++d0) {
        if (d0 == 0) { p0 = MFMA32(kf[0], qr[0], c0); p1 = MFMA32(kf[1], qr[0], c1); }
        else { p0 = MFMA32(kf[2 * d0], qr[d0], p0); p1 = MFMA32(kf[2 * d0 + 1], qr[d0], p1); }
    }
    __builtin_amdgcn_s_setprio(0);
}
DI s16x4 vtr(const LAS char* p) { typedef short v4i16_t __attribute__((ext_vector_type(4))); return __builtin_bit_cast(s16x4, __builtin_amdgcn_ds_read_tr16_b64_v4i16((LAS v4i16_t*)p)); }

template <bool NOMAX, bool SUML> DI void softmax_pv(FState& s, f32x16& p0, f32x16& p1, const LAS char* Vs, LAS float* wsf, int lane, int r32, int hi) {
    if (!NOMAX) {
        asm volatile("s_nop 15\n\ts_nop 7" : "+v"(p0), "+v"(p1));
        float rm = max3f(p0[0], p0[1], p1[0]), rm2 = max3f(p0[2], p0[3], p1[1]);
        rm = max3f(rm, p1[2], p1[3]);
#pragma unroll
        for (int r = 4; r < 16; r += 4) { rm = max3f(rm, p0[r], p0[r + 1]); rm2 = max3f(rm2, p0[r + 2], p0[r + 3]); rm = max3f(rm, p1[r], p1[r + 1]); rm2 = max3f(rm2, p1[r + 2], p1[r + 3]); }
        rm = fmaxf(rm, rm2);
        rm = fmaxf(rm, __shfl_xor(rm, 32));
        if (__any(rm > 8.0f)) {
            const float dl = fmaxf(rm, 0.f);
            s.m += dl; const float alpha = __builtin_amdgcn_exp2f(-dl);
#pragma unroll
            for (int r = 0; r < 16; ++r) s.negm[r] = -s.m;
#pragma unroll
            for (int r = 0; r < 16; ++r) { p0[r] -= dl; p1[r] -= dl; }
            if (hi == 0) wsf[r32] = alpha;
#pragma unroll
            for (int r = 0; r < 16; ++r) { const float a = wsf[crow(r, hi)]; s.o0[r] *= a; s.o1[r] *= a; s.la[r] *= a; }
            if (SUML) s.l *= alpha;
        }
    }
#pragma unroll
    for (int r = 0; r < 16; ++r) { p0[r] = __builtin_amdgcn_exp2f(p0[r]); p1[r] = __builtin_amdgcn_exp2f(p1[r]); }
    if (SUML) { float sum = 0.f;
#pragma unroll
        for (int r = 0; r < 16; ++r) sum += p0[r] + p1[r];
        s.l += sum; }
    u32x4 pw[4];
    pw[0] = (u32x4){cvtpk(p0[0], p0[1]), cvtpk(p0[2], p0[3]), cvtpk(p0[4], p0[5]), cvtpk(p0[6], p0[7])};
    pw[1] = (u32x4){cvtpk(p0[8], p0[9]), cvtpk(p0[10], p0[11]), cvtpk(p0[12], p0[13]), cvtpk(p0[14], p0[15])};
    pw[2] = (u32x4){cvtpk(p1[0], p1[1]), cvtpk(p1[2], p1[3]), cvtpk(p1[4], p1[5]), cvtpk(p1[6], p1[7])};
    pw[3] = (u32x4){cvtpk(p1[8], p1[9]), cvtpk(p1[10], p1[11]), cvtpk(p1[12], p1[13]), cvtpk(p1[14], p1[15])};
    const bf16x8 ones = (bf16x8){0x3F80, 0x3F80, 0x3F80, 0x3F80, 0x3F80, 0x3F80, 0x3F80, 0x3F80};
    const LAS char* vp = Vs + ((lane >> 4) & 1) * 32 + (lane & 3) * 8 + (4 * hi + ((lane & 15) >> 2)) * 64;
#pragma unroll
    for (int ks = 0; ks < 4; ++ks) {
        const bf16x8 pa = __builtin_bit_cast(bf16x8, pw[ks]);
        { const s16x4 lo = vtr(vp + ks * 1024), hh = vtr(vp + ks * 1024 + 512); const bf16x8 vf = (bf16x8){lo[0], lo[1], lo[2], lo[3], hh[0], hh[1], hh[2], hh[3]}; s.o0 = MFMA32(pa, vf, s.o0); }
        { const s16x4 lo = vtr(vp + 4096 + ks * 1024), hh = vtr(vp + 4096 + ks * 1024 + 512); const bf16x8 vf = (bf16x8){lo[0], lo[1], lo[2], lo[3], hh[0], hh[1], hh[2], hh[3]}; s.o1 = MFMA32(pa, vf, s.o1); }
        s.la = MFMA32(pa, ones, s.la);
    }
}
template <int MODE> DI float fs_finish(const FState& s, const float (&gr)[16], LAS float* wsf, LAS char* stg_bf, LAS char* stg_f32, int r32, int hi) {
    LAS bf16_t* sb = (LAS bf16_t*)stg_bf; LAS float* sf = (LAS float*)stg_f32;
#pragma unroll
    for (int r = 0; r < 16; ++r) {
        const int orow = crow(r, hi); const float lt = s.la[r]; const float inv = lt > 0.f ? __builtin_amdgcn_rcpf(lt) : 0.f; const float f = inv * gr[r];
        float c0 = s.o0[r] * f, c1 = s.o1[r] * f;
        if (MODE == 1) { c0 += bf2f(sb[orow * 64 + r32]); c1 += bf2f(sb[orow * 64 + 32 + r32]); sf[orow * 64 + r32] = c0; sf[orow * 64 + 32 + r32] = c1; }
        else { if (MODE == 2) { c0 += sf[orow * 64 + r32]; c1 += sf[orow * 64 + 32 + r32]; }
            sb[orow * 64 + r32] = (bf16_t)(cvtpk(c0, 0.f) & 0xffffu); sb[orow * 64 + 32 + r32] = (bf16_t)(cvtpk(c1, 0.f) & 0xffffu); }
    }
    if (MODE == 0) { const float lt = s.l + __shfl_xor(s.l, 32); return lt > 0.f ? 1.0f / lt : 0.f; }
    return 0.f;
}
DI void store_o(bf16_t* Orow0  , int ldo, const LAS char* stg, int lane) {
#pragma unroll
    for (int i = 0; i < 4; ++i) { const int row = i * 8 + (lane >> 3), ch = lane & 7; const u32x4 v = *(const LAS u32x4*)(stg + row * 128 + ch * 16); *(u32x4*)(Orow0 + (size_t)row * ldo + ch * 8) = v; }
}

struct BrP { int cur; int tq; int tt; unsigned long long msk, anym; int jlo, jhi; int fox_lim, fox_lo; float m_c, inv_c; int head_l, tok_l; };
template <int BR> DI int next_tile(const BrP& b, int j) {
    ++j;
    if (BR == 1) { while (j <= b.jhi && !((b.anym >> j) & 1ull)) ++j; }
    return j <= b.jhi ? j : -1;
}
template <int BR, bool NOMAX> DI void sweep(FState& st, const Sweep& sw, const BrP& b, const bf16x8 (&qr)[4], LAS char* lds, LAS float* wsf, int tid, int lane, int r32, int hi, float& carry) {
    const int wid_ = __builtin_amdgcn_readfirstlane(tid >> 6);
#define ATT_WAIT_BAR(n) asm volatile("s_waitcnt vmcnt(" #n ") lgkmcnt(0)\n\ts_barrier" ::: "memory")
#define ATT_END_TILE(more) do { if (more) { if (BR == 3) ATT_WAIT_BAR(3); else ATT_WAIT_BAR(2); } else ATT_WAIT_BAR(0); } while (0)
    int j = next_tile<BR>(b, b.jlo - 1);
    if (j < 0) return;
    int jn = next_tile<BR>(b, j);
    kv_dma(sw, j, lds, 0, tid, wid_, BR == 3);
    if (jn >= 0) kv_dma(sw, jn, lds, 1, tid, wid_, BR == 3);
    ATT_END_TILE(jn >= 0);
    int slot = 0;
    while (j >= 0) {
        const int jn2 = jn >= 0 ? next_tile<BR>(b, jn) : -1;
        if (jn2 >= 0) kv_dma(sw, jn2, lds, slot >= 1 ? slot - 1 : 2, tid, wid_, BR == 3);
        const LAS char* Ks = lds + A_KV + slot * 16384; const LAS char* Vs = Ks + 8192;
        bool active = true;
        if (BR == 3) active = (j <= b.fox_lim) && (j >= b.fox_lo);
        if (active) {
            f32x16 p0, p1;
            const float NEG = -__builtin_inff();
            if (BR == 3) {
                f32x16 c0, c1;
                const LAS float* kb = (const LAS float*)(lds + A_KB + slot * 256);
#pragma unroll
                for (int i = 0; i < 4; ++i) { const f32x4 k0 = *(const LAS f32x4*)(kb + 8 * i + 4 * hi), k1 = *(const LAS f32x4*)(kb + 32 + 8 * i + 4 * hi);
#pragma unroll
                    for (int e = 0; e < 4; ++e) { c0[4 * i + e] = k0[e] + st.negm[4 * i + e]; c1[4 * i + e] = k1[e] + st.negm[4 * i + e]; } }
                qk_tile(p0, p1, c0, c1, Ks, qr, r32, hi);
            } else if (BR == 1) {
                f32x16 cs; const bool sel = (b.msk >> j) & 1ull;
#pragma unroll
                for (int r = 0; r < 16; ++r) cs[r] = sel ? (NOMAX ? 0.f : st.negm[r]) : NEG;
                qk_tile(p0, p1, cs, cs, Ks, qr, r32, hi);
            } else if (NOMAX) {
                f32x16 z;
#pragma unroll
                for (int r = 0; r < 16; ++r) z[r] = 0.f;
                qk_tile(p0, p1, z, z, Ks, qr, r32, hi);
            } else qk_tile(p0, p1, st.negm, st.negm, Ks, qr, r32, hi);
            int tth = b.tt - 4 * hi; asm volatile("" : "+v"(tth));
            if (BR == 0 || BR == 4) {
                int lim = ((b.tq - 31) >> 4) - 64 * j - 4 * hi; asm volatile("" : "+v"(lim));
#pragma unroll
                for (int r = 0; r < 16; ++r) { if (crc(r) > lim) p0[r] = NEG; if (crc(r) + 32 > lim) p1[r] = NEG; }
            } else if (BR == 1) {
                if (j == b.cur) {
#pragma unroll
                    for (int r = 0; r < 16; ++r) { if (crc(r) > tth) p0[r] = NEG; if (crc(r) + 32 > tth) p1[r] = NEG; }
                }
            } else if (BR == 2) {
                if (j == b.cur) {
#pragma unroll
                    for (int r = 0; r < 16; ++r) { if (crc(r) > tth) p0[r] = NEG; if (crc(r) + 32 > tth) p1[r] = NEG; }
                } else if (j == b.cur - 8) {
#pragma unroll
                    for (int r = 0; r < 16; ++r) { if (crc(r) <= tth) p0[r] = NEG; if (crc(r) + 32 <= tth) p1[r] = NEG; }
                }
            } else if (BR == 3) {
                if (j == b.fox_lim) {
#pragma unroll
                    for (int r = 0; r < 16; ++r) { if (crc(r) > tth) p0[r] = NEG; if (crc(r) + 32 > tth) p1[r] = NEG; }
                }
            }
            if (BR != 4) softmax_pv<NOMAX, BR == 0>(st, p0, p1, Vs, wsf, lane, r32, hi);
            if (BR == 4 || (BR == 0 && NOMAX)) {
                const float scl = (BR == 4) ? b.inv_c : 1.0f;
                float G[8], H[8];
#pragma unroll
                for (int i = 0; i < 4; ++i) {
                    float a[4], c[4];
#pragma unroll
                    for (int e = 0; e < 4; ++e) { a[e] = (BR == 4 ? __builtin_amdgcn_exp2f(p0[4 * i + e]) : p0[4 * i + e]) * scl; c[e] = (BR == 4 ? __builtin_amdgcn_exp2f(p1[4 * i + e]) : p1[4 * i + e]) * scl; }
                    H[i] = 0.5f * a[3]; G[i] = a[0] + a[1] + a[2] + H[i]; H[4 + i] = 0.5f * c[3]; G[4 + i] = c[0] + c[1] + c[2] + H[4 + i];
                }
                float Hp[8];
#pragma unroll
                for (int k = 0; k < 8; ++k) Hp[k] = __shfl_xor(H[k], 32);
                LAS float* imp = (LAS float*)(lds + A_IMP) + (b.head_l * 64 + b.tok_l) * IMP_LD + 16 * j;
#pragma unroll
                for (int k = 0; k < 8; ++k) {
                    const float prev = (hi == 1) ? Hp[k] : (k == 0 ? carry : Hp[k - 1]);
                    const int sidx = (k < 4) ? (2 * k + hi) : (8 + 2 * (k - 4) + hi);
                    imp[sidx] = G[k] + prev;
                }
                carry = Hp[7];
            }
        }
        ATT_END_TILE(jn2 >= 0);
        slot = slot == 2 ? 0 : slot + 1; j = jn; jn = jn2;
    }
#undef ATT_WAIT_BAR
#undef ATT_END_TILE
}

struct Tensors {
    const bf16_t* projA; const bf16_t* kcmp; const bf16_t* vcmp; const float* gate; const float* cumneg; bf16_t* O; const float* fqn; const float* fkn; const float* aqn; const float* akn;
};

template <bool NOMAX> DI void nsa_unit(const Tensors& T_, int b, int g, int qt, LAS char* lds, int brm = 15) {
    int tid_ = threadIdx.x; asm volatile("" : "+v"(tid_));
    const int tid = tid_, lane = tid & 63, r32 = lane & 31, hi = lane >> 5, wid = __builtin_amdgcn_readfirstlane(tid >> 6);
    LAS float* wsf = (LAS float*)(lds + A_WS) + wid * 64;
    const int head_l = wid >> 1, head = 4 * g + head_l, tok_l = 32 * (wid & 1) + r32;
    const int tq = 64 * qt + tok_l;
    const size_t rowq = (size_t)b * SEQ + tq;
    bf16x8 qr[4];
#pragma unroll
    for (int d0 = 0; d0 < 4; ++d0) qr[d0] = *(const bf16x8*)(T_.projA + rowq * LDA + PA_QA + head * 64 + d0 * 16 + hi * 8);
    LAS char* stg_bf = lds + A_OC + wid * 4096; LAS char* stg_f32 = lds + A_IMP + wid * 8192;
    const size_t rowbase = (size_t)b * SEQ + 64 * qt + 32 * (wid & 1);
    float gr[16];
    BrP bp; bp.cur = qt; bp.tq = tq; bp.tt = tok_l; bp.msk = 0; bp.anym = 0; bp.fox_lim = 0; bp.fox_lo = 0; bp.head_l = head_l; bp.tok_l = tok_l; bp.m_c = 0.f; bp.inv_c = 0.f;
    float carry = 0.f;
    {
        Sweep sw; sw.K = T_.kcmp + ((size_t)b * NCMP_PAD * 2 + g) * 64; sw.V = T_.vcmp + ((size_t)b * NCMP_PAD * 2 + g) * 64; sw.ld = 128; sw.kbias = nullptr;
        const int ntc = (4 * qt + 2) / 64 + 1;
        bp.jlo = 0; bp.jhi = ntc - 1;
        FState st; fs_init(st);
        LAS float* imp = (LAS float*)(lds + A_IMP) + (head_l * 64 + tok_l) * IMP_LD;
        for (int s2 = 16 * ntc + hi; s2 < 64; s2 += 2) imp[s2] = 0.f;
        carry = 0.f;
#pragma unroll
        for (int r = 0; r < 16; ++r) gr[r] = T_.gate[(rowbase + crow(r, hi)) * 24 + 3 * head + 0];
        if (brm & 1) sweep<0, NOMAX>(st, sw, bp, qr, lds, wsf, tid, lane, r32, hi, carry);
        bp.inv_c = fs_finish<0>(st, gr, wsf, stg_bf, stg_f32, r32, hi); bp.m_c = st.m;
        if (hi == 0) ((LAS float*)(lds + A_IVC))[head_l * 64 + tok_l] = NOMAX ? bp.inv_c : 1.0f;
        if (!NOMAX) { carry = 0.f; if (brm & 2) sweep<4, NOMAX>(st, sw, bp, qr, lds, wsf, tid, lane, r32, hi, carry); }
    }
    __syncthreads();
    {
        LAS float* imp = (LAS float*)(lds + A_IMP); const LAS float* ivc = (const LAS float*)(lds + A_IVC);
        const int tok = tid & 63, part = __builtin_amdgcn_readfirstlane(tid >> 6);
        float v[8];
#pragma unroll
        for (int k = 0; k < 8; ++k) { const int s2 = 8 * part + k;
            float x = ((imp[(0 * 64 + tok) * IMP_LD + s2] * ivc[tok] + imp[(1 * 64 + tok) * IMP_LD + s2] * ivc[64 + tok]) + imp[(2 * 64 + tok) * IMP_LD + s2] * ivc[128 + tok]) + imp[(3 * 64 + tok) * IMP_LD + s2] * ivc[192 + tok];
            if (s2 == 0 || s2 == qt || s2 == qt - 1) x = 1e6f; else if (s2 > qt) x = -1e6f;
            v[k] = x; }
        __syncthreads();
#pragma unroll
        for (int k = 0; k < 8; ++k) imp[tok * IMP_LD + 8 * part + k] = v[k];
        __syncthreads();
        int rank[8];
#pragma unroll
        for (int k = 0; k < 8; ++k) rank[k] = 0;
        const int lim = qt + 1, a1 = 8 * part < lim ? 8 * part : lim, b1 = 8 * part + 8 < lim ? 8 * part + 8 : lim;
        for (int s2 = 0; s2 < a1; ++s2) { const float x = imp[tok * IMP_LD + s2];
#pragma unroll
            for (int k = 0; k < 8; ++k) rank[k] += (x >= v[k]) ? 1 : 0; }
        for (int s2 = a1; s2 < b1; ++s2) { const float x = imp[tok * IMP_LD + s2];
#pragma unroll
            for (int k = 0; k < 8; ++k) rank[k] += (x > v[k] || (x == v[k] && s2 < 8 * part + k)) ? 1 : 0; }
        for (int s2 = b1; s2 < lim; ++s2) { const float x = imp[tok * IMP_LD + s2];
#pragma unroll
            for (int k = 0; k < 8; ++k) rank[k] += (x > v[k]) ? 1 : 0; }
        unsigned byte = 0;
#pragma unroll
        for (int k = 0; k < 8; ++k) byte |= (rank[k] < 16 ? 1u : 0u) << k;
        ((LAS unsigned char*)(lds + A_MASK))[tok * 8 + part] = (unsigned char)byte;
        __syncthreads();
        const LAS unsigned long long* mk = (const LAS unsigned long long*)(lds + A_MASK);
        bp.msk = mk[tok_l];
        unsigned long long am = mk[lane];
        unsigned lo = (unsigned)am, hh = (unsigned)(am >> 32);
#pragma unroll
        for (int o = 1; o < 64; o <<= 1) { lo |= (unsigned)__shfl_xor((int)lo, o); hh |= (unsigned)__shfl_xor((int)hh, o); }
        bp.anym = ((unsigned long long)(unsigned)__builtin_amdgcn_readfirstlane((int)hh) << 32) | (unsigned)__builtin_amdgcn_readfirstlane((int)lo);
    }
    {
        Sweep sw; sw.K = T_.projA + (size_t)b * SEQ * LDA + PA_KSL + g * 64; sw.V = T_.projA + (size_t)b * SEQ * LDA + PA_VSL + g * 64; sw.ld = LDA; sw.kbias = nullptr;
        bp.jlo = 0; bp.jhi = qt;
        FState st; fs_init(st);
#pragma unroll
        for (int r = 0; r < 16; ++r) gr[r] = T_.gate[(rowbase + crow(r, hi)) * 24 + 3 * head + 1];
        if (brm & 4) sweep<1, NOMAX>(st, sw, bp, qr, lds, wsf, tid, lane, r32, hi, carry);
        fs_finish<1>(st, gr, wsf, stg_bf, stg_f32, r32, hi);
    }
    {
        Sweep sw; sw.K = T_.projA + (size_t)b * SEQ * LDA + PA_KWN + g * 64; sw.V = T_.projA + (size_t)b * SEQ * LDA + PA_VWN + g * 64; sw.ld = LDA; sw.kbias = nullptr;
        bp.jlo = qt - 8 < 0 ? 0 : qt - 8; bp.jhi = qt;
        FState st; fs_init(st);
#pragma unroll
        for (int r = 0; r < 16; ++r) gr[r] = T_.gate[(rowbase + crow(r, hi)) * 24 + 3 * head + 2];
        if (brm & 8) sweep<2, NOMAX>(st, sw, bp, qr, lds, wsf, tid, lane, r32, hi, carry);
        fs_finish<2>(st, gr, wsf, stg_bf, stg_f32, r32, hi);
    }
    store_o(T_.O + rowbase * DM + head * 64, DM, stg_bf, lane);
    __syncthreads();
}

DI void fox_unit(const Tensors& T_, int b, int h, int qb, LAS char* lds) {
    int tid_ = threadIdx.x; asm volatile("" : "+v"(tid_));
    const int tid = tid_, lane = tid & 63, r32 = lane & 31, hi = lane >> 5, wid = __builtin_amdgcn_readfirstlane(tid >> 6);
    LAS float* wsf = (LAS float*)(lds + A_WS) + wid * 64;
    const int tq = 256 * qb + 32 * wid + r32;
    const size_t rowq = (size_t)b * SEQ + tq;
    bf16x8 qr[4];
#pragma unroll
    for (int d0 = 0; d0 < 4; ++d0) qr[d0] = *(const bf16x8*)(T_.projA + rowq * LDA + PA_QB + h * 64 + d0 * 16 + hi * 8);
    LAS char* stg_bf = lds + A_OC + wid * 4096;
    BrP bp; bp.cur = 0; bp.tq = tq; bp.tt = 32 * (wid & 1) + r32; bp.msk = 0; bp.anym = 0; bp.head_l = 0; bp.tok_l = 0; bp.m_c = 0.f; bp.inv_c = 0.f;
    bp.jlo = 0; bp.jhi = 4 * qb + 3; bp.fox_lim = 4 * qb + (wid >> 1);
    bool fnomax = false;
    {
        float gq = fabsf(T_.fqn[lane]), gk = fabsf(T_.fkn[lane]);
#pragma unroll
        for (int o = 1; o < 64; o <<= 1) { gq = fmaxf(gq, __shfl_xor(gq, o)); gk = fmaxf(gk, __shfl_xor(gk, o)); }
        const float need = 2.0f * 11.66f * gq * gk + 40.0f;
        fnomax = __builtin_amdgcn_readfirstlane((int)(11.66f * gq * gk < 50.0f)) != 0;
        const float* kbp = T_.cumneg + ((size_t)b * FOX_H + h) * SEQ;
        const float kb0 = kbp[256 * qb];
        const bool needed = (lane <= bp.jhi) && (kb0 - kbp[64 * lane + 63] <= need);
        const unsigned long long bal = __ballot(needed);
        bp.jlo = bal ? (int)__builtin_ctzll(bal) : 0;
        const bool needed_w = (lane <= bp.jhi) && (kbp[256 * qb + 32 * wid] - kbp[64 * lane + 63] <= need);
        const unsigned long long balw = __ballot(needed_w);
        bp.fox_lo = balw ? (int)__builtin_ctzll(balw) : 0;
    }
    Sweep sw; sw.K = T_.projA + (size_t)b * SEQ * LDA + PA_KB + h * 64; sw.V = T_.projA + (size_t)b * SEQ * LDA + PA_VB + h * 64; sw.ld = LDA;
    sw.kbias = T_.cumneg + ((size_t)b * FOX_H + h) * SEQ;
    FState st; fs_init(st);
    float carry = 0.f;
    if (fnomax) { const float nk = -sw.kbias[tq];
#pragma unroll
        for (int r = 0; r < 16; ++r) st.negm[r] = nk;
        sweep<3, true>(st, sw, bp, qr, lds, wsf, tid, lane, r32, hi, carry); }
    else sweep<3, false>(st, sw, bp, qr, lds, wsf, tid, lane, r32, hi, carry);
    float gr[16];
#pragma unroll
    for (int r = 0; r < 16; ++r) gr[r] = 1.f;
    fs_finish<3>(st, gr, wsf, stg_bf, stg_bf, r32, hi);
    const size_t rowbase = (size_t)b * SEQ + 256 * qb + 32 * wid;
    store_o(T_.O + rowbase * DM + 512 + h * 64, DM, stg_bf, lane);
    __syncthreads();
}

DI void attn_phase(const Tensors& T_, unsigned* ctr, LAS char* lds, int which = 3, int brm = 15) {
    LAS int* shq = (LAS int*)(lds + A_SHQ);
    bool nomax;
    { const int lane = threadIdx.x & 63; float gq = fabsf(T_.aqn[lane]), gk = fabsf(T_.akn[lane]);
#pragma unroll
      for (int o = 1; o < 64; o <<= 1) { gq = fmaxf(gq, __shfl_xor(gq, o)); gk = fmaxf(gk, __shfl_xor(gk, o)); }
      nomax = __builtin_amdgcn_readfirstlane((int)(11.66f * gq * gk < 50.0f)) != 0; }
    for (;;) {
        if (threadIdx.x == 0) shq[0] = (int)__hip_atomic_fetch_add(ctr, 1u, __ATOMIC_RELAXED, __HIP_MEMORY_SCOPE_AGENT);
        __syncthreads();
        const int i = __builtin_amdgcn_readfirstlane(shq[0]);
        __syncthreads();
        if (i >= 2048) break;
        if (i < 1024) { if (which & 2) { if (nomax) nsa_unit<true>(T_, (i & 15) >> 1, i & 1, 63 - (i >> 4), lds, brm); else nsa_unit<false>(T_, (i & 15) >> 1, i & 1, 63 - (i >> 4), lds, brm); } }
        else { const int r = i - 1024; if (which & 1) fox_unit(T_, (r & 63) >> 3, r & 7, 15 - (r >> 6), lds); }
    }
}
}

namespace gla {
constexpr int G_A1 = 0, G_QI = 4096, G_QR = 20480, G_KR = 36864, G_KH = 53248, G_V = 69632, G_BQ = 73728, G_ST = 77824, G_DEC = 94208;
DI int swo(int row, int colbyte) { return row * 256 + (colbyte ^ ((row & 15) << 4)); }
using att::crow; using att::vtr;

struct GlaT { bf16_t* projC; const float* a1; const float* w_a2; const float* b_a; bf16_t* O; bf16_t* att; float* dec; };

DI void gla_a1_item(const bf16_t* xb, const bf16_t* wa1t  , const float* ss2, float* a1, int item, LAS char* lds) {
    int tid_l_ = threadIdx.x; asm volatile("" : "+v"(tid_l_)); const int tid = tid_l_, lane = tid & 63, r32 = lane & 31, hi = lane >> 5, wid = __builtin_amdgcn_readfirstlane(tid >> 6);
    const int rg = wid & 3, kh = wid >> 2;
    const size_t row0 = (size_t)item * 128 + 32 * rg;
    const bf16_t* ap = xb + (row0 + r32) * DM + 512 * kh + 8 * hi;
    const bf16_t* bp = wa1t + (size_t)(r32 & 15) * DM + 512 * kh + 8 * hi;
    f32x16 c;
#pragma unroll
    for (int r = 0; r < 16; ++r) c[r] = 0.f;
#pragma unroll 8
    for (int ks = 0; ks < 32; ++ks) {
        const bf16x8 A = *(const bf16x8*)(ap + 16 * ks);
        bf16x8 B = *(const bf16x8*)(bp + 16 * ks);
        if (r32 >= 16) B = (bf16x8){0, 0, 0, 0, 0, 0, 0, 0};
        c = MFMA32(A, B, c);
    }
    LAS float* red = (LAS float*)lds + rg * 1024;
    if (kh == 1) {
#pragma unroll
        for (int r = 0; r < 16; ++r) red[crow(r, hi) * 32 + r32] = c[r];
    }
    __syncthreads();
    if (kh == 0 && r32 < 16) {
#pragma unroll
        for (int r = 0; r < 16; ++r) { const int rw = crow(r, hi); const size_t grow = row0 + rw;
            a1[grow * 16 + r32] = (c[r] + red[rw * 32 + r32]) * pg8::row_rstd(ss2, (int)grow); }
    }
    __syncthreads();
}

constexpr int P_A1 = 0, P_QR = 4096, P_KR = 20480, P_BQ = 36864;
struct PrepRegs { unsigned q[8], k[8]; f32x4 a1; };
DI void prep_load(PrepRegs& R, const GlaT& G, int item, int tid) {
    const int ch = item & 63, h = (item >> 6) & 3, b = item >> 8, d0 = 2 * (tid & 63), tg = tid >> 6;
    const size_t rb = (size_t)b * SEQ + 64 * ch;
#pragma unroll
    for (int c8 = 0; c8 < 8; ++c8) { const size_t rw = rb + 8 * tg + c8; R.q[c8] = *(const unsigned*)(G.projC + rw * LDC + PC_Q + h * 128 + d0); R.k[c8] = *(const unsigned*)(G.projC + rw * LDC + PC_K + h * 128 + d0); }
    R.a1 = (tid < 256) ? *(const f32x4*)(G.a1 + (rb + (tid >> 2)) * 16 + (tid & 3) * 4) : (f32x4){0.f, 0.f, 0.f, 0.f};
}
DI void gla_prep(const GlaT& G, int item, const PrepRegs& R, LAS char* lds) {
    int tid_l_ = threadIdx.x; asm volatile("" : "+v"(tid_l_)); const int tid = tid_l_, lane = tid & 63, r32 = lane & 31, hi = lane >> 5, wid = __builtin_amdgcn_readfirstlane(tid >> 6);
    const int ch = item & 63, h = (item >> 6) & 3, b = item >> 8;
    const int dp = tid & 63, tg = wid, d0 = 2 * dp;
    const size_t rb = (size_t)b * SEQ + 64 * ch;
    unsigned qraw[8], kraw[8];
#pragma unroll
    for (int c8 = 0; c8 < 8; ++c8) { qraw[c8] = R.q[c8]; kraw[c8] = R.k[c8]; }
    if (tid < 256) *(LAS f32x4*)(lds + P_A1 + tid * 16) = R.a1;
    float w2a[16], w2b[16];
#pragma unroll
    for (int r = 0; r < 16; ++r) { const f32x2 w = *(const f32x2*)(G.w_a2 + r * 512 + h * 128 + d0); w2a[r] = w[0]; w2b[r] = w[1]; }
    const f32x2 bav = *(const f32x2*)(G.b_a + h * 128 + d0);
    __syncthreads();
    float lp0[8], lp1[8]; float run0 = 0.f, run1 = 0.f;
#pragma unroll
    for (int c8 = 0; c8 < 8; ++c8) {
        const LAS f32x4* ar = (const LAS f32x4*)(lds + P_A1 + (8 * tg + c8) * 64);
        float z0 = bav[0], z1 = bav[1];
#pragma unroll
        for (int q4 = 0; q4 < 4; ++q4) { const f32x4 a = ar[q4];
#pragma unroll
            for (int e = 0; e < 4; ++e) { z0 += a[e] * w2a[4 * q4 + e]; z1 += a[e] * w2b[4 * q4 + e]; } }
        const float l0 = fminf(z0, 0.f) - __logf(1.0f + __expf(-fabsf(z0))), l1 = fminf(z1, 0.f) - __logf(1.0f + __expf(-fabsf(z1)));
        run0 += l0 * (1.0f / 16.0f); run1 += l1 * (1.0f / 16.0f);
        lp0[c8] = run0; lp1[c8] = run1;
    }
    *(LAS f32x2*)(lds + P_BQ + tg * 512 + d0 * 4) = (f32x2){run0, run1};
    __syncthreads();
    {
        float off0 = 0.f, off1 = 0.f, ref0 = 0.f, ref1 = 0.f, last0 = 0.f, last1 = 0.f;
#pragma unroll
        for (int t8 = 0; t8 < 8; ++t8) { const f32x2 q = *(const LAS f32x2*)(lds + P_BQ + t8 * 512 + d0 * 4);
            if (t8 < tg) { off0 += q[0]; off1 += q[1]; } if (t8 < 4) { ref0 += q[0]; ref1 += q[1]; } last0 += q[0]; last1 += q[1]; }
        const float emr0 = __expf(-ref0), emr1 = __expf(-ref1), epr0 = __expf(ref0), epr1 = __expf(ref1), epl0 = __expf(last0), epl1 = __expf(last1);
#pragma unroll
        for (int c8 = 0; c8 < 8; ++c8) {
            const int c = 8 * tg + c8;
            const float eb0 = __expf(off0 + lp0[c8]), eb1 = __expf(off1 + lp1[c8]);
            const float ib0 = __builtin_amdgcn_rcpf(eb0), ib1 = __builtin_amdgcn_rcpf(eb1);
            const float q0 = bflo(qraw[c8]), q1 = bfhi(qraw[c8]), k0 = bflo(kraw[c8]), k1 = bfhi(kraw[c8]);
            const float qi0 = q0 * eb0, qi1 = q1 * eb1, kb0 = k0 * ib0, kb1 = k1 * ib1;
            const int o = swo(c, 4 * dp);
            *(LAS unsigned*)(lds + P_QR + o) = cvtpk(qi0 * emr0, qi1 * emr1);
            *(LAS unsigned*)(lds + P_KR + o) = cvtpk(kb0 * epr0, kb1 * epr1);
            const size_t rw = rb + c;
            *(unsigned*)(G.projC + rw * LDC + PC_Q + h * 128 + d0) = cvtpk(qi0, qi1);
            *(unsigned*)(G.projC + rw * LDC + PC_K + h * 128 + d0) = cvtpk(kb0 * epl0, kb1 * epl1);
        }
        if (tg == 0) *(f32x2*)(G.dec + (size_t)item * 128 + d0) = (f32x2){epl0, epl1};
    }
    __syncthreads();
    if (wid < 3) {
        const int jt = wid == 2 ? 1 : 0, it = wid == 0 ? 0 : 1;
        f32x16 X;
#pragma unroll
        for (int r = 0; r < 16; ++r) X[r] = 0.f;
#pragma unroll
        for (int ks = 0; ks < 8; ++ks) {
            const bf16x8 A = *(const LAS bf16x8*)(lds + P_KR + swo(32 * jt + r32, (16 * ks + 8 * hi) * 2));
            const bf16x8 B = *(const LAS bf16x8*)(lds + P_QR + swo(32 * it + r32, (16 * ks + 8 * hi) * 2));
            X = MFMA32(A, B, X);
        }
        if (jt == it) {
#pragma unroll
            for (int r = 0; r < 16; ++r) if (att::crc(r) > r32 - 4 * hi) X[r] = 0.f;
        }
        bf16_t* ap = G.att + (size_t)item * 4096 + (32 * it + r32) * 64 + 32 * jt + 4 * hi;
#pragma unroll
        for (int g4 = 0; g4 < 4; ++g4) *(u32x2*)(ap + 8 * g4) = (u32x2){cvtpk(X[4 * g4], X[4 * g4 + 1]), cvtpk(X[4 * g4 + 2], X[4 * g4 + 3])};
    }
    __syncthreads();
}

constexpr int R_QI = 0, R_KH = 16384, R_ATT = 32768, R_V = 40960, R_DEC = 45056, R_BUF = 45568, R_ST = 2 * R_BUF;
DI void gla_unit(const GlaT& G, int b, int h, int es, LAS char* lds) {
    int tid_l_ = threadIdx.x; asm volatile("" : "+v"(tid_l_)); const int tid = tid_l_, lane = tid & 63, r32 = lane & 31, hi = lane >> 5, wid = __builtin_amdgcn_readfirstlane(tid >> 6);
    f32x16 S;
#pragma unroll
    for (int r = 0; r < 16; ++r) S[r] = 0.f;
    *(LAS u32x4*)(lds + R_ST + tid * 16) = (u32x4){0u, 0u, 0u, 0u};
    const size_t row00 = (size_t)b * SEQ;
    const int lrow = tid >> 3, lc = tid & 7;
    struct GlaRegs { u32x4 q0, q1, k0, k1, a, v; };
    GlaRegs RA, RB;
#define GLA_LOAD(R_, ch) do { const size_t rw_ = row00 + 64 * (ch) + lrow; const bf16_t* pq_ = G.projC + rw_ * LDC + h * 128 + lc * 8; \
        R_.q0 = *(const u32x4*)(pq_ + PC_Q); R_.q1 = *(const u32x4*)(pq_ + PC_Q + 64); R_.k0 = *(const u32x4*)(pq_ + PC_K); R_.k1 = *(const u32x4*)(pq_ + PC_K + 64); \
        R_.a = *(const u32x4*)(G.att + ((size_t)((b * 4 + h) * 64 + (ch))) * 4096 + tid * 8); \
        if (tid < 256) R_.v = *(const u32x4*)(G.projC + (row00 + 64 * (ch) + (tid >> 2)) * LDC + PC_V + h * 256 + 32 * es + (tid & 3) * 8); \
        else if (tid < 288) R_.v = *(const u32x4*)(G.dec + ((size_t)((b * 4 + h) * 64 + (ch))) * 128 + (tid - 256) * 4); } while (0)
#define GLA_COMMIT(R_, buf) do { LAS char* bb_ = lds + (buf) * R_BUF; \
        *(LAS u32x4*)(bb_ + R_QI + swo(lrow, lc * 16)) = R_.q0; *(LAS u32x4*)(bb_ + R_QI + swo(lrow, (lc + 8) * 16)) = R_.q1; \
        *(LAS u32x4*)(bb_ + R_KH + swo(lrow, lc * 16)) = R_.k0; *(LAS u32x4*)(bb_ + R_KH + swo(lrow, (lc + 8) * 16)) = R_.k1; \
        *(LAS u32x4*)(bb_ + R_ATT + lrow * 128 + ((lc ^ (lrow & 7)) * 16)) = R_.a; \
        if (tid < 256) *(LAS u32x4*)(bb_ + R_V + tid * 16) = R_.v; else if (tid < 288) *(LAS u32x4*)(bb_ + R_DEC + (tid - 256) * 16) = R_.v; } while (0)
    auto step = [&](const int ch, const int par) __attribute__((always_inline)) {
        const LAS char* bb = lds + par * R_BUF;
        const size_t rowc = row00 + 64 * ch;
        if (wid < 2) {
            const int it = wid;
            f32x16 oacc;
#pragma unroll
            for (int r = 0; r < 16; ++r) oacc[r] = 0.f;
#pragma unroll
            for (int s = 0; s < 4; ++s) {
                if (s < 2 || it == 1) {
                    const int i = 32 * it + r32;
                    const bf16x8 A = *(const LAS bf16x8*)(bb + R_ATT + i * 128 + (((2 * s + hi) ^ (i & 7)) * 16));
                    const LAS char* vb = bb + R_V + (16 * s + 8 * hi + ((lane & 15) >> 2)) * 64 + ((lane >> 4) & 1) * 32 + (lane & 3) * 8;
                    const s16x4 lo = vtr(vb), hh = vtr(vb + 256);
                    const bf16x8 vf = (bf16x8){lo[0], lo[1], lo[2], lo[3], hh[0], hh[1], hh[2], hh[3]};
                    oacc = MFMA32(A, vf, oacc);
                }
            }
#pragma unroll
            for (int ks = 0; ks < 8; ++ks) {
                const bf16x8 A = *(const LAS bf16x8*)(bb + R_QI + swo(32 * it + r32, (16 * ks + 8 * hi) * 2));
                const bf16x8 B = *(const LAS bf16x8*)(lds + R_ST + par * 8192 + swo(r32, (16 * ks + 8 * hi) * 2));
                oacc = MFMA32(A, B, oacc);
            }
            LAS bf16_t* stg = (LAS bf16_t*)(lds + R_ST + 16384) + it * 1024;
#pragma unroll
            for (int r = 0; r < 16; ++r) stg[crow(r, hi) * 32 + r32] = (bf16_t)(cvtpk(oacc[r], 0.f) & 0xffffu);
#pragma unroll
            for (int i = 0; i < 2; ++i) { const int pc = lane + 64 * i, row = pc >> 2, q4 = pc & 3; const u32x4 v = *(const LAS u32x4*)(stg + row * 32 + q4 * 8);
                *(u32x4*)(G.O + (rowc + 32 * it + row) * DM + h * 256 + 32 * es + q4 * 8) = v; }
        } else if (wid >= 4) {
            const int dt = wid - 4;
            const LAS float* dec = (const LAS float*)(bb + R_DEC) + 32 * dt;
#pragma unroll
            for (int i = 0; i < 4; ++i) { const f32x4 dv = *(const LAS f32x4*)(dec + 8 * i + 4 * hi);
#pragma unroll
                for (int e = 0; e < 4; ++e) S[4 * i + e] *= dv[e]; }
#pragma unroll
            for (int s = 0; s < 4; ++s) {
                const int cq = 16 * s + 4 * hi + ((lane & 15) >> 2), colb = (32 * dt + 16 * ((lane >> 4) & 1) + 4 * (lane & 3)) * 2;
                const s16x4 alo = vtr(bb + R_KH + swo(cq, colb)), ahh = vtr(bb + R_KH + swo(cq + 8, colb));
                const LAS char* vb = bb + R_V + cq * 64 + ((lane >> 4) & 1) * 32 + (lane & 3) * 8;
                const s16x4 lo = vtr(vb), hh = vtr(vb + 512);
                const bf16x8 af = (bf16x8){alo[0], alo[1], alo[2], alo[3], ahh[0], ahh[1], ahh[2], ahh[3]};
                const bf16x8 vf = (bf16x8){lo[0], lo[1], lo[2], lo[3], hh[0], hh[1], hh[2], hh[3]};
                S = MFMA32(af, vf, S);
            }
#pragma unroll
            for (int i = 0; i < 4; ++i)
                *(LAS u32x2*)(lds + R_ST + (par ^ 1) * 8192 + swo(r32, (32 * dt + 8 * i + 4 * hi) * 2)) = (u32x2){cvtpk(S[4 * i], S[4 * i + 1]), cvtpk(S[4 * i + 2], S[4 * i + 3])};
        }
    };
    GLA_LOAD(RA, 0); GLA_COMMIT(RA, 0); GLA_LOAD(RA, 1); GLA_LOAD(RB, 2);
    __syncthreads();
#pragma unroll 1
    for (int ch = 0; ch < 64; ch += 2) {
        step(ch, 0);
        GLA_COMMIT(RA, 1);
        { const int c3 = ch + 3 < 64 ? ch + 3 : 63; GLA_LOAD(RA, c3); }
        asm volatile("s_waitcnt lgkmcnt(0)" ::: "memory"); __builtin_amdgcn_s_barrier();
        step(ch + 1, 1);
        GLA_COMMIT(RB, 0);
        { const int c4 = ch + 4 < 64 ? ch + 4 : 63; GLA_LOAD(RB, c4); }
        asm volatile("s_waitcnt lgkmcnt(0)" ::: "memory"); __builtin_amdgcn_s_barrier();
    }
#undef GLA_LOAD
#undef GLA_COMMIT
}

DI void gla_gate_rows2(bf16_t* O, const bf16_t* R, const float* gain, int m0, int lane) {
    u32x4 o0[2], o1[2], r0[2], r1[2];
#pragma unroll
    for (int u = 0; u < 2; ++u) { const bf16_t* Orow = O + (size_t)(m0 + u) * DM; const bf16_t* Rrow = R + (size_t)(m0 + u) * LDC;
        o0[u] = *(const u32x4*)(Orow + lane * 16); o1[u] = *(const u32x4*)(Orow + lane * 16 + 8); r0[u] = *(const u32x4*)(Rrow + lane * 16); r1[u] = *(const u32x4*)(Rrow + lane * 16 + 8); }
    const int c0 = (lane & 15) * 16;
    float gn[16];
#pragma unroll
    for (int i = 0; i < 4; ++i) { const f32x4 g4 = *(const f32x4*)(gain + c0 + 4 * i); gn[4 * i] = g4[0]; gn[4 * i + 1] = g4[1]; gn[4 * i + 2] = g4[2]; gn[4 * i + 3] = g4[3]; }
#pragma unroll
    for (int u = 0; u < 2; ++u) {
        float o[16], rr[16];
#pragma unroll
        for (int i = 0; i < 4; ++i) { o[2 * i] = bflo(o0[u][i]); o[2 * i + 1] = bfhi(o0[u][i]); o[8 + 2 * i] = bflo(o1[u][i]); o[8 + 2 * i + 1] = bfhi(o1[u][i]);
            rr[2 * i] = bflo(r0[u][i]); rr[2 * i + 1] = bfhi(r0[u][i]); rr[8 + 2 * i] = bflo(r1[u][i]); rr[8 + 2 * i + 1] = bfhi(r1[u][i]); }
        float ss = 0.f;
#pragma unroll
        for (int i = 0; i < 16; ++i) ss += o[i] * o[i];
        ss += __shfl_xor(ss, 1); ss += __shfl_xor(ss, 2); ss += __shfl_xor(ss, 4); ss += __shfl_xor(ss, 8);
        const float rs = rsqrtf(ss * (1.0f / 256.0f) + EPS);
        unsigned w[8];
#pragma unroll
        for (int i = 0; i < 8; ++i) { const float x0 = o[2 * i] * rs * gn[2 * i] * siluf_(rr[2 * i]), x1 = o[2 * i + 1] * rs * gn[2 * i + 1] * siluf_(rr[2 * i + 1]); w[i] = cvtpk(x0, x1); }
        bf16_t* Orow = O + (size_t)(m0 + u) * DM;
        *(u32x4*)(Orow + lane * 16) = (u32x4){w[0], w[1], w[2], w[3]}; *(u32x4*)(Orow + lane * 16 + 8) = (u32x4){w[4], w[5], w[6], w[7]};
    }
}
}

struct Ptrs {
    const float* in[31]; float* out; unsigned char* ws;
    DI bf16_t* bf(size_t off) const { return (bf16_t*)(ws + off); }
    DI float* f32(size_t off) const { return (float*)(ws + off); }
    DI int* i32(size_t off) const { return (int*)(ws + off); }
};
enum { I_X = 0, I_ANORM, I_AWIN, I_AQN, I_AKN, I_APEK, I_APEV, I_CK1, I_CK2, I_CV1, I_CV2, I_GBIAS, I_FQN, I_FKN, I_FFB, I_AWOUT, I_FNORM, I_FWG, I_FWU, I_FWD,
       I_CNORM, I_CWIN, I_CWA2, I_CBA, I_CONORM, I_CWOUT, I_MNORM, I_MROUTER, I_MWG, I_MWU, I_MWD };

namespace pro {
struct ConvM { const float* src; const float* src2; const float* gain; bf16_t* dst; int K, Ns, Nd, mode; int f8; float wsc; };
DI int srccolA(int n) {
    const int pn = n >> 8, bj = (n >> 7) & 1, wc = (n >> 5) & 3, j = n & 31, s = 4 * pn + wc, d = 32 * bj + j;
    if (s < 8) return 64 * s + d;
    if (s < 10) return 768 + 64 * (s - 8) + d;
    if (s < 12) return 1024 + 64 * (s - 10) + d;
    if (s < 14) return 896 + 64 * (s - 12) + d;
    if (s < 16) return 1152 + 64 * (s - 14) + d;
    if (s < 18) return 512 + 64 * (s - 16) + d;
    if (s < 20) return 640 + 64 * (s - 18) + d;
    if (s < 28) return 1304 + 64 * (s - 20) + d;
    if (s < 36) return 1816 + 64 * (s - 28) + d;
    if (s < 44) return 2328 + 64 * (s - 36) + d;
    if (s == 44) { if (d < 24) return 1280 + d; if (d < 32) return 2840 + d - 24; }
    return -1;
}
DI void conv_item(const ConvM& M, int item, LAS float* scr, int lane) {
    const int nblk = M.Nd / 32, kb = item / nblk, nb = item % nblk, k0 = 64 * kb, n0 = 32 * nb;
    const int n = n0 + (lane & 31);
    const float* sp = M.src; int col = n;
    if (M.mode == 0) { if (n >= M.Ns) col = -1; }
    else if (M.mode == 1) col = srccolA(n);
    else { const int pn = n >> 8, half = (n >> 7) & 1, j = n & 127; sp = half ? M.src2 : M.src; col = 128 * pn + j; }
#pragma unroll 8
    for (int i = 0; i < 32; ++i) { const int kk = 2 * i + (lane >> 5); float w = 0.f; if (col >= 0) w = sp[(size_t)(k0 + kk) * M.Ns + col]; if (M.gain) w *= M.gain[k0 + kk]; scr[kk * 33 + (lane & 31)] = w; }
    const int c = lane & 7;
#pragma unroll
    for (int j = 0; j < 4; ++j) { const int nn = (lane >> 3) + 8 * j; const LAS float* s = scr + (8 * c) * 33 + nn;
        u32x4 o; o.x = cvtpk(s[0 * 33], s[1 * 33]); o.y = cvtpk(s[2 * 33], s[3 * 33]); o.z = cvtpk(s[4 * 33], s[5 * 33]); o.w = cvtpk(s[6 * 33], s[7 * 33]);
        *(u32x4*)(M.dst + (size_t)(n0 + nn) * M.K + k0 + 8 * c) = o; }
}
struct ConvRegs { f32x4 v[8]; };
DI void conv_big_load(ConvRegs& R, const ConvM& M, int item, int wid, int lane) {
    const int nblk = M.Nd / 256, kb = item / nblk, nb = item % nblk;
    const int k0 = 64 * kb + 8 * wid, n = 256 * nb + 4 * lane;
    const float* sp = M.src; int col = n;
    if (M.mode == 0) { if (n >= M.Ns) col = -1; }
    else if (M.mode == 1) col = srccolA(n);
    else { const int pn = n >> 8, half = (n >> 7) & 1, j = n & 127; sp = half ? M.src2 : M.src; col = 128 * pn + j; }
#pragma unroll
    for (int j = 0; j < 8; ++j) R.v[j] = (col >= 0) ? __builtin_nontemporal_load((const f32x4*)(sp + (size_t)(k0 + j) * M.Ns + col)) : (f32x4){0.f, 0.f, 0.f, 0.f};
}
DI void conv_big_store(ConvRegs& R, const ConvM& M, int item, LAS char* tile, int tid, int wid, int lane) {
    const int nblk = M.Nd / 256, kb = item / nblk, nb = item % nblk;
    if (M.gain) { const int k0 = 64 * kb + 8 * wid;
#pragma unroll
        for (int j = 0; j < 8; ++j) R.v[j] = R.v[j] * M.gain[k0 + j]; }
    if (M.f8) {
#pragma unroll
        for (int c = 0; c < 4; ++c) { unsigned w0 = 0, w1 = 0; const float sc = M.wsc;
            w0 = __builtin_amdgcn_cvt_pk_fp8_f32(::f8sat(R.v[0][c] * sc), ::f8sat(R.v[1][c] * sc), w0, false); w0 = __builtin_amdgcn_cvt_pk_fp8_f32(::f8sat(R.v[2][c] * sc), ::f8sat(R.v[3][c] * sc), w0, true);
            w1 = __builtin_amdgcn_cvt_pk_fp8_f32(::f8sat(R.v[4][c] * sc), ::f8sat(R.v[5][c] * sc), w1, false); w1 = __builtin_amdgcn_cvt_pk_fp8_f32(::f8sat(R.v[6][c] * sc), ::f8sat(R.v[7][c] * sc), w1, true);
            const int nl = 4 * lane + c; *(LAS u32x2*)(tile + nl * 64 + ((((wid >> 1) ^ (lane & 3)) << 1) | (wid & 1)) * 8) = (u32x2){w0, w1}; }
        __syncthreads();
#pragma unroll
        for (int i = 0; i < 2; ++i) { const int idx = tid + 512 * i, r = idx >> 2, ch = idx & 3; const u32x4 o = *(const LAS u32x4*)(tile + r * 64 + ((ch ^ ((r >> 2) & 3)) * 16));
            *(u32x4*)((unsigned char*)M.dst + (size_t)(256 * nb + r) * M.K + 64 * kb + 16 * ch) = o; }
        __syncthreads();
        return;
    }
#pragma unroll
    for (int c = 0; c < 4; ++c) { u32x4 o; o.x = cvtpk(R.v[0][c], R.v[1][c]); o.y = cvtpk(R.v[2][c], R.v[3][c]); o.z = cvtpk(R.v[4][c], R.v[5][c]); o.w = cvtpk(R.v[6][c], R.v[7][c]);
        const int nl = 4 * lane + c; *(LAS u32x4*)(tile + nl * 128 + ((wid ^ (lane & 7)) * 16)) = o; }
    __syncthreads();
#pragma unroll
    for (int i = 0; i < 4; ++i) { const int r = (tid >> 3) + 64 * i, ch = tid & 7; const u32x4 o = *(const LAS u32x4*)(tile + r * 128 + ((ch ^ ((r >> 2) & 7)) * 16));
        *(u32x4*)(M.dst + (size_t)(256 * nb + r) * M.K + 64 * kb + 8 * ch) = o; }
    __syncthreads();
}
DI ConvM conv_desc(const Ptrs& P, int mat) {
    ConvM M; M.src2 = nullptr; M.gain = nullptr; M.mode = 0; M.f8 = 0; M.wsc = 1.f;
    switch (mat) {
    case 0: M.src = P.in[I_AWIN]; M.gain = P.in[I_ANORM]; M.dst = P.bf(WS_WA); M.K = 1024; M.Ns = IN_A; M.Nd = NA_PAD; M.mode = 1; break;
    case 1: M.src = P.in[I_AWOUT]; M.dst = P.bf(WS_WO); M.K = 1024; M.Ns = 1024; M.Nd = 1024; break;
    case 2: M.src = P.in[I_FWG]; M.src2 = P.in[I_FWU]; M.gain = P.in[I_FNORM]; M.dst = P.bf(WS_WFGU); M.K = 1024; M.Ns = DFF; M.Nd = 2 * DFF; M.mode = 2; break;
    case 3: M.src = P.in[I_FWD]; M.dst = P.bf(WS_WFD); M.K = DFF; M.Ns = 1024; M.Nd = 1024; break;
    case 4: M.src = P.in[I_CWIN]; M.gain = P.in[I_CNORM]; M.dst = P.bf(WS_WC); M.K = 1024; M.Ns = IN_C; M.Nd = NC_PAD; break;
    case 5: M.src = P.in[I_CWOUT]; M.dst = P.bf(WS_WCO); M.K = 1024; M.Ns = 1024; M.Nd = 1024; break;
    case 6: M.src = P.in[I_CK1]; M.dst = P.bf(CT_CW); M.K = 2048; M.Ns = 64; M.Nd = 64; break;
    case 7: M.src = P.in[I_CV1]; M.dst = P.bf(CT_CW + 262144); M.K = 2048; M.Ns = 64; M.Nd = 64; break;
    case 8: M.src = P.in[I_CK2]; M.dst = P.bf(CT_CW + 524288); M.K = 64; M.Ns = 64; M.Nd = 64; break;
    case 9: M.src = P.in[I_CV2]; M.dst = P.bf(CT_CW + 524288 + 8192); M.K = 64; M.Ns = 64; M.Nd = 64; break;
    default:
        if (mat < 18) { const int e = mat - 10; M.src = P.in[I_MWG] + (size_t)e * 1024 * DFF; M.src2 = P.in[I_MWU] + (size_t)e * 1024 * DFF; M.gain = P.in[I_MNORM];
            M.dst = (bf16_t*)(P.ws + WS_WMGU + (size_t)e * 2 * DFF * 1024); M.K = 1024; M.Ns = DFF; M.Nd = 2 * DFF; M.mode = 2; M.f8 = 1; M.wsc = (float)(1 << MOE_WS_GU); }
        else { const int e = mat - 18; M.src = P.in[I_MWD] + (size_t)e * DFF * 1024; M.dst = (bf16_t*)(P.ws + WS_WMD + (size_t)e * 1024 * DFF); M.K = DFF; M.Ns = 1024; M.Nd = 1024; M.f8 = 1; M.wsc = (float)(1 << MOE_WS_D); }
    }
    return M;
}
DI int conv_items(int mat) {
    switch (mat) { case 0: return 16 * 12; case 1: return 16 * 4; case 2: return 16 * 22; case 3: return 44 * 4; case 4: return 16 * 13; case 5: return 16 * 4;
                   case 6: case 7: return 32 * 2; case 8: case 9: return 2; default: return mat < 18 ? 16 * 22 : 44 * 4; }
}
DI void prologue(const Ptrs& P, LAS char* lds) {
    int tid_l_ = threadIdx.x; asm volatile("" : "+v"(tid_l_)); const int tid = tid_l_, lane = tid & 63, wid = __builtin_amdgcn_readfirstlane(tid >> 6);
    const int gw = blockIdx.x * 8 + wid, NGW = gridDim.x * 8;
    LAS float* scr = (LAS float*)(lds + wid * 16384);
    {
        ConvRegs Ra, Rb; ConvM Ma, Mb; int ia = -1, ib = -1;
        int g = blockIdx.x, mat = 25, base = 0;
        auto advance = [&](ConvM& M, int& it) {
            it = -1;
            while (mat >= 0) {
                if (mat >= 6 && mat <= 9) { --mat; continue; }
                const int ni = conv_items(mat);
                if (g - base < ni) { M = conv_desc(P, mat); it = g - base; g += gridDim.x; return; }
                base += ni; --mat;
            }
        };
        advance(Ma, ia); if (ia >= 0) conv_big_load(Ra, Ma, ia, wid, lane);
        while (ia >= 0) {
            advance(Mb, ib); if (ib >= 0) conv_big_load(Rb, Mb, ib, wid, lane);
            conv_big_store(Ra, Ma, ia, lds + 65536 + 2048, tid, wid, lane);
            if (ib < 0) break;
            advance(Ma, ia); if (ia >= 0) conv_big_load(Ra, Ma, ia, wid, lane);
            conv_big_store(Rb, Mb, ib, lds + 65536 + 2048, tid, wid, lane);
        }
        if (gridDim.x == 256) {
            const int b = (int)blockIdx.x - 160, sidx = wid * 96 + b;
            if (b >= 0 && wid < 2 && sidx < 132) { const int m2 = sidx < 64 ? 6 : sidx < 128 ? 7 : sidx < 130 ? 8 : 9, it = sidx < 64 ? sidx : sidx < 128 ? sidx - 64 : sidx < 130 ? sidx - 128 : sidx - 130;
                const ConvM M = conv_desc(P, m2); conv_item(M, it, scr, lane); }
        } else
        for (int m2 = 6; m2 <= 9; ++m2) { const ConvM M = conv_desc(P, m2); const int ni = conv_items(m2); for (int it = gw; it < ni; it += NGW) conv_item(M, it, scr, lane); }
    }
    const float* x = P.in[I_X]; bf16_t* xb = P.bf(WS_XB); float* rstd0 = P.f32(CT_RSTD0);
    for (int m0 = gw * 2; m0 < T; m0 += NGW * 2) {
        f32x4 v[2][4];
#pragma unroll
        for (int u = 0; u < 2; ++u) { const f32x4* xr = (const f32x4*)(x + (size_t)(m0 + u) * DM) + lane;
#pragma unroll
            for (int j = 0; j < 4; ++j) v[u][j] = __builtin_nontemporal_load(xr + 64 * j); }
#pragma unroll
        for (int u = 0; u < 2; ++u) {
            float s = 0.f;
#pragma unroll
            for (int j = 0; j < 4; ++j) s += (v[u][j][0] * v[u][j][0] + v[u][j][1] * v[u][j][1]) + (v[u][j][2] * v[u][j][2] + v[u][j][3] * v[u][j][3]);
            s = wave_sum(s);
            if (lane == 0) rstd0[m0 + u] = rsqrtf(s * (1.0f / 1024.0f) + EPS);
            u32x2* o8 = (u32x2*)(xb + (size_t)(m0 + u) * DM) + lane;
#pragma unroll
            for (int j = 0; j < 4; ++j) o8[64 * j] = (u32x2){cvtpk(v[u][j][0], v[u][j][1]), cvtpk(v[u][j][2], v[u][j][3])};
        }
    }
    float* cosT = P.f32(CT_ROPE); float* sinT = cosT + SEQ * 8;
    for (int idx = blockIdx.x * 512 + tid; idx < SEQ * 8; idx += gridDim.x * 512) {
        const int pos = idx >> 3, i = idx & 7;
        const float inv = powf(500000.0f, -(float)(2 * i) / 16.0f);
        const float ang = (float)pos * inv;
        const double rev = (double)ang * 0.15915494309189535; const float fr = (float)(rev - floor(rev));
        cosT[idx] = __builtin_amdgcn_cosf(fr); sinT[idx] = __builtin_amdgcn_sinf(fr);
    }
}

DI void fox_cum(const Ptrs& P, int bh, int lane) {
    const f32x4* lf = (const f32x4*)(P.f32(CT_LOGF) + (size_t)bh * SEQ + 64 * lane); f32x4* dst = (f32x4*)(P.f32(CT_CUM) + (size_t)bh * SEQ + 64 * lane);
    f32x4 v[16]; float tot = 0.f;
#pragma unroll
    for (int i = 0; i < 16; ++i) { v[i] = lf[i]; }
#pragma unroll
    for (int i = 0; i < 16; ++i) { v[i][1] += v[i][0]; v[i][2] += v[i][1]; v[i][3] += v[i][2]; const float t = v[i][3]; v[i] = v[i] + tot; tot += t; }
    float inc = tot;
#pragma unroll
    for (int o = 1; o < 64; o <<= 1) { const float t = __shfl_up(inc, o); if (lane >= o) inc += t; }
    const float base = inc - tot;
#pragma unroll
    for (int i = 0; i < 16; ++i) dst[i] = (v[i] + base) * (-LOG2E);
}

DI void compress_item(const Ptrs& P, int item, LAS char* lds) {
    int tid_l_ = threadIdx.x; asm volatile("" : "+v"(tid_l_)); const int tid = tid_l_, lane = tid & 63, r32 = lane & 31, hi = lane >> 5, wid = __builtin_amdgcn_readfirstlane(tid >> 6);
    const int kv = item >> 7, b = (item >> 4) & 7, g = (item >> 3) & 1, nt = item & 7;
    const bf16_t* projA = P.bf(WS_BIG);
    const float* pe = (kv ? P.in[I_APEV] : P.in[I_APEK]);
    const bf16_t* w1t = P.bf(CT_CW + (kv ? 262144 : 0)); const bf16_t* w2t = P.bf(CT_CW + 524288 + (kv ? 8192 : 0));
    int n = 32 * nt + r32; if (n > 254) n = 254;
    f32x16 c0, c1;
#pragma unroll
    for (int r = 0; r < 16; ++r) { c0[r] = 0.f; c1[r] = 0.f; }
#pragma unroll 8
    for (int kk = 0; kk < 16; ++kk) { const int ks = 16 * wid + kk;
        const int l = ks >> 2, d = 16 * (ks & 3) + 8 * hi;
        const u32x4 raw = *(const u32x4*)(projA + ((size_t)b * SEQ + 16 * n + l) * LDA + (kv ? PA_VC : PA_KC) + g * 64 + d);
        const f32x4 p0 = *(const f32x4*)(pe + l * 64 + d), p1 = *(const f32x4*)(pe + l * 64 + d + 4);
        u32x4 aw; aw.x = cvtpk(bflo(raw.x) + p0[0], bfhi(raw.x) + p0[1]); aw.y = cvtpk(bflo(raw.y) + p0[2], bfhi(raw.y) + p0[3]);
        aw.z = cvtpk(bflo(raw.z) + p1[0], bfhi(raw.z) + p1[1]); aw.w = cvtpk(bflo(raw.w) + p1[2], bfhi(raw.w) + p1[3]);
        const bf16x8 A = __builtin_bit_cast(bf16x8, aw);
        const bf16x8 B0 = *(const bf16x8*)(w1t + (size_t)r32 * 2048 + 16 * ks + 8 * hi), B1 = *(const bf16x8*)(w1t + (size_t)(32 + r32) * 2048 + 16 * ks + 8 * hi);
        c0 = MFMA32(A, B0, c0); c1 = MFMA32(A, B1, c1);
    }
    LAS float* red = (LAS float*)lds + wid * 2048;
#pragma unroll
    for (int r = 0; r < 16; ++r) { const int nn = att::crow(r, hi); red[nn * 64 + r32] = c0[r]; red[nn * 64 + 32 + r32] = c1[r]; }
    __syncthreads();
    {
        LAS bf16_t* H1 = (LAS bf16_t*)(lds + 65536);
        const LAS float* rd = (const LAS float*)lds;
        float s4[4];
#pragma unroll
        for (int e = 0; e < 4; ++e) { float s = 0.f;
#pragma unroll
            for (int w = 0; w < 8; ++w) s += rd[w * 2048 + tid * 4 + e];
            s4[e] = gelu_tanh(s); }
        *(LAS u32x2*)(H1 + tid * 4) = (u32x2){cvtpk(s4[0], s4[1]), cvtpk(s4[2], s4[3])};
    }
    __syncthreads();
    if (wid == 0) {
        f32x16 o0, o1;
#pragma unroll
        for (int r = 0; r < 16; ++r) { o0[r] = 0.f; o1[r] = 0.f; }
#pragma unroll
        for (int ks = 0; ks < 4; ++ks) {
            const bf16x8 A = *(const LAS bf16x8*)(lds + 65536 + r32 * 128 + (16 * ks + 8 * hi) * 2);
            const bf16x8 B0 = *(const bf16x8*)(w2t + r32 * 64 + 16 * ks + 8 * hi), B1 = *(const bf16x8*)(w2t + (32 + r32) * 64 + 16 * ks + 8 * hi);
            o0 = MFMA32(A, B0, o0); o1 = MFMA32(A, B1, o1);
        }
        bf16_t* dst = P.bf(kv ? CT_VCMP : CT_KCMP);
        if (kv == 0) {
            const float* kn = P.in[I_AKN]; const float g0 = kn[r32], g1 = kn[32 + r32];
            const float* cosT = P.f32(CT_ROPE); const float* sinT = cosT + SEQ * 8;
#pragma unroll
            for (int r = 0; r < 16; ++r) {
                float ss = o0[r] * o0[r] + o1[r] * o1[r];
                ss += __shfl_xor(ss, 1); ss += __shfl_xor(ss, 2); ss += __shfl_xor(ss, 4); ss += __shfl_xor(ss, 8); ss += __shfl_xor(ss, 16);
                const float rs = rsqrtf(ss * (1.0f / 64.0f) + EPS);
                float y0 = o0[r] * rs * g0; const float y1 = o1[r] * rs * g1;
                const float oth = __shfl_xor(y0, 8);
                const int nn = 32 * nt + att::crow(r, hi); const int pos = (16 * nn + 31) & (SEQ - 1);
                const float cc = cosT[pos * 8 + (r32 & 7)], sn = sinT[pos * 8 + (r32 & 7)];
                if (r32 < 8) y0 = y0 * cc - oth * sn; else if (r32 < 16) y0 = oth * sn + y0 * cc;
                o0[r] = y0; o1[r] = y1;
            }
        }
#pragma unroll
        for (int r = 0; r < 16; ++r) {
            const int nn = 32 * nt + att::crow(r, hi);
            const bool pad = nn > 254;
            bf16_t* dp = dst + (((size_t)b * NCMP_PAD + nn) * 2 + g) * 64;
            dp[r32] = pad ? (bf16_t)0 : (bf16_t)(cvtpk(o0[r], 0.f) & 0xffffu); dp[32 + r32] = pad ? (bf16_t)0 : (bf16_t)(cvtpk(o1[r], 0.f) & 0xffffu);
        }
    }
    __syncthreads();
}
}

namespace moe {
DI void route_block(const Ptrs& P, int blk, LAS char* lds) {
    int tid_l_ = threadIdx.x; asm volatile("" : "+v"(tid_l_)); const int tid = tid_l_, lane = tid & 63, r32 = lane & 31, hi = lane >> 5, wid = __builtin_amdgcn_readfirstlane(tid >> 6);
    constexpr int RPITCH = 1032;
    LAS bf16_t* RBH = (LAS bf16_t*)lds; LAS bf16_t* RBL = RBH + 8 * RPITCH;
    LAS float* PART = (LAS float*)(lds + 36864); LAS float* LG = (LAS float*)(lds + 40960);
    LAS int* einfo = (LAS int*)(lds + 33280);
    const float* router = P.in[I_MROUTER]; const float* mg = P.in[I_MNORM];
    for (int i = tid; i < 8192; i += 512) { const int k = i >> 3, e = i & 7; const float v = router[i] * mg[k];
        const unsigned hb = cvtpk(v, 0.f) & 0xffffu; const float vh = __uint_as_float(hb << 16); const unsigned lb = cvtpk(v - vh, 0.f) & 0xffffu;
        RBH[e * RPITCH + k] = (bf16_t)hb; RBL[e * RPITCH + k] = (bf16_t)lb; }
    __syncthreads();
    const bf16_t* xb3 = P.bf(WS_HM);
    {
        const int rt = wid & 3, kh = wid >> 2;
        const bf16_t* ap = xb3 + ((size_t)blk * 128 + 32 * rt + r32) * DM + 512 * kh + 8 * hi;
        const LAS bf16_t* bh = RBH + (r32 & 7) * RPITCH + 512 * kh + 8 * hi; const LAS bf16_t* bl = RBL + (r32 & 7) * RPITCH + 512 * kh + 8 * hi;
        f32x16 c;
#pragma unroll
        for (int r = 0; r < 16; ++r) c[r] = 0.f;
#pragma unroll
        for (int ks = 0; ks < 32; ++ks) {
            const bf16x8 A = *(const bf16x8*)(ap + 16 * ks);
            c = MFMA32(A, *(const LAS bf16x8*)(bh + 16 * ks), c); c = MFMA32(A, *(const LAS bf16x8*)(bl + 16 * ks), c);
        }
        if (kh == 1 && r32 < 8) {
#pragma unroll
            for (int r = 0; r < 16; ++r) PART[(32 * rt + att::crow(r, hi)) * 8 + r32] = c[r];
        }
        __syncthreads();
        if (kh == 0 && r32 < 8) {
#pragma unroll
            for (int r = 0; r < 16; ++r) { const int tk = 32 * rt + att::crow(r, hi); LG[tk * 8 + r32] = c[r] + PART[tk * 8 + r32]; }
        }
        __syncthreads();
    }
    if (tid < 128) {
        const int tl = tid, t = blk * 128 + tl;
        const f32x4 la = *(const LAS f32x4*)(LG + tl * 8), lb = *(const LAS f32x4*)(LG + tl * 8 + 4);
        const float rs = pg8::row_rstd(P.f32(CT_SS3), t);
        const float acc[8] = {la[0], la[1], la[2], la[3], lb[0], lb[1], lb[2], lb[3]};
        int e1 = 0; float l1 = acc[0] * rs;
#pragma unroll
        for (int e = 1; e < 8; ++e) { const float l = acc[e] * rs; if (l > l1) { l1 = l; e1 = e; } }
        int e2 = -1; float l2 = -3.0e38f;
#pragma unroll
        for (int e = 0; e < 8; ++e) { const float l = acc[e] * rs; if (e != e1 && l > l2) { l2 = l; e2 = e; } }
        const float w1 = 1.0f / (1.0f + __expf(l2 - l1));
        einfo[tl * 2] = e1; einfo[tl * 2 + 1] = e2;
        P.f32(MO_TOKW)[(size_t)t * 2] = w1; P.f32(MO_TOKW)[(size_t)t * 2 + 1] = 1.0f - w1;
        P.f32(MO_TOKR)[t] = rs;
    }
    __syncthreads();
    LAS int* rk = (LAS int*)(lds + 34304);
    if (tid < 256) { const int e = einfo[tid]; int r = 0; for (int j = 0; j < tid; ++j) r += (einfo[j] == e) ? 1 : 0; rk[tid] = r; }
    if (tid >= 256 && tid < 264) { const int e = tid - 256; int c = 0; for (int j = 0; j < 256; ++j) c += (einfo[j] == e) ? 1 : 0; P.i32(MO_HIST)[blk * 8 + e] = c; }
    __syncthreads();
    if (tid < 128) { const int t = blk * 128 + tid; ((unsigned*)P.i32(MO_TOKE))[t] = (unsigned)einfo[2 * tid] | ((unsigned)einfo[2 * tid + 1] << 4) | ((unsigned)rk[2 * tid] << 8) | ((unsigned)rk[2 * tid + 1] << 20); }
    __syncthreads();
}
DI unsigned f8pack4(unsigned b01, unsigned b23) {
    unsigned w = 0; w = __builtin_amdgcn_cvt_pk_fp8_f32(::f8sat(bflo(b01)), ::f8sat(bfhi(b01)), w, false); w = __builtin_amdgcn_cvt_pk_fp8_f32(::f8sat(bflo(b23)), ::f8sat(bfhi(b23)), w, true); return w; }
DI void scatter_block(const Ptrs& P, int blk, LAS char* lds) {
    int tid_l_ = threadIdx.x; asm volatile("" : "+v"(tid_l_)); const int tid = tid_l_, lane = tid & 63, wid = __builtin_amdgcn_readfirstlane(tid >> 6);
    LAS int* sh = (LAS int*)lds;
    const int* hist = P.i32(MO_HIST);
    { typedef int i32x4 __attribute__((ext_vector_type(4))); *(LAS i32x4*)(sh + 64 + tid * 4) = *(const i32x4*)(hist + tid * 4); }
    __syncthreads();
    if (tid < 8) { int c = 0, pre = 0; for (int j = 0; j < 256; ++j) { const int v = sh[64 + j * 8 + tid]; c += v; if (j < blk) pre += v; } sh[tid] = c; sh[8 + tid] = pre; }
    __syncthreads();
    if (tid == 0) { int acc = 0; for (int e = 0; e < 8; ++e) { sh[16 + e] = acc; acc += ((sh[e] + 255) >> 8) << 8; } sh[24] = acc; }
    __syncthreads();
    const bf16_t* xb3 = P.bf(WS_HM); bf16_t* xy = P.bf(WS_XY);
    for (int q0 = wid * 32; q0 < wid * 32 + 32; q0 += 4) {
        u32x4 a[4], c[4]; int rowv[4];
#pragma unroll
        for (int u = 0; u < 4; ++u) {
            const int q = q0 + u, tl = q >> 1, slot = q & 1, t = blk * 128 + tl;
            const unsigned info = ((const unsigned*)P.i32(MO_TOKE))[t];
            const int e = slot ? (info >> 4) & 15 : info & 15, lr = slot ? (info >> 20) & 4095 : (info >> 8) & 4095;
            rowv[u] = sh[16 + e] + sh[8 + e] + lr;
            const u32x4* src = (const u32x4*)(xb3 + (size_t)t * DM) + lane;
            if ((u & 1) == 0) { a[u] = src[0]; c[u] = src[64]; } else { a[u] = a[u - 1]; c[u] = c[u - 1]; }
            if (lane == 0) { P.f32(MO_RSCALE)[rowv[u]] = P.f32(MO_TOKR)[t] * (1.0f / (float)(1 << MOE_WS_GU)); P.f32(MO_RGATE)[rowv[u]] = P.f32(MO_TOKW)[(size_t)t * 2 + slot] * (1.0f / (float)(1 << (MOE_HS + MOE_WS_D))); P.f32(MO_RKEEP)[rowv[u]] = slot ? 0.f : 1.f; P.i32(MO_POS)[(size_t)t * 2 + slot] = rowv[u];
                if (rowv[u] >= MOE_XROW0) P.i32(MO_ROWTOK)[rowv[u] - MOE_XROW0] = t; }
        }
#pragma unroll
        for (int u = 0; u < 4; ++u) { if ((u & 1) == 0) { u32x4* dst = (u32x4*)(xy + (size_t)rowv[u] * DM) + lane; dst[0] = a[u]; dst[64] = c[u]; }
            u32x2* d8 = (u32x2*)((unsigned char*)P.out + (size_t)rowv[u] * DM) + lane;
            const int us = u & ~1; const u32x2 pa = {f8pack4(a[us].x, a[us].y), f8pack4(a[us].z, a[us].w)}, pc = {f8pack4(c[us].x, c[us].y), f8pack4(c[us].z, c[us].w)};
            d8[0] = pa; d8[64] = pc; }
    }
    {
        const int e = blk & 7, r0 = sh[16 + e] + sh[e], r1 = sh[16 + e + 1];
        for (int row = r0 + (blk >> 3) * 8 + wid; row < r1; row += 256) { u32x2* o8 = (u32x2*)(xy + (size_t)row * DM) + lane;
#pragma unroll
            for (int j = 0; j < 4; ++j) o8[64 * j] = (u32x2){0u, 0u};
            { u32x2* z8 = (u32x2*)((unsigned char*)P.out + (size_t)row * DM) + lane; z8[0] = (u32x2){0u, 0u}; z8[64] = (u32x2){0u, 0u}; }
            if (lane == 0) { P.f32(MO_RSCALE)[row] = 0.f; P.f32(MO_RGATE)[row] = 0.f; P.f32(MO_RKEEP)[row] = 0.f; if (row >= MOE_XROW0) P.i32(MO_ROWTOK)[row - MOE_XROW0] = -1; } }
    }
    if (blk == 8) {
        int* te = P.i32(MO_TILEE); const int ntl = sh[24] >> 8;
        for (int tl = tid; tl < 271; tl += 512) { int e = 0; for (int k = 1; k < 8; ++k) if (tl * 256 >= sh[16 + k]) e = k; te[tl] = e; }
        if (tid == 0) te[271] = ntl;
    }
    __syncthreads();
}
DI f32x4 moe_row_piece(const Ptrs& P, int p, int lane, int j) {
    const u32x2 w = ((const u32x2*)(P.bf(WS_XY) + (size_t)p * DM) + lane)[64 * j];
    const f32x4 old = {bflo(w[0]), bfhi(w[0]), bflo(w[1]), bfhi(w[1])};
    if (p < MOE_XROW0) return old;
    const f32x4* pp = (const f32x4*)(P.f32(WS_PART) + (size_t)(p - MOE_XROW0) * MOE_NSL * DM) + 64 * j + lane;
    f32x4 s = pp[0];
#pragma unroll
    for (int k = 1; k < MOE_NSL; ++k) s += pp[k * (DM / 4)];
    return old * P.f32(MO_RKEEP)[p] + s * P.f32(MO_RGATE)[p];
}
DI void combine_tail_row(const Ptrs& P, int xr, int lane) {
    const int t = __builtin_amdgcn_readfirstlane(P.i32(MO_ROWTOK)[xr]);
    if (t < 0) return;
    const int p1 = __builtin_amdgcn_readfirstlane(P.i32(MO_POS)[(size_t)t * 2]), p2 = __builtin_amdgcn_readfirstlane(P.i32(MO_POS)[(size_t)t * 2 + 1]);
    if (p1 >= MOE_XROW0 && p2 >= MOE_XROW0 && (p1 < p2 ? p1 : p2) != MOE_XROW0 + xr) return;
    f32x4* orow = (f32x4*)(P.out + (size_t)t * DM) + lane;
#pragma unroll 2
    for (int j = 0; j < 4; ++j) orow[64 * j] = moe_row_piece(P, p1, lane, j) + moe_row_piece(P, p2, lane, j);
}
template <int NR> DI void combine_rows(const Ptrs& P, int t0, int lane) {
    const bf16_t* y = P.bf(WS_XY);
    int p1[NR], p2[NR];
#pragma unroll
    for (int u = 0; u < NR; ++u) { p1[u] = P.i32(MO_POS)[(size_t)(t0 + u) * 2]; p2[u] = P.i32(MO_POS)[(size_t)(t0 + u) * 2 + 1]; }
    { bool tail = false;
#pragma unroll
      for (int u = 0; u < NR; ++u) tail = tail || p1[u] >= MOE_XROW0 || p2[u] >= MOE_XROW0;
      if (tail) {
#pragma unroll 1
        for (int u = 0; u < NR; ++u) { if (p1[u] >= MOE_XROW0 || p2[u] >= MOE_XROW0) continue;
            f32x4* orow = (f32x4*)(P.out + (size_t)(t0 + u) * DM) + lane;
#pragma unroll 1
            for (int j = 0; j < 4; ++j) orow[64 * j] = moe_row_piece(P, p1[u], lane, j) + moe_row_piece(P, p2[u], lane, j); }
        return; } }
    u32x2 a[NR][4], c[NR][4];
#pragma unroll
    for (int u = 0; u < NR; ++u) {
        const u32x2* y1 = (const u32x2*)(y + (size_t)p1[u] * DM) + lane; const u32x2* y2 = (const u32x2*)(y + (size_t)p2[u] * DM) + lane;
#pragma unroll
        for (int j = 0; j < 4; ++j) { a[u][j] = y1[64 * j]; c[u][j] = y2[64 * j]; }
    }
#pragma unroll
    for (int u = 0; u < NR; ++u) {
        f32x4* orow = (f32x4*)(P.out + (size_t)(t0 + u) * DM) + lane;
#pragma unroll
        for (int j = 0; j < 4; ++j) { f32x4 w; w[0] = bflo(a[u][j][0]) + bflo(c[u][j][0]); w[1] = bfhi(a[u][j][0]) + bfhi(c[u][j][0]); w[2] = bflo(a[u][j][1]) + bflo(c[u][j][1]); w[3] = bfhi(a[u][j][1]) + bfhi(c[u][j][1]); orow[64 * j] = w; }
    }
}
}
#define XB_TMO      128
#define XB_XCNT(j)  (256  + 64 * (j))
#define XB_XSUB(j)  (1280 + 64 * (j))
#define XB_XGEN(j)  (2304 + 64 * (j))
#define XB_TOP      3328
#define XB_TOPGEN   3392
#define XCD_BAR_WORDS 3456
#define XB_SPIN_CAP (1u << 18)

__device__ __forceinline__ unsigned xb_ld(unsigned* p)              { return __hip_atomic_load(p, __ATOMIC_RELAXED, __HIP_MEMORY_SCOPE_AGENT); }
__device__ __forceinline__ unsigned xb_add(unsigned* p, unsigned v) { return __hip_atomic_fetch_add(p, v, __ATOMIC_RELAXED, __HIP_MEMORY_SCOPE_AGENT); }
__device__ __forceinline__ unsigned xb_xcc_id() { return (unsigned)__builtin_amdgcn_s_getreg((3 << 11) | 20) & 0xFu; }
#define XB_SPIN(cond, bar) do { unsigned _sp = 0; while (cond) { __builtin_amdgcn_s_sleep(1); \
    if ((++_sp & 255u) == 0u) { if (xb_ld(&(bar)[XB_TMO])) break; if (_sp > XB_SPIN_CAP) { atomicAdd(&(bar)[XB_TMO], 1u); break; } } } } while (0)

struct XcdBarrier {
    unsigned* bar; unsigned x;
    volatile LAS unsigned* st;
};

__device__ __forceinline__ XcdBarrier xcd_barrier_post(unsigned* bar, volatile LAS unsigned* st) {
    XcdBarrier b; b.bar = bar; b.x = xb_xcc_id(); b.st = st;
    if (threadIdx.x == 0) (void)xb_add(&bar[XB_XCNT(b.x)], 1u);
    return b;
}
__device__ __forceinline__ void xcd_barrier_complete(unsigned* bar, unsigned x, unsigned& nloc, unsigned& nx) {
    const unsigned G = gridDim.x * gridDim.y * gridDim.z;
    unsigned sum, cnt, mine, sp = 0u;
    for (;;) {
        sum = 0u; cnt = 0u; mine = 0u;
#pragma unroll
        for (unsigned j = 0; j < 16; ++j) { const unsigned c = xb_ld(&bar[XB_XCNT(j)]); sum += c; cnt += (c > 0u) ? 1u : 0u; mine = (j == x) ? c : mine; }
        if (sum == G) break;
        __builtin_amdgcn_s_sleep(1);
        if ((++sp & 255u) == 0u) { if (xb_ld(&bar[XB_TMO])) break; if (sp > XB_SPIN_CAP) { atomicAdd(&bar[XB_TMO], 1u); break; } }
    }
    nloc = mine > 0u ? mine : 1u; nx = cnt > 0u ? cnt : 1u;
}

__device__ __forceinline__ void xcd_barrier(const XcdBarrier& b) {
    asm volatile("s_waitcnt vmcnt(0)" ::: "memory");
    __syncthreads();
    if (threadIdx.x == 0) {
        unsigned* bar = b.bar;
        __builtin_amdgcn_s_waitcnt(0);
        unsigned nloc = b.st[0], nx = b.st[1];
        if (nloc == 0u) { xcd_barrier_complete(bar, b.x, nloc, nx); b.st[0] = nloc; b.st[1] = nx; }
        const unsigned old = xb_add(&bar[XB_XSUB(b.x)], 1u);
        const unsigned gen = old / nloc;
        if (old + 1u == (gen + 1u) * nloc) {
            __builtin_amdgcn_fence(__ATOMIC_RELEASE, "agent");
            asm volatile("s_waitcnt vmcnt(0)" ::: "memory");
            const unsigned og = xb_add(&bar[XB_TOP], 1u);
            const unsigned tg = og / nx;
            if (og + 1u == (tg + 1u) * nx) xb_add(&bar[XB_TOPGEN], 1u);
            else XB_SPIN(xb_ld(&bar[XB_TOPGEN]) == tg, bar);
            __builtin_amdgcn_fence(__ATOMIC_ACQUIRE, "agent");
            xb_add(&bar[XB_XGEN(b.x)], 1u);
            asm volatile("s_waitcnt vmcnt(0)" ::: "memory");
        } else {
            XB_SPIN(xb_ld(&bar[XB_XGEN(b.x)]) == gen, bar);
            __builtin_amdgcn_fence(__ATOMIC_ACQUIRE, "agent");
            asm volatile("s_waitcnt vmcnt(0)" ::: "memory");
        }
    }
    __syncthreads();
}

#ifndef MK_N_LAUNCHES
#define MK_N_LAUNCHES 1
#endif
constexpr int N_PHASES = 18;

DI Ptrs load_ptrs() {
    typedef const __attribute__((address_space(4))) Args* KArgs;
    KArgs ka = (KArgs)__builtin_amdgcn_kernarg_segment_ptr();
    asm volatile("" : "+s"(ka));
    Ptrs P;
#pragma unroll
    for (int i = 0; i < 31; ++i) P.in[i] = ka->in[i];
    P.out = ka->out; P.ws = ka->ws;
    return P;
}
__global__ void __launch_bounds__(512, 2) mega_fwd(Args args) {
    extern __shared__ __attribute__((aligned(16))) unsigned char lds_raw[];
    LAS char* lds = (LAS char*)lds_raw;
    cg::grid_group grid = cg::this_grid();
    Ptrs P;
#pragma unroll
    for (int i = 0; i < 31; ++i) P.in[i] = args.in[i];
    P.out = args.out; P.ws = args.ws;
    const int lo = args.ph_lo, hi_ = args.ph_hi;
    const int tid = threadIdx.x, lane = tid & 63, wid = __builtin_amdgcn_readfirstlane(tid >> 6);
    const int G = gridDim.x, gw = blockIdx.x * 8 + wid, NGW = G * 8;
#ifndef PH_MASK
#define PH_MASK 0xFFFFFFFFu
#endif
#define IN(k) (((PH_MASK >> (k)) & 1u) && lo <= (k) && (k) < hi_)
#ifndef REP_MASK
#define REP_MASK 0u
#endif
#define REPS(k) for (int rep_ = 0; rep_ < (((REP_MASK >> (k)) & 1u) ? 2 : 1); ++rep_, (rep_ < (((REP_MASK >> (k)) & 1u) ? 2 : 1) ? xcd_barrier(xbar) : (void)0))
    { volatile LAS unsigned* st0 = (volatile LAS unsigned*)(lds_raw + LDS_MISC); if (tid < 64) st0[tid] = 0u; }
    __syncthreads();
    XcdBarrier xbar; xbar.bar = (unsigned*)(args.ws + CT_BAR); xbar.x = 0; xbar.st = (volatile LAS unsigned*)(lds_raw + LDS_MISC) + 8;
    const bool one_launch = (lo == 0 && hi_ == N_PHASES);
    if (one_launch) { if (blockIdx.x == 0) { for (int i = tid; i < 1024; i += 512) ((unsigned*)(args.ws + CT_CTR))[i] = 0u; for (int i = tid; i < 4096; i += 512) ((unsigned*)(args.ws + CT_BAR))[i] = 0u; } }
    else xbar = xcd_barrier_post((unsigned*)(args.ws + CT_BAR), (volatile LAS unsigned*)(lds_raw + LDS_MISC) + 8);
#ifdef TIMEPROBE
#define TSTAMP(k) do { if (blockIdx.x == 0 && tid == 0) ((unsigned long long*)(args.ws + CT_CTR + 2048))[(k)] = __builtin_amdgcn_s_memrealtime(); } while (0)
#else
#define TSTAMP(k) do {} while (0)
#endif
#define SEAM(k) do { if (IN(k) && IN((k) + 1)) { if ((k) == 0) { grid.sync(); if (one_launch) xbar = xcd_barrier_post((unsigned*)(args.ws + CT_BAR), (volatile LAS unsigned*)(lds_raw + LDS_MISC) + 8); } else xcd_barrier(xbar); } TSTAMP((k) + 1); } while (0)
    LAS unsigned char* glds = (LAS unsigned char*)lds_raw;

    if (IN(0)) REPS(0) { const Ptrs P = load_ptrs(); int tid_p_ = threadIdx.x; asm volatile("" : "+v"(tid_p_)); const int tid = tid_p_;        pro::prologue(P, lds); }
    SEAM(0);
    if (IN(1)) REPS(1) { const Ptrs P = load_ptrs(); int tid_p_ = threadIdx.x; asm volatile("" : "+v"(tid_p_)); const int tid = tid_p_;
        pg8::Gemm g{P.bf(WS_XB), P.bf(WS_WA), T, NA_PAD, DM}; pg8::StaticOrder S; S.init(T, NA_PAD, G, (int)blockIdx.x);
        const float* cosT = P.f32(CT_ROPE);
        pg8::EpiInA E{P.bf(WS_BIG), P.f32(CT_RSTD0), cosT, cosT + SEQ * 8, P.in[I_AQN], P.in[I_AKN], P.in[I_FQN], P.in[I_FKN], P.in[I_GBIAS], P.in[I_FFB], P.f32(CT_GATE), P.f32(CT_LOGF)};
        pg8::gemm_phase<pg8::EpiInA, pg8::StaticOrder, true, true>(glds, g, S, E);
    }
    SEAM(1);
    if (IN(2)) REPS(2) { const Ptrs P = load_ptrs(); int tid_p_ = threadIdx.x; asm volatile("" : "+v"(tid_p_)); const int tid = tid_p_;
        if (gw < 64) pro::fox_cum(P, gw, tid & 63);
        for (int it = blockIdx.x; it < 256; it += G) pro::compress_item(P, it, lds);
    }
    SEAM(2);
    if (IN(3)) REPS(3) { const Ptrs P = load_ptrs(); int tid_p_ = threadIdx.x; asm volatile("" : "+v"(tid_p_)); const int tid = tid_p_;
        att::Tensors AT{P.bf(WS_BIG), P.bf(CT_KCMP), P.bf(CT_VCMP), P.f32(CT_GATE), P.f32(CT_CUM), P.bf(WS_O), P.in[I_FQN], P.in[I_FKN], P.in[I_AQN], P.in[I_AKN]};
        #ifndef ATT_REP_WHICH
#define ATT_REP_WHICH 3
#endif
#ifndef ATT_REP_BRM
#define ATT_REP_BRM 15
#endif
        att::attn_phase(AT, (unsigned*)(P.ws + CT_CTR) + 64 * rep_, lds, rep_ == 0 ? 3 : ATT_REP_WHICH, rep_ == 0 ? 15 : ATT_REP_BRM);
    }
    SEAM(3);
#ifdef SELFCHECK
    {
        float* errp = P.f32(CT_CTR) + 256;
        for (int sm = blockIdx.x; sm < 256; sm += G) {
            if (SELFCHECK == 1) chk::check_proj(P, sm, lds, errp);
            else if (SELFCHECK == 2) chk::check_cmp(P, sm, lds, errp);
            else chk::check_nsa(P, sm, lds, errp);
        }
        xcd_barrier(xbar);
    }
#endif
    if (IN(4)) REPS(4) { const Ptrs P = load_ptrs(); int tid_p_ = threadIdx.x; asm volatile("" : "+v"(tid_p_)); const int tid = tid_p_;
        pg8::Gemm g{P.bf(WS_O), P.bf(WS_WO), T, DM, DM}; pg8::StaticOrder S; S.init(T, DM, G, (int)blockIdx.x);
        pg8::EpiResid<false> E{P.bf(WS_XB), P.bf(WS_XB), P.f32(CT_SS1)};
        pg8::gemm_phase<pg8::EpiResid<false>, pg8::StaticOrder, true, true>(glds, g, S, E);
    }
    SEAM(4);
    if (IN(5)) REPS(5) { const Ptrs P = load_ptrs(); int tid_p_ = threadIdx.x; asm volatile("" : "+v"(tid_p_)); const int tid = tid_p_;
        pg8::Gemm g{P.bf(WS_XB), P.bf(WS_WFGU), T, 2 * DFF, DM}; pg8::StaticOrder S; S.init(T, 2 * DFF, G, (int)blockIdx.x);
        for (int blk = blockIdx.x; blk < 256; blk += G) if (tid < 128) { const int row = blk * 128 + tid; P.f32(CT_RSTD0)[row] = pg8::row_rstd(P.f32(CT_SS1), row); }
        xcd_barrier(xbar);
        pg8::EpiSwiglu<true> E{P.bf(WS_BIG), P.f32(CT_RSTD0), 0};
        pg8::gemm_phase<pg8::EpiSwiglu<true>, pg8::StaticOrder, true, true>(glds, g, S, E);
    }
    SEAM(5);
    if (IN(6)) { const Ptrs P = load_ptrs(); int tid_p_ = threadIdx.x; asm volatile("" : "+v"(tid_p_)); const int tid = tid_p_;
        pg8::Gemm g{P.bf(WS_BIG), P.bf(WS_WFD), T, DM, DFF}; pg8::StaticOrder S; S.init(T, DM, G, (int)blockIdx.x);
        pg8::EpiResid<false> E{P.bf(WS_XB), P.bf(WS_XB), P.f32(CT_SS2)};
        pg8::gemm_phase<pg8::EpiResid<false>, pg8::StaticOrder, true, true>(glds, g, S, E);
    }
    SEAM(6);
    if (IN(7)) REPS(7) { const Ptrs P = load_ptrs(); int tid_p_ = threadIdx.x; asm volatile("" : "+v"(tid_p_)); const int tid = tid_p_;
        for (int blk = blockIdx.x; blk < 256; blk += G) if (tid < 128) { const int row = blk * 128 + tid; P.f32(CT_RSTD0)[row] = pg8::row_rstd(P.f32(CT_SS2), row); }
        for (int it = blockIdx.x; it < T / 128; it += G) gla::gla_a1_item(P.bf(WS_XB), P.bf(WS_WC) + (size_t)LDC * DM, P.f32(CT_SS2), P.f32(CT_A1), it, lds);
        xcd_barrier(xbar);
        pg8::Gemm g{P.bf(WS_XB), P.bf(WS_WC), T, LDC, DM}; pg8::StaticOrder S; S.init(T, LDC, G, (int)blockIdx.x);
        pg8::EpiGlaIn E{P.bf(WS_BIG), P.f32(CT_RSTD0)};
        pg8::gemm_phase<pg8::EpiGlaIn, pg8::StaticOrder, true, true>(glds, g, S, E);
    }
    SEAM(7);
    if (IN(8)) REPS(8) { const Ptrs P = load_ptrs(); int tid_p_ = threadIdx.x; asm volatile("" : "+v"(tid_p_)); const int tid = tid_p_;
        gla::GlaT GT{P.bf(WS_BIG), P.f32(CT_A1), P.in[I_CWA2], P.in[I_CBA], P.bf(WS_O), P.bf(WS_ATT), P.f32(CT_GATE)};
        {
            gla::PrepRegs Ra, Rb; int it = blockIdx.x;
            if (it < 2048) gla::prep_load(Ra, GT, it, tid);
            while (it < 2048) {
                const int i1 = it + G; if (i1 < 2048) gla::prep_load(Rb, GT, i1, tid);
                gla::gla_prep(GT, it, Ra, lds);
                if (i1 >= 2048) break;
                const int i2 = i1 + G; if (i2 < 2048) gla::prep_load(Ra, GT, i2, tid);
                gla::gla_prep(GT, i1, Rb, lds);
                it = i2;
            }
        }
        xcd_barrier(xbar);
        for (int u = blockIdx.x; u < 256; u += G) { const int bh = (u & 7) * 4 + (u >> 6), es = (u >> 3) & 7; gla::gla_unit(GT, bh >> 2, bh & 3, es, lds); }
    }
    SEAM(8);
    if (IN(9)) { const Ptrs P = load_ptrs(); int tid_p_ = threadIdx.x; asm volatile("" : "+v"(tid_p_)); const int tid = tid_p_;
        for (int m = gw * 2; m < T; m += NGW * 2) gla::gla_gate_rows2(P.bf(WS_O), P.bf(WS_BIG) + PC_R, P.in[I_CONORM], m, tid & 63);
    }
    SEAM(9);
    if (IN(10)) { const Ptrs P = load_ptrs(); int tid_p_ = threadIdx.x; asm volatile("" : "+v"(tid_p_)); const int tid = tid_p_;
        pg8::Gemm g{P.bf(WS_O), P.bf(WS_WCO), T, DM, DM}; pg8::StaticOrder S; S.init(T, DM, G, (int)blockIdx.x);
        pg8::EpiResid<false> E{P.bf(WS_XB), P.bf(WS_HM), P.f32(CT_SS3)};
        pg8::gemm_phase<pg8::EpiResid<false>, pg8::StaticOrder, true, true>(glds, g, S, E);
    }
    SEAM(10);
    if (IN(11)) REPS(11) { const Ptrs P = load_ptrs(); int tid_p_ = threadIdx.x; asm volatile("" : "+v"(tid_p_)); const int tid = tid_p_;        for (int blk = blockIdx.x; blk < 256; blk += G) moe::route_block(P, blk, lds); }
    SEAM(11);
    if (IN(12)) REPS(12) { const Ptrs P = load_ptrs(); int tid_p_ = threadIdx.x; asm volatile("" : "+v"(tid_p_)); const int tid = tid_p_;        for (int blk = blockIdx.x; blk < 256; blk += G) moe::scatter_block(P, blk, lds); }
    SEAM(12);
    int npass_ = 1; asm volatile("" : "+s"(npass_));
#pragma unroll 1
    for (int pass = 0; pass < npass_; ++pass) {
        const int tile0 = pass * MOE_PASS_TILES;
        if (IN(13 + 2 * pass)) REPS(13 + 2 * pass) { const Ptrs P = load_ptrs(); int tid_p_ = threadIdx.x; asm volatile("" : "+v"(tid_p_)); const int tid = tid_p_;
            int ntp = __builtin_amdgcn_readfirstlane(P.i32(MO_TILEE)[271]) - tile0; { const int cap = MOE_TILES_MAX; ntp = ntp < 0 ? 0 : (ntp > cap ? cap : ntp); }
            if (ntp > 0) {
                pg8::Gemm g{(const bf16_t*)((const unsigned char*)P.out + (size_t)tile0 * 256 * DM), P.bf(WS_WMGU), ntp * 256, 2 * DFF, DM / 2};
                pg8::GroupedOrder S; S.so.init(ntp * 256, 2 * DFF, G, (int)blockIdx.x); S.tile_e = P.i32(MO_TILEE); S.tile0 = tile0; S.nN = 22;
                pg8::EpiSwiglu<true, true> E{P.bf(WS_HM), P.f32(MO_RSCALE), tile0 * 256};
                pg8::gemm_phase<pg8::EpiSwiglu<true, true>, pg8::GroupedOrder, true, true, true>(glds, g, S, E);
            }
        }
        SEAM(13 + 2 * pass);
        if (IN(14 + 2 * pass)) REPS(14 + 2 * pass) { const Ptrs P = load_ptrs(); int tid_p_ = threadIdx.x; asm volatile("" : "+v"(tid_p_)); const int tid = tid_p_;
            int ntp = __builtin_amdgcn_readfirstlane(P.i32(MO_TILEE)[271]) - tile0; { const int cap = MOE_TILES_MAX; ntp = ntp < 0 ? 0 : (ntp > cap ? cap : ntp); }
            const int ntm = ntp < MOE_PASS_TILES ? ntp : MOE_PASS_TILES, nx = ntp - ntm;
            if (ntm > 0) {
                pg8::Gemm g{P.bf(WS_HM), P.bf(WS_WMD), ntm * 256, DM, DFF / 2};
                pg8::GroupedOrder S; S.so.init(ntm * 256, DM, G, (int)blockIdx.x); S.tile_e = P.i32(MO_TILEE); S.tile0 = tile0; S.nN = 4;
                pg8::EpiMoeDown E{P.bf(WS_XY), P.f32(MO_RGATE), P.f32(MO_RKEEP), tile0 * 256};
                pg8::gemm_phase<pg8::EpiMoeDown, pg8::GroupedOrder, true, true, true>(glds, g, S, E);
            }
            if (nx > 0) {
                pg8::Gemm g{P.bf(WS_HM), P.bf(WS_WMD), ntp * 256, DM, 256, DFF / 2};
                pg8::SliceOrder S{P.i32(MO_TILEE), tile0, ntm, nx * 4 * MOE_NSL, G, (int)blockIdx.x};
                pg8::EpiMoePart E{P.f32(WS_PART), ntm};
                pg8::gemm_phase<pg8::EpiMoePart, pg8::SliceOrder, true, true, true>(glds, g, S, E);
            }
        }
        SEAM(14 + 2 * pass);
    }
    if (IN(17)) { const Ptrs P = load_ptrs(); int tid_p_ = threadIdx.x; asm volatile("" : "+v"(tid_p_)); const int tid = tid_p_;        int t17 = tid; asm volatile("" : "+v"(t17)); const int lane17 = t17 & 63;
        { const int nxr = (__builtin_amdgcn_readfirstlane(P.i32(MO_TILEE)[271]) - MOE_PASS_TILES) * 256;
          for (int xr = (int)blockIdx.x + G * wid; xr < nxr; xr += NGW) moe::combine_tail_row(P, xr, lane17); }
        for (int m = gw * 2; m < T; m += NGW * 2) moe::combine_rows<2>(P, m, lane17); }
#ifdef TIMEPROBE
    xcd_barrier(xbar);
    if (blockIdx.x == 0 && tid == 0) { const unsigned long long* ts = (const unsigned long long*)(args.ws + CT_CTR + 2048); P.out[0] += 1000.0f * (float)((ts[TIMEPROBE + 1] - ts[TIMEPROBE]) / (100ull * TQ)); }
#endif
#ifdef SELFCHECK
    xcd_barrier(xbar);
    if (blockIdx.x == 0 && tid == 0) { const float* errp = P.f32(CT_CTR) + 256;
#ifdef SC_MAG
        P.out[0] += 100.0f * errp[2];
#else
        P.out[0] += 1.0e4f * errp[0];
#endif
    }
#endif
#undef IN
#undef SEAM
}

extern "C" void kernel_launch(void* const* d_in, const int* in_sizes, int n_in, void* d_out, int out_size, void* d_ws, size_t ws_size, hipStream_t stream) {
    static int grid = 0;
    if (grid == 0) {
        if (n_in != 31 || out_size != T * DM || ws_size < WS_END) { fprintf(stderr, "kernel_launch: unexpected problem (n_in %d, out %d, ws %zu)\n", n_in, out_size, ws_size); grid = -1; return; }
        int dev = 0, cus = 0, per_cu = 0;
        hipGetDevice(&dev); hipDeviceGetAttribute(&cus, hipDeviceAttributeMultiprocessorCount, dev);
        if (hipFuncSetAttribute((const void*)mega_fwd, hipFuncAttributeMaxDynamicSharedMemorySize, LDS_BYTES) != hipSuccess) { fprintf(stderr, "kernel_launch: hipFuncSetAttribute failed\n"); grid = -1; return; }
        if (hipOccupancyMaxActiveBlocksPerMultiprocessor(&per_cu, (const void*)mega_fwd, 512, LDS_BYTES) != hipSuccess || per_cu < 1) { fprintf(stderr, "kernel_launch: occupancy query says %d\n", per_cu); per_cu = 1; }
        (void)hipGetLastError();
        grid = cus * 1;
        if (per_cu < 1) grid = -1;
    }
    if (grid < 0) return;
#if MK_N_LAUNCHES != 1
    hipMemsetAsync((char*)d_ws, 0, CT_ZERO_BYTES, stream);
#endif
    Args a{};
    for (int i = 0; i < 31; ++i) a.in[i] = (const float*)d_in[i];
    a.out = (float*)d_out; a.ws = (unsigned char*)d_ws;
#if MK_N_LAUNCHES == 1
    a.ph_lo = 0; a.ph_hi = N_PHASES;
    void* kargs[] = {&a};
    hipError_t e = hipLaunchCooperativeKernel((const void*)mega_fwd, dim3(grid), dim3(512), kargs, LDS_BYTES, stream);
    if (e != hipSuccess) fprintf(stderr, "cooperative launch failed: %s (grid %d)\n", hipGetErrorString(e), grid);
#else
    for (int ph = 0; ph < N_PHASES; ++ph) {
        a.ph_lo = ph; a.ph_hi = ph + 1;
        hipLaunchKernelGGL(mega_fwd, dim3(grid), dim3(512), LDS_BYTES, stream, a);
    }
#endif
}
```
